# Optimizing an MI355X kernel written in HIP

```python
import jax, jax.numpy as jnp
from jax import lax
import numpy as np

D_MODEL = 2048
BATCH = 8
SEQ = 2048
DEPTH = 2

GLA_HEADS = 4
GLA_KEY_W = D_MODEL // 4
GLA_VAL_W = D_MODEL // 2
GLA_DK = GLA_KEY_W // GLA_HEADS
GLA_DV = GLA_VAL_W // GLA_HEADS
GLA_GATE_RANK = 16
GLA_GATE_NORM = 16.0
GLA_CHUNK = 64
MOBA_HEAD_DIM = 128
MOBA_W = D_MODEL // 2
MOBA_HEADS = MOBA_W // MOBA_HEAD_DIM
MOBA_BLOCK = 256
MOBA_TOPK = 3
MOBA_QCHUNK = 16
D_FF = ((8 * D_MODEL // 3 + 255) // 256) * 256
N_BRANCH = 2
EPS = 1e-6
IN_SPLITS = (GLA_KEY_W, GLA_KEY_W, GLA_VAL_W, GLA_VAL_W, GLA_GATE_RANK, MOBA_W, MOBA_W, MOBA_W, N_BRANCH * D_MODEL)
IN_COLS = GLA_KEY_W * 2 + GLA_VAL_W * 2 + GLA_GATE_RANK + MOBA_W * 3 + N_BRANCH * D_MODEL

kernel_name = 'hybrid_gla_moba_adaln_block'


def rms_norm(x, g):
    x32 = x.astype(jnp.float32)
    y = x32 * lax.rsqrt(jnp.mean(x32 * x32, axis=-1, keepdims=True) + EPS)
    return (y * g.astype(jnp.float32)).astype(x.dtype)


def gla_chunk_step(state, inp):
    q, k, v, g = inp
    C = q.shape[2]
    b = jnp.cumsum(g, axis=2)
    causal = jnp.tril(jnp.ones((C, C), dtype=bool))
    diff = b[:, :, :, None, :] - b[:, :, None, :, :]
    decay = jnp.exp(jnp.where(causal[None, None, :, :, None], diff, -jnp.inf))
    attn = jnp.einsum('bhtsd,bhsd->bhts', q[:, :, :, None, :] * decay, k)
    o = (jnp.einsum('bhts,bhsv->bhtv', attn, v)
         + jnp.einsum('bhtd,bhdv->bhtv', q * jnp.exp(b), state))
    b_last = b[:, :, -1:, :]
    state = (jnp.exp(b_last[:, :, 0, :])[..., None] * state
             + jnp.einsum('bhsd,bhsv->bhdv', k * jnp.exp(b_last - b), v))
    return state, o


def gla_mixer(q, k, v, log_a):
    B, S = q.shape[0], q.shape[1]
    nc = S // GLA_CHUNK

    def to_chunks(t):
        t = t.astype(jnp.float32).reshape(B, nc, GLA_CHUNK, GLA_HEADS, t.shape[-1])
        return jnp.transpose(t, (1, 0, 3, 2, 4))

    q = q * (GLA_DK ** -0.5)
    state0 = jnp.zeros((B, GLA_HEADS, GLA_DK, GLA_DV), jnp.float32)
    _, o = lax.scan(gla_chunk_step, state0,
                    (to_chunks(q), to_chunks(k), to_chunks(v), to_chunks(log_a)))
    return jnp.transpose(o, (1, 0, 3, 2, 4)).reshape(B, S, GLA_HEADS, GLA_DV)


def moba_mixer(q, k, v):
    B, S = q.shape[0], q.shape[1]
    H, hd, BS, QC = MOBA_HEADS, MOBA_HEAD_DIM, MOBA_BLOCK, MOBA_QCHUNK
    nb = -(-S // BS)
    sp = nb * BS
    pad = ((0, 0), (0, sp - S), (0, 0), (0, 0))
    q = jnp.transpose(jnp.pad(q, pad), (0, 2, 1, 3)) * (hd ** -0.5)
    k = jnp.transpose(jnp.pad(k, pad), (0, 2, 1, 3))
    v = jnp.transpose(jnp.pad(v, pad), (0, 2, 1, 3))
    kb = k.reshape(B, H, nb, BS, hd)
    vb = v.reshape(B, H, nb, BS, hd)
    k_mean = jnp.mean(kb.astype(jnp.float32), axis=3)
    q_block = jnp.arange(sp) // BS
    past = jnp.arange(nb)[None, :] < q_block[:, None]
    blk_score = jnp.einsum('bhsd,bhnd->bhsn', q.astype(jnp.float32), k_mean)
    blk_score = jnp.where(past[None, None], blk_score, -jnp.inf)
    topk = min(MOBA_TOPK, nb)
    _, sel = lax.top_k(blk_score, topk)
    nq = sp // QC

    def chunks(t):
        return jnp.moveaxis(t.reshape(B, H, nq, QC, t.shape[-1]), 2, 0)

    bi = jnp.arange(B)[:, None, None, None]
    hi = jnp.arange(H)[None, :, None, None]

    def attend(args):
        qc, selc, ci = args
        own = (ci * QC) // BS
        k_sel = kb[bi, hi, selc]
        v_sel = vb[bi, hi, selc]
        k_own = lax.dynamic_index_in_dim(kb, own, axis=2, keepdims=False)
        v_own = lax.dynamic_index_in_dim(vb, own, axis=2, keepdims=False)
        s_sel = jnp.einsum('bhqd,bhqjtd->bhqjt', qc, k_sel).reshape(B, H, QC, topk * BS)
        s_own = jnp.einsum('bhqd,bhtd->bhqt', qc, k_own)
        sel_ok = jnp.repeat(selc < own, BS, axis=-1)
        q_pos = ci * QC + jnp.arange(QC)
        k_pos = own * BS + jnp.arange(BS)
        own_ok = k_pos[None, :] <= q_pos[:, None]
        scores = jnp.concatenate(
            [jnp.where(sel_ok, s_sel.astype(jnp.float32), -jnp.inf),
             jnp.where(own_ok[None, None], s_own.astype(jnp.float32), -jnp.inf)], axis=-1)
        p = jax.nn.softmax(scores, axis=-1).astype(v.dtype)
        p_sel = p[..., :topk * BS].reshape(B, H, QC, topk, BS)
        return (jnp.einsum('bhqjt,bhqjtd->bhqd', p_sel, v_sel)
                + jnp.einsum('bhqt,bhtd->bhqd', p[..., topk * BS:], v_own))

    o = lax.map(attend, (chunks(q), chunks(sel), jnp.arange(nq)))
    o = jnp.moveaxis(o, 0, 2).reshape(B, H, sp, hd)[:, :, :S]
    return jnp.transpose(o, (0, 2, 1, 3))


def setup_inputs(seed: int = 0) -> dict:
    key = jax.random.key(seed)
    ks = jax.random.split(key, 16)

    def w(k, shape, fan_in):
        return jax.random.normal(k, shape, jnp.float32) * (fan_in ** -0.5)

    def gain(k, shape):
        return 1.0 + 0.05 * jax.random.normal(k, shape, jnp.float32)

    return {
        'x': jax.random.normal(ks[0], (BATCH, SEQ, D_MODEL), jnp.float32),
        'c': jax.random.normal(ks[1], (BATCH, D_MODEL), jnp.float32),
        'ada_w': w(ks[2], (DEPTH, D_MODEL, 6 * D_MODEL), D_MODEL),
        'ada_b': 0.02 * jax.random.normal(ks[3], (DEPTH, 6 * D_MODEL), jnp.float32),
        'norm1_g': gain(ks[4], (DEPTH, D_MODEL)),
        'w_in': w(ks[5], (DEPTH, D_MODEL, IN_COLS), D_MODEL),
        'gla_gate_w2': w(ks[6], (DEPTH, GLA_GATE_RANK, GLA_KEY_W), GLA_GATE_RANK),
        'gla_gate_b': 0.02 * jax.random.normal(ks[7], (DEPTH, GLA_KEY_W), jnp.float32),
        'gla_norm_g': gain(ks[8], (DEPTH, GLA_DV)),
        'w_up_gla': w(ks[9], (DEPTH, GLA_VAL_W, D_MODEL), GLA_VAL_W),
        'w_up_moba': w(ks[10], (DEPTH, MOBA_W, D_MODEL), MOBA_W),
        'w_out': w(ks[11], (DEPTH, D_MODEL, D_MODEL), D_MODEL),
        'norm2_g': gain(ks[12], (DEPTH, D_MODEL)),
        'w_ffn_in': w(ks[13], (DEPTH, D_MODEL, 2 * D_FF), D_MODEL),
        'w_ffn_out': w(ks[14], (DEPTH, D_FF, D_MODEL), D_FF),
        'final_g': gain(ks[15], (D_MODEL,)),
    }


def reference(x, c, ada_w, ada_b, norm1_g, w_in, gla_gate_w2, gla_gate_b, gla_norm_g,
              w_up_gla, w_up_moba, w_out, norm2_g, w_ffn_in, w_ffn_out, final_g):
    B, S = x.shape[0], x.shape[1]
    split_pts = np.cumsum(np.array(IN_SPLITS))[:-1].tolist()
    c_act = jax.nn.silu(c)
    for l in range(DEPTH):
        mod = c_act @ ada_w[l] + ada_b[l]
        sh1, sc1, gt1, sh2, sc2, gt2 = jnp.split(mod, 6, axis=-1)
        h = rms_norm(x, norm1_g[l]) * (1.0 + sc1[:, None]) + sh1[:, None]
        proj = h @ w_in[l]
        gq, gk, gv, gr, glr, mq, mk, mv, gates = jnp.split(proj, split_pts, axis=-1)
        log_a = jax.nn.log_sigmoid((glr @ gla_gate_w2[l] + gla_gate_b[l]).astype(jnp.float32)) / GLA_GATE_NORM
        o_gla = gla_mixer(gq.reshape(B, S, GLA_HEADS, GLA_DK), gk.reshape(B, S, GLA_HEADS, GLA_DK),
                          gv.reshape(B, S, GLA_HEADS, GLA_DV), log_a.reshape(B, S, GLA_HEADS, GLA_DK))
        o_gla = rms_norm(o_gla.astype(x.dtype), gla_norm_g[l]).reshape(B, S, GLA_VAL_W) * jax.nn.silu(gr)
        y_gla = o_gla @ w_up_gla[l]
        o_moba = moba_mixer(mq.reshape(B, S, MOBA_HEADS, MOBA_HEAD_DIM), mk.reshape(B, S, MOBA_HEADS, MOBA_HEAD_DIM),
                            mv.reshape(B, S, MOBA_HEADS, MOBA_HEAD_DIM)).reshape(B, S, MOBA_W)
        y_moba = o_moba @ w_up_moba[l]
        g_gla, g_moba = jnp.split(jax.nn.sigmoid(gates), 2, axis=-1)
        x = x + gt1[:, None] * ((g_gla * y_gla + g_moba * y_moba) @ w_out[l])
        h = rms_norm(x, norm2_g[l]) * (1.0 + sc2[:, None]) + sh2[:, None]
        a, u = jnp.split(h @ w_ffn_in[l], 2, axis=-1)
        x = x + gt2[:, None] * ((jax.nn.silu(a) * u) @ w_ffn_out[l])
    return rms_norm(x, final_g)
```

```cpp
#include <hip/hip_runtime.h>
#include <cstdio>
#include <cstdint>

constexpr int NB = 8, SEQ = 2048, DM = 2048, MT = NB * SEQ, DEPTH = 2;
constexpr int GH = 4, GDK = 128, GDV = 256, GKW = 512, GVW = 1024, GRANK = 16, GCH = 64;
constexpr int MH = 8, MHD = 128, MW = 1024, MBLK = 256, MNB = SEQ / MBLK, MTOPK = 3;
constexpr int DFF = 5632, NFFI = 2 * DFF;
constexpr int NINSRC = 10256, NIN = 10240;
constexpr float EPS = 1e-6f;
constexpr int GQ_OFF = 0, GK_OFF = 512, GV_OFF = 1024, GR_OFF = 2048, MQ_OFF = 3072, MK_OFF = 4096, MV_OFF = 5120, GT_OFF = 6144;
constexpr int GLR_SRC = 3072;

constexpr size_t MiB = 1u << 20;
constexpr size_t WS_CTL = 0, CTL_ZERO_BYTES = 2 * MiB;
constexpr size_t WS_SSQ = 1 * MiB;
constexpr size_t WS_MODP = 2 * MiB;
constexpr size_t WS_MODV = 8 * MiB;
constexpr size_t WS_SHWIN = 9 * MiB;
constexpr size_t WS_SHWFFI = 10 * MiB;
constexpr size_t WS_SHWGLR = 11 * MiB;
constexpr size_t WS_GLR = 12 * MiB;
constexpr size_t WS_KMEAN = 13 * MiB;
constexpr size_t WS_SSQ0 = 14 * MiB;
constexpr size_t WS_WT = 16 * MiB, WT_LAYER = 123 * MiB;
constexpr size_t WT_IN = 0, WT_GLR = 40 * MiB, WT_UPG = 41 * MiB, WT_UPM = 45 * MiB, WT_OUT = 49 * MiB, WT_FFI = 57 * MiB, WT_FFO = 101 * MiB;
constexpr size_t WS_ABUF = 262 * MiB;
constexpr size_t WS_OGOM = 326 * MiB;
constexpr size_t WS_PROJ = 390 * MiB;
constexpr size_t WS_END = 710 * MiB;
constexpr size_t WS_DBG_G = 710 * MiB;
constexpr size_t WS_DBG_O = 742 * MiB;
constexpr size_t WS_DBG_END = 806 * MiB;

typedef unsigned short bf16;
typedef short bf16x8 __attribute__((ext_vector_type(8)));
typedef float f32x4 __attribute__((ext_vector_type(4)));
typedef unsigned u32x4 __attribute__((ext_vector_type(4)));
typedef unsigned u32x2 __attribute__((ext_vector_type(2)));

struct Params {
    const float* x; const float* c; const float* ada_w; const float* ada_b; const float* norm1_g; const float* w_in;
    const float* gate_w2; const float* gate_b; const float* gla_norm_g; const float* w_up_gla; const float* w_up_moba;
    const float* w_out; const float* norm2_g; const float* w_ffn_in; const float* w_ffn_out; const float* final_g;
    float* out; unsigned char* ws;
};

__device__ __forceinline__ unsigned f2bf(float f) { unsigned u = __builtin_bit_cast(unsigned, f); return (u + 0x7fffu + ((u >> 16) & 1u)) >> 16; }
__device__ __forceinline__ unsigned pk2(float lo, float hi) { return f2bf(lo) | (f2bf(hi) << 16); }
__device__ __forceinline__ float bf2f(unsigned short b) { return __builtin_bit_cast(float, ((unsigned)b) << 16); }
__device__ __forceinline__ float wave_sum(float v) {
#pragma unroll
    for (int o = 1; o < 64; o <<= 1) v += __shfl_xor(v, o);
    return v;
}
__device__ __forceinline__ float sigmoidf_(float v) { return 1.0f / (1.0f + __expf(-v)); }
__device__ __forceinline__ float siluf_(float v) { return v / (1.0f + __expf(-v)); }
__device__ __forceinline__ float logsigmoidf_(float v) { return fminf(v, 0.f) - log1pf(__expf(-fabsf(v))); }

__device__ __forceinline__ const bf16* wt_ptr(const Params& P, int l, size_t off) { return (const bf16*)(P.ws + WS_WT + (size_t)l * WT_LAYER + off); }
__device__ __forceinline__ int in_src_col(int n) { return n < 3072 ? n : n + 16; }
__device__ __forceinline__ int ffi_src_col(int r) { const int pn = r >> 8, c = r & 255; return c < 128 ? pn * 128 + c : DFF + pn * 128 + (c - 128); }

__device__ __forceinline__ void ada_item(const Params& P, int item, int lane, float* scr) {
    const int cg = item % 96, kc = (item / 96) % 8, l = item / 768;
    const int k0 = kc * 256;
    for (int i = 0; i < 32; ++i) { const int idx = lane + 64 * i, b = idx >> 8, kk = idx & 255; scr[idx] = siluf_(P.c[b * DM + k0 + kk]); }
    __builtin_amdgcn_s_waitcnt(0);
    const float* W = P.ada_w + (size_t)l * DM * (6 * DM) + (size_t)k0 * (6 * DM) + cg * 128 + 2 * lane;
    float a0[8], a1[8];
#pragma unroll
    for (int b = 0; b < 8; ++b) { a0[b] = 0.f; a1[b] = 0.f; }
#pragma unroll 8
    for (int kk = 0; kk < 256; ++kk) {
        const float2 w = *(const float2*)(W + (size_t)kk * (6 * DM));
#pragma unroll
        for (int b = 0; b < 8; ++b) { const float cv = scr[b * 256 + kk]; a0[b] += cv * w.x; a1[b] += cv * w.y; }
    }
    float* MP = (float*)(P.ws + WS_MODP) + ((size_t)(kc * 2 + l) * 8) * (6 * DM) + cg * 128 + 2 * lane;
#pragma unroll
    for (int b = 0; b < 8; ++b) *(float2*)(MP + (size_t)b * (6 * DM)) = make_float2(a0[b], a1[b]);
    __builtin_amdgcn_s_waitcnt(0);
}
__device__ __forceinline__ void transpose_item(const float* W, int Nsrc, int src_col0, int K, int k0, bf16* WT, int dst_row0, float* scr, int lane) {
    float v[32];
#pragma unroll
    for (int i = 0; i < 32; ++i) { const int kk = 2 * i + (lane >> 5); v[i] = W[(size_t)(k0 + kk) * Nsrc + src_col0 + (lane & 31)]; }
#pragma unroll
    for (int i = 0; i < 32; ++i) { const int kk = 2 * i + (lane >> 5); scr[kk * 33 + (lane & 31)] = v[i]; }
    __builtin_amdgcn_s_waitcnt(0);
    const int c = lane & 7;
#pragma unroll
    for (int j = 0; j < 4; ++j) { const int n = (lane >> 3) + 8 * j; const float* s = scr + (8 * c) * 33 + n;
        u32x4 o; o.x = pk2(s[0 * 33], s[1 * 33]); o.y = pk2(s[2 * 33], s[3 * 33]); o.z = pk2(s[4 * 33], s[5 * 33]); o.w = pk2(s[6 * 33], s[7 * 33]);
        *(u32x4*)(WT + (size_t)(dst_row0 + n) * K + k0 + 8 * c) = o; }
    __builtin_amdgcn_s_waitcnt(0);
}
constexpr int TI_IN = (DM / 64) * (NIN / 32), TI_UP = (GVW / 64) * (DM / 32), TI_OUT = (DM / 64) * (DM / 32), TI_FFI = (DM / 64) * (NFFI / 32), TI_FFO = (DFF / 64) * (DM / 32), TI_GLR = DM / 64;
constexpr int TI_LAYER = TI_IN + 2 * TI_UP + TI_OUT + TI_FFI + TI_FFO + TI_GLR;
__device__ __forceinline__ void wconv_item(const Params& P, int item, int lane, float* scr) {
    const int l = item / TI_LAYER; int r = item % TI_LAYER;
    unsigned char* wl = P.ws + WS_WT + (size_t)l * WT_LAYER;
    if (r < TI_IN) { const int nb = r % (NIN / 32), kb = r / (NIN / 32);
        transpose_item(P.w_in + (size_t)l * DM * NINSRC, NINSRC, in_src_col(nb * 32), DM, kb * 64, (bf16*)(wl + WT_IN), nb * 32, scr, lane); return; } r -= TI_IN;
    if (r < TI_UP) { const int nb = r % (DM / 32), kb = r / (DM / 32);
        transpose_item(P.w_up_gla + (size_t)l * GVW * DM, DM, nb * 32, GVW, kb * 64, (bf16*)(wl + WT_UPG), nb * 32, scr, lane); return; } r -= TI_UP;
    if (r < TI_UP) { const int nb = r % (DM / 32), kb = r / (DM / 32);
        transpose_item(P.w_up_moba + (size_t)l * MW * DM, DM, nb * 32, MW, kb * 64, (bf16*)(wl + WT_UPM), nb * 32, scr, lane); return; } r -= TI_UP;
    if (r < TI_OUT) { const int nb = r % (DM / 32), kb = r / (DM / 32);
        transpose_item(P.w_out + (size_t)l * DM * DM, DM, nb * 32, DM, kb * 64, (bf16*)(wl + WT_OUT), nb * 32, scr, lane); return; } r -= TI_OUT;
    if (r < TI_FFI) { const int nb = r % (NFFI / 32), kb = r / (NFFI / 32);
        transpose_item(P.w_ffn_in + (size_t)l * DM * NFFI, NFFI, ffi_src_col(nb * 32), DM, kb * 64, (bf16*)(wl + WT_FFI), nb * 32, scr, lane); return; } r -= TI_FFI;
    if (r < TI_FFO) { const int nb = r % (DM / 32), kb = r / (DM / 32);
        transpose_item(P.w_ffn_out + (size_t)l * DFF * DM, DM, nb * 32, DFF, kb * 64, (bf16*)(wl + WT_FFO), nb * 32, scr, lane); return; } r -= TI_FFO;
    { const int k0 = r * 64, j = lane & 15, kq = lane >> 4; bf16* G = (bf16*)(wl + WT_GLR); const float* W = P.w_in + (size_t)l * DM * NINSRC;
        for (int kk = 0; kk < 16; ++kk) { const int k = k0 + kq * 16 + kk; G[(size_t)j * DM + k] = (bf16)f2bf(W[(size_t)k * NINSRC + GLR_SRC + j]); } }
}
__device__ __forceinline__ void phase_p0a(const Params& P, int gw, int ngw, int lane, float* scr) {
    constexpr int NADA = 2 * 8 * 96;
    for (int it = gw; it < NADA; it += ngw) ada_item(P, it, lane, scr);
    for (int it = gw; it < DEPTH * TI_LAYER; it += ngw) wconv_item(P, it, lane, scr);
}
__device__ __forceinline__ void phase_p0b(const Params& P, int gtid, int ngt) {
    const float* MP = (const float*)(P.ws + WS_MODP); float* MV = (float*)(P.ws + WS_MODV);
    for (int i = gtid; i < 2 * 8 * DM; i += ngt) {
        const int j = i % DM, b = (i / DM) % 8, l = i / (8 * DM);
        float m[6];
#pragma unroll
        for (int s = 0; s < 6; ++s) { float a = P.ada_b[l * 6 * DM + s * DM + j];
            for (int kc = 0; kc < 8; ++kc) a += MP[((size_t)(kc * 2 + l) * 8 + b) * (6 * DM) + s * DM + j]; m[s] = a; }
        float* o = MV + ((size_t)(l * 8 + b) * 6) * DM + j;
        o[0 * DM] = m[0]; o[1 * DM] = P.norm1_g[l * DM + j] * (1.f + m[1]); o[2 * DM] = m[2];
        o[3 * DM] = m[3]; o[4 * DM] = P.norm2_g[l * DM + j] * (1.f + m[4]); o[5 * DM] = m[5];
    }
}
__device__ __forceinline__ void a1prep_row(const Params& P, int m, int lane) {
    const int b = m / SEQ; const float* gm = (const float*)(P.ws + WS_MODV) + ((size_t)(0 * 8 + b) * 6 + 1) * DM;
    const f32x4* xr = (const f32x4*)(P.x + (size_t)m * DM); bf16* A = (bf16*)(P.ws + WS_ABUF) + (size_t)m * DM;
    float s = 0.f;
#pragma unroll
    for (int j = 0; j < 8; ++j) { const f32x4 v = xr[lane + 64 * j]; const f32x4 g = *(const f32x4*)(gm + 4 * (lane + 64 * j));
        s += (v.x * v.x + v.y * v.y) + (v.z * v.z + v.w * v.w);
        u32x2 w; w.x = pk2(v.x * g.x, v.y * g.y); w.y = pk2(v.z * g.z, v.w * g.w); *(u32x2*)(A + 4 * (lane + 64 * j)) = w; }
    s = wave_sum(s);
    if (lane == 0) ((float*)(P.ws + WS_SSQ0))[m] = s;
}
__device__ __forceinline__ void shw_combo(const Params& P, int combo, int wgw, int nwg_waves, int gw, int ngw, int tid, int nthr, int lane, float* shl) {
    const int l = combo >> 1, which = combo & 1;
    const float* MV = (const float*)(P.ws + WS_MODV);
    for (int i = tid; i < 8 * DM; i += nthr) { const int b = i / DM, k = i % DM; shl[i] = MV[((size_t)(l * 8 + b) * 6 + (which ? 3 : 0)) * DM + k]; }
    __syncthreads();
    const int nrows = which ? NFFI : NIN + GRANK;
    for (int n = gw; n < nrows; n += ngw) {
        const bf16* row = which ? wt_ptr(P, l, WT_FFI) + (size_t)n * DM : (n < NIN ? wt_ptr(P, l, WT_IN) + (size_t)n * DM : wt_ptr(P, l, WT_GLR) + (size_t)(n - NIN) * DM);
        float acc[8];
#pragma unroll
        for (int b = 0; b < 8; ++b) acc[b] = 0.f;
#pragma unroll 1
        for (int j = 0; j < 4; ++j) { const int k0 = 8 * lane + 512 * j; const u32x4 w = *(const u32x4*)(row + k0);
            float wf[8]; wf[0] = bf2f(w.x & 0xffff); wf[1] = bf2f(w.x >> 16); wf[2] = bf2f(w.y & 0xffff); wf[3] = bf2f(w.y >> 16); wf[4] = bf2f(w.z & 0xffff); wf[5] = bf2f(w.z >> 16); wf[6] = bf2f(w.w & 0xffff); wf[7] = bf2f(w.w >> 16);
#pragma unroll
            for (int b = 0; b < 8; ++b) { const f32x4 s0 = *(const f32x4*)(shl + b * DM + k0), s1 = *(const f32x4*)(shl + b * DM + k0 + 4);
                acc[b] += (s0.x * wf[0] + s0.y * wf[1]) + (s0.z * wf[2] + s0.w * wf[3]) + (s1.x * wf[4] + s1.y * wf[5]) + (s1.z * wf[6] + s1.w * wf[7]); } }
#pragma unroll
        for (int b = 0; b < 8; ++b) acc[b] = wave_sum(acc[b]);
        if (lane == 0) {
#pragma unroll
            for (int b = 0; b < 8; ++b) {
                if (which) ((float*)(P.ws + WS_SHWFFI))[((size_t)l * 8 + b) * NFFI + n] = acc[b];
                else if (n < NIN) ((float*)(P.ws + WS_SHWIN))[((size_t)l * 8 + b) * NIN + n] = acc[b];
                else ((float*)(P.ws + WS_SHWGLR))[((size_t)l * 8 + b) * GRANK + (n - NIN)] = acc[b]; } }
    }
    __syncthreads();
}

__global__ __launch_bounds__(512) void k_p0a(Params P) {
    __shared__ float scr[8][2176];
    const int wave = threadIdx.x >> 6, lane = threadIdx.x & 63;
    phase_p0a(P, blockIdx.x * 8 + wave, gridDim.x * 8, lane, scr[wave]);
}
__global__ __launch_bounds__(512) void k_p0b(Params P) { phase_p0b(P, blockIdx.x * 512 + threadIdx.x, gridDim.x * 512); }
__global__ __launch_bounds__(512) void k_p0c(Params P) {
    extern __shared__ __attribute__((aligned(16))) float shl[];
    const int wave = threadIdx.x >> 6, lane = threadIdx.x & 63, gw = blockIdx.x * 8 + wave, ngw = gridDim.x * 8;
    for (int m = gw; m < MT; m += ngw) a1prep_row(P, m, lane);
    for (int combo = 0; combo < 4; ++combo) shw_combo(P, combo, wave, 8, gw, ngw, threadIdx.x, 512, lane, shl);
}

template <int TN, class Epi>
__global__ __launch_bounds__(256) void k_naive_gemm(const bf16* A, int lda, const bf16* Bt, int ldb, int K, Epi E) {
    const int wave = threadIdx.x >> 6, lane = threadIdx.x & 63, r16 = lane & 15, q = lane >> 4;
    const int row0 = blockIdx.y * 64 + wave * 16, col0 = blockIdx.x * 16 * TN;
    f32x4 acc[TN];
#pragma unroll
    for (int t = 0; t < TN; ++t) acc[t] = (f32x4){0.f, 0.f, 0.f, 0.f};
    const bf16* ap = A + (size_t)(row0 + r16) * lda + 8 * q;
    const bf16* bp = Bt + (size_t)(col0 + r16) * ldb + 8 * q;
    for (int k0 = 0; k0 < K; k0 += 32) {
        const bf16x8 a = *(const bf16x8*)(ap + k0);
#pragma unroll
        for (int t = 0; t < TN; ++t) { const bf16x8 b = *(const bf16x8*)(bp + (size_t)t * 16 * ldb + k0);
            acc[t] = __builtin_amdgcn_mfma_f32_16x16x32_bf16(a, b, acc[t], 0, 0, 0); }
    }
#pragma unroll
    for (int t = 0; t < TN; ++t)
#pragma unroll
        for (int j = 0; j < 4; ++j) E(row0 + 4 * q + j, col0 + t * 16 + r16, acc[t][j]);
}
struct NEpiIn {
    const float* ssq; const float* shw; bf16* proj;
    __device__ void operator()(int row, int col, float a) const {
        const int b = row / SEQ; const float rstd = rsqrtf(ssq[row] * (1.f / DM) + EPS);
        float v = rstd * a + shw[(size_t)b * NIN + col];
        if (col < GK_OFF) v *= 0.08838834764831845f;
        else if (col >= GR_OFF && col < MQ_OFF) v = siluf_(v);
        else if (col >= GT_OFF) v = sigmoidf_(v);
        proj[(size_t)row * NIN + col] = (bf16)f2bf(v);
    }
};
struct NEpiGlr { const float* ssq; const float* shw; float* glr;
    __device__ void operator()(int row, int col, float a) const { const int b = row / SEQ; glr[(size_t)row * GRANK + col] = rsqrtf(ssq[row] * (1.f / DM) + EPS) * a + shw[b * GRANK + col]; } };
struct NEpiUp1 { const bf16* proj; bf16* mg;
    __device__ void operator()(int row, int col, float a) const { mg[(size_t)row * DM + col] = (bf16)f2bf(bf2f(proj[(size_t)row * NIN + GT_OFF + col]) * a); } };
struct NEpiUp2 { const bf16* proj; bf16* mg;
    __device__ void operator()(int row, int col, float a) const { const size_t i = (size_t)row * DM + col; mg[i] = (bf16)f2bf(bf2f(mg[i]) + bf2f(proj[(size_t)row * NIN + GT_OFF + DM + col]) * a); } };
struct NEpiRes {
    const float* xin; float* xout; const float* gate; const float* gm; bf16* aout;
    __device__ void operator()(int row, int col, float a) const { const int b = row / SEQ; const size_t i = (size_t)row * DM + col;
        const float v = xin[i] + gate[(size_t)b * 6 * DM + col] * a; xout[i] = v; if (aout) aout[i] = (bf16)f2bf(v * gm[(size_t)b * 6 * DM + col]); } };
struct NEpiFfi {
    const float* ssq; const float* shw; bf16* hid;
    __device__ void operator()(int row, int col, float a) const { (void)row; (void)col; (void)a; } };
__global__ __launch_bounds__(256) void k_naive_ffi(const bf16* A, const bf16* Bt, const float* ssq, const float* shw, bf16* hid) {
    const int wave = threadIdx.x >> 6, lane = threadIdx.x & 63, r16 = lane & 15, q = lane >> 4;
    const int row0 = blockIdx.y * 64 + wave * 16, j0 = blockIdx.x * 16;
    const int pn = j0 >> 7, c = j0 & 127, ra = pn * 256 + c, ru = ra + 128;
    f32x4 aa = {0.f, 0.f, 0.f, 0.f}, au = {0.f, 0.f, 0.f, 0.f};
    const bf16* ap = A + (size_t)(row0 + r16) * DM + 8 * q;
    const bf16* bpa = Bt + (size_t)(ra + r16) * DM + 8 * q; const bf16* bpu = Bt + (size_t)(ru + r16) * DM + 8 * q;
    for (int k0 = 0; k0 < DM; k0 += 32) { const bf16x8 a = *(const bf16x8*)(ap + k0);
        aa = __builtin_amdgcn_mfma_f32_16x16x32_bf16(a, *(const bf16x8*)(bpa + k0), aa, 0, 0, 0);
        au = __builtin_amdgcn_mfma_f32_16x16x32_bf16(a, *(const bf16x8*)(bpu + k0), au, 0, 0, 0); }
#pragma unroll
    for (int j = 0; j < 4; ++j) { const int row = row0 + 4 * q + j, b = row / SEQ; const float rstd = rsqrtf(ssq[row] * (1.f / DM) + EPS);
        const float va = rstd * aa[j] + shw[(size_t)b * NFFI + ra + r16], vu = rstd * au[j] + shw[(size_t)b * NFFI + ru + r16];
        hid[(size_t)row * DFF + j0 + r16] = (bf16)f2bf(siluf_(va) * vu); }
}
__global__ __launch_bounds__(256) void k_rowssq(const float* x, float* ssq) {
    const int m = blockIdx.x * 4 + (threadIdx.x >> 6), lane = threadIdx.x & 63; const f32x4* xr = (const f32x4*)(x + (size_t)m * DM); float s = 0.f;
#pragma unroll
    for (int j = 0; j < 8; ++j) { const f32x4 v = xr[lane + 64 * j]; s += (v.x * v.x + v.y * v.y) + (v.z * v.z + v.w * v.w); }
    s = wave_sum(s); if (lane == 0) ssq[m] = s;
}
__global__ __launch_bounds__(256) void k_final(float* x, const float* g) {
    const int m = blockIdx.x * 4 + (threadIdx.x >> 6), lane = threadIdx.x & 63; f32x4* xr = (f32x4*)(x + (size_t)m * DM); float s = 0.f; f32x4 v[8];
#pragma unroll
    for (int j = 0; j < 8; ++j) { v[j] = xr[lane + 64 * j]; s += (v[j].x * v[j].x + v[j].y * v[j].y) + (v[j].z * v[j].z + v[j].w * v[j].w); }
    const float rstd = rsqrtf(wave_sum(s) * (1.f / DM) + EPS);
#pragma unroll
    for (int j = 0; j < 8; ++j) { const f32x4 gg = *(const f32x4*)(g + 4 * (lane + 64 * j)); xr[lane + 64 * j] = v[j] * rstd * gg; }
}
__global__ __launch_bounds__(128) void k_kmean(const bf16* proj, float* kmean) {
    const int blk = blockIdx.x % MNB, bh = blockIdx.x / MNB, b = bh / MH, h = bh % MH, d = threadIdx.x;
    const bf16* p = proj + (size_t)(b * SEQ + blk * MBLK) * NIN + MK_OFF + h * MHD + d; float s = 0.f;
    for (int r = 0; r < MBLK; ++r) s += bf2f(p[(size_t)r * NIN]);
    kmean[((size_t)bh * MNB + blk) * MHD + d] = s * (1.f / MBLK);
}
__global__ __launch_bounds__(512) void k_gla_g(const float* glr, const float* w2, const float* gb, float* g) {
    const int m = blockIdx.x, d = threadIdx.x; float a = gb[d];
#pragma unroll
    for (int r = 0; r < GRANK; ++r) a += glr[(size_t)m * GRANK + r] * w2[r * GKW + d];
    g[(size_t)m * GKW + d] = logsigmoidf_(a) * (1.f / 16.f);
}
__global__ __launch_bounds__(256) void k_gla_rec(const bf16* proj, const float* g, float* oraw) {
    const int bh = blockIdx.x, b = bh / GH, h = bh % GH, dv = threadIdx.x;
    float S[GDK];
#pragma unroll
    for (int d = 0; d < GDK; ++d) S[d] = 0.f;
    for (int t = 0; t < SEQ; ++t) { const size_t m = (size_t)b * SEQ + t; const bf16* pr = proj + m * NIN;
        const float v = bf2f(pr[GV_OFF + h * GDV + dv]); float o = 0.f;
#pragma unroll
        for (int d = 0; d < GDK; ++d) { const float dec = __expf(g[m * GKW + h * GDK + d]); S[d] = dec * S[d] + bf2f(pr[GK_OFF + h * GDK + d]) * v; o += bf2f(pr[GQ_OFF + h * GDK + d]) * S[d]; }
        oraw[m * GVW + h * GDV + dv] = o; }
}
__global__ __launch_bounds__(256) void k_gla_norm(const float* oraw, const bf16* proj, const float* gn, bf16* og) {
    const int idx = blockIdx.x * 4 + (threadIdx.x >> 6), lane = threadIdx.x & 63, m = idx / GH, h = idx % GH;
    const f32x4 v = *(const f32x4*)(oraw + (size_t)m * GVW + h * GDV + 4 * lane);
    const float rstd = rsqrtf(wave_sum((v.x * v.x + v.y * v.y) + (v.z * v.z + v.w * v.w)) * (1.f / GDV) + EPS);
    const f32x4 gg = *(const f32x4*)(gn + 4 * lane); const bf16* sg = proj + (size_t)m * NIN + GR_OFF + h * GDV + 4 * lane;
    u32x2 w; w.x = pk2(v.x * rstd * gg.x * bf2f(sg[0]), v.y * rstd * gg.y * bf2f(sg[1])); w.y = pk2(v.z * rstd * gg.z * bf2f(sg[2]), v.w * rstd * gg.w * bf2f(sg[3]));
    *(u32x2*)(og + (size_t)m * DM + h * GDV + 4 * lane) = w;
}
__global__ __launch_bounds__(128) void k_moba_naive(const bf16* proj, const float* kmean, bf16* om) {
    __shared__ float qs[MHD]; __shared__ float sc[SEQ / 2 + MBLK]; __shared__ float red[128]; __shared__ float bsc[8]; __shared__ int selb;
    const int t = blockIdx.x % SEQ, bh = blockIdx.x / SEQ, b = bh / MH, h = bh % MH, tid = threadIdx.x, qb = t / MBLK;
    const size_t m = (size_t)b * SEQ + t;
    qs[tid] = bf2f(proj[m * NIN + MQ_OFF + h * MHD + tid]);
    __syncthreads();
    if (tid < 8) { float s = -INFINITY; if (tid < qb) { s = 0.f; const float* km = kmean + ((size_t)bh * MNB + tid) * MHD; for (int d = 0; d < MHD; ++d) s += qs[d] * km[d]; } bsc[tid] = s; }
    __syncthreads();
    if (tid == 0) { int bits = 0;
        for (int r = 0; r < MTOPK; ++r) { int best = -1; float bv = -INFINITY; for (int j = 0; j < qb; ++j) if (!((bits >> j) & 1) && (best < 0 || bsc[j] > bv)) { best = j; bv = bsc[j]; } if (best >= 0) bits |= 1 << best; }
        selb = bits; }
    __syncthreads();
    const int bits = selb;
    const int nsel = __popc(bits);
    const int nown = t - qb * MBLK + 1, ncand = nsel * MBLK + nown;
#define KEY_OF(i, key) do { const int sblk_ = (i) / MBLK; if (sblk_ >= nsel) key = qb * MBLK + ((i) - nsel * MBLK); else { int cnt_ = 0, blk_ = 0; for (int j_ = 0; j_ < 8; ++j_) if ((bits >> j_) & 1) { if (cnt_ == sblk_) blk_ = j_; ++cnt_; } key = blk_ * MBLK + ((i) % MBLK); } } while (0)
    float mx = -INFINITY;
    for (int i = tid; i < ncand; i += 128) { int key; KEY_OF(i, key);
        const bf16* kr = proj + ((size_t)b * SEQ + key) * NIN + MK_OFF + h * MHD; float s = 0.f;
        for (int d8 = 0; d8 < MHD / 8; ++d8) { const u32x4 w = *(const u32x4*)(kr + 8 * d8); const float* qq = qs + 8 * d8;
            s += qq[0] * bf2f(w.x & 0xffff) + qq[1] * bf2f(w.x >> 16) + qq[2] * bf2f(w.y & 0xffff) + qq[3] * bf2f(w.y >> 16) + qq[4] * bf2f(w.z & 0xffff) + qq[5] * bf2f(w.z >> 16) + qq[6] * bf2f(w.w & 0xffff) + qq[7] * bf2f(w.w >> 16); }
        s *= 0.08838834764831845f; sc[i] = s; mx = fmaxf(mx, s); }
    red[tid] = mx; __syncthreads();
    for (int o = 64; o > 0; o >>= 1) { if (tid < o) red[tid] = fmaxf(red[tid], red[tid + o]); __syncthreads(); }
    mx = red[0]; __syncthreads();
    float sum = 0.f;
    for (int i = tid; i < ncand; i += 128) { const float p = __expf(sc[i] - mx); sc[i] = p; sum += p; }
    red[tid] = sum; __syncthreads();
    for (int o = 64; o > 0; o >>= 1) { if (tid < o) red[tid] += red[tid + o]; __syncthreads(); }
    sum = red[0];
    float o = 0.f;
    for (int i = 0; i < ncand; ++i) { int key; KEY_OF(i, key);
        o += sc[i] * bf2f(proj[((size_t)b * SEQ + key) * NIN + MV_OFF + h * MHD + tid]); }
    om[m * DM + GVW + h * MHD + tid] = (bf16)f2bf(o / sum);
}

extern "C" void kernel_launch(void* const* d_in, const int* in_sizes, int n_in, void* d_out, int out_size, void* d_ws, size_t ws_size, hipStream_t stream) {
    static int ok = 0;
    if (ok == 0) {
        if (n_in != 16 || in_sizes[0] != MT * DM || out_size != MT * DM || ws_size < WS_DBG_END) { fprintf(stderr, "kernel_launch: unexpected shapes/ws (n_in %d, ws %zu, need %zu)\n", n_in, ws_size, (size_t)WS_DBG_END); ok = -1; return; }
        if (hipFuncSetAttribute((const void*)k_p0c, hipFuncAttributeMaxDynamicSharedMemorySize, 65536) != hipSuccess) { fprintf(stderr, "kernel_launch: hipFuncSetAttribute failed\n"); ok = -1; return; }
        ok = 1;
    }
    if (ok < 0) return;
    Params P{};
    P.x = (const float*)d_in[0]; P.c = (const float*)d_in[1]; P.ada_w = (const float*)d_in[2]; P.ada_b = (const float*)d_in[3]; P.norm1_g = (const float*)d_in[4]; P.w_in = (const float*)d_in[5];
    P.gate_w2 = (const float*)d_in[6]; P.gate_b = (const float*)d_in[7]; P.gla_norm_g = (const float*)d_in[8]; P.w_up_gla = (const float*)d_in[9]; P.w_up_moba = (const float*)d_in[10];
    P.w_out = (const float*)d_in[11]; P.norm2_g = (const float*)d_in[12]; P.w_ffn_in = (const float*)d_in[13]; P.w_ffn_out = (const float*)d_in[14]; P.final_g = (const float*)d_in[15];
    P.out = (float*)d_out; P.ws = (unsigned char*)d_ws;
    unsigned char* ws = (unsigned char*)d_ws;
    (void)hipMemsetAsync(ws + WS_CTL, 0, CTL_ZERO_BYTES, stream);
    k_p0a<<<512, 512, 0, stream>>>(P);
    k_p0b<<<64, 512, 0, stream>>>(P);
    k_p0c<<<256, 512, 65536, stream>>>(P);
    bf16* ABUF = (bf16*)(ws + WS_ABUF); bf16* OGOM = (bf16*)(ws + WS_OGOM); bf16* PROJ = (bf16*)(ws + WS_PROJ); bf16* HID = PROJ;
    float* SSQA = (float*)(ws + WS_SSQ0); float* SSQB = (float*)(ws + WS_SSQ); float* GLR = (float*)(ws + WS_GLR); float* KMEAN = (float*)(ws + WS_KMEAN);
    float* DBG_G = (float*)(ws + WS_DBG_G); float* DBG_O = (float*)(ws + WS_DBG_O);
    const float* MODV = (const float*)(ws + WS_MODV);
    float* xs = (float*)d_out;
    for (int l = 0; l < DEPTH; ++l) {
        const bf16* Win = (const bf16*)(ws + WS_WT + (size_t)l * WT_LAYER + WT_IN); const bf16* Wglr = (const bf16*)(ws + WS_WT + (size_t)l * WT_LAYER + WT_GLR);
        const bf16* Wupg = (const bf16*)(ws + WS_WT + (size_t)l * WT_LAYER + WT_UPG); const bf16* Wupm = (const bf16*)(ws + WS_WT + (size_t)l * WT_LAYER + WT_UPM);
        const bf16* Wout = (const bf16*)(ws + WS_WT + (size_t)l * WT_LAYER + WT_OUT); const bf16* Wffi = (const bf16*)(ws + WS_WT + (size_t)l * WT_LAYER + WT_FFI); const bf16* Wffo = (const bf16*)(ws + WS_WT + (size_t)l * WT_LAYER + WT_FFO);
        const float* shwin = (const float*)(ws + WS_SHWIN) + (size_t)l * 8 * NIN; const float* shwglr = (const float*)(ws + WS_SHWGLR) + (size_t)l * 8 * GRANK; const float* shwffi = (const float*)(ws + WS_SHWFFI) + (size_t)l * 8 * NFFI;
        const float* mv = MODV + (size_t)l * 8 * 6 * DM;
        k_naive_gemm<4, NEpiIn><<<dim3(NIN / 64, MT / 64), 256, 0, stream>>>(ABUF, DM, Win, DM, DM, NEpiIn{SSQA, shwin, PROJ});
        k_naive_gemm<1, NEpiGlr><<<dim3(1, MT / 64), 256, 0, stream>>>(ABUF, DM, Wglr, DM, DM, NEpiGlr{SSQA, shwglr, GLR});
        k_kmean<<<NB * MH * MNB, 128, 0, stream>>>(PROJ, KMEAN);
        k_gla_g<<<MT, 512, 0, stream>>>(GLR, P.gate_w2 + (size_t)l * GRANK * GKW, P.gate_b + (size_t)l * GKW, DBG_G);
        k_gla_rec<<<NB * GH, 256, 0, stream>>>(PROJ, DBG_G, DBG_O);
        k_gla_norm<<<MT * GH / 4, 256, 0, stream>>>(DBG_O, PROJ, P.gla_norm_g + (size_t)l * GDV, OGOM);
        k_moba_naive<<<NB * MH * SEQ, 128, 0, stream>>>(PROJ, KMEAN, OGOM);
        k_naive_gemm<4, NEpiUp1><<<dim3(DM / 64, MT / 64), 256, 0, stream>>>(OGOM, DM, Wupg, GVW, GVW, NEpiUp1{PROJ, ABUF});
        k_naive_gemm<4, NEpiUp2><<<dim3(DM / 64, MT / 64), 256, 0, stream>>>(OGOM + GVW, DM, Wupm, MW, MW, NEpiUp2{PROJ, ABUF});
        k_naive_gemm<4, NEpiRes><<<dim3(DM / 64, MT / 64), 256, 0, stream>>>(ABUF, DM, Wout, DM, DM, NEpiRes{l == 0 ? P.x : xs, xs, mv + 2 * DM, mv + 4 * DM, OGOM});
        k_rowssq<<<MT / 4, 256, 0, stream>>>(xs, SSQB);
        k_naive_ffi<<<dim3(DFF / 16, MT / 64), 256, 0, stream>>>(OGOM, Wffi, SSQB, shwffi, HID);
        const float* mvn = MODV + (size_t)(l + 1 < DEPTH ? l + 1 : l) * 8 * 6 * DM;
        k_naive_gemm<4, NEpiRes><<<dim3(DM / 64, MT / 64), 256, 0, stream>>>(HID, DFF, Wffo, DFF, DFF, NEpiRes{xs, xs, mv + 5 * DM, mvn + 1 * DM, l + 1 < DEPTH ? ABUF : nullptr});
        k_rowssq<<<MT / 4, 256, 0, stream>>>(xs, SSQA);
    }
    k_final<<<MT / 4, 256, 0, stream>>>(xs, P.final_g);
}
```

```cpp
#include <hip/hip_runtime.h>
#include <cstdio>
#include <cstdint>

constexpr int NB = 8, SEQ = 2048, DM = 2048, MT = NB * SEQ, DEPTH = 2;
constexpr int GH = 4, GDK = 128, GDV = 256, GKW = 512, GVW = 1024, GRANK = 16, GCH = 64;
constexpr int MH = 8, MHD = 128, MW = 1024, MBLK = 256, MNB = SEQ / MBLK, MTOPK = 3;
constexpr int DFF = 5632, NFFI = 2 * DFF;
constexpr int NINSRC = 10256, NIN = 10240;
constexpr float EPS = 1e-6f;
constexpr int GQ_OFF = 0, GK_OFF = 512, GV_OFF = 1024, GR_OFF = 2048, MQ_OFF = 3072, MK_OFF = 4096, MV_OFF = 5120, GT_OFF = 6144;
constexpr int GLR_SRC = 3072;

constexpr size_t MiB = 1u << 20;
constexpr size_t WS_CTL = 0, CTL_ZERO_BYTES = 2 * MiB;
constexpr size_t WS_SSQ = 1 * MiB;
constexpr size_t WS_MODP = 2 * MiB;
constexpr size_t WS_MODV = 8 * MiB;
constexpr size_t WS_SHWIN = 9 * MiB;
constexpr size_t WS_SHWFFI = 10 * MiB;
constexpr size_t WS_SHWGLR = 11 * MiB;
constexpr size_t WS_GLR = 12 * MiB;
constexpr size_t WS_KMEAN = 13 * MiB;
constexpr size_t WS_SSQ0 = 14 * MiB;
constexpr size_t WS_WT = 16 * MiB, WT_LAYER = 123 * MiB;
constexpr size_t WT_IN = 0, WT_GLR = 40 * MiB, WT_UPG = 41 * MiB, WT_UPM = 45 * MiB, WT_OUT = 49 * MiB, WT_FFI = 57 * MiB, WT_FFO = 101 * MiB;
constexpr size_t WS_ABUF = 262 * MiB;
constexpr size_t WS_OGOM = 326 * MiB;
constexpr size_t WS_PROJ = 390 * MiB;
constexpr size_t WS_END = 710 * MiB;
constexpr size_t WS_DBG_G = 710 * MiB;
constexpr size_t WS_DBG_O = 742 * MiB;
constexpr size_t WS_DBG_END = 806 * MiB;

typedef unsigned short bf16;
typedef short bf16x8 __attribute__((ext_vector_type(8)));
typedef float f32x4 __attribute__((ext_vector_type(4)));
typedef unsigned u32x4 __attribute__((ext_vector_type(4)));
typedef unsigned u32x2 __attribute__((ext_vector_type(2)));

struct Params {
    const float* x; const float* c; const float* ada_w; const float* ada_b; const float* norm1_g; const float* w_in;
    const float* gate_w2; const float* gate_b; const float* gla_norm_g; const float* w_up_gla; const float* w_up_moba;
    const float* w_out; const float* norm2_g; const float* w_ffn_in; const float* w_ffn_out; const float* final_g;
    float* out; unsigned char* ws;
};

__device__ __forceinline__ unsigned f2bf(float f) { unsigned u = __builtin_bit_cast(unsigned, f); return (u + 0x7fffu + ((u >> 16) & 1u)) >> 16; }
__device__ __forceinline__ unsigned pk2(float lo, float hi) { return f2bf(lo) | (f2bf(hi) << 16); }
__device__ __forceinline__ float bf2f(unsigned short b) { return __builtin_bit_cast(float, ((unsigned)b) << 16); }
__device__ __forceinline__ float wave_sum(float v) {
#pragma unroll
    for (int o = 1; o < 64; o <<= 1) v += __shfl_xor(v, o);
    return v;
}
__device__ __forceinline__ float sigmoidf_(float v) { return 1.0f / (1.0f + __expf(-v)); }
__device__ __forceinline__ float siluf_(float v) { return v / (1.0f + __expf(-v)); }
__device__ __forceinline__ float logsigmoidf_(float v) { return fminf(v, 0.f) - log1pf(__expf(-fabsf(v))); }

__device__ __forceinline__ const bf16* wt_ptr(const Params& P, int l, size_t off) { return (const bf16*)(P.ws + WS_WT + (size_t)l * WT_LAYER + off); }
__device__ __forceinline__ int in_src_col(int n) { return n < 3072 ? n : n + 16; }
__device__ __forceinline__ int ffi_src_col(int r) { const int pn = r >> 8, c = r & 255; return c < 128 ? pn * 128 + c : DFF + pn * 128 + (c - 128); }

__device__ __forceinline__ void ada_item(const Params& P, int item, int lane, float* scr) {
    const int cg = item % 96, kc = (item / 96) % 8, l = item / 768;
    const int k0 = kc * 256;
    for (int i = 0; i < 32; ++i) { const int idx = lane + 64 * i, b = idx >> 8, kk = idx & 255; scr[idx] = siluf_(P.c[b * DM + k0 + kk]); }
    __builtin_amdgcn_s_waitcnt(0);
    const float* W = P.ada_w + (size_t)l * DM * (6 * DM) + (size_t)k0 * (6 * DM) + cg * 128 + 2 * lane;
    float a0[8], a1[8];
#pragma unroll
    for (int b = 0; b < 8; ++b) { a0[b] = 0.f; a1[b] = 0.f; }
#pragma unroll 8
    for (int kk = 0; kk < 256; ++kk) {
        const float2 w = *(const float2*)(W + (size_t)kk * (6 * DM));
#pragma unroll
        for (int b = 0; b < 8; ++b) { const float cv = scr[b * 256 + kk]; a0[b] += cv * w.x; a1[b] += cv * w.y; }
    }
    float* MP = (float*)(P.ws + WS_MODP) + ((size_t)(kc * 2 + l) * 8) * (6 * DM) + cg * 128 + 2 * lane;
#pragma unroll
    for (int b = 0; b < 8; ++b) *(float2*)(MP + (size_t)b * (6 * DM)) = make_float2(a0[b], a1[b]);
    __builtin_amdgcn_s_waitcnt(0);
}
__device__ __forceinline__ void transpose_item(const float* W, int Nsrc, int src_col0, int K, int k0, bf16* WT, int dst_row0, float* scr, int lane) {
    float v[32];
#pragma unroll
    for (int i = 0; i < 32; ++i) { const int kk = 2 * i + (lane >> 5); v[i] = W[(size_t)(k0 + kk) * Nsrc + src_col0 + (lane & 31)]; }
#pragma unroll
    for (int i = 0; i < 32; ++i) { const int kk = 2 * i + (lane >> 5); scr[kk * 33 + (lane & 31)] = v[i]; }
    __builtin_amdgcn_s_waitcnt(0);
    const int c = lane & 7;
#pragma unroll
    for (int j = 0; j < 4; ++j) { const int n = (lane >> 3) + 8 * j; const float* s = scr + (8 * c) * 33 + n;
        u32x4 o; o.x = pk2(s[0 * 33], s[1 * 33]); o.y = pk2(s[2 * 33], s[3 * 33]); o.z = pk2(s[4 * 33], s[5 * 33]); o.w = pk2(s[6 * 33], s[7 * 33]);
        *(u32x4*)(WT + (size_t)(dst_row0 + n) * K + k0 + 8 * c) = o; }
    __builtin_amdgcn_s_waitcnt(0);
}
constexpr int TI_IN = (DM / 64) * (NIN / 32), TI_UP = (GVW / 64) * (DM / 32), TI_OUT = (DM / 64) * (DM / 32), TI_FFI = (DM / 64) * (NFFI / 32), TI_FFO = (DFF / 64) * (DM / 32), TI_GLR = DM / 64;
constexpr int TI_LAYER = TI_IN + 2 * TI_UP + TI_OUT + TI_FFI + TI_FFO + TI_GLR;
__device__ __forceinline__ void wconv_item(const Params& P, int item, int lane, float* scr) {
    const int l = item / TI_LAYER; int r = item % TI_LAYER;
    unsigned char* wl = P.ws + WS_WT + (size_t)l * WT_LAYER;
    if (r < TI_IN) { const int nb = r % (NIN / 32), kb = r / (NIN / 32);
        transpose_item(P.w_in + (size_t)l * DM * NINSRC, NINSRC, in_src_col(nb * 32), DM, kb * 64, (bf16*)(wl + WT_IN), nb * 32, scr, lane); return; } r -= TI_IN;
    if (r < TI_UP) { const int nb = r % (DM / 32), kb = r / (DM / 32);
        transpose_item(P.w_up_gla + (size_t)l * GVW * DM, DM, nb * 32, GVW, kb * 64, (bf16*)(wl + WT_UPG), nb * 32, scr, lane); return; } r -= TI_UP;
    if (r < TI_UP) { const int nb = r % (DM / 32), kb = r / (DM / 32);
        transpose_item(P.w_up_moba + (size_t)l * MW * DM, DM, nb * 32, MW, kb * 64, (bf16*)(wl + WT_UPM), nb * 32, scr, lane); return; } r -= TI_UP;
    if (r < TI_OUT) { const int nb = r % (DM / 32), kb = r / (DM / 32);
        transpose_item(P.w_out + (size_t)l * DM * DM, DM, nb * 32, DM, kb * 64, (bf16*)(wl + WT_OUT), nb * 32, scr, lane); return; } r -= TI_OUT;
    if (r < TI_FFI) { const int nb = r % (NFFI / 32), kb = r / (NFFI / 32);
        transpose_item(P.w_ffn_in + (size_t)l * DM * NFFI, NFFI, ffi_src_col(nb * 32), DM, kb * 64, (bf16*)(wl + WT_FFI), nb * 32, scr, lane); return; } r -= TI_FFI;
    if (r < TI_FFO) { const int nb = r % (DM / 32), kb = r / (DM / 32);
        transpose_item(P.w_ffn_out + (size_t)l * DFF * DM, DM, nb * 32, DFF, kb * 64, (bf16*)(wl + WT_FFO), nb * 32, scr, lane); return; } r -= TI_FFO;
    { const int k0 = r * 64, j = lane & 15, kq = lane >> 4; bf16* G = (bf16*)(wl + WT_GLR); const float* W = P.w_in + (size_t)l * DM * NINSRC;
        for (int kk = 0; kk < 16; ++kk) { const int k = k0 + kq * 16 + kk; G[(size_t)j * DM + k] = (bf16)f2bf(W[(size_t)k * NINSRC + GLR_SRC + j]); } }
}
__device__ __forceinline__ void phase_p0a(const Params& P, int gw, int ngw, int lane, float* scr) {
    constexpr int NADA = 2 * 8 * 96;
    for (int it = gw; it < NADA; it += ngw) ada_item(P, it, lane, scr);
    for (int it = gw; it < DEPTH * TI_LAYER; it += ngw) wconv_item(P, it, lane, scr);
}
__device__ __forceinline__ void phase_p0b(const Params& P, int gtid, int ngt) {
    const float* MP = (const float*)(P.ws + WS_MODP); float* MV = (float*)(P.ws + WS_MODV);
    for (int i = gtid; i < 2 * 8 * DM; i += ngt) {
        const int j = i % DM, b = (i / DM) % 8, l = i / (8 * DM);
        float m[6];
#pragma unroll
        for (int s = 0; s < 6; ++s) { float a = P.ada_b[l * 6 * DM + s * DM + j];
            for (int kc = 0; kc < 8; ++kc) a += MP[((size_t)(kc * 2 + l) * 8 + b) * (6 * DM) + s * DM + j]; m[s] = a; }
        float* o = MV + ((size_t)(l * 8 + b) * 6) * DM + j;
        o[0 * DM] = m[0]; o[1 * DM] = P.norm1_g[l * DM + j] * (1.f + m[1]); o[2 * DM] = m[2];
        o[3 * DM] = m[3]; o[4 * DM] = P.norm2_g[l * DM + j] * (1.f + m[4]); o[5 * DM] = m[5];
    }
}
__device__ __forceinline__ void a1prep_row(const Params& P, int m, int lane) {
    const int b = m / SEQ; const float* gm = (const float*)(P.ws + WS_MODV) + ((size_t)(0 * 8 + b) * 6 + 1) * DM;
    const f32x4* xr = (const f32x4*)(P.x + (size_t)m * DM); bf16* A = (bf16*)(P.ws + WS_ABUF) + (size_t)m * DM;
    float s = 0.f;
#pragma unroll
    for (int j = 0; j < 8; ++j) { const f32x4 v = xr[lane + 64 * j]; const f32x4 g = *(const f32x4*)(gm + 4 * (lane + 64 * j));
        s += (v.x * v.x + v.y * v.y) + (v.z * v.z + v.w * v.w);
        u32x2 w; w.x = pk2(v.x * g.x, v.y * g.y); w.y = pk2(v.z * g.z, v.w * g.w); *(u32x2*)(A + 4 * (lane + 64 * j)) = w; }
    s = wave_sum(s);
    if (lane == 0) ((float*)(P.ws + WS_SSQ0))[m] = s;
}
__device__ __forceinline__ void shw_combo(const Params& P, int combo, int wgw, int nwg_waves, int gw, int ngw, int tid, int nthr, int lane, float* shl) {
    const int l = combo >> 1, which = combo & 1;
    const float* MV = (const float*)(P.ws + WS_MODV);
    for (int i = tid; i < 8 * DM; i += nthr) { const int b = i / DM, k = i % DM; shl[i] = MV[((size_t)(l * 8 + b) * 6 + (which ? 3 : 0)) * DM + k]; }
    __syncthreads();
    const int nrows = which ? NFFI : NIN + GRANK;
    for (int n = gw; n < nrows; n += ngw) {
        const bf16* row = which ? wt_ptr(P, l, WT_FFI) + (size_t)n * DM : (n < NIN ? wt_ptr(P, l, WT_IN) + (size_t)n * DM : wt_ptr(P, l, WT_GLR) + (size_t)(n - NIN) * DM);
        float acc[8];
#pragma unroll
        for (int b = 0; b < 8; ++b) acc[b] = 0.f;
#pragma unroll 1
        for (int j = 0; j < 4; ++j) { const int k0 = 8 * lane + 512 * j; const u32x4 w = *(const u32x4*)(row + k0);
            float wf[8]; wf[0] = bf2f(w.x & 0xffff); wf[1] = bf2f(w.x >> 16); wf[2] = bf2f(w.y & 0xffff); wf[3] = bf2f(w.y >> 16); wf[4] = bf2f(w.z & 0xffff); wf[5] = bf2f(w.z >> 16); wf[6] = bf2f(w.w & 0xffff); wf[7] = bf2f(w.w >> 16);
#pragma unroll
            for (int b = 0; b < 8; ++b) { const f32x4 s0 = *(const f32x4*)(shl + b * DM + k0), s1 = *(const f32x4*)(shl + b * DM + k0 + 4);
                acc[b] += (s0.x * wf[0] + s0.y * wf[1]) + (s0.z * wf[2] + s0.w * wf[3]) + (s1.x * wf[4] + s1.y * wf[5]) + (s1.z * wf[6] + s1.w * wf[7]); } }
#pragma unroll
        for (int b = 0; b < 8; ++b) acc[b] = wave_sum(acc[b]);
        if (lane == 0) {
#pragma unroll
            for (int b = 0; b < 8; ++b) {
                if (which) ((float*)(P.ws + WS_SHWFFI))[((size_t)l * 8 + b) * NFFI + n] = acc[b];
                else if (n < NIN) ((float*)(P.ws + WS_SHWIN))[((size_t)l * 8 + b) * NIN + n] = acc[b];
                else ((float*)(P.ws + WS_SHWGLR))[((size_t)l * 8 + b) * GRANK + (n - NIN)] = acc[b]; } }
    }
    __syncthreads();
}

namespace pg8 {
#define PG8_LAS __attribute__((address_space(3)))
typedef unsigned short bf16_t;
typedef short bf16x8 __attribute__((ext_vector_type(8)));
typedef float f32x4 __attribute__((ext_vector_type(4)));
typedef unsigned u32x4 __attribute__((ext_vector_type(4)));
constexpr int BM = 256, BK = 64, HALF = 128, HTB = HALF * BK * 2  , STAGE_BYTES = 8 * HTB, NXCD = 8, WGM = 8;

__host__ __device__ __forceinline__ int lds_byte(int r, int c) { const int st = (r >> 4) * 2 + (c >> 5), rr = r & 15, cc = c & 31, ob = rr * 64 + cc * 2; return st * 1024 + (ob ^ (((ob >> 9) & 1) << 5)); }
__host__ __device__ __forceinline__ void stage_rc(int b, int& R, int& C) { const int st = b / 1024, sb = b % 1024, swz = sb ^ (((sb >> 9) & 1) << 5); R = (st >> 1) * 16 + swz / 64; C = (st & 1) * 32 + (swz % 64) / 2; }
__host__ __device__ __forceinline__ int perm32(int rho) { const int n = rho >> 4, i = rho & 15; return 8 * (i >> 2) + 4 * n + (i & 3); }

struct Unit { int pm, pn; };
struct Gemm { const bf16_t* A; const bf16_t* Bt; int M, N, K; };

struct StaticOrder {
    int nM, nN, nwg, G, c;
    __host__ __device__ void init(int M, int N, int G_, int c_) { nM = M / BM; nN = N / BM; nwg = nM * nN; G = G_; c = c_; }
    __host__ __device__ bool next(int i, Unit& u) const {
        const long L = (long)i * G + c; if (L >= nwg) return false;
        int wgid = (int)L; { const int q = nwg / NXCD, r = nwg % NXCD, xcd = wgid % NXCD, off = wgid / NXCD; wgid = (xcd < r ? xcd * (q + 1) : r * (q + 1) + (xcd - r) * q) + off; }
        const int nig = WGM * nN, gid = wgid / nig, fm = gid * WGM, gsz = (nM - fm) < WGM ? (nM - fm) : WGM;
        u.pm = fm + ((wgid % nig) % gsz); u.pn = (wgid % nig) / gsz; return true;
    }
    __device__ __forceinline__ void a_ready(const Unit&) const {}
    __device__ __forceinline__ void done(const Unit&) const {}
};
__device__ __forceinline__ unsigned cvt_pk_bf16(float lo, float hi) { unsigned r; asm volatile("v_cvt_pk_bf16_f32 %0, %1, %2" : "=v"(r) : "v"(lo), "v"(hi)); return r; }
typedef float f32x2 __attribute__((ext_vector_type(2)));
__device__ __forceinline__ float fsig(float v) { return __builtin_amdgcn_rcpf(1.0f + __builtin_amdgcn_exp2f(-1.4426950408889634f * v)); }
__device__ __forceinline__ float bflo(unsigned w) { return __builtin_bit_cast(float, w << 16); }
__device__ __forceinline__ float bfhi(unsigned w) { return __builtin_bit_cast(float, w & 0xffff0000u); }
struct EpiIn {
    static constexpr bool PERM = true, AFTER_DRAIN = false;
    const float* ssq; const float* shw; bf16_t* proj;
    __device__ __forceinline__ void operator()(const f32x4 (&acc)[2][2][4][2], const Unit& u, int wr, int wc, int fr, int fq) const {
        const int row0 = u.pm * BM + wr * 64 + fr, col0 = u.pn * BM + wc * 32 + 8 * fq, b = u.pm >> 3;
        const int mode = u.pn < 2 ? 1 : ((u.pn >= 8 && u.pn < 12) ? 2 : (u.pn >= 24 ? 3 : 0));
        f32x4 bv[2][2];
#pragma unroll
        for (int bj = 0; bj < 2; ++bj)
#pragma unroll
            for (int n = 0; n < 2; ++n) bv[bj][n] = *(const f32x4*)(shw + (size_t)b * NIN + col0 + bj * HALF + 4 * n);
#pragma unroll
        for (int ai = 0; ai < 2; ++ai)
#pragma unroll
            for (int m = 0; m < 4; ++m) { const int r = row0 + ai * HALF + m * 16; const float rstd = rsqrtf(ssq[r] * (1.0f / DM) + EPS);
                bf16_t* rowp = proj + (size_t)r * NIN + col0;
#pragma unroll
                for (int bj = 0; bj < 2; ++bj) { f32x4 v0 = acc[ai][bj][m][0] * rstd + bv[bj][0], v1 = acc[ai][bj][m][1] * rstd + bv[bj][1];
                    if (mode == 1) { v0 = v0 * 0.08838834764831845f; v1 = v1 * 0.08838834764831845f; }
                    else if (mode == 2) {
#pragma unroll
                        for (int j = 0; j < 4; ++j) { v0[j] = v0[j] * fsig(v0[j]); v1[j] = v1[j] * fsig(v1[j]); } }
                    else if (mode == 3) {
#pragma unroll
                        for (int j = 0; j < 4; ++j) { v0[j] = fsig(v0[j]); v1[j] = fsig(v1[j]); } }
                    u32x4 w; w.x = cvt_pk_bf16(v0[0], v0[1]); w.y = cvt_pk_bf16(v0[2], v0[3]); w.z = cvt_pk_bf16(v1[0], v1[1]); w.w = cvt_pk_bf16(v1[2], v1[3]);
                    *(u32x4*)(rowp + bj * HALF) = w; } }
    }
};
struct EpiFfi {
    static constexpr bool PERM = true, AFTER_DRAIN = false;
    const float* ssq; const float* shw; bf16_t* hid;
    __device__ __forceinline__ void operator()(const f32x4 (&acc)[2][2][4][2], const Unit& u, int wr, int wc, int fr, int fq) const {
        const int row0 = u.pm * BM + wr * 64 + fr, bcol0 = u.pn * BM + wc * 32 + 8 * fq, hcol0 = u.pn * HALF + wc * 32 + 8 * fq, b = u.pm >> 3;
        f32x4 bv[2][2];
#pragma unroll
        for (int bj = 0; bj < 2; ++bj)
#pragma unroll
            for (int n = 0; n < 2; ++n) bv[bj][n] = *(const f32x4*)(shw + (size_t)b * NFFI + bcol0 + bj * HALF + 4 * n);
#pragma unroll
        for (int ai = 0; ai < 2; ++ai)
#pragma unroll
            for (int m = 0; m < 4; ++m) { const int r = row0 + ai * HALF + m * 16; const float rstd = rsqrtf(ssq[r] * (1.0f / DM) + EPS);
                f32x4 a0 = acc[ai][0][m][0] * rstd + bv[0][0], a1 = acc[ai][0][m][1] * rstd + bv[0][1];
                const f32x4 u0 = acc[ai][1][m][0] * rstd + bv[1][0], u1 = acc[ai][1][m][1] * rstd + bv[1][1];
#pragma unroll
                for (int j = 0; j < 4; ++j) { a0[j] = a0[j] * fsig(a0[j]) * u0[j]; a1[j] = a1[j] * fsig(a1[j]) * u1[j]; }
                u32x4 w; w.x = cvt_pk_bf16(a0[0], a0[1]); w.y = cvt_pk_bf16(a0[2], a0[3]); w.z = cvt_pk_bf16(a1[0], a1[1]); w.w = cvt_pk_bf16(a1[2], a1[3]);
                *(u32x4*)(hid + (size_t)r * DFF + hcol0) = w; }
    }
};
template <bool SECOND> struct EpiUp {
    static constexpr bool PERM = true, AFTER_DRAIN = false;
    const bf16_t* proj; int goff; bf16_t* mg;
    __device__ __forceinline__ void operator()(const f32x4 (&acc)[2][2][4][2], const Unit& u, int wr, int wc, int fr, int fq) const {
        const int row0 = u.pm * BM + wr * 64 + fr, col0 = u.pn * BM + wc * 32 + 8 * fq;
#pragma unroll
        for (int ai = 0; ai < 2; ++ai)
#pragma unroll
            for (int m = 0; m < 4; ++m) { const int r = row0 + ai * HALF + m * 16;
#pragma unroll
                for (int bj = 0; bj < 2; ++bj) { const u32x4 g = *(const u32x4*)(proj + (size_t)r * NIN + goff + col0 + bj * HALF);
                    bf16_t* op = mg + (size_t)r * DM + col0 + bj * HALF;
                    f32x4 v0 = acc[ai][bj][m][0], v1 = acc[ai][bj][m][1];
                    v0[0] *= bflo(g.x); v0[1] *= bfhi(g.x); v0[2] *= bflo(g.y); v0[3] *= bfhi(g.y); v1[0] *= bflo(g.z); v1[1] *= bfhi(g.z); v1[2] *= bflo(g.w); v1[3] *= bfhi(g.w);
                    if (SECOND) { const u32x4 t = *(const u32x4*)op;
                        v0[0] += bflo(t.x); v0[1] += bfhi(t.x); v0[2] += bflo(t.y); v0[3] += bfhi(t.y); v1[0] += bflo(t.z); v1[1] += bfhi(t.z); v1[2] += bflo(t.w); v1[3] += bfhi(t.w); }
                    u32x4 w; w.x = cvt_pk_bf16(v0[0], v0[1]); w.y = cvt_pk_bf16(v0[2], v0[3]); w.z = cvt_pk_bf16(v1[0], v1[1]); w.w = cvt_pk_bf16(v1[2], v1[3]);
                    *(u32x4*)op = w; }
                asm volatile("" ::: "memory"); }
    }
};
struct EpiRes {
    static constexpr bool PERM = false, AFTER_DRAIN = false;
    const float* xin; float* xout; const float* gate; const float* gm; bf16_t* aout; float* ssq;
    __device__ __forceinline__ void operator()(const f32x4 (&acc)[2][2][4][2], const Unit& u, int wr, int wc, int fr, int fq) const {
        const int row0 = u.pm * BM + wr * 64 + fr, col0 = u.pn * BM + wc * 32 + 4 * fq, b = u.pm >> 3;
        f32x4 gv[2][2], mv[2][2];
#pragma unroll
        for (int bj = 0; bj < 2; ++bj)
#pragma unroll
            for (int n = 0; n < 2; ++n) { gv[bj][n] = *(const f32x4*)(gate + (size_t)b * 6 * DM + col0 + bj * HALF + n * 16);
                mv[bj][n] = aout ? *(const f32x4*)(gm + (size_t)b * 6 * DM + col0 + bj * HALF + n * 16) : (f32x4){0.f, 0.f, 0.f, 0.f}; }
#pragma unroll
        for (int ai = 0; ai < 2; ++ai)
#pragma unroll
            for (int m = 0; m < 4; ++m) { const int r = row0 + ai * HALF + m * 16; const size_t off = (size_t)r * DM + col0; float s = 0.f;
#pragma unroll
                for (int bj = 0; bj < 2; ++bj)
#pragma unroll
                    for (int n = 0; n < 2; ++n) { const f32x4 xv = *(const f32x4*)(xin + off + bj * HALF + n * 16); const f32x4 o = xv + gv[bj][n] * acc[ai][bj][m][n];
                        *(f32x4*)(xout + off + bj * HALF + n * 16) = o; s += (o[0] * o[0] + o[1] * o[1]) + (o[2] * o[2] + o[3] * o[3]);
                        if (aout) { const f32x4 a = o * mv[bj][n]; u32x2 w; w.x = cvt_pk_bf16(a[0], a[1]); w.y = cvt_pk_bf16(a[2], a[3]); *(u32x2*)(aout + off + bj * HALF + n * 16) = w; } }
                if (ssq) { s += __shfl_xor(s, 16); s += __shfl_xor(s, 32); if (fq == 0) __hip_atomic_fetch_add(ssq + r, s, __ATOMIC_RELAXED, __HIP_MEMORY_SCOPE_AGENT); }
                asm volatile("" ::: "memory"); }
    }
};
template <class Epi, class Sched, bool ALIGN_EPI = false, bool SP2 = false>
__device__ __forceinline__ void gemm_phase(PG8_LAS unsigned char* lds, const Gemm g, const Sched& S, const Epi& E) {
    int tid_ = threadIdx.x; asm volatile("" : "+v"(tid_));
    const int tid = tid_, wid = __builtin_amdgcn_readfirstlane(tid >> 6), lane = tid & 63, wr = wid >> 2, wc = wid & 3, fr = lane & 15, fq = lane >> 4;
    const int K = g.K, nt = K / BK;
    unsigned voffA[2], voffB[2];
#pragma unroll
    for (int i = 0; i < 2; ++i) { int R, C; stage_rc(tid * 16 + i * 8192, R, C); const int Rb = Epi::PERM ? ((R & ~31) + perm32(R & 31)) : R;
        voffA[i] = (unsigned)(R * K + C) * 2u; voffB[i] = (unsigned)(Rb * K + C) * 2u; }
    const size_t kstep = (size_t)(BK * 2);
    const size_t hstep = (size_t)HALF * K * 2;
    const size_t tstep = 2 * hstep;
    const unsigned ldsw = (unsigned)wid * 1024u;
    const int aoff = lds_byte(wr * 64 + fr, fq * 8), boff = lds_byte(wc * 32 + fr, fq * 8);
#define PG8_SA(b, h) (((b) * 2 + (h)) * HTB)
#define PG8_SB(b, h) ((4 + (b) * 2 + (h)) * HTB)
#define PG8_STAGE(bufoff, gbase, voff) do { _Pragma("unroll") for (int _i = 0; _i < 2; ++_i) \
        __builtin_amdgcn_global_load_lds((const unsigned*)((const char*)(gbase) + (voff)[_i]), (PG8_LAS unsigned*)(lds + (bufoff) + ldsw + _i * 8192), 16, 0, 0); } while (0)
#define PG8_LDA(dst, b, h) do { _Pragma("unroll") for (int m = 0; m < 4; ++m) _Pragma("unroll") for (int k = 0; k < 2; ++k) dst[m][k] = *(const PG8_LAS bf16x8*)(lds + PG8_SA(b, h) + aoff + m * 2048 + k * 1024); } while (0)
#define PG8_LDB(dst, b, h) do { _Pragma("unroll") for (int n = 0; n < 2; ++n) _Pragma("unroll") for (int k = 0; k < 2; ++k) dst[n][k] = *(const PG8_LAS bf16x8*)(lds + PG8_SB(b, h) + boff + n * 2048 + k * 1024); } while (0)
#define PG8_MMA(ai, bj, At, Bt) do { __builtin_amdgcn_s_setprio(1); _Pragma("unroll") for (int m = 0; m < 4; ++m) _Pragma("unroll") for (int n = 0; n < 2; ++n) _Pragma("unroll") for (int k = 0; k < 2; ++k) \
        acc[ai][bj][m][n] = __builtin_amdgcn_mfma_f32_16x16x32_bf16(Bt[n][k], At[m][k], acc[ai][bj][m][n], 0, 0, 0); __builtin_amdgcn_s_setprio(0); } while (0)
#define PG8_WAIT_V(n) asm volatile("s_waitcnt vmcnt(" #n ")" ::: "memory")
#define PG8_WAIT_L(n) asm volatile("s_waitcnt lgkmcnt(" #n ")" ::: "memory")
#define PG8_BAR __builtin_amdgcn_s_barrier()
#define PG8_SCHED __builtin_amdgcn_sched_barrier(0)
    Unit cur, nxt; int ui = 0;
    if (!S.next(0, cur)) return;
    f32x4 acc[2][2][4][2];
#pragma unroll
    for (int a = 0; a < 2; ++a)
#pragma unroll
        for (int b = 0; b < 2; ++b)
#pragma unroll
            for (int m = 0; m < 4; ++m)
#pragma unroll
                for (int n = 0; n < 2; ++n) acc[a][b][m][n] = (f32x4){0.f, 0.f, 0.f, 0.f};
    bf16x8 At[4][2], B0[2][2], B1[2][2];
    const char* cA = (const char*)g.A + (size_t)cur.pm * tstep; const char* cB = (const char*)g.Bt + (size_t)cur.pn * tstep;
    S.a_ready(cur);
    if constexpr (SP2) {
        PG8_STAGE(PG8_SB(0, 0), cB, voffB); PG8_STAGE(PG8_SB(0, 1), cB + hstep, voffB); PG8_STAGE(PG8_SA(0, 0), cA, voffA); PG8_STAGE(PG8_SA(0, 1), cA + hstep, voffA);
        if (wr == 1) PG8_BAR;
        PG8_WAIT_V(2); PG8_BAR;
        PG8_STAGE(PG8_SB(1, 0), cB + kstep, voffB); PG8_STAGE(PG8_SA(1, 0), cA + kstep, voffA); PG8_STAGE(PG8_SB(1, 1), cB + hstep + kstep, voffB);
        PG8_WAIT_V(6); PG8_BAR;
    } else {
        PG8_STAGE(PG8_SB(0, 0), cB, voffB); PG8_STAGE(PG8_SA(0, 0), cA, voffA); PG8_STAGE(PG8_SB(0, 1), cB + hstep, voffB); PG8_STAGE(PG8_SA(0, 1), cA + hstep, voffA);
        if (wr == 1) PG8_BAR;
        PG8_WAIT_V(4); PG8_BAR;
        PG8_STAGE(PG8_SB(1, 0), cB + kstep, voffB); PG8_STAGE(PG8_SA(1, 0), cA + kstep, voffA); PG8_STAGE(PG8_SB(1, 1), cB + hstep + kstep, voffB);
        PG8_WAIT_V(6); PG8_BAR;
    }
    for (;;) {
        const bool has_next = S.next(ui + 1, nxt);
        const char* nA = has_next ? (const char*)g.A + (size_t)nxt.pm * tstep : cA; const char* nB = has_next ? (const char*)g.Bt + (size_t)nxt.pn * tstep : cB;
        for (int t = 0; t < nt; t += 2) {
            const bool last = (t == nt - 2);
            const char* a1 = cA + (size_t)(t + 1) * kstep;
            const char* a2 = last ? nA : cA + (size_t)(t + 2) * kstep; const char* b2 = last ? nB : cB + (size_t)(t + 2) * kstep;
            const char* a3 = a2 + kstep; const char* b3 = b2 + kstep;
            if (last && has_next) S.a_ready(nxt);
            if constexpr (SP2) {
            PG8_LDB(B0, 0, 0); PG8_LDB(B1, 0, 1); PG8_SCHED; PG8_LDA(At, 0, 0); PG8_STAGE(PG8_SA(1, 1), a1 + hstep, voffA);
            PG8_WAIT_V(8); PG8_WAIT_L(0); PG8_BAR; PG8_MMA(0, 0, At, B0); PG8_MMA(0, 1, At, B1); PG8_BAR; PG8_SCHED;
            PG8_LDA(At, 0, 1); PG8_STAGE(PG8_SB(0, 0), b2, voffB); PG8_STAGE(PG8_SB(0, 1), b2 + hstep, voffB); PG8_STAGE(PG8_SA(0, 0), a2, voffA);
            PG8_WAIT_V(8); PG8_WAIT_L(0); PG8_BAR; PG8_MMA(1, 0, At, B0); PG8_MMA(1, 1, At, B1); PG8_BAR; PG8_SCHED;
            PG8_LDB(B0, 1, 0); PG8_LDB(B1, 1, 1); PG8_SCHED; PG8_LDA(At, 1, 0); PG8_STAGE(PG8_SA(0, 1), a2 + hstep, voffA);
            PG8_WAIT_V(8); PG8_WAIT_L(0); PG8_BAR; PG8_MMA(0, 0, At, B0); PG8_MMA(0, 1, At, B1); PG8_BAR; PG8_SCHED;
            PG8_LDA(At, 1, 1); PG8_STAGE(PG8_SB(1, 0), b3, voffB); PG8_STAGE(PG8_SB(1, 1), b3 + hstep, voffB); PG8_STAGE(PG8_SA(1, 0), a3, voffA);
            PG8_WAIT_V(8); PG8_WAIT_L(0); PG8_BAR; PG8_MMA(1, 0, At, B0); PG8_MMA(1, 1, At, B1); PG8_BAR; PG8_SCHED;
            } else {
            PG8_LDB(B0, 0, 0); PG8_SCHED; PG8_LDA(At, 0, 0); PG8_STAGE(PG8_SA(1, 1), a1 + hstep, voffA);
            PG8_WAIT_L(8); PG8_BAR; PG8_WAIT_L(0); PG8_MMA(0, 0, At, B0); PG8_BAR; PG8_SCHED;
            PG8_LDB(B1, 0, 1); PG8_STAGE(PG8_SB(0, 0), b2, voffB);
            PG8_BAR; PG8_WAIT_L(0); PG8_MMA(0, 1, At, B1); PG8_BAR;
            PG8_LDA(At, 0, 1); PG8_STAGE(PG8_SA(0, 0), a2, voffA);
            PG8_BAR; PG8_WAIT_L(0); PG8_MMA(1, 0, At, B0); PG8_BAR; PG8_SCHED;
            PG8_STAGE(PG8_SB(0, 1), b2 + hstep, voffB);
            PG8_WAIT_V(6); PG8_BAR; PG8_MMA(1, 1, At, B1); PG8_BAR;
            PG8_LDB(B0, 1, 0); PG8_SCHED; PG8_LDA(At, 1, 0); PG8_STAGE(PG8_SA(0, 1), a2 + hstep, voffA);
            PG8_WAIT_L(8); PG8_BAR; PG8_WAIT_L(0); PG8_MMA(0, 0, At, B0); PG8_BAR; PG8_SCHED;
            PG8_LDB(B1, 1, 1); PG8_STAGE(PG8_SB(1, 0), b3, voffB);
            PG8_BAR; PG8_WAIT_L(0); PG8_MMA(0, 1, At, B1); PG8_BAR;
            PG8_LDA(At, 1, 1); PG8_STAGE(PG8_SA(1, 0), a3, voffA);
            PG8_BAR; PG8_WAIT_L(0); PG8_MMA(1, 0, At, B0); PG8_BAR; PG8_SCHED;
            PG8_STAGE(PG8_SB(1, 1), b3 + hstep, voffB);
            PG8_WAIT_V(6); PG8_BAR; PG8_MMA(1, 1, At, B1); PG8_BAR;
            }
        }
        if constexpr (ALIGN_EPI) { if (wr == 0) PG8_BAR; }
        if constexpr (!Epi::AFTER_DRAIN) { E(acc, cur, wr, wc, fr, fq); S.done(cur); }
        if (!has_next) break;
#pragma unroll
        for (int a = 0; a < 2; ++a)
#pragma unroll
            for (int b = 0; b < 2; ++b)
#pragma unroll
                for (int m = 0; m < 4; ++m)
#pragma unroll
                    for (int n = 0; n < 2; ++n) acc[a][b][m][n] = (f32x4){0.f, 0.f, 0.f, 0.f};
        cur = nxt; cA = nA; cB = nB; ++ui;
        if constexpr (ALIGN_EPI) { if (wr == 1) PG8_BAR; }
    }
    PG8_WAIT_V(0);
    if constexpr (!ALIGN_EPI) { if (wr == 0) PG8_BAR; }
    PG8_BAR;
    if constexpr (Epi::AFTER_DRAIN) { E.fused(acc, cur, wr, wc, fr, fq, lds, wid, lane); S.done(cur); }
#undef PG8_SA
#undef PG8_SB
#undef PG8_STAGE
#undef PG8_LDA
#undef PG8_LDB
#undef PG8_MMA
#undef PG8_WAIT_V
#undef PG8_WAIT_L
#undef PG8_BAR
#undef PG8_SCHED
}
}
#define LAS __attribute__((address_space(3)))
#define XB_TMO      128
#define XB_XCNT(j)  (256  + 64 * (j))
#define XB_XSUB(j)  (1280 + 64 * (j))
#define XB_XGEN(j)  (2304 + 64 * (j))
#define XB_TOP      3328
#define XB_TOPGEN   3392
#define XCD_BAR_WORDS 3456
#define XB_SPIN_CAP (1u << 18)

__device__ __forceinline__ unsigned xb_ld(unsigned* p)              { return __hip_atomic_load(p, __ATOMIC_RELAXED, __HIP_MEMORY_SCOPE_AGENT); }
__device__ __forceinline__ unsigned xb_add(unsigned* p, unsigned v) { return __hip_atomic_fetch_add(p, v, __ATOMIC_RELAXED, __HIP_MEMORY_SCOPE_AGENT); }
__device__ __forceinline__ unsigned xb_xcc_id() { return (unsigned)__builtin_amdgcn_s_getreg((3 << 11) | 20) & 0xFu; }
#define XB_SPIN(cond, bar) do { unsigned _sp = 0; while (cond) { __builtin_amdgcn_s_sleep(1); \
    if ((++_sp & 255u) == 0u) { if (xb_ld(&(bar)[XB_TMO])) break; if (_sp > XB_SPIN_CAP) { atomicAdd(&(bar)[XB_TMO], 1u); break; } } } } while (0)

struct XcdBarrier {
    unsigned* bar; unsigned x;
    volatile LAS unsigned* st;
};

__device__ __forceinline__ XcdBarrier xcd_barrier_post(unsigned* bar, volatile LAS unsigned* st) {
    XcdBarrier b; b.bar = bar; b.x = xb_xcc_id(); b.st = st;
    if (threadIdx.x == 0) (void)xb_add(&bar[XB_XCNT(b.x)], 1u);
    return b;
}
__device__ __forceinline__ void xcd_barrier_complete(unsigned* bar, unsigned x, unsigned& nloc, unsigned& nx) {
    const unsigned G = gridDim.x * gridDim.y * gridDim.z;
    unsigned sum, cnt, mine, sp = 0u;
    for (;;) {
        sum = 0u; cnt = 0u; mine = 0u;
#pragma unroll
        for (unsigned j = 0; j < 16; ++j) { const unsigned c = xb_ld(&bar[XB_XCNT(j)]); sum += c; cnt += (c > 0u) ? 1u : 0u; mine = (j == x) ? c : mine; }
        if (sum == G) break;
        __builtin_amdgcn_s_sleep(1);
        if ((++sp & 255u) == 0u) { if (xb_ld(&bar[XB_TMO])) break; if (sp > XB_SPIN_CAP) { atomicAdd(&bar[XB_TMO], 1u); break; } }
    }
    nloc = mine > 0u ? mine : 1u; nx = cnt > 0u ? cnt : 1u;
}

__device__ __forceinline__ void xcd_barrier(const XcdBarrier& b) {
    asm volatile("s_waitcnt vmcnt(0)" ::: "memory");
    __syncthreads();
    if (threadIdx.x == 0) {
        unsigned* bar = b.bar;
        __builtin_amdgcn_s_waitcnt(0);
        unsigned nloc = b.st[0], nx = b.st[1];
        if (nloc == 0u) { xcd_barrier_complete(bar, b.x, nloc, nx); b.st[0] = nloc; b.st[1] = nx; }
        const unsigned old = xb_add(&bar[XB_XSUB(b.x)], 1u);
        const unsigned gen = old / nloc;
        if (old + 1u == (gen + 1u) * nloc) {
            __builtin_amdgcn_fence(__ATOMIC_RELEASE, "agent");
            asm volatile("s_waitcnt vmcnt(0)" ::: "memory");
            const unsigned og = xb_add(&bar[XB_TOP], 1u);
            const unsigned tg = og / nx;
            if (og + 1u == (tg + 1u) * nx) xb_add(&bar[XB_TOPGEN], 1u);
            else XB_SPIN(xb_ld(&bar[XB_TOPGEN]) == tg, bar);
            __builtin_amdgcn_fence(__ATOMIC_ACQUIRE, "agent");
            xb_add(&bar[XB_XGEN(b.x)], 1u);
            asm volatile("s_waitcnt vmcnt(0)" ::: "memory");
        } else {
            XB_SPIN(xb_ld(&bar[XB_XGEN(b.x)]) == gen, bar);
            __builtin_amdgcn_fence(__ATOMIC_ACQUIRE, "agent");
            asm volatile("s_waitcnt vmcnt(0)" ::: "memory");
        }
    }
    __syncthreads();
}
namespace moba {
constexpr int D = 128;
constexpr float THR = 8.f;
constexpr bool WSKIP = false;
constexpr int QP = NIN, KVP = NIN, OP = MW;
template <class A, class Bt> struct same_t { static constexpr bool v = false; };
template <class A> struct same_t<A, A> { static constexpr bool v = true; };
constexpr float SCALE = 0.08838834764831845f;
constexpr int NW = 8, QBLK = 32, KVBLK = 64, QB = NW * QBLK;
constexpr int SHM_V = KVBLK * D * 2, SHM_K = KVBLK * D * 2;
constexpr int LDS_BYTES = 2 * SHM_V + 2 * SHM_K + NW * 64 * 4;
using bf16 = unsigned short;
typedef short bf16x8 __attribute__((ext_vector_type(8)));
typedef short s16x4 __attribute__((ext_vector_type(4)));
typedef float f32x16 __attribute__((ext_vector_type(16)));
typedef float f32x4 __attribute__((ext_vector_type(4)));
typedef unsigned u32x4 __attribute__((ext_vector_type(4)));
#define KSWZ(row, colB) ((row) * 256 + ((colB) ^ (((row) & 7) << 4)))
#define SBAR() __builtin_amdgcn_sched_barrier(0)
__device__ __forceinline__ int v_st(int k, int c) { const int kk = (k & ~0xC) | ((k & 4) << 1) | ((k & 8) >> 1); return ((kk >> 3) * 4 + (c >> 5)) * 512 + ((kk & 7) * 32 + (c & 31)) * 2; }
__device__ __forceinline__ int v_rd_base(int lane) { return ((lane & 3) << 3) | (((lane >> 2) & 3) << 6) | (((lane >> 4) & 1) << 5) | (((lane >> 5) & 1) << 8); }
constexpr int v_rd_off(int d0, int ks, int half) { return d0 * 512 + ks * 4096 + half * 2048; }
__device__ __forceinline__ int crow(int r, int hi) { return (r & 3) + 8 * (r >> 2) + 4 * hi; }
__device__ __forceinline__ unsigned cvtpk(float lo, float hi) {
    unsigned r; asm volatile("v_cvt_pk_bf16_f32 %0, %1, %2" : "=v"(r) : "v"(lo), "v"(hi)); return r;
}
__device__ __forceinline__ bf16x8 pack8(f32x4 a, f32x4 b) {
    u32x4 w = {cvtpk(a[0], a[1]), cvtpk(a[2], a[3]), cvtpk(b[0], b[1]), cvtpk(b[2], b[3])};
    return *reinterpret_cast<bf16x8*>(&w);
}
template <class T> __device__ __forceinline__ bf16x8 load8(const T* p) {
    if constexpr (same_t<T, float>::v) { return pack8(*(const f32x4*)p, *(const f32x4*)(p + 4)); }
    else { return *reinterpret_cast<const bf16x8*>(p); }
}
__device__ __forceinline__ void mask_tile(f32x16& p0, f32x16& p1, int dq, unsigned W) {
    const float NEG = -__builtin_inff();
#pragma unroll
    for (int r = 0; r < 16; ++r) {
        const int c = (r & 3) + 8 * (r >> 2);
        if ((unsigned)(dq - c) >= W) p0[r] = NEG;
        if ((unsigned)(dq - c - 32) >= W) p1[r] = NEG;
    }
}
__device__ __forceinline__ void partialSM(f32x16& p0, f32x16& p1, float& m_reg, float& mn, float& alpha) {
    float pmax = p0[0]; for (int r = 1; r < 16; ++r) pmax = fmaxf(pmax, p0[r]); for (int r = 0; r < 16; ++r) pmax = fmaxf(pmax, p1[r]);
    { auto rr = __builtin_amdgcn_permlane32_swap(__float_as_uint(pmax), __float_as_uint(pmax), false, false);
      pmax = fmaxf(__uint_as_float(rr[0]), __uint_as_float(rr[1])); }
    constexpr float C2 = 1.4426950408889634f * SCALE;
    if (__builtin_expect(__all((pmax - m_reg) * SCALE <= THR), 1)) { mn = m_reg; alpha = 1.f; }
    else { mn = fmaxf(m_reg, pmax); alpha = __builtin_amdgcn_exp2f((m_reg - mn) * C2); m_reg = mn; }
    const float mnL = -mn * C2;
    for (int r = 0; r < 16; ++r) p0[r] = fmaf(p0[r], C2, mnL); for (int r = 0; r < 16; ++r) p1[r] = fmaf(p1[r], C2, mnL);
    for (int r = 0; r < 16; ++r) p0[r] = __builtin_amdgcn_exp2f(p0[r]);
}
__device__ __forceinline__ void finishSM(f32x16& p0, f32x16& p1, float alpha, float& l_reg, bf16x8& pa0, bf16x8& pa1, bf16x8& pa2, bf16x8& pa3) {
    for (int r = 0; r < 16; ++r) p1[r] = __builtin_amdgcn_exp2f(p1[r]);
    float ps = 0; for (int r = 0; r < 16; ++r) ps += p0[r]; for (int r = 0; r < 16; ++r) ps += p1[r];
    { auto rr = __builtin_amdgcn_permlane32_swap(__float_as_uint(ps), __float_as_uint(ps), false, false);
      ps = __uint_as_float(rr[0]) + __uint_as_float(rr[1]); }
    l_reg = l_reg * alpha + ps;
#define PK4(P, B_, OUT) do { unsigned a0 = cvtpk(P[B_+0], P[B_+1]), a1 = cvtpk(P[B_+2], P[B_+3]);                          \
        unsigned b0 = cvtpk(P[B_+4], P[B_+5]), b1 = cvtpk(P[B_+6], P[B_+7]);                                             \
        auto r0 = __builtin_amdgcn_permlane32_swap(a0, b0, false, false); auto r1 = __builtin_amdgcn_permlane32_swap(a1, b1, false, false); \
        u32x4 w = {r0[0], r1[0], r0[1], r1[1]}; OUT = *reinterpret_cast<bf16x8*>(&w); } while (0)
    PK4(p0, 0, pa0); PK4(p0, 8, pa1); PK4(p1, 0, pa2); PK4(p1, 8, pa3);
#undef PK4
}
template <int KB, bool SK>
__device__ __forceinline__ void qkt(f32x16& p0, f32x16& p1, const char* K_lds, int r32, int hi, const bf16x8* qr, bool act) {
    if (SK && !act) { const float NEG = -__builtin_inff();
#pragma unroll
        for (int r = 0; r < 16; ++r) { p0[r] = NEG; p1[r] = NEG; } return; }
    p0 = f32x16{}; p1 = f32x16{};
    const char* kb[4];
#pragma unroll
    for (int dd = 0; dd < 4; ++dd) kb[dd] = K_lds + KB * SHM_K + KSWZ(r32, (dd * 16 + hi * 8) * 2);
#pragma unroll
    for (int d0 = 0; d0 < 8; ++d0) { const char* a = kb[d0 & 3] + (d0 >> 2) * 128;
        bf16x8 b0 = *reinterpret_cast<const bf16x8*>(a);
        bf16x8 b1 = *reinterpret_cast<const bf16x8*>(a + 32 * 256);
        p0 = __builtin_amdgcn_mfma_f32_32x32x16_bf16(b0, qr[d0], p0, 0, 0, 0);
        p1 = __builtin_amdgcn_mfma_f32_32x32x16_bf16(b1, qr[d0], p1, 0, 0, 0); }
}
template <int VB, bool SK>
__device__ __forceinline__ void pv_tile(f32x16* o, int vb0, bf16x8 pa0, bf16x8 pa1, bf16x8 pa2, bf16x8 pa3, bool act) {
    if (SK && !act) return;
#define TRRD(dst, off) asm volatile("ds_read_b64_tr_b16 %0, %1 offset:%2" : "=&v"(dst) : "v"(vb0), "i"(off) : "memory")
#define PV_D0(d0) do { s16x4 l0, l1, l2, l3, h0, h1, h2, h3; constexpr int b_ = VB * SHM_V + v_rd_off(d0, 0, 0);     \
        TRRD(l0, b_); TRRD(h0, b_ + 2048); TRRD(l1, b_ + 4096); TRRD(h1, b_ + 6144); TRRD(l2, b_ + 8192); TRRD(h2, b_ + 10240); TRRD(l3, b_ + 12288); TRRD(h3, b_ + 14336); \
        asm volatile("s_waitcnt lgkmcnt(0)" ::: "memory"); SBAR();                 \
        o[d0] = __builtin_amdgcn_mfma_f32_32x32x16_bf16(pa0, (bf16x8){l0[0], l0[1], l0[2], l0[3], h0[0], h0[1], h0[2], h0[3]}, o[d0], 0, 0, 0);   \
        o[d0] = __builtin_amdgcn_mfma_f32_32x32x16_bf16(pa1, (bf16x8){l1[0], l1[1], l1[2], l1[3], h1[0], h1[1], h1[2], h1[3]}, o[d0], 0, 0, 0);   \
        o[d0] = __builtin_amdgcn_mfma_f32_32x32x16_bf16(pa2, (bf16x8){l2[0], l2[1], l2[2], l2[3], h2[0], h2[1], h2[2], h2[3]}, o[d0], 0, 0, 0);   \
        o[d0] = __builtin_amdgcn_mfma_f32_32x32x16_bf16(pa3, (bf16x8){l3[0], l3[1], l3[2], l3[3], h3[0], h3[1], h3[2], h3[3]}, o[d0], 0, 0, 0); } while (0)
    PV_D0(0); PV_D0(1); PV_D0(2); PV_D0(3);
#undef PV_D0
#undef TRRD
}
__device__ __forceinline__ float bfv(short s) { return __builtin_bit_cast(float, ((unsigned)(unsigned short)s) << 16); }
__device__ __forceinline__ void sel_fill(f32x16& p0, f32x16& p1, bool ok) { const float NEG = -__builtin_inff();
#pragma unroll
    for (int r = 0; r < 16; ++r) { p0[r] = ok ? p0[r] : NEG; p1[r] = ok ? p1[r] : NEG; } }
template <class TIn, class TOut> struct BlockRef { const TIn* Q; const TIn* K; const TIn* V; TOut* O; int P0; const float* km; int qb; };
template <class TIn> struct Seam {
    bf16x8 qr[8];
    bf16x8 st_v0, st_v1, st_k0, st_k1; f32x4 sf0, sf1, sf2, sf3;
    f32x4 tq[16];
};
__device__ __forceinline__ int swa_jlo(int P0, int W) { const int lowk = P0 - W + 1; return lowk > 0 ? lowk / KVBLK : 0; }
#define ROW(p, k0, rr) ((p) + (size_t)((k0) + (rr)) * KVP + sc)
#define VMW() asm volatile("s_waitcnt vmcnt(0)" ::: "memory")
#define VMWN(n) asm volatile("s_waitcnt vmcnt(%0)" :: "i"(n) : "memory")
#define SLOAD_H(Kp, Vp, k0) do { S.st_v0 = load8<TIn>(ROW(Vp, k0, sr)); S.st_v1 = load8<TIn>(ROW(Vp, k0, 32 + sr));              \
                         S.st_k0 = load8<TIn>(ROW(Kp, k0, sr)); S.st_k1 = load8<TIn>(ROW(Kp, k0, 32 + sr)); } while (0)
#define SWRITE_HK(bf) do { *(bf16x8*)(K_lds + (bf) * SHM_K + kws) = S.st_k0; *(bf16x8*)(K_lds + (bf) * SHM_K + kws + 32 * 256) = S.st_k1; } while (0)
#define SWRITE_HV(bf) do { *(bf16x8*)(V_lds + (bf) * SHM_V + vst0) = S.st_v0; *(bf16x8*)(V_lds + (bf) * SHM_V + vst1) = S.st_v1; } while (0)
#define SWRITE_H(bf) do { SWRITE_HV(bf); SWRITE_HK(bf); } while (0)
#define SLOAD_F(p, k0) do { S.sf0 = *(const f32x4*)ROW(p, k0, sr); S.sf1 = *(const f32x4*)(ROW(p, k0, sr) + 4);                \
                            S.sf2 = *(const f32x4*)ROW(p, k0, 32 + sr); S.sf3 = *(const f32x4*)(ROW(p, k0, 32 + sr) + 4); } while (0)
#define SWRITE_KF(bf) do { *(bf16x8*)(K_lds + (bf) * SHM_K + kws) = pack8(S.sf0, S.sf1); *(bf16x8*)(K_lds + (bf) * SHM_K + kws + 32 * 256) = pack8(S.sf2, S.sf3); } while (0)
#define SWRITE_VF(bf) do { *(bf16x8*)(V_lds + (bf) * SHM_V + vst0) = pack8(S.sf0, S.sf1); *(bf16x8*)(V_lds + (bf) * SHM_V + vst1) = pack8(S.sf2, S.sf3); } while (0)
template <class TIn, class TOut>
__device__ __forceinline__ void causal_swa_prime(const BlockRef<TIn, TOut>& cur, int W, char* lds, Seam<TIn>& S) {
    constexpr bool F32 = same_t<TIn, float>::v;
    int tid_o = threadIdx.x; asm volatile("" : "+v"(tid_o));
    const int tid = tid_o, wid = __builtin_amdgcn_readfirstlane(tid >> 6), lane = tid & 63, r32 = lane & 31, hi = lane >> 5;
    const int sr = tid >> 4, sc = (tid & 15) * 8, kws = KSWZ(sr, sc * 2); char* K_lds = lds + 2 * SHM_V;
    const int kb0 = swa_jlo(cur.P0, W) * KVBLK;
    for (int d0 = 0; d0 < 8; ++d0) S.qr[d0] = load8<TIn>(cur.Q + (size_t)(wid * QBLK + r32) * QP + d0 * 16 + hi * 8);
    if constexpr (F32) { SLOAD_F((const float*)cur.K, kb0); VMW(); SWRITE_KF(0); SBAR(); SLOAD_F((const float*)cur.V, kb0); }
    else { SLOAD_H(cur.K, cur.V, kb0); VMW(); SWRITE_HK(0); }
    __syncthreads();
}
template <class TIn, class TOut>
__device__ __forceinline__ void causal_swa_block(const BlockRef<TIn, TOut>& cur, const BlockRef<TIn, TOut>& nxt, int skv, int W, char* lds, Seam<TIn>& S) {
    constexpr bool F32 = same_t<TIn, float>::v;
    int tid_o = threadIdx.x; asm volatile("" : "+v"(tid_o));
    const int tid = tid_o, wid = __builtin_amdgcn_readfirstlane(tid >> 6), lane = tid & 63, r32 = lane & 31, hi = lane >> 5;
    const int j_lo = swa_jlo(cur.P0, W);
    int j_hi = (cur.P0 + QB - 1) / KVBLK + 1; if (j_hi > skv / KVBLK) j_hi = skv / KVBLK;
    const int NT = j_hi - j_lo;
    const int kbn = swa_jlo(nxt.P0, W) * KVBLK;
    const int qlo = cur.P0 + wid * QBLK, qm = qlo + r32 - 4 * hi;
    char* V_lds = lds; char* K_lds = lds + 2 * SHM_V;
    float* ws = (float*)(lds + 2 * SHM_V + 2 * SHM_K) + wid * 64; float* li_l = ws, * al_l = ws + 32;
    float m_reg = -1e30f, l_reg = 0; f32x16 o[4] = {};
    unsigned selbits = 0u;
    if (cur.qb > 0) {
        float sc_[7];
#pragma unroll
        for (int j = 0; j < 7; ++j) { float a_ = 0.f;
            if (j < cur.qb) { const float* kmj = cur.km + j * 128 + hi * 8;
#pragma unroll
                for (int d0 = 0; d0 < 8; ++d0) { const f32x4 k0_ = *(const f32x4*)(kmj + d0 * 16), k1_ = *(const f32x4*)(kmj + d0 * 16 + 4); const bf16x8 q_ = S.qr[d0];
                    a_ += (bfv(q_[0]) * k0_[0] + bfv(q_[1]) * k0_[1]) + (bfv(q_[2]) * k0_[2] + bfv(q_[3]) * k0_[3]) + (bfv(q_[4]) * k1_[0] + bfv(q_[5]) * k1_[1]) + (bfv(q_[6]) * k1_[2] + bfv(q_[7]) * k1_[3]); }
                a_ += __shfl_xor(a_, 32); }
            sc_[j] = a_; }
#pragma unroll
        for (int j = 0; j < 7; ++j) { int rank_ = 0;
#pragma unroll
            for (int i = 0; i < 7; ++i) if (i != j) rank_ += (i < cur.qb && (sc_[i] > sc_[j] || (sc_[i] == sc_[j] && i < j))) ? 1 : 0;
            if (j < cur.qb && rank_ < 3) selbits |= 1u << j; }
    }
    const int sr = tid >> 4, sc = (tid & 15) * 8, vst0 = v_st(sr, sc), vst1 = v_st(32 + sr, sc), kws = KSWZ(sr, sc * 2);
    const int vb0 = (int)(uintptr_t)V_lds + v_rd_base(lane);
    const TIn* Kh = cur.K; const TIn* Vh = cur.V;
#define RESC(a) do { if (__any((a) < 1.f)) { if (hi == 0) al_l[r32] = (a); asm volatile("s_waitcnt lgkmcnt(0)" ::: "memory");              \
                     for (int d_ = 0; d_ < 4; ++d_) for (int r = 0; r < 16; ++r) o[d_][r] *= al_l[crow(r, hi)]; } } while (0)
#define KBASE(t) ((j_lo + (t)) * KVBLK)
#define ACT(t) (KBASE(t) <= qlo + QBLK - 1 && KBASE(t) + KVBLK - 1 >= qlo - W + 1)
#define MASKT(P0_, P1_, t) do { const int kb_ = KBASE(t); if (kb_ + KVBLK - 1 > qlo) mask_tile(P0_, P1_, qm - kb_, (unsigned)W); \
        else if ((t) < 4 * cur.qb) { const bool ok_ = ((selbits >> ((t) >> 2)) & 1u) != 0u; if (!__all(ok_)) sel_fill(P0_, P1_, ok_); } } while (0)
    constexpr int NQL = F32 ? 16 : 8;
    constexpr bool SK = WSKIP && !F32;
#define SEAM_K0() do { VMWN(NQL); if constexpr (F32) { SWRITE_KF(0); SBAR(); SLOAD_F((const float*)nxt.V, kbn); } else { SWRITE_HK(0); } SBAR(); } while (0)
    f32x16 pA0, pA1, pB0, pB1; float mnA, mnB, alA, alB; bf16x8 pa0, pa1, pa2, pa3;
    if constexpr (F32) { VMW(); SWRITE_VF(0); SBAR(); } else { SWRITE_HV(0); SBAR(); }
    if (NT > 1) { if constexpr (F32) SLOAD_F((const float*)Kh, KBASE(1)); else SLOAD_H(Kh, Vh, KBASE(1)); }
    SBAR(); qkt<0, SK>(pA0, pA1, K_lds, r32, hi, S.qr, ACT(0));
    if constexpr (F32) { if (NT > 1) { VMW(); SWRITE_KF(1); SBAR(); SLOAD_F((const float*)Vh, KBASE(1)); } }
    MASKT(pA0, pA1, 0); partialSM(pA0, pA1, m_reg, mnA, alA);
    if (NT > 1) { VMW(); if constexpr (F32) { SWRITE_VF(1); SBAR(); if (NT > 2) SLOAD_F((const float*)Kh, KBASE(2)); } else SWRITE_H(1); }
    __syncthreads();
#define HALF_STEP(PX0, PX1, mnX, alX, PY0, PY1, alY, t, KB, VB, SB) do {                                                      \
        SBAR(); qkt<KB, SK>(PX0, PX1, K_lds, r32, hi, S.qr, ACT(t));                                             \
        finishSM(PY0, PY1, alY, l_reg, pa0, pa1, pa2, pa3); SBAR();                                                           \
        if ((t) + 1 < NT) { if constexpr (F32) { VMW(); SWRITE_KF(SB); SBAR(); SLOAD_F((const float*)Vh, KBASE((t) + 1)); }  \
                            else { SLOAD_H(Kh, Vh, KBASE((t) + 1)); } SBAR(); }                                               \
        pv_tile<VB, SK>(o, vb0, pa0, pa1, pa2, pa3, ACT((t) - 1)); MASKT(PX0, PX1, (t)); partialSM(PX0, PX1, m_reg, mnX, alX);                                        \
        __syncthreads();                                                                                                      \
        if ((t) + 1 < NT) { VMW(); if constexpr (F32) { SWRITE_VF(SB); SBAR(); if ((t) + 2 < NT) SLOAD_F((const float*)Kh, KBASE((t) + 2)); } \
                            else { SWRITE_H(SB); } }                                                                          \
        RESC(alX); __syncthreads(); } while (0)
    for (int t = 1; t + 1 < NT; t += 2) {
        HALF_STEP(pB0, pB1, mnB, alB, pA0, pA1, alA, t, 1, 0, 0);
        HALF_STEP(pA0, pA1, mnA, alA, pB0, pB1, alB, t + 1, 0, 1, 1);
    }
    const bool even = (NT & 1) == 0;
    if (even) { SBAR(); qkt<1, SK>(pB0, pB1, K_lds, r32, hi, S.qr, ACT(NT - 1)); SBAR(); }
#define QROW(e) (nxt.Q + (size_t)(wid * QBLK + r32) * QP + ((e) >> 1) * 16 + hi * 8 + ((e) & 1) * 4)
    if constexpr (F32) { SLOAD_F((const float*)nxt.K, kbn); SBAR();
#pragma unroll
        for (int e = 0; e < 8; ++e) S.tq[e] = *(const f32x4*)QROW(e); }
    else { SLOAD_H(nxt.K, nxt.V, kbn); SBAR();
#pragma unroll
        for (int d0 = 0; d0 < 8; ++d0) S.qr[d0] = load8<TIn>(nxt.Q + (size_t)(wid * QBLK + r32) * QP + d0 * 16 + hi * 8); }
    SBAR();
    finishSM(pA0, pA1, alA, l_reg, pa0, pa1, pa2, pa3); SBAR();
    if constexpr (F32) {
#pragma unroll
        for (int e = 8; e < 16; ++e) S.tq[e] = *(const f32x4*)QROW(e); SBAR(); }
#undef QROW
    pv_tile<0, SK>(o, vb0, pa0, pa1, pa2, pa3, ACT(even ? NT - 2 : NT - 1));
    if (even) { MASKT(pB0, pB1, NT - 1); partialSM(pB0, pB1, m_reg, mnB, alB); __syncthreads(); RESC(alB);
        finishSM(pB0, pB1, alB, l_reg, pa0, pa1, pa2, pa3); SBAR(); pv_tile<1, SK>(o, vb0, pa0, pa1, pa2, pa3, ACT(NT - 1)); }
    SBAR(); SEAM_K0();
    if (hi == 0) li_l[r32] = l_reg; asm volatile("s_waitcnt lgkmcnt(0)" ::: "memory");
    float rli[16];
#pragma unroll
    for (int r = 0; r < 16; ++r) rli[r] = __builtin_amdgcn_rcpf(li_l[crow(r, hi)]);
    TOut* Ow = cur.O + (size_t)(wid * QBLK) * OP;
#pragma unroll
    for (int r = 0; r < 16; ++r) { const int orow = crow(r, hi);
#pragma unroll
        for (int d0 = 0; d0 < 4; ++d0) { const float v = o[d0][r] * rli[r];
            if constexpr (same_t<TOut, float>::v) { Ow[(size_t)orow * OP + d0 * 32 + r32] = v; }
            else { const float vn = __shfl_xor(v, 1);
                   if ((r32 & 1) == 0) *(unsigned*)(Ow + (size_t)orow * OP + d0 * 32 + r32) = cvtpk(v, vn); } } }
    if constexpr (F32) {
#pragma unroll
        for (int d0 = 0; d0 < 8; ++d0) S.qr[d0] = pack8(S.tq[2 * d0], S.tq[2 * d0 + 1]); }
    __syncthreads();
#undef RESC
#undef KBASE
#undef ACT
#undef MASKT
#undef SEAM_K0
#undef HALF_STEP
}
#undef ROW
#undef VMW
#undef VMWN
#undef SLOAD_H
#undef SWRITE_HK
#undef SWRITE_HV
#undef SWRITE_H
#undef SLOAD_F
#undef SWRITE_KF
#undef SWRITE_VF
}
namespace gla {
typedef float f32x16 __attribute__((ext_vector_type(16)));
typedef short s16x4 __attribute__((ext_vector_type(4)));
typedef float f32x2_t __attribute__((ext_vector_type(2)));
typedef __bf16 bf16x2_t __attribute__((ext_vector_type(2)));
__device__ __forceinline__ unsigned cvt2(float lo, float hi) { f32x2_t v = {lo, hi}; bf16x2_t b = __builtin_convertvector(v, bf16x2_t); return __builtin_bit_cast(unsigned, b); }
__device__ __forceinline__ float bfu(unsigned short s) { return __builtin_bit_cast(float, ((unsigned)s) << 16); }
constexpr int RS = 272, VS = 528, AS = 144;
constexpr int L_QT = 0, L_KT = 17408, L_KH = 34816, L_V = 52224, L_AT = 86016, L_GLR = 95232, L_DEC = 99328, L_SEG = 99840, L_RED = 101888, L_END = 103936;
#define GLA_MFMA(a, b, c) __builtin_amdgcn_mfma_f32_32x32x16_bf16((a), (b), (c), 0, 0, 0)
#define GLA_TR(off) __builtin_amdgcn_ds_read_tr16_b64_v4i16((LAS s16x4*)(lds + (off)))

__device__ __forceinline__ void gla_unit(const Params& P, int l, int bh, LAS unsigned char* lds, int tid) {
    const int lane = tid & 63, w = __builtin_amdgcn_readfirstlane(tid >> 6), r = lane & 31, hh = lane >> 5;
    const int b = bh >> 2, h = bh & 3, sd = tid & 127, stq = tid >> 7;
    const int blk = (lane >> 4) & 1, q4 = (lane & 15) >> 2, p4 = lane & 3;
    const bf16* proj = (const bf16*)(P.ws + WS_PROJ) + (size_t)(b * SEQ) * NIN;
    const float* glrg = (const float*)(P.ws + WS_GLR) + (size_t)(b * SEQ) * GRANK;
    bf16* og = (bf16*)(P.ws + WS_OGOM) + (size_t)(b * SEQ) * GVW + h * GDV + 32 * w + 4 * hh;
    const float* gn = P.gla_norm_g + (size_t)l * GDV + 32 * w + 4 * hh;
    float w2r[16];
#pragma unroll
    for (int j = 0; j < 16; ++j) w2r[j] = P.gate_w2[((size_t)l * GRANK + j) * GKW + h * GDK + sd];
    const float gbias = P.gate_b[(size_t)l * GKW + h * GDK + sd];
    const unsigned tr_v = L_V + (8 * hh + q4) * VS + (32 * w + 16 * blk + 4 * p4) * 2;
    const unsigned tr_kh = L_KH + (8 * hh + q4) * RS + (16 * blk + 4 * p4) * 2;
    f32x16 S[4];
#pragma unroll
    for (int d = 0; d < 4; ++d)
#pragma unroll
        for (int i = 0; i < 16; ++i) S[d][i] = 0.f;
    u32x4 pq[2], pk[2], pv[4]; f32x4 pg = {0.f, 0.f, 0.f, 0.f};
#define GLA_LOAD(t0_) do { \
        _Pragma("unroll") for (int i = 0; i < 2; ++i) { const int idx = tid + 512 * i, row = idx >> 4, ch = idx & 15; \
            pq[i] = *(const u32x4*)(proj + (size_t)((t0_) + row) * NIN + GQ_OFF + h * GDK + ch * 8); pk[i] = *(const u32x4*)(proj + (size_t)((t0_) + row) * NIN + GK_OFF + h * GDK + ch * 8); } \
        _Pragma("unroll") for (int i = 0; i < 4; ++i) { const int idx = tid + 512 * i, row = idx >> 5, ch = idx & 31; \
            pv[i] = *(const u32x4*)(proj + (size_t)((t0_) + row) * NIN + GV_OFF + h * GDV + ch * 8); } \
        if (tid < 256) pg = *(const f32x4*)(glrg + (size_t)((t0_) + (tid >> 2)) * GRANK + (tid & 3) * 4); } while (0)
    GLA_LOAD(0);
    for (int c = 0; c < SEQ / GCH; ++c) {
        const int t0 = c * GCH;
#pragma unroll
        for (int i = 0; i < 2; ++i) { const int idx = tid + 512 * i, row = idx >> 4, ch = idx & 15; *(LAS u32x4*)(lds + L_QT + row * RS + ch * 16) = pq[i]; *(LAS u32x4*)(lds + L_KT + row * RS + ch * 16) = pk[i]; }
#pragma unroll
        for (int i = 0; i < 4; ++i) { const int idx = tid + 512 * i, row = idx >> 5, ch = idx & 31; *(LAS u32x4*)(lds + L_V + row * VS + ch * 16) = pv[i]; }
        if (tid < 256) *(LAS f32x4*)(lds + L_GLR + (tid >> 2) * 64 + (tid & 3) * 16) = pg;
        u32x2 sg[2][4];
#pragma unroll
        for (int ti = 0; ti < 2; ++ti)
#pragma unroll
            for (int g = 0; g < 4; ++g) sg[ti][g] = *(const u32x2*)(proj + (size_t)(t0 + 32 * ti + r) * NIN + GR_OFF + h * GDV + 32 * w + 8 * g + 4 * hh);
        if (c + 1 < SEQ / GCH) GLA_LOAD(t0 + GCH);
        __syncthreads();
        float bl[16]; float run = 0.f;
#pragma unroll
        for (int i = 0; i < 16; ++i) { const LAS f32x4* gr4 = (const LAS f32x4*)(lds + L_GLR + (16 * stq + i) * 64); float x = gbias;
#pragma unroll
            for (int j = 0; j < 4; ++j) { const f32x4 gv = gr4[j]; x += (gv[0] * w2r[4 * j] + gv[1] * w2r[4 * j + 1]) + (gv[2] * w2r[4 * j + 2] + gv[3] * w2r[4 * j + 3]); }
            run += logsigmoidf_(x) * (1.0f / 16.0f); bl[i] = run; }
        *(LAS float*)(lds + L_SEG + (stq * 128 + sd) * 4) = run;
        __syncthreads();
        float prefix = 0.f, total = 0.f;
#pragma unroll
        for (int j = 0; j < 4; ++j) { const float sv = *(const LAS float*)(lds + L_SEG + (j * 128 + sd) * 4); total += sv; prefix += (j < stq) ? sv : 0.f; }
#pragma unroll
        for (int i = 0; i < 16; ++i) { const int row = 16 * stq + i; const float bb = bl[i] + prefix; const float eb = __expf(bb), enb = __expf(-bb), ekl = __expf(total - bb);
            LAS unsigned short* qp = (LAS unsigned short*)(lds + L_QT + row * RS + sd * 2); LAS unsigned short* kp = (LAS unsigned short*)(lds + L_KT + row * RS + sd * 2);
            const float qv = bfu(*qp), kv = bfu(*kp);
            *qp = (unsigned short)f2bf(qv * eb); *kp = (unsigned short)f2bf(kv * enb); *(LAS unsigned short*)(lds + L_KH + row * RS + sd * 2) = (unsigned short)f2bf(kv * ekl); }
        if (stq == 0) *(LAS float*)(lds + L_DEC + sd * 4) = __expf(total);
        __syncthreads();
        if (w < 4) { const int ti = w >> 1, si = w & 1; f32x16 at;
#pragma unroll
            for (int i = 0; i < 16; ++i) at[i] = 0.f;
            if (si <= ti) {
#pragma unroll
                for (int kk = 0; kk < 8; ++kk) { const bf16x8 a = *(const LAS bf16x8*)(lds + L_KT + (32 * si + r) * RS + (16 * kk + 8 * hh) * 2); const bf16x8 bq = *(const LAS bf16x8*)(lds + L_QT + (32 * ti + r) * RS + (16 * kk + 8 * hh) * 2);
                    at = GLA_MFMA(a, bq, at); } }
            const int t = 32 * ti + r;
#pragma unroll
            for (int g = 0; g < 4; ++g) { const int s0 = 32 * si + 8 * g + 4 * hh; float v[4];
#pragma unroll
                for (int e = 0; e < 4; ++e) v[e] = (s0 + e <= t) ? at[4 * g + e] : 0.f;
                u32x2 pkd; pkd.x = cvt2(v[0], v[1]); pkd.y = cvt2(v[2], v[3]); *(LAS u32x2*)(lds + L_AT + t * AS + s0 * 2) = pkd; } }
        bf16x8 vf[4];
#pragma unroll
        for (int kk = 0; kk < 4; ++kk) { const s16x4 lo = GLA_TR(tr_v + kk * 16 * VS), hi = GLA_TR(tr_v + kk * 16 * VS + 4 * VS); vf[kk] = __builtin_shufflevector(lo, hi, 0, 1, 2, 3, 4, 5, 6, 7); }
        f32x16 ot[2];
#pragma unroll
        for (int ti = 0; ti < 2; ++ti)
#pragma unroll
            for (int i = 0; i < 16; ++i) ot[ti][i] = 0.f;
#pragma unroll
        for (int dblk = 0; dblk < 4; ++dblk)
#pragma unroll
            for (int s = 0; s < 2; ++s) { u32x4 pa; pa.x = cvt2(S[dblk][8 * s + 0], S[dblk][8 * s + 1]); pa.y = cvt2(S[dblk][8 * s + 2], S[dblk][8 * s + 3]); pa.z = cvt2(S[dblk][8 * s + 4], S[dblk][8 * s + 5]); pa.w = cvt2(S[dblk][8 * s + 6], S[dblk][8 * s + 7]);
                const bf16x8 a = __builtin_bit_cast(bf16x8, pa);
#pragma unroll
                for (int ti = 0; ti < 2; ++ti) { const LAS unsigned char* qa = lds + L_QT + (32 * ti + r) * RS + (32 * dblk + 16 * s + 4 * hh) * 2;
                    const s16x4 lo = *(const LAS s16x4*)qa, hi = *(const LAS s16x4*)(qa + 16); const bf16x8 bq = __builtin_shufflevector(lo, hi, 0, 1, 2, 3, 4, 5, 6, 7);
                    ot[ti] = GLA_MFMA(a, bq, ot[ti]); } }
#pragma unroll
        for (int dblk = 0; dblk < 4; ++dblk) {
#pragma unroll
            for (int g = 0; g < 4; ++g) { const f32x4 dc = *(const LAS f32x4*)(lds + L_DEC + (32 * dblk + 8 * g + 4 * hh) * 4);
#pragma unroll
                for (int e = 0; e < 4; ++e) S[dblk][4 * g + e] *= dc[e]; }
#pragma unroll
            for (int kk = 0; kk < 4; ++kk) { const s16x4 lo = GLA_TR(tr_kh + dblk * 64 + kk * 16 * RS), hi = GLA_TR(tr_kh + dblk * 64 + kk * 16 * RS + 4 * RS);
                const bf16x8 a = __builtin_shufflevector(lo, hi, 0, 1, 2, 3, 4, 5, 6, 7); S[dblk] = GLA_MFMA(a, vf[kk], S[dblk]); } }
        __syncthreads();
#pragma unroll
        for (int ti = 0; ti < 2; ++ti)
#pragma unroll
            for (int kk = 0; kk < 4; ++kk) { if (ti == 0 && kk >= 2) continue;
                const bf16x8 ba = *(const LAS bf16x8*)(lds + L_AT + (32 * ti + r) * AS + (16 * kk + 8 * hh) * 2); ot[ti] = GLA_MFMA(vf[kk], ba, ot[ti]); }
#pragma unroll
        for (int ti = 0; ti < 2; ++ti) { float ss = 0.f;
#pragma unroll
            for (int i = 0; i < 16; ++i) ss += ot[ti][i] * ot[ti][i];
            ss += __shfl_xor(ss, 32); if (hh == 0) *(LAS float*)(lds + L_RED + (w * 64 + 32 * ti + r) * 4) = ss; }
        __syncthreads();
#pragma unroll
        for (int ti = 0; ti < 2; ++ti) { float tot = 0.f;
#pragma unroll
            for (int ww = 0; ww < 8; ++ww) tot += *(const LAS float*)(lds + L_RED + (ww * 64 + 32 * ti + r) * 4);
            const float rstd = rsqrtf(tot * (1.0f / GDV) + EPS);
#pragma unroll
            for (int g = 0; g < 4; ++g) { const f32x4 gg = *(const f32x4*)(gn + 8 * g); const u32x2 sv = sg[ti][g];
                const float o0 = ot[ti][4 * g + 0] * rstd * gg[0] * pg8::bflo(sv.x), o1 = ot[ti][4 * g + 1] * rstd * gg[1] * pg8::bfhi(sv.x), o2 = ot[ti][4 * g + 2] * rstd * gg[2] * pg8::bflo(sv.y), o3 = ot[ti][4 * g + 3] * rstd * gg[3] * pg8::bfhi(sv.y);
                u32x2 pkd; pkd.x = cvt2(o0, o1); pkd.y = cvt2(o2, o3); *(u32x2*)(og + (size_t)(t0 + 32 * ti + r) * GVW + 8 * g) = pkd; } }
    }
#undef GLA_LOAD
}
#undef GLA_MFMA
#undef GLA_TR
}
constexpr int NWAVES = 8;
constexpr int RING_BYTES = 131072;
constexpr int LDSCTL_OFF = RING_BYTES, MISC_OFF = LDSCTL_OFF + 320;
constexpr int LDS_BYTES = 147456;
constexpr int CW_TMO = 0, CW_QUEUE = 64, CW_BAR = 4096;
constexpr int PH_P0A = 0, PH_P0B = 1, PH_P0C = 2, PH_L0 = 3, PH_PER_LAYER = 7, PH_FINAL = PH_L0 + DEPTH * PH_PER_LAYER, PH_COUNT = PH_FINAL + 1;
constexpr int PL_IN = 0, PL_PRE = 1, PL_MIX = 2, PL_UP = 3, PL_OUT = 4, PL_FFI = 5, PL_FFO = 6;

#ifndef EN_P0
#define EN_P0 1
#endif
#ifndef EN_IN
#define EN_IN 1
#endif
#ifndef EN_PRE
#define EN_PRE 1
#endif
#ifndef EN_MOBA
#define EN_MOBA 1
#endif
#ifndef EN_GLA
#define EN_GLA 1
#endif
#ifndef EN_UP
#define EN_UP 1
#endif
#ifndef EN_OUT
#define EN_OUT 1
#endif
#ifndef EN_FFI
#define EN_FFI 1
#endif
#ifndef EN_FFO
#define EN_FFO 1
#endif
struct Args { Params P; int ph_lo, ph_hi, li, pad; };

__device__ __forceinline__ void glr_unit(const Params& P, int l, const float* ssq, int rg64, int wave, int lane, LAS unsigned char* lds) {
    const bf16* A = (const bf16*)(P.ws + WS_ABUF); const bf16* W = wt_ptr(P, l, WT_GLR);
    const int rg = wave & 3, kh = wave >> 2, r16 = lane & 15, q = lane >> 4, row0 = rg64 * 64 + rg * 16;
    const bf16* ap = A + (size_t)(row0 + r16) * DM + kh * 1024 + 8 * q; const bf16* bp = W + (size_t)r16 * DM + kh * 1024 + 8 * q;
    f32x4 acc = {0.f, 0.f, 0.f, 0.f};
#pragma unroll 8
    for (int k0 = 0; k0 < 1024; k0 += 32) acc = __builtin_amdgcn_mfma_f32_16x16x32_bf16(*(const bf16x8*)(ap + k0), *(const bf16x8*)(bp + k0), acc, 0, 0, 0);
    LAS f32x4* part = (LAS f32x4*)lds;
    if (kh == 1) part[rg * 64 + lane] = acc;
    __syncthreads();
    if (kh == 0) { const f32x4 o = part[rg * 64 + lane];
        const float* shw = (const float*)(P.ws + WS_SHWGLR) + (size_t)l * 8 * GRANK; float* glr = (float*)(P.ws + WS_GLR);
#pragma unroll
        for (int j = 0; j < 4; ++j) { const int row = row0 + 4 * q + j, b = row / SEQ; glr[(size_t)row * GRANK + r16] = rsqrtf(ssq[row] * (1.f / DM) + EPS) * (acc[j] + o[j]) + shw[b * GRANK + r16]; } }
    __syncthreads();
}
__device__ __forceinline__ void kmean_unit(const Params& P, int item, int tid, LAS unsigned char* lds) {
    const int blk = item % MNB, bh = item / MNB, b = bh / MH, h = bh % MH, c8 = tid & 15, rgp = tid >> 4;
    const bf16* p = (const bf16*)(P.ws + WS_PROJ) + (size_t)(b * SEQ + blk * MBLK + rgp) * NIN + MK_OFF + h * MHD + 8 * c8;
    float s[8];
#pragma unroll
    for (int j = 0; j < 8; ++j) s[j] = 0.f;
#pragma unroll
    for (int i = 0; i < 8; ++i) { const u32x4 w = *(const u32x4*)(p + (size_t)(32 * i) * NIN);
        s[0] += pg8::bflo(w.x); s[1] += pg8::bfhi(w.x); s[2] += pg8::bflo(w.y); s[3] += pg8::bfhi(w.y); s[4] += pg8::bflo(w.z); s[5] += pg8::bfhi(w.z); s[6] += pg8::bflo(w.w); s[7] += pg8::bfhi(w.w); }
    LAS float* red = (LAS float*)lds;
#pragma unroll
    for (int j = 0; j < 8; ++j) red[rgp * 128 + 8 * c8 + j] = s[j];
    __syncthreads();
    if (tid < 128) { float a = 0.f;
#pragma unroll
        for (int r = 0; r < 32; ++r) a += red[r * 128 + tid];
        ((float*)(P.ws + WS_KMEAN))[((size_t)bh * MNB + blk) * MHD + tid] = a * (1.f / MBLK); }
    __syncthreads();
}
__device__ __forceinline__ void final_row(float* x, const float* g, int m, int lane) {
    f32x4* xr = (f32x4*)(x + (size_t)m * DM); float s = 0.f; f32x4 v[8];
#pragma unroll
    for (int j = 0; j < 8; ++j) { v[j] = xr[lane + 64 * j]; s += (v[j].x * v[j].x + v[j].y * v[j].y) + (v[j].z * v[j].z + v[j].w * v[j].w); }
    const float rstd = rsqrtf(wave_sum(s) * (1.f / DM) + EPS);
#pragma unroll
    for (int j = 0; j < 8; ++j) { const f32x4 gg = *(const f32x4*)(g + 4 * (lane + 64 * j)); xr[lane + 64 * j] = v[j] * rstd * gg; }
}

__device__ __forceinline__ void moba_phase(const Params& P, unsigned* queue, char* ldsg, volatile LAS unsigned* qslot, int tid) {
    const bf16* PROJ = (const bf16*)(P.ws + WS_PROJ); bf16* OM = (bf16*)(P.ws + WS_OGOM) + (size_t)MT * GVW; const float* KM = (const float*)(P.ws + WS_KMEAN);
    constexpr int W = 1 << 20;
    int it = 0;
    if (tid == 0) qslot[0] = __hip_atomic_fetch_add(queue, 1u, __ATOMIC_RELAXED, __HIP_MEMORY_SCOPE_AGENT);
    __syncthreads();
    unsigned u = __builtin_amdgcn_readfirstlane(qslot[0]);
    moba::Seam<bf16> S;
    while (u < (unsigned)(NB * MH * MNB)) {
        if (tid == 0) qslot[(it + 1) & 1] = __hip_atomic_fetch_add(queue, 1u, __ATOMIC_RELAXED, __HIP_MEMORY_SCOPE_AGENT);
        const int qb = MNB - 1 - (int)(u >> 6), bh = (int)(u & 63u), b = bh >> 3, h = bh & 7;
        moba::BlockRef<bf16, bf16> cur;
        cur.Q = PROJ + (size_t)(b * SEQ + qb * MBLK) * NIN + MQ_OFF + h * MHD; cur.K = PROJ + (size_t)(b * SEQ) * NIN + MK_OFF + h * MHD; cur.V = PROJ + (size_t)(b * SEQ) * NIN + MV_OFF + h * MHD;
        cur.O = OM + (size_t)(b * SEQ + qb * MBLK) * MW + h * MHD; cur.P0 = qb * MBLK; cur.km = KM + (size_t)bh * MNB * MHD; cur.qb = qb;
        moba::causal_swa_prime<bf16, bf16>(cur, W, ldsg, S);
        moba::causal_swa_block<bf16, bf16>(cur, cur, SEQ, W, ldsg, S);
        ++it; u = __builtin_amdgcn_readfirstlane(qslot[it & 1]);
    }
}

__global__ void __launch_bounds__(NWAVES * 64, 2) mega(Args args) {
    extern __shared__ __attribute__((aligned(16))) unsigned char lds_raw[];
    LAS unsigned char* lds = (LAS unsigned char*)lds_raw;
    volatile LAS unsigned* MISC = (volatile LAS unsigned*)(lds + MISC_OFF);
    const Params& P = args.P;
    const int wave = __builtin_amdgcn_readfirstlane(threadIdx.x >> 6);
#define OTID(name) int name = threadIdx.x; asm volatile("" : "+v"(name))
    const int G = gridDim.x, bx = blockIdx.x, vcu = (G % 8 == 0) ? (bx % 8) * (G / 8) + bx / 8 : bx;
    const int gw = vcu * NWAVES + wave, ngw = G * NWAVES;
    unsigned* ctl = (unsigned*)(P.ws + WS_CTL);
    { OTID(t0); for (int u = t0; u < (LDS_BYTES - LDSCTL_OFF) / 4; u += NWAVES * 64) ((LAS unsigned*)(lds + LDSCTL_OFF))[u] = 0u; }
    __syncthreads();
    const int lo = args.ph_lo, hi = args.ph_hi;
    XcdBarrier bar; bar.bar = ctl + CW_BAR + args.li * XCD_BAR_WORDS; bar.x = 0; bar.st = nullptr;
    if (hi - lo > 1) bar = xcd_barrier_post(ctl + CW_BAR + args.li * XCD_BAR_WORDS, MISC + 8);
#define IN(k) (lo <= (k) && (k) < hi)
#define SEAM(k) do { if (IN(k) && IN((k) + 1)) xcd_barrier(bar); } while (0)

    if (EN_P0 && IN(PH_P0A)) { OTID(t1); phase_p0a(P, gw, ngw, t1 & 63, (float*)(lds_raw + wave * 16384)); __syncthreads(); SEAM(PH_P0A); }
    if (EN_P0 && IN(PH_P0B)) { OTID(t1); phase_p0b(P, vcu * NWAVES * 64 + t1, G * NWAVES * 64); SEAM(PH_P0B); }
    if (EN_P0 && IN(PH_P0C)) {
        OTID(t1);
        for (int m = gw; m < MT; m += ngw) a1prep_row(P, m, t1 & 63);
        for (int combo = 0; combo < 4; ++combo) shw_combo(P, combo, wave, NWAVES, gw, ngw, t1, NWAVES * 64, t1 & 63, (float*)lds_raw);
        SEAM(PH_P0C);
    }
    for (int l = 0; l < DEPTH; ++l) {
        const int pb = PH_L0 + l * PH_PER_LAYER;
        bf16* ABUF = (bf16*)(P.ws + WS_ABUF); bf16* OGOM = (bf16*)(P.ws + WS_OGOM); bf16* PROJ = (bf16*)(P.ws + WS_PROJ); bf16* HID = PROJ;
        float* SSQA = (float*)(P.ws + WS_SSQ0); float* SSQB = (float*)(P.ws + WS_SSQ) + (size_t)l * MT; float* SSQN = (float*)(P.ws + WS_SSQ) + (size_t)(2 + l) * MT;
        const float* mv = (const float*)(P.ws + WS_MODV) + (size_t)l * 8 * 6 * DM;
        const float* mvn = (const float*)(P.ws + WS_MODV) + (size_t)(l + 1 < DEPTH ? l + 1 : l) * 8 * 6 * DM;
        const float* ssq_in = l == 0 ? SSQA : (const float*)(P.ws + WS_SSQ) + (size_t)(2 + l - 1) * MT;
        if (EN_IN && IN(pb + PL_IN)) {
            pg8::Gemm g{ABUF, wt_ptr(P, l, WT_IN), MT, NIN, DM}; pg8::StaticOrder S; S.init(MT, NIN, G, bx);
            pg8::EpiIn E{ssq_in, (const float*)(P.ws + WS_SHWIN) + (size_t)l * 8 * NIN, PROJ};
            pg8::gemm_phase<pg8::EpiIn, pg8::StaticOrder, true, true>(lds, g, S, E);
            SEAM(pb + PL_IN);
        }
        if (EN_PRE && IN(pb + PL_PRE)) {
            OTID(t2);
            for (int u = vcu; u < MT / 64; u += G) glr_unit(P, l, ssq_in, u, wave, t2 & 63, lds);
            for (int it = vcu; it < NB * MH * MNB; it += G) kmean_unit(P, it, t2, lds);
            SEAM(pb + PL_PRE);
        }
        if (IN(pb + PL_MIX)) {
            if (EN_GLA && bx < NB * GH) { OTID(t3); gla::gla_unit(P, l, bx, lds, t3); }
            if (EN_MOBA) { OTID(t4); moba_phase(P, ctl + CW_QUEUE + 64 * l, (char*)lds_raw, MISC + 16, t4); }
            SEAM(pb + PL_MIX);
        }
        if (EN_UP && IN(pb + PL_UP)) {
            { pg8::Gemm g{OGOM, wt_ptr(P, l, WT_UPG), MT, DM, GVW};     pg8::StaticOrder S; S.init(MT, DM, G, bx); pg8::EpiUp<false> E{PROJ, GT_OFF, ABUF};
              pg8::gemm_phase<pg8::EpiUp<false>, pg8::StaticOrder, true, true>(lds, g, S, E); }
            { pg8::Gemm g{OGOM + (size_t)MT * GVW, wt_ptr(P, l, WT_UPM), MT, DM, MW};     pg8::StaticOrder S; S.init(MT, DM, G, bx); pg8::EpiUp<true> E{PROJ, GT_OFF + DM, ABUF};
              pg8::gemm_phase<pg8::EpiUp<true>, pg8::StaticOrder, true, true>(lds, g, S, E); }
            SEAM(pb + PL_UP);
        }
        if (EN_OUT && IN(pb + PL_OUT)) {
            pg8::Gemm g{ABUF, wt_ptr(P, l, WT_OUT), MT, DM, DM}; pg8::StaticOrder S; S.init(MT, DM, G, bx);
            pg8::EpiRes E{l == 0 ? P.x : P.out, P.out, mv + 2 * DM, mv + 4 * DM, OGOM, SSQB};
            pg8::gemm_phase<pg8::EpiRes, pg8::StaticOrder, true, true>(lds, g, S, E);
            SEAM(pb + PL_OUT);
        }
        if (EN_FFI && IN(pb + PL_FFI)) {
            pg8::Gemm g{OGOM, wt_ptr(P, l, WT_FFI), MT, NFFI, DM}; pg8::StaticOrder S; S.init(MT, NFFI, G, bx);
            pg8::EpiFfi E{SSQB, (const float*)(P.ws + WS_SHWFFI) + (size_t)l * 8 * NFFI, HID};
            pg8::gemm_phase<pg8::EpiFfi, pg8::StaticOrder, true, true>(lds, g, S, E);
            SEAM(pb + PL_FFI);
        }
        if (EN_FFO && IN(pb + PL_FFO)) {
            pg8::Gemm g{HID, wt_ptr(P, l, WT_FFO), MT, DM, DFF}; pg8::StaticOrder S; S.init(MT, DM, G, bx);
            pg8::EpiRes E{P.out, P.out, mv + 5 * DM, mvn + 1 * DM, l + 1 < DEPTH ? ABUF : nullptr, l + 1 < DEPTH ? SSQN : nullptr};
            pg8::gemm_phase<pg8::EpiRes, pg8::StaticOrder, true, true>(lds, g, S, E);
            SEAM(pb + PL_FFO);
        }
    }
    if (IN(PH_FINAL)) { OTID(t5); for (int m = gw; m < MT; m += ngw) final_row(P.out, P.final_g, m, t5 & 63); }
#undef IN
#undef SEAM
#undef OTID
}
template <int TN, class Epi>
__global__ __launch_bounds__(256) void k_naive_gemm(const bf16* A, int lda, const bf16* Bt, int ldb, int K, Epi E) {
    const int wave = threadIdx.x >> 6, lane = threadIdx.x & 63, r16 = lane & 15, q = lane >> 4;
    const int row0 = blockIdx.y * 64 + wave * 16, col0 = blockIdx.x * 16 * TN;
    f32x4 acc[TN];
#pragma unroll
    for (int t = 0; t < TN; ++t) acc[t] = (f32x4){0.f, 0.f, 0.f, 0.f};
    const bf16* ap = A + (size_t)(row0 + r16) * lda + 8 * q;
    const bf16* bp = Bt + (size_t)(col0 + r16) * ldb + 8 * q;
    for (int k0 = 0; k0 < K; k0 += 32) {
        const bf16x8 a = *(const bf16x8*)(ap + k0);
#pragma unroll
        for (int t = 0; t < TN; ++t) { const bf16x8 b = *(const bf16x8*)(bp + (size_t)t * 16 * ldb + k0);
            acc[t] = __builtin_amdgcn_mfma_f32_16x16x32_bf16(a, b, acc[t], 0, 0, 0); }
    }
#pragma unroll
    for (int t = 0; t < TN; ++t)
#pragma unroll
        for (int j = 0; j < 4; ++j) E(row0 + 4 * q + j, col0 + t * 16 + r16, acc[t][j]);
}
struct NEpiIn {
    const float* ssq; const float* shw; bf16* proj;
    __device__ void operator()(int row, int col, float a) const {
        const int b = row / SEQ; const float rstd = rsqrtf(ssq[row] * (1.f / DM) + EPS);
        float v = rstd * a + shw[(size_t)b * NIN + col];
        if (col < GK_OFF) v *= 0.08838834764831845f;
        else if (col >= GR_OFF && col < MQ_OFF) v = siluf_(v);
        else if (col >= GT_OFF) v = sigmoidf_(v);
        proj[(size_t)row * NIN + col] = (bf16)f2bf(v);
    }
};
struct NEpiGlr { const float* ssq; const float* shw; float* glr;
    __device__ void operator()(int row, int col, float a) const { const int b = row / SEQ; glr[(size_t)row * GRANK + col] = rsqrtf(ssq[row] * (1.f / DM) + EPS) * a + shw[b * GRANK + col]; } };
struct NEpiUp1 { const bf16* proj; bf16* mg;
    __device__ void operator()(int row, int col, float a) const { mg[(size_t)row * DM + col] = (bf16)f2bf(bf2f(proj[(size_t)row * NIN + GT_OFF + col]) * a); } };
struct NEpiUp2 { const bf16* proj; bf16* mg;
    __device__ void operator()(int row, int col, float a) const { const size_t i = (size_t)row * DM + col; mg[i] = (bf16)f2bf(bf2f(mg[i]) + bf2f(proj[(size_t)row * NIN + GT_OFF + DM + col]) * a); } };
struct NEpiRes {
    const float* xin; float* xout; const float* gate; const float* gm; bf16* aout;
    __device__ void operator()(int row, int col, float a) const { const int b = row / SEQ; const size_t i = (size_t)row * DM + col;
        const float v = xin[i] + gate[(size_t)b * 6 * DM + col] * a; xout[i] = v; if (aout) aout[i] = (bf16)f2bf(v * gm[(size_t)b * 6 * DM + col]); } };
struct NEpiFfi {
    const float* ssq; const float* shw; bf16* hid;
    __device__ void operator()(int row, int col, float a) const { (void)row; (void)col; (void)a; } };
__global__ __launch_bounds__(256) void k_naive_ffi(const bf16* A, const bf16* Bt, const float* ssq, const float* shw, bf16* hid) {
    const int wave = threadIdx.x >> 6, lane = threadIdx.x & 63, r16 = lane & 15, q = lane >> 4;
    const int row0 = blockIdx.y * 64 + wave * 16, j0 = blockIdx.x * 16;
    const int pn = j0 >> 7, c = j0 & 127, ra = pn * 256 + c, ru = ra + 128;
    f32x4 aa = {0.f, 0.f, 0.f, 0.f}, au = {0.f, 0.f, 0.f, 0.f};
    const bf16* ap = A + (size_t)(row0 + r16) * DM + 8 * q;
    const bf16* bpa = Bt + (size_t)(ra + r16) * DM + 8 * q; const bf16* bpu = Bt + (size_t)(ru + r16) * DM + 8 * q;
    for (int k0 = 0; k0 < DM; k0 += 32) { const bf16x8 a = *(const bf16x8*)(ap + k0);
        aa = __builtin_amdgcn_mfma_f32_16x16x32_bf16(a, *(const bf16x8*)(bpa + k0), aa, 0, 0, 0);
        au = __builtin_amdgcn_mfma_f32_16x16x32_bf16(a, *(const bf16x8*)(bpu + k0), au, 0, 0, 0); }
#pragma unroll
    for (int j = 0; j < 4; ++j) { const int row = row0 + 4 * q + j, b = row / SEQ; const float rstd = rsqrtf(ssq[row] * (1.f / DM) + EPS);
        const float va = rstd * aa[j] + shw[(size_t)b * NFFI + ra + r16], vu = rstd * au[j] + shw[(size_t)b * NFFI + ru + r16];
        hid[(size_t)row * DFF + j0 + r16] = (bf16)f2bf(siluf_(va) * vu); }
}
__global__ __launch_bounds__(256) void k_rowssq(const float* x, float* ssq) {
    const int m = blockIdx.x * 4 + (threadIdx.x >> 6), lane = threadIdx.x & 63; const f32x4* xr = (const f32x4*)(x + (size_t)m * DM); float s = 0.f;
#pragma unroll
    for (int j = 0; j < 8; ++j) { const f32x4 v = xr[lane + 64 * j]; s += (v.x * v.x + v.y * v.y) + (v.z * v.z + v.w * v.w); }
    s = wave_sum(s); if (lane == 0) ssq[m] = s;
}
__global__ __launch_bounds__(256) void k_final(float* x, const float* g) {
    const int m = blockIdx.x * 4 + (threadIdx.x >> 6), lane = threadIdx.x & 63; f32x4* xr = (f32x4*)(x + (size_t)m * DM); float s = 0.f; f32x4 v[8];
#pragma unroll
    for (int j = 0; j < 8; ++j) { v[j] = xr[lane + 64 * j]; s += (v[j].x * v[j].x + v[j].y * v[j].y) + (v[j].z * v[j].z + v[j].w * v[j].w); }
    const float rstd = rsqrtf(wave_sum(s) * (1.f / DM) + EPS);
#pragma unroll
    for (int j = 0; j < 8; ++j) { const f32x4 gg = *(const f32x4*)(g + 4 * (lane + 64 * j)); xr[lane + 64 * j] = v[j] * rstd * gg; }
}
__global__ __launch_bounds__(128) void k_kmean(const bf16* proj, float* kmean) {
    const int blk = blockIdx.x % MNB, bh = blockIdx.x / MNB, b = bh / MH, h = bh % MH, d = threadIdx.x;
    const bf16* p = proj + (size_t)(b * SEQ + blk * MBLK) * NIN + MK_OFF + h * MHD + d; float s = 0.f;
    for (int r = 0; r < MBLK; ++r) s += bf2f(p[(size_t)r * NIN]);
    kmean[((size_t)bh * MNB + blk) * MHD + d] = s * (1.f / MBLK);
}
__global__ __launch_bounds__(512) void k_gla_g(const float* glr, const float* w2, const float* gb, float* g) {
    const int m = blockIdx.x, d = threadIdx.x; float a = gb[d];
#pragma unroll
    for (int r = 0; r < GRANK; ++r) a += glr[(size_t)m * GRANK + r] * w2[r * GKW + d];
    g[(size_t)m * GKW + d] = logsigmoidf_(a) * (1.f / 16.f);
}
__global__ __launch_bounds__(256) void k_gla_rec(const bf16* proj, const float* g, float* oraw) {
    const int bh = blockIdx.x, b = bh / GH, h = bh % GH, dv = threadIdx.x;
    float S[GDK];
#pragma unroll
    for (int d = 0; d < GDK; ++d) S[d] = 0.f;
    for (int t = 0; t < SEQ; ++t) { const size_t m = (size_t)b * SEQ + t; const bf16* pr = proj + m * NIN;
        const float v = bf2f(pr[GV_OFF + h * GDV + dv]); float o = 0.f;
#pragma unroll
        for (int d = 0; d < GDK; ++d) { const float dec = __expf(g[m * GKW + h * GDK + d]); S[d] = dec * S[d] + bf2f(pr[GK_OFF + h * GDK + d]) * v; o += bf2f(pr[GQ_OFF + h * GDK + d]) * S[d]; }
        oraw[m * GVW + h * GDV + dv] = o; }
}
__global__ __launch_bounds__(256) void k_gla_norm(const float* oraw, const bf16* proj, const float* gn, bf16* og) {
    const int idx = blockIdx.x * 4 + (threadIdx.x >> 6), lane = threadIdx.x & 63, m = idx / GH, h = idx % GH;
    const f32x4 v = *(const f32x4*)(oraw + (size_t)m * GVW + h * GDV + 4 * lane);
    const float rstd = rsqrtf(wave_sum((v.x * v.x + v.y * v.y) + (v.z * v.z + v.w * v.w)) * (1.f / GDV) + EPS);
    const f32x4 gg = *(const f32x4*)(gn + 4 * lane); const bf16* sg = proj + (size_t)m * NIN + GR_OFF + h * GDV + 4 * lane;
    u32x2 w; w.x = pk2(v.x * rstd * gg.x * bf2f(sg[0]), v.y * rstd * gg.y * bf2f(sg[1])); w.y = pk2(v.z * rstd * gg.z * bf2f(sg[2]), v.w * rstd * gg.w * bf2f(sg[3]));
    *(u32x2*)(og + (size_t)m * GVW + h * GDV + 4 * lane) = w;
}
__global__ __launch_bounds__(128) void k_moba_naive(const bf16* proj, const float* kmean, bf16* om) {
    __shared__ float qs[MHD]; __shared__ float sc[SEQ / 2 + MBLK]; __shared__ float red[128]; __shared__ float bsc[8]; __shared__ int selb;
    const int t = blockIdx.x % SEQ, bh = blockIdx.x / SEQ, b = bh / MH, h = bh % MH, tid = threadIdx.x, qb = t / MBLK;
    const size_t m = (size_t)b * SEQ + t;
    qs[tid] = bf2f(proj[m * NIN + MQ_OFF + h * MHD + tid]);
    __syncthreads();
    if (tid < 8) { float s = -INFINITY; if (tid < qb) { s = 0.f; const float* km = kmean + ((size_t)bh * MNB + tid) * MHD; for (int d = 0; d < MHD; ++d) s += qs[d] * km[d]; } bsc[tid] = s; }
    __syncthreads();
    if (tid == 0) { int bits = 0;
        for (int r = 0; r < MTOPK; ++r) { int best = -1; float bv = -INFINITY; for (int j = 0; j < qb; ++j) if (!((bits >> j) & 1) && (best < 0 || bsc[j] > bv)) { best = j; bv = bsc[j]; } if (best >= 0) bits |= 1 << best; }
        selb = bits; }
    __syncthreads();
    const int bits = selb;
    const int nsel = __popc(bits);
    const int nown = t - qb * MBLK + 1, ncand = nsel * MBLK + nown;
#define KEY_OF(i, key) do { const int sblk_ = (i) / MBLK; if (sblk_ >= nsel) key = qb * MBLK + ((i) - nsel * MBLK); else { int cnt_ = 0, blk_ = 0; for (int j_ = 0; j_ < 8; ++j_) if ((bits >> j_) & 1) { if (cnt_ == sblk_) blk_ = j_; ++cnt_; } key = blk_ * MBLK + ((i) % MBLK); } } while (0)
    float mx = -INFINITY;
    for (int i = tid; i < ncand; i += 128) { int key; KEY_OF(i, key);
        const bf16* kr = proj + ((size_t)b * SEQ + key) * NIN + MK_OFF + h * MHD; float s = 0.f;
        for (int d8 = 0; d8 < MHD / 8; ++d8) { const u32x4 w = *(const u32x4*)(kr + 8 * d8); const float* qq = qs + 8 * d8;
            s += qq[0] * bf2f(w.x & 0xffff) + qq[1] * bf2f(w.x >> 16) + qq[2] * bf2f(w.y & 0xffff) + qq[3] * bf2f(w.y >> 16) + qq[4] * bf2f(w.z & 0xffff) + qq[5] * bf2f(w.z >> 16) + qq[6] * bf2f(w.w & 0xffff) + qq[7] * bf2f(w.w >> 16); }
        s *= 0.08838834764831845f; sc[i] = s; mx = fmaxf(mx, s); }
    red[tid] = mx; __syncthreads();
    for (int o = 64; o > 0; o >>= 1) { if (tid < o) red[tid] = fmaxf(red[tid], red[tid + o]); __syncthreads(); }
    mx = red[0]; __syncthreads();
    float sum = 0.f;
    for (int i = tid; i < ncand; i += 128) { const float p = __expf(sc[i] - mx); sc[i] = p; sum += p; }
    red[tid] = sum; __syncthreads();
    for (int o = 64; o > 0; o >>= 1) { if (tid < o) red[tid] += red[tid + o]; __syncthreads(); }
    sum = red[0];
    float o = 0.f;
    for (int i = 0; i < ncand; ++i) { int key; KEY_OF(i, key);
        o += sc[i] * bf2f(proj[((size_t)b * SEQ + key) * NIN + MV_OFF + h * MHD + tid]); }
    om[m * MW + h * MHD + tid] = (bf16)f2bf(o / sum);
}

#ifndef FAST_P0
#define FAST_P0 1
#endif
#ifndef FAST_IN
#define FAST_IN 1
#endif
#ifndef FAST_PRE
#define FAST_PRE 1
#endif
#ifndef FAST_MIX
#define FAST_MIX 0
#endif
#ifndef FAST_UP
#define FAST_UP 1
#endif
#ifndef FAST_OUT
#define FAST_OUT 1
#endif
#ifndef FAST_FFI
#define FAST_FFI 1
#endif
#ifndef FAST_FFO
#define FAST_FFO 1
#endif
#ifndef FAST_FINAL
#define FAST_FINAL 1
#endif
#ifndef ONE_LAUNCH
#define ONE_LAUNCH 1
#endif
#ifndef HYBRID_BAR
#define HYBRID_BAR 1
#endif
extern "C" void kernel_launch(void* const* d_in, const int* in_sizes, int n_in, void* d_out, int out_size, void* d_ws, size_t ws_size, hipStream_t stream) {
    static int grid = 0;
    if (grid == 0) {
        if (n_in != 16 || in_sizes[0] != MT * DM || out_size != MT * DM || ws_size < WS_DBG_END) { fprintf(stderr, "kernel_launch: unexpected shapes/ws (n_in %d, ws %zu, need %zu)\n", n_in, ws_size, (size_t)WS_DBG_END); grid = -1; return; }
        int dev = 0, cus = 0, per_cu = 0;
        if (hipGetDevice(&dev) != hipSuccess || hipDeviceGetAttribute(&cus, hipDeviceAttributeMultiprocessorCount, dev) != hipSuccess) { grid = -1; return; }
        if (hipFuncSetAttribute((const void*)mega, hipFuncAttributeMaxDynamicSharedMemorySize, LDS_BYTES) != hipSuccess) { fprintf(stderr, "kernel_launch: hipFuncSetAttribute failed\n"); grid = -1; return; }
        if (hipOccupancyMaxActiveBlocksPerMultiprocessor(&per_cu, (const void*)mega, NWAVES * 64, LDS_BYTES) != hipSuccess || per_cu < 1) fprintf(stderr, "kernel_launch: occupancy query says %d\n", per_cu);
        (void)hipGetLastError();
        grid = cus;
    }
    if (grid < 0) return;
    Args a{};
    Params& P = a.P;
    P.x = (const float*)d_in[0]; P.c = (const float*)d_in[1]; P.ada_w = (const float*)d_in[2]; P.ada_b = (const float*)d_in[3]; P.norm1_g = (const float*)d_in[4]; P.w_in = (const float*)d_in[5];
    P.gate_w2 = (const float*)d_in[6]; P.gate_b = (const float*)d_in[7]; P.gla_norm_g = (const float*)d_in[8]; P.w_up_gla = (const float*)d_in[9]; P.w_up_moba = (const float*)d_in[10];
    P.w_out = (const float*)d_in[11]; P.norm2_g = (const float*)d_in[12]; P.w_ffn_in = (const float*)d_in[13]; P.w_ffn_out = (const float*)d_in[14]; P.final_g = (const float*)d_in[15];
    P.out = (float*)d_out; P.ws = (unsigned char*)d_ws;
    unsigned char* ws = (unsigned char*)d_ws;
    (void)hipMemsetAsync(ws + WS_CTL, 0, CTL_ZERO_BYTES, stream);
#define MEGA(lo_, hi_) do { a.ph_lo = (lo_); a.ph_hi = (hi_); a.li = 0; hipLaunchKernelGGL(mega, dim3(grid), dim3(NWAVES * 64), LDS_BYTES, stream, a); } while (0)
#define MEGAB(lo_, hi_, li_) do { a.ph_lo = (lo_); a.ph_hi = (hi_); a.li = (li_); hipLaunchKernelGGL(mega, dim3(grid), dim3(NWAVES * 64), LDS_BYTES, stream, a); } while (0)
#if ONE_LAUNCH
    MEGA(0, PH_COUNT);
#elif HYBRID_BAR
    {
        bf16* OGOM = (bf16*)(ws + WS_OGOM); bf16* PROJ = (bf16*)(ws + WS_PROJ); float* GLR = (float*)(ws + WS_GLR); float* KMEAN = (float*)(ws + WS_KMEAN);
        float* DBG_G = (float*)(ws + WS_DBG_G); float* DBG_O = (float*)(ws + WS_DBG_O);
        const int resume = EN_MOBA ? PL_MIX : PL_UP;
        for (int l = 0; l < DEPTH; ++l) {
            const int pb = PH_L0 + l * PH_PER_LAYER;
            MEGAB(l == 0 ? 0 : PH_L0 + (l - 1) * PH_PER_LAYER + resume, pb + PL_PRE + 1, l);
            if (!EN_GLA) {
                k_gla_g<<<MT, 512, 0, stream>>>(GLR, P.gate_w2 + (size_t)l * GRANK * GKW, P.gate_b + (size_t)l * GKW, DBG_G);
                k_gla_rec<<<NB * GH, 256, 0, stream>>>(PROJ, DBG_G, DBG_O);
                k_gla_norm<<<MT * GH / 4, 256, 0, stream>>>(DBG_O, PROJ, P.gla_norm_g + (size_t)l * GDV, OGOM); }
            if (!EN_MOBA) k_moba_naive<<<NB * MH * SEQ, 128, 0, stream>>>(PROJ, KMEAN, OGOM + (size_t)MT * GVW);
        }
        MEGAB(PH_L0 + (DEPTH - 1) * PH_PER_LAYER + resume, PH_COUNT, DEPTH);
    }
#else
    bf16* ABUF = (bf16*)(ws + WS_ABUF); bf16* OGOM = (bf16*)(ws + WS_OGOM); bf16* PROJ = (bf16*)(ws + WS_PROJ); bf16* HID = PROJ;
    float* GLR = (float*)(ws + WS_GLR); float* KMEAN = (float*)(ws + WS_KMEAN);
    float* DBG_G = (float*)(ws + WS_DBG_G); float* DBG_O = (float*)(ws + WS_DBG_O);
    const float* MODV = (const float*)(ws + WS_MODV);
    float* xs = (float*)d_out;
    MEGA(PH_P0A, PH_P0A + 1); MEGA(PH_P0B, PH_P0B + 1); MEGA(PH_P0C, PH_P0C + 1);
    for (int l = 0; l < DEPTH; ++l) {
        const int pb = PH_L0 + l * PH_PER_LAYER;
        const bf16* Win = (const bf16*)(ws + WS_WT + (size_t)l * WT_LAYER + WT_IN); const bf16* Wglr = (const bf16*)(ws + WS_WT + (size_t)l * WT_LAYER + WT_GLR);
        const bf16* Wupg = (const bf16*)(ws + WS_WT + (size_t)l * WT_LAYER + WT_UPG); const bf16* Wupm = (const bf16*)(ws + WS_WT + (size_t)l * WT_LAYER + WT_UPM);
        const bf16* Wout = (const bf16*)(ws + WS_WT + (size_t)l * WT_LAYER + WT_OUT); const bf16* Wffi = (const bf16*)(ws + WS_WT + (size_t)l * WT_LAYER + WT_FFI); const bf16* Wffo = (const bf16*)(ws + WS_WT + (size_t)l * WT_LAYER + WT_FFO);
        const float* shwin = (const float*)(ws + WS_SHWIN) + (size_t)l * 8 * NIN; const float* shwglr = (const float*)(ws + WS_SHWGLR) + (size_t)l * 8 * GRANK; const float* shwffi = (const float*)(ws + WS_SHWFFI) + (size_t)l * 8 * NFFI;
        const float* mv = MODV + (size_t)l * 8 * 6 * DM; const float* mvn = MODV + (size_t)(l + 1 < DEPTH ? l + 1 : l) * 8 * 6 * DM;
        float* SSQB = (float*)(ws + WS_SSQ) + (size_t)l * MT; float* SSQN = (float*)(ws + WS_SSQ) + (size_t)(2 + l) * MT;
        const float* ssq_in = l == 0 ? (const float*)(ws + WS_SSQ0) : (const float*)(ws + WS_SSQ) + (size_t)(2 + l - 1) * MT;
        if (FAST_IN) MEGA(pb + PL_IN, pb + PL_IN + 1);
        else k_naive_gemm<4, NEpiIn><<<dim3(NIN / 64, MT / 64), 256, 0, stream>>>(ABUF, DM, Win, DM, DM, NEpiIn{ssq_in, shwin, PROJ});
        if (FAST_PRE) MEGA(pb + PL_PRE, pb + PL_PRE + 1);
        else { k_naive_gemm<1, NEpiGlr><<<dim3(1, MT / 64), 256, 0, stream>>>(ABUF, DM, Wglr, DM, DM, NEpiGlr{ssq_in, shwglr, GLR});
               k_kmean<<<NB * MH * MNB, 128, 0, stream>>>(PROJ, KMEAN); }
        if (FAST_MIX) MEGA(pb + PL_MIX, pb + PL_MIX + 1);
        else { k_gla_g<<<MT, 512, 0, stream>>>(GLR, P.gate_w2 + (size_t)l * GRANK * GKW, P.gate_b + (size_t)l * GKW, DBG_G);
               k_gla_rec<<<NB * GH, 256, 0, stream>>>(PROJ, DBG_G, DBG_O);
               k_gla_norm<<<MT * GH / 4, 256, 0, stream>>>(DBG_O, PROJ, P.gla_norm_g + (size_t)l * GDV, OGOM);
               k_moba_naive<<<NB * MH * SEQ, 128, 0, stream>>>(PROJ, KMEAN, OGOM + (size_t)MT * GVW); }
        if (FAST_UP) MEGA(pb + PL_UP, pb + PL_UP + 1);
        else { k_naive_gemm<4, NEpiUp1><<<dim3(DM / 64, MT / 64), 256, 0, stream>>>(OGOM, GVW, Wupg, GVW, GVW, NEpiUp1{PROJ, ABUF});
               k_naive_gemm<4, NEpiUp2><<<dim3(DM / 64, MT / 64), 256, 0, stream>>>(OGOM + (size_t)MT * GVW, MW, Wupm, MW, MW, NEpiUp2{PROJ, ABUF}); }
        if (FAST_OUT) MEGA(pb + PL_OUT, pb + PL_OUT + 1);
        else { k_naive_gemm<4, NEpiRes><<<dim3(DM / 64, MT / 64), 256, 0, stream>>>(ABUF, DM, Wout, DM, DM, NEpiRes{l == 0 ? P.x : xs, xs, mv + 2 * DM, mv + 4 * DM, OGOM});
               k_rowssq<<<MT / 4, 256, 0, stream>>>(xs, SSQB); }
        if (FAST_FFI) MEGA(pb + PL_FFI, pb + PL_FFI + 1);
        else k_naive_ffi<<<dim3(DFF / 16, MT / 64), 256, 0, stream>>>(OGOM, Wffi, SSQB, shwffi, HID);
        if (FAST_FFO) MEGA(pb + PL_FFO, pb + PL_FFO + 1);
        else { k_naive_gemm<4, NEpiRes><<<dim3(DM / 64, MT / 64), 256, 0, stream>>>(HID, DFF, Wffo, DFF, DFF, NEpiRes{xs, xs, mv + 5 * DM, mvn + 1 * DM, l + 1 < DEPTH ? ABUF : nullptr});
               k_rowssq<<<MT / 4, 256, 0, stream>>>(xs, SSQN); }
    }
    if (FAST_FINAL) MEGA(PH_FINAL, PH_FINAL + 1);
    else k_final<<<MT / 4, 256, 0, stream>>>(xs, P.final_g);
#endif
#undef MEGA
#undef MEGAB
}
```

```cpp
#include <hip/hip_runtime.h>
#include <cstdio>
#include <cstdint>

constexpr int NB = 8, SEQ = 2048, DM = 2048, MT = NB * SEQ, DEPTH = 2;
constexpr int GH = 4, GDK = 128, GDV = 256, GKW = 512, GVW = 1024, GRANK = 16, GCH = 64;
constexpr int MH = 8, MHD = 128, MW = 1024, MBLK = 256, MNB = SEQ / MBLK, MTOPK = 3;
constexpr int DFF = 5632, NFFI = 2 * DFF;
constexpr int NINSRC = 10256, NIN = 10240;
constexpr float EPS = 1e-6f;
constexpr int GQ_OFF = 0, GK_OFF = 512, GV_OFF = 1024, GR_OFF = 2048, MQ_OFF = 3072, MK_OFF = 4096, MV_OFF = 5120, GT_OFF = 6144;
constexpr int GLR_SRC = 3072;
constexpr size_t PJ_GQ = 0, PJ_GK = (size_t)MT * 512, PJ_GV = (size_t)MT * 1024, PJ_GR = (size_t)MT * 2048, PJ_MQ = (size_t)MT * 3072, PJ_MK = (size_t)MT * 4096, PJ_MV = (size_t)MT * 5120, PJ_GT = (size_t)MT * 6144;

constexpr size_t MiB = 1u << 20;
constexpr size_t WS_CTL = 0, CTL_ZERO_BYTES = 2 * MiB;
constexpr size_t WS_SSQ = 1 * MiB;
constexpr size_t WS_MODP = 2 * MiB;
constexpr size_t WS_MODV = 8 * MiB;
constexpr size_t WS_SHWIN = 9 * MiB;
constexpr size_t WS_SHWFFI = 10 * MiB;
constexpr size_t WS_SHWGLR = 11 * MiB;
constexpr size_t WS_GLR = 12 * MiB;
constexpr size_t WS_KMEAN = 13 * MiB;
constexpr size_t WS_SSQ0 = 14 * MiB;
constexpr size_t WS_WT = 16 * MiB, WT_LAYER = 123 * MiB;
constexpr size_t WT_IN = 0, WT_GLR = 40 * MiB, WT_UPG = 41 * MiB, WT_UPM = 45 * MiB, WT_OUT = 49 * MiB, WT_FFI = 57 * MiB, WT_FFO = 101 * MiB;
constexpr size_t WS_ABUF = 262 * MiB;
constexpr size_t WS_OGOM = 326 * MiB;
constexpr size_t WS_PROJ = 390 * MiB;
constexpr size_t WS_END = 710 * MiB;
constexpr size_t WS_DBG_G = 710 * MiB;
constexpr size_t WS_DBG_O = 742 * MiB;
constexpr size_t WS_DBG_END = 806 * MiB;

typedef unsigned short bf16;
typedef short bf16x8 __attribute__((ext_vector_type(8)));
typedef float f32x4 __attribute__((ext_vector_type(4)));
typedef unsigned u32x4 __attribute__((ext_vector_type(4)));
typedef unsigned u32x2 __attribute__((ext_vector_type(2)));

struct Params {
    const float* x; const float* c; const float* ada_w; const float* ada_b; const float* norm1_g; const float* w_in;
    const float* gate_w2; const float* gate_b; const float* gla_norm_g; const float* w_up_gla; const float* w_up_moba;
    const float* w_out; const float* norm2_g; const float* w_ffn_in; const float* w_ffn_out; const float* final_g;
    float* out; unsigned char* ws;
};

__device__ __forceinline__ unsigned f2bf(float f) { unsigned u = __builtin_bit_cast(unsigned, f); return (u + 0x7fffu + ((u >> 16) & 1u)) >> 16; }
__device__ __forceinline__ unsigned pk2(float lo, float hi) { return f2bf(lo) | (f2bf(hi) << 16); }
__device__ __forceinline__ float bf2f(unsigned short b) { return __builtin_bit_cast(float, ((unsigned)b) << 16); }
__device__ __forceinline__ float wave_sum(float v) {
#pragma unroll
    for (int o = 1; o < 64; o <<= 1) v += __shfl_xor(v, o);
    return v;
}
__device__ __forceinline__ float sigmoidf_(float v) { return 1.0f / (1.0f + __expf(-v)); }
__device__ __forceinline__ float siluf_(float v) { return v / (1.0f + __expf(-v)); }
__device__ __forceinline__ float logsigmoidf_(float v) { return fminf(v, 0.f) - log1pf(__expf(-fabsf(v))); }

__device__ __forceinline__ const bf16* wt_ptr(const Params& P, int l, size_t off) { return (const bf16*)(P.ws + WS_WT + (size_t)l * WT_LAYER + off); }
__device__ __forceinline__ int in_src_col(int n) { return n < 3072 ? n : n + 16; }
__device__ __forceinline__ int ffi_src_col(int r) { const int pn = r >> 8, c = r & 255; return c < 128 ? pn * 128 + c : DFF + pn * 128 + (c - 128); }

__device__ __forceinline__ void ada_item(const Params& P, int item, int lane, float* scr) {
    const int cg = item % 96, kc = (item / 96) % 8, l = item / 768;
    const int k0 = kc * 256;
    for (int i = 0; i < 32; ++i) { const int idx = lane + 64 * i, b = idx >> 8, kk = idx & 255; scr[idx] = siluf_(P.c[b * DM + k0 + kk]); }
    __builtin_amdgcn_s_waitcnt(0);
    const float* W = P.ada_w + (size_t)l * DM * (6 * DM) + (size_t)k0 * (6 * DM) + cg * 128 + 2 * lane;
    float a0[8], a1[8];
#pragma unroll
    for (int b = 0; b < 8; ++b) { a0[b] = 0.f; a1[b] = 0.f; }
#pragma unroll 8
    for (int kk = 0; kk < 256; ++kk) {
        const float2 w = *(const float2*)(W + (size_t)kk * (6 * DM));
#pragma unroll
        for (int b = 0; b < 8; ++b) { const float cv = scr[b * 256 + kk]; a0[b] += cv * w.x; a1[b] += cv * w.y; }
    }
    float* MP = (float*)(P.ws + WS_MODP) + ((size_t)(kc * 2 + l) * 8) * (6 * DM) + cg * 128 + 2 * lane;
#pragma unroll
    for (int b = 0; b < 8; ++b) *(float2*)(MP + (size_t)b * (6 * DM)) = make_float2(a0[b], a1[b]);
    __builtin_amdgcn_s_waitcnt(0);
}
__device__ __forceinline__ void transpose_item(const float* W, int Nsrc, int src_col0, int K, int k0, bf16* WT, int dst_row0, float* scr, int lane) {
    f32x4 v[8];
    const float* src = W + (size_t)(k0 + (lane >> 3)) * Nsrc + src_col0 + 4 * (lane & 7);
#pragma unroll
    for (int i = 0; i < 8; ++i) v[i] = *(const f32x4*)(src + (size_t)(8 * i) * Nsrc);
#pragma unroll
    for (int i = 0; i < 8; ++i) { float* d = scr + (8 * i + (lane >> 3)) * 33 + 4 * (lane & 7); d[0] = v[i][0]; d[1] = v[i][1]; d[2] = v[i][2]; d[3] = v[i][3]; }
    __builtin_amdgcn_s_waitcnt(0);
    const int c = lane & 7;
#pragma unroll
    for (int j = 0; j < 4; ++j) { const int n = (lane >> 3) + 8 * j; const float* s = scr + (8 * c) * 33 + n;
        u32x4 o; o.x = pk2(s[0 * 33], s[1 * 33]); o.y = pk2(s[2 * 33], s[3 * 33]); o.z = pk2(s[4 * 33], s[5 * 33]); o.w = pk2(s[6 * 33], s[7 * 33]);
        *(u32x4*)(WT + (size_t)(dst_row0 + n) * K + k0 + 8 * c) = o; }
    __builtin_amdgcn_s_waitcnt(0);
}
constexpr int TI_IN = (DM / 64) * (NIN / 32), TI_UP = (GVW / 64) * (DM / 32), TI_OUT = (DM / 64) * (DM / 32), TI_FFI = (DM / 64) * (NFFI / 32), TI_FFO = (DFF / 64) * (DM / 32), TI_GLR = DM / 64;
constexpr int TI_LAYER = TI_IN + 2 * TI_UP + TI_OUT + TI_FFI + TI_FFO + TI_GLR;
__device__ __forceinline__ void wconv_item(const Params& P, int item, int lane, float* scr) {
    const int l = item / TI_LAYER; int r = item % TI_LAYER;
    unsigned char* wl = P.ws + WS_WT + (size_t)l * WT_LAYER;
    if (r < TI_IN) { const int nb = r % (NIN / 32), kb = r / (NIN / 32);
        transpose_item(P.w_in + (size_t)l * DM * NINSRC, NINSRC, in_src_col(nb * 32), DM, kb * 64, (bf16*)(wl + WT_IN), nb * 32, scr, lane); return; } r -= TI_IN;
    if (r < TI_UP) { const int nb = r % (DM / 32), kb = r / (DM / 32);
        transpose_item(P.w_up_gla + (size_t)l * GVW * DM, DM, nb * 32, GVW, kb * 64, (bf16*)(wl + WT_UPG), nb * 32, scr, lane); return; } r -= TI_UP;
    if (r < TI_UP) { const int nb = r % (DM / 32), kb = r / (DM / 32);
        transpose_item(P.w_up_moba + (size_t)l * MW * DM, DM, nb * 32, MW, kb * 64, (bf16*)(wl + WT_UPM), nb * 32, scr, lane); return; } r -= TI_UP;
    if (r < TI_OUT) { const int nb = r % (DM / 32), kb = r / (DM / 32);
        transpose_item(P.w_out + (size_t)l * DM * DM, DM, nb * 32, DM, kb * 64, (bf16*)(wl + WT_OUT), nb * 32, scr, lane); return; } r -= TI_OUT;
    if (r < TI_FFI) { const int nb = r % (NFFI / 32), kb = r / (NFFI / 32);
        transpose_item(P.w_ffn_in + (size_t)l * DM * NFFI, NFFI, ffi_src_col(nb * 32), DM, kb * 64, (bf16*)(wl + WT_FFI), nb * 32, scr, lane); return; } r -= TI_FFI;
    if (r < TI_FFO) { const int nb = r % (DM / 32), kb = r / (DM / 32);
        transpose_item(P.w_ffn_out + (size_t)l * DFF * DM, DM, nb * 32, DFF, kb * 64, (bf16*)(wl + WT_FFO), nb * 32, scr, lane); return; } r -= TI_FFO;
    { const int k0 = r * 64, j = lane & 15, kq = lane >> 4; bf16* G = (bf16*)(wl + WT_GLR); const float* W = P.w_in + (size_t)l * DM * NINSRC;
        for (int kk = 0; kk < 16; ++kk) { const int k = k0 + kq * 16 + kk; G[(size_t)j * DM + k] = (bf16)f2bf(W[(size_t)k * NINSRC + GLR_SRC + j]); } }
}
__device__ __forceinline__ void phase_p0a(const Params& P, int gw, int ngw, int lane, float* scr) {
    constexpr int NADA = 2 * 8 * 96;
    for (int it = gw; it < NADA; it += ngw) ada_item(P, it, lane, scr);
    for (int it = gw; it < DEPTH * TI_LAYER; it += ngw) wconv_item(P, it, lane, scr);
}
__device__ __forceinline__ void phase_p0b(const Params& P, int gtid, int ngt) {
    const float* MP = (const float*)(P.ws + WS_MODP); float* MV = (float*)(P.ws + WS_MODV);
    for (int i = gtid; i < 2 * 8 * DM; i += ngt) {
        const int j = i % DM, b = (i / DM) % 8, l = i / (8 * DM);
        float m[6];
#pragma unroll
        for (int s = 0; s < 6; ++s) { float a = P.ada_b[l * 6 * DM + s * DM + j];
            for (int kc = 0; kc < 8; ++kc) a += MP[((size_t)(kc * 2 + l) * 8 + b) * (6 * DM) + s * DM + j]; m[s] = a; }
        float* o = MV + ((size_t)(l * 8 + b) * 6) * DM + j;
        o[0 * DM] = m[0]; o[1 * DM] = P.norm1_g[l * DM + j] * (1.f + m[1]); o[2 * DM] = m[2];
        o[3 * DM] = m[3]; o[4 * DM] = P.norm2_g[l * DM + j] * (1.f + m[4]); o[5 * DM] = m[5];
    }
}
__device__ __forceinline__ void a1prep_row(const Params& P, int m, int lane) {
    const int b = m / SEQ; const float* gm = (const float*)(P.ws + WS_MODV) + ((size_t)(0 * 8 + b) * 6 + 1) * DM;
    const f32x4* xr = (const f32x4*)(P.x + (size_t)m * DM); bf16* A = (bf16*)(P.ws + WS_ABUF) + (size_t)m * DM;
    float s = 0.f;
#pragma unroll
    for (int j = 0; j < 8; ++j) { const f32x4 v = xr[lane + 64 * j]; const f32x4 g = *(const f32x4*)(gm + 4 * (lane + 64 * j));
        s += (v.x * v.x + v.y * v.y) + (v.z * v.z + v.w * v.w);
        u32x2 w; w.x = pk2(v.x * g.x, v.y * g.y); w.y = pk2(v.z * g.z, v.w * g.w); *(u32x2*)(A + 4 * (lane + 64 * j)) = w; }
    s = wave_sum(s);
    if (lane == 0) ((float*)(P.ws + WS_SSQ0))[m] = s;
}
__device__ __forceinline__ void shw_combo(const Params& P, int combo, int wgw, int nwg_waves, int gw, int ngw, int tid, int nthr, int lane, float* shl) {
    const int l = combo >> 1, which = combo & 1;
    const float* MV = (const float*)(P.ws + WS_MODV);
    for (int i = tid; i < 8 * DM; i += nthr) { const int b = i / DM, k = i % DM; shl[i] = MV[((size_t)(l * 8 + b) * 6 + (which ? 3 : 0)) * DM + k]; }
    __syncthreads();
    const int nrows = which ? NFFI : NIN + GRANK;
    for (int n = gw; n < nrows; n += ngw) {
        const bf16* row = which ? wt_ptr(P, l, WT_FFI) + (size_t)n * DM : (n < NIN ? wt_ptr(P, l, WT_IN) + (size_t)n * DM : wt_ptr(P, l, WT_GLR) + (size_t)(n - NIN) * DM);
        float acc[8];
#pragma unroll
        for (int b = 0; b < 8; ++b) acc[b] = 0.f;
#pragma unroll 1
        for (int j = 0; j < 4; ++j) { const int k0 = 8 * lane + 512 * j; const u32x4 w = *(const u32x4*)(row + k0);
            float wf[8]; wf[0] = bf2f(w.x & 0xffff); wf[1] = bf2f(w.x >> 16); wf[2] = bf2f(w.y & 0xffff); wf[3] = bf2f(w.y >> 16); wf[4] = bf2f(w.z & 0xffff); wf[5] = bf2f(w.z >> 16); wf[6] = bf2f(w.w & 0xffff); wf[7] = bf2f(w.w >> 16);
#pragma unroll
            for (int b = 0; b < 8; ++b) { const f32x4 s0 = *(const f32x4*)(shl + b * DM + k0), s1 = *(const f32x4*)(shl + b * DM + k0 + 4);
                acc[b] += (s0.x * wf[0] + s0.y * wf[1]) + (s0.z * wf[2] + s0.w * wf[3]) + (s1.x * wf[4] + s1.y * wf[5]) + (s1.z * wf[6] + s1.w * wf[7]); } }
#pragma unroll
        for (int b = 0; b < 8; ++b) acc[b] = wave_sum(acc[b]);
        if (lane == 0) {
#pragma unroll
            for (int b = 0; b < 8; ++b) {
                if (which) ((float*)(P.ws + WS_SHWFFI))[((size_t)l * 8 + b) * NFFI + n] = acc[b];
                else if (n < NIN) ((float*)(P.ws + WS_SHWIN))[((size_t)l * 8 + b) * NIN + n] = acc[b];
                else ((float*)(P.ws + WS_SHWGLR))[((size_t)l * 8 + b) * GRANK + (n - NIN)] = acc[b]; } }
    }
    __syncthreads();
}

namespace pg8 {
#define PG8_LAS __attribute__((address_space(3)))
typedef unsigned short bf16_t;
typedef short bf16x8 __attribute__((ext_vector_type(8)));
typedef float f32x4 __attribute__((ext_vector_type(4)));
typedef unsigned u32x4 __attribute__((ext_vector_type(4)));
constexpr int BM = 256, BK = 64, HALF = 128, HTB = HALF * BK * 2  , STAGE_BYTES = 8 * HTB, NXCD = 8, WGM = 8;

__host__ __device__ __forceinline__ int lds_byte(int r, int c) { const int st = (r >> 4) * 2 + (c >> 5), rr = r & 15, cc = c & 31, ob = rr * 64 + cc * 2; return st * 1024 + (ob ^ (((ob >> 9) & 1) << 5)); }
__host__ __device__ __forceinline__ void stage_rc(int b, int& R, int& C) { const int st = b / 1024, sb = b % 1024, swz = sb ^ (((sb >> 9) & 1) << 5); R = (st >> 1) * 16 + swz / 64; C = (st & 1) * 32 + (swz % 64) / 2; }
__host__ __device__ __forceinline__ int perm32(int rho) { const int n = rho >> 4, i = rho & 15; return 8 * (i >> 2) + 4 * n + (i & 3); }

struct Unit { int pm, pn; };
struct Gemm { const bf16_t* A; const bf16_t* Bt; int M, N, K; };

struct StaticOrder {
    int nM, nN, nwg, G, c;
    __host__ __device__ void init(int M, int N, int G_, int c_) { nM = M / BM; nN = N / BM; nwg = nM * nN; G = G_; c = c_; }
    __host__ __device__ bool next(int i, Unit& u) const {
        const long L = (long)i * G + c; if (L >= nwg) return false;
        int wgid = (int)L; { const int q = nwg / NXCD, r = nwg % NXCD, xcd = wgid % NXCD, off = wgid / NXCD; wgid = (xcd < r ? xcd * (q + 1) : r * (q + 1) + (xcd - r) * q) + off; }
        const int nig = WGM * nN, gid = wgid / nig, fm = gid * WGM, gsz = (nM - fm) < WGM ? (nM - fm) : WGM;
        u.pm = fm + ((wgid % nig) % gsz); u.pn = (wgid % nig) / gsz; return true;
    }
    __device__ __forceinline__ void a_ready(const Unit&) const {}
    __device__ __forceinline__ void done(const Unit&) const {}
};
__device__ __forceinline__ unsigned cvt_pk_bf16(float lo, float hi) { unsigned r; asm volatile("v_cvt_pk_bf16_f32 %0, %1, %2" : "=v"(r) : "v"(lo), "v"(hi)); return r; }
typedef float f32x2 __attribute__((ext_vector_type(2)));
__device__ __forceinline__ float fsig(float v) { return __builtin_amdgcn_rcpf(1.0f + __builtin_amdgcn_exp2f(-1.4426950408889634f * v)); }
__device__ __forceinline__ float bflo(unsigned w) { return __builtin_bit_cast(float, w << 16); }
__device__ __forceinline__ float bfhi(unsigned w) { return __builtin_bit_cast(float, w & 0xffff0000u); }
struct EpiIn {
    static constexpr bool PERM = true, AFTER_DRAIN = false;
    const float* ssq; const float* shw; bf16_t* proj;
    __device__ __forceinline__ void operator()(const f32x4 (&acc)[2][2][4][2], const Unit& u, int wr, int wc, int fr, int fq) const {
        const int row0 = u.pm * BM + wr * 64 + fr, col0 = u.pn * BM + wc * 32 + 8 * fq, b = u.pm >> 3, t0 = (u.pm & 7) * BM + wr * 64 + fr;
        const int mode = u.pn < 2 ? 1 : ((u.pn >= 8 && u.pn < 12) ? 2 : (u.pn >= 24 ? 3 : 0));
        size_t off[2]; int stride;
        if (u.pn >= 24) { stride = 4096; off[0] = PJ_GT + (size_t)b * SEQ * 4096 + (u.pn * BM - GT_OFF) + wc * 32 + 8 * fq; off[1] = off[0] + HALF; }
        else { const int seg = u.pn < 2 ? 0 : u.pn < 4 ? 1 : u.pn < 8 ? 2 : u.pn < 12 ? 3 : u.pn < 16 ? 4 : u.pn < 20 ? 5 : 6;
            const size_t base = seg == 0 ? PJ_GQ : seg == 1 ? PJ_GK : seg == 2 ? PJ_GV : seg == 3 ? PJ_GR : seg == 4 ? PJ_MQ : seg == 5 ? PJ_MK : PJ_MV;
            const int c0 = seg == 0 ? GQ_OFF : seg == 1 ? GK_OFF : seg == 2 ? GV_OFF : seg == 3 ? GR_OFF : seg == 4 ? MQ_OFF : seg == 5 ? MK_OFF : MV_OFF;
            const bool wide = (seg == 2 || seg == 3); const int nh = seg >= 4 ? MH : GH; stride = wide ? 256 : 128;
#pragma unroll
            for (int bj = 0; bj < 2; ++bj) { const int cs = u.pn * BM - c0 + bj * HALF, head = wide ? (cs >> 8) : (cs >> 7), d = (wide ? (cs & 255) : 0) + wc * 32 + 8 * fq;
                off[bj] = base + ((size_t)(b * nh + head) * SEQ) * stride + d; } }
        f32x4 bv[2][2];
#pragma unroll
        for (int bj = 0; bj < 2; ++bj)
#pragma unroll
            for (int n = 0; n < 2; ++n) bv[bj][n] = *(const f32x4*)(shw + (size_t)b * NIN + col0 + bj * HALF + 4 * n);
#pragma unroll
        for (int ai = 0; ai < 2; ++ai)
#pragma unroll
            for (int m = 0; m < 4; ++m) { const int r = row0 + ai * HALF + m * 16, t = t0 + ai * HALF + m * 16; const float rstd = rsqrtf(ssq[r] * (1.0f / DM) + EPS);
#pragma unroll
                for (int bj = 0; bj < 2; ++bj) { f32x4 v0 = acc[ai][bj][m][0] * rstd + bv[bj][0], v1 = acc[ai][bj][m][1] * rstd + bv[bj][1];
                    if (mode == 1) { v0 = v0 * 0.08838834764831845f; v1 = v1 * 0.08838834764831845f; }
                    else if (mode == 2) {
#pragma unroll
                        for (int j = 0; j < 4; ++j) { v0[j] = v0[j] * fsig(v0[j]); v1[j] = v1[j] * fsig(v1[j]); } }
                    else if (mode == 3) {
#pragma unroll
                        for (int j = 0; j < 4; ++j) { v0[j] = fsig(v0[j]); v1[j] = fsig(v1[j]); } }
                    u32x4 w; w.x = cvt_pk_bf16(v0[0], v0[1]); w.y = cvt_pk_bf16(v0[2], v0[3]); w.z = cvt_pk_bf16(v1[0], v1[1]); w.w = cvt_pk_bf16(v1[2], v1[3]);
                    *(u32x4*)(proj + off[bj] + (size_t)t * stride) = w; } }
    }
};
struct EpiFfi {
    static constexpr bool PERM = true, AFTER_DRAIN = false;
    const float* ssq; const float* shw; bf16_t* hid;
    __device__ __forceinline__ void operator()(const f32x4 (&acc)[2][2][4][2], const Unit& u, int wr, int wc, int fr, int fq) const {
        const int row0 = u.pm * BM + wr * 64 + fr, bcol0 = u.pn * BM + wc * 32 + 8 * fq, hcol0 = u.pn * HALF + wc * 32 + 8 * fq, b = u.pm >> 3;
        f32x4 bv[2][2];
#pragma unroll
        for (int bj = 0; bj < 2; ++bj)
#pragma unroll
            for (int n = 0; n < 2; ++n) bv[bj][n] = *(const f32x4*)(shw + (size_t)b * NFFI + bcol0 + bj * HALF + 4 * n);
#pragma unroll
        for (int ai = 0; ai < 2; ++ai)
#pragma unroll
            for (int m = 0; m < 4; ++m) { const int r = row0 + ai * HALF + m * 16; const float rstd = rsqrtf(ssq[r] * (1.0f / DM) + EPS);
                f32x4 a0 = acc[ai][0][m][0] * rstd + bv[0][0], a1 = acc[ai][0][m][1] * rstd + bv[0][1];
                const f32x4 u0 = acc[ai][1][m][0] * rstd + bv[1][0], u1 = acc[ai][1][m][1] * rstd + bv[1][1];
#pragma unroll
                for (int j = 0; j < 4; ++j) { a0[j] = a0[j] * fsig(a0[j]) * u0[j]; a1[j] = a1[j] * fsig(a1[j]) * u1[j]; }
                u32x4 w; w.x = cvt_pk_bf16(a0[0], a0[1]); w.y = cvt_pk_bf16(a0[2], a0[3]); w.z = cvt_pk_bf16(a1[0], a1[1]); w.w = cvt_pk_bf16(a1[2], a1[3]);
                *(u32x4*)(hid + (size_t)r * DFF + hcol0) = w; }
    }
};
template <bool SECOND> struct EpiUp {
    static constexpr bool PERM = true, AFTER_DRAIN = false;
    const bf16_t* proj; int goff; bf16_t* mg;
    __device__ __forceinline__ void operator()(const f32x4 (&acc)[2][2][4][2], const Unit& u, int wr, int wc, int fr, int fq) const {
        const int row0 = u.pm * BM + wr * 64 + fr, col0 = u.pn * BM + wc * 32 + 8 * fq;
#pragma unroll
        for (int ai = 0; ai < 2; ++ai)
#pragma unroll
            for (int m = 0; m < 4; ++m) { const int r = row0 + ai * HALF + m * 16;
#pragma unroll
                for (int bj = 0; bj < 2; ++bj) { const u32x4 g = *(const u32x4*)(proj + PJ_GT + (size_t)r * 4096 + (goff - GT_OFF) + col0 + bj * HALF);
                    bf16_t* op = mg + (size_t)r * DM + col0 + bj * HALF;
                    f32x4 v0 = acc[ai][bj][m][0], v1 = acc[ai][bj][m][1];
                    v0[0] *= bflo(g.x); v0[1] *= bfhi(g.x); v0[2] *= bflo(g.y); v0[3] *= bfhi(g.y); v1[0] *= bflo(g.z); v1[1] *= bfhi(g.z); v1[2] *= bflo(g.w); v1[3] *= bfhi(g.w);
                    if (SECOND) { const u32x4 t = *(const u32x4*)op;
                        v0[0] += bflo(t.x); v0[1] += bfhi(t.x); v0[2] += bflo(t.y); v0[3] += bfhi(t.y); v1[0] += bflo(t.z); v1[1] += bfhi(t.z); v1[2] += bflo(t.w); v1[3] += bfhi(t.w); }
                    u32x4 w; w.x = cvt_pk_bf16(v0[0], v0[1]); w.y = cvt_pk_bf16(v0[2], v0[3]); w.z = cvt_pk_bf16(v1[0], v1[1]); w.w = cvt_pk_bf16(v1[2], v1[3]);
                    *(u32x4*)op = w; }
                asm volatile("" ::: "memory"); }
    }
};
struct EpiRes {
    static constexpr bool PERM = false, AFTER_DRAIN = false;
    const float* xin; float* xout; const float* gate; const float* gm; bf16_t* aout; float* ssq;
    __device__ __forceinline__ void operator()(const f32x4 (&acc)[2][2][4][2], const Unit& u, int wr, int wc, int fr, int fq) const {
        const int row0 = u.pm * BM + wr * 64 + fr, col0 = u.pn * BM + wc * 32 + 4 * fq, b = u.pm >> 3;
        f32x4 gv[2][2], mv[2][2];
#pragma unroll
        for (int bj = 0; bj < 2; ++bj)
#pragma unroll
            for (int n = 0; n < 2; ++n) { gv[bj][n] = *(const f32x4*)(gate + (size_t)b * 6 * DM + col0 + bj * HALF + n * 16);
                mv[bj][n] = aout ? *(const f32x4*)(gm + (size_t)b * 6 * DM + col0 + bj * HALF + n * 16) : (f32x4){0.f, 0.f, 0.f, 0.f}; }
#pragma unroll
        for (int ai = 0; ai < 2; ++ai)
#pragma unroll
            for (int m = 0; m < 4; ++m) { const int r = row0 + ai * HALF + m * 16; const size_t off = (size_t)r * DM + col0; float s = 0.f;
#pragma unroll
                for (int bj = 0; bj < 2; ++bj)
#pragma unroll
                    for (int n = 0; n < 2; ++n) { const f32x4 xv = *(const f32x4*)(xin + off + bj * HALF + n * 16); const f32x4 o = xv + gv[bj][n] * acc[ai][bj][m][n];
                        *(f32x4*)(xout + off + bj * HALF + n * 16) = o; s += (o[0] * o[0] + o[1] * o[1]) + (o[2] * o[2] + o[3] * o[3]);
                        if (aout) { const f32x4 a = o * mv[bj][n]; u32x2 w; w.x = cvt_pk_bf16(a[0], a[1]); w.y = cvt_pk_bf16(a[2], a[3]); *(u32x2*)(aout + off + bj * HALF + n * 16) = w; } }
                if (ssq) { s += __shfl_xor(s, 16); s += __shfl_xor(s, 32); if (fq == 0) __hip_atomic_fetch_add(ssq + r, s, __ATOMIC_RELAXED, __HIP_MEMORY_SCOPE_AGENT); }
                asm volatile("" ::: "memory"); }
    }
};
template <class Epi, class Sched, bool ALIGN_EPI = false, bool SP2 = false>
__device__ __forceinline__ void gemm_phase(PG8_LAS unsigned char* lds, const Gemm g, const Sched& S, const Epi& E) {
    int tid_ = threadIdx.x; asm volatile("" : "+v"(tid_));
    const int tid = tid_, wid = __builtin_amdgcn_readfirstlane(tid >> 6), lane = tid & 63, wr = wid >> 2, wc = wid & 3, fr = lane & 15, fq = lane >> 4;
    const int K = g.K, nt = K / BK;
    unsigned voffA[2], voffB[2];
#pragma unroll
    for (int i = 0; i < 2; ++i) { int R, C; stage_rc(tid * 16 + i * 8192, R, C); const int Rb = Epi::PERM ? ((R & ~31) + perm32(R & 31)) : R;
        voffA[i] = (unsigned)(R * K + C) * 2u; voffB[i] = (unsigned)(Rb * K + C) * 2u; }
    const size_t kstep = (size_t)(BK * 2);
    const size_t hstep = (size_t)HALF * K * 2;
    const size_t tstep = 2 * hstep;
    const unsigned ldsw = (unsigned)wid * 1024u;
    const int aoff = lds_byte(wr * 64 + fr, fq * 8), boff = lds_byte(wc * 32 + fr, fq * 8);
#define PG8_SA(b, h) (((b) * 2 + (h)) * HTB)
#define PG8_SB(b, h) ((4 + (b) * 2 + (h)) * HTB)
#define PG8_STAGE(bufoff, gbase, voff) do { _Pragma("unroll") for (int _i = 0; _i < 2; ++_i) \
        __builtin_amdgcn_global_load_lds((const unsigned*)((const char*)(gbase) + (voff)[_i]), (PG8_LAS unsigned*)(lds + (bufoff) + ldsw + _i * 8192), 16, 0, 0); } while (0)
#define PG8_LDA(dst, b, h) do { _Pragma("unroll") for (int m = 0; m < 4; ++m) _Pragma("unroll") for (int k = 0; k < 2; ++k) dst[m][k] = *(const PG8_LAS bf16x8*)(lds + PG8_SA(b, h) + aoff + m * 2048 + k * 1024); } while (0)
#define PG8_LDB(dst, b, h) do { _Pragma("unroll") for (int n = 0; n < 2; ++n) _Pragma("unroll") for (int k = 0; k < 2; ++k) dst[n][k] = *(const PG8_LAS bf16x8*)(lds + PG8_SB(b, h) + boff + n * 2048 + k * 1024); } while (0)
#define PG8_MMA(ai, bj, At, Bt) do { __builtin_amdgcn_s_setprio(1); _Pragma("unroll") for (int m = 0; m < 4; ++m) _Pragma("unroll") for (int n = 0; n < 2; ++n) _Pragma("unroll") for (int k = 0; k < 2; ++k) \
        acc[ai][bj][m][n] = __builtin_amdgcn_mfma_f32_16x16x32_bf16(Bt[n][k], At[m][k], acc[ai][bj][m][n], 0, 0, 0); __builtin_amdgcn_s_setprio(0); } while (0)
#define PG8_WAIT_V(n) asm volatile("s_waitcnt vmcnt(" #n ")" ::: "memory")
#define PG8_WAIT_L(n) asm volatile("s_waitcnt lgkmcnt(" #n ")" ::: "memory")
#define PG8_BAR __builtin_amdgcn_s_barrier()
#define PG8_SCHED __builtin_amdgcn_sched_barrier(0)
    Unit cur, nxt; int ui = 0;
    if (!S.next(0, cur)) return;
    f32x4 acc[2][2][4][2];
#pragma unroll
    for (int a = 0; a < 2; ++a)
#pragma unroll
        for (int b = 0; b < 2; ++b)
#pragma unroll
            for (int m = 0; m < 4; ++m)
#pragma unroll
                for (int n = 0; n < 2; ++n) acc[a][b][m][n] = (f32x4){0.f, 0.f, 0.f, 0.f};
    bf16x8 At[4][2], B0[2][2], B1[2][2];
    const char* cA = (const char*)g.A + (size_t)cur.pm * tstep; const char* cB = (const char*)g.Bt + (size_t)cur.pn * tstep;
    S.a_ready(cur);
    if constexpr (SP2) {
        PG8_STAGE(PG8_SB(0, 0), cB, voffB); PG8_STAGE(PG8_SB(0, 1), cB + hstep, voffB); PG8_STAGE(PG8_SA(0, 0), cA, voffA); PG8_STAGE(PG8_SA(0, 1), cA + hstep, voffA);
        if (wr == 1) PG8_BAR;
        PG8_WAIT_V(2); PG8_BAR;
        PG8_STAGE(PG8_SB(1, 0), cB + kstep, voffB); PG8_STAGE(PG8_SA(1, 0), cA + kstep, voffA); PG8_STAGE(PG8_SB(1, 1), cB + hstep + kstep, voffB);
        PG8_WAIT_V(6); PG8_BAR;
    } else {
        PG8_STAGE(PG8_SB(0, 0), cB, voffB); PG8_STAGE(PG8_SA(0, 0), cA, voffA); PG8_STAGE(PG8_SB(0, 1), cB + hstep, voffB); PG8_STAGE(PG8_SA(0, 1), cA + hstep, voffA);
        if (wr == 1) PG8_BAR;
        PG8_WAIT_V(4); PG8_BAR;
        PG8_STAGE(PG8_SB(1, 0), cB + kstep, voffB); PG8_STAGE(PG8_SA(1, 0), cA + kstep, voffA); PG8_STAGE(PG8_SB(1, 1), cB + hstep + kstep, voffB);
        PG8_WAIT_V(6); PG8_BAR;
    }
    for (;;) {
        const bool has_next = S.next(ui + 1, nxt);
        const char* nA = has_next ? (const char*)g.A + (size_t)nxt.pm * tstep : cA; const char* nB = has_next ? (const char*)g.Bt + (size_t)nxt.pn * tstep : cB;
        for (int t = 0; t < nt; t += 2) {
            const bool last = (t == nt - 2);
            const char* a1 = cA + (size_t)(t + 1) * kstep;
            const char* a2 = last ? nA : cA + (size_t)(t + 2) * kstep; const char* b2 = last ? nB : cB + (size_t)(t + 2) * kstep;
            const char* a3 = a2 + kstep; const char* b3 = b2 + kstep;
            if (last && has_next) S.a_ready(nxt);
            if constexpr (SP2) {
            PG8_LDB(B0, 0, 0); PG8_LDB(B1, 0, 1); PG8_SCHED; PG8_LDA(At, 0, 0); PG8_STAGE(PG8_SA(1, 1), a1 + hstep, voffA);
            PG8_WAIT_V(8); PG8_WAIT_L(0); PG8_BAR; PG8_MMA(0, 0, At, B0); PG8_MMA(0, 1, At, B1); PG8_BAR; PG8_SCHED;
            PG8_LDA(At, 0, 1); PG8_STAGE(PG8_SB(0, 0), b2, voffB); PG8_STAGE(PG8_SB(0, 1), b2 + hstep, voffB); PG8_STAGE(PG8_SA(0, 0), a2, voffA);
            PG8_WAIT_V(8); PG8_WAIT_L(0); PG8_BAR; PG8_MMA(1, 0, At, B0); PG8_MMA(1, 1, At, B1); PG8_BAR; PG8_SCHED;
            PG8_LDB(B0, 1, 0); PG8_LDB(B1, 1, 1); PG8_SCHED; PG8_LDA(At, 1, 0); PG8_STAGE(PG8_SA(0, 1), a2 + hstep, voffA);
            PG8_WAIT_V(8); PG8_WAIT_L(0); PG8_BAR; PG8_MMA(0, 0, At, B0); PG8_MMA(0, 1, At, B1); PG8_BAR; PG8_SCHED;
            PG8_LDA(At, 1, 1); PG8_STAGE(PG8_SB(1, 0), b3, voffB); PG8_STAGE(PG8_SB(1, 1), b3 + hstep, voffB); PG8_STAGE(PG8_SA(1, 0), a3, voffA);
            PG8_WAIT_V(8); PG8_WAIT_L(0); PG8_BAR; PG8_MMA(1, 0, At, B0); PG8_MMA(1, 1, At, B1); PG8_BAR; PG8_SCHED;
            } else {
            PG8_LDB(B0, 0, 0); PG8_SCHED; PG8_LDA(At, 0, 0); PG8_STAGE(PG8_SA(1, 1), a1 + hstep, voffA);
            PG8_WAIT_L(8); PG8_BAR; PG8_WAIT_L(0); PG8_MMA(0, 0, At, B0); PG8_BAR; PG8_SCHED;
            PG8_LDB(B1, 0, 1); PG8_STAGE(PG8_SB(0, 0), b2, voffB);
            PG8_BAR; PG8_WAIT_L(0); PG8_MMA(0, 1, At, B1); PG8_BAR;
            PG8_LDA(At, 0, 1); PG8_STAGE(PG8_SA(0, 0), a2, voffA);
            PG8_BAR; PG8_WAIT_L(0); PG8_MMA(1, 0, At, B0); PG8_BAR; PG8_SCHED;
            PG8_STAGE(PG8_SB(0, 1), b2 + hstep, voffB);
            PG8_WAIT_V(6); PG8_BAR; PG8_MMA(1, 1, At, B1); PG8_BAR;
            PG8_LDB(B0, 1, 0); PG8_SCHED; PG8_LDA(At, 1, 0); PG8_STAGE(PG8_SA(0, 1), a2 + hstep, voffA);
            PG8_WAIT_L(8); PG8_BAR; PG8_WAIT_L(0); PG8_MMA(0, 0, At, B0); PG8_BAR; PG8_SCHED;
            PG8_LDB(B1, 1, 1); PG8_STAGE(PG8_SB(1, 0), b3, voffB);
            PG8_BAR; PG8_WAIT_L(0); PG8_MMA(0, 1, At, B1); PG8_BAR;
            PG8_LDA(At, 1, 1); PG8_STAGE(PG8_SA(1, 0), a3, voffA);
            PG8_BAR; PG8_WAIT_L(0); PG8_MMA(1, 0, At, B0); PG8_BAR; PG8_SCHED;
            PG8_STAGE(PG8_SB(1, 1), b3 + hstep, voffB);
            PG8_WAIT_V(6); PG8_BAR; PG8_MMA(1, 1, At, B1); PG8_BAR;
            }
        }
        if constexpr (ALIGN_EPI) { if (wr == 0) PG8_BAR; }
        if constexpr (!Epi::AFTER_DRAIN) { E(acc, cur, wr, wc, fr, fq); S.done(cur); }
        if (!has_next) break;
#pragma unroll
        for (int a = 0; a < 2; ++a)
#pragma unroll
            for (int b = 0; b < 2; ++b)
#pragma unroll
                for (int m = 0; m < 4; ++m)
#pragma unroll
                    for (int n = 0; n < 2; ++n) acc[a][b][m][n] = (f32x4){0.f, 0.f, 0.f, 0.f};
        cur = nxt; cA = nA; cB = nB; ++ui;
        if constexpr (ALIGN_EPI) { if (wr == 1) PG8_BAR; }
    }
    PG8_WAIT_V(0);
    if constexpr (!ALIGN_EPI) { if (wr == 0) PG8_BAR; }
    PG8_BAR;
    if constexpr (Epi::AFTER_DRAIN) { E.fused(acc, cur, wr, wc, fr, fq, lds, wid, lane); S.done(cur); }
#undef PG8_SA
#undef PG8_SB
#undef PG8_STAGE
#undef PG8_LDA
#undef PG8_LDB
#undef PG8_MMA
#undef PG8_WAIT_V
#undef PG8_WAIT_L
#undef PG8_BAR
#undef PG8_SCHED
}
}
#define LAS __attribute__((address_space(3)))
#define XB_TMO      128
#define XB_XCNT(j)  (256  + 64 * (j))
#define XB_XSUB(j)  (1280 + 64 * (j))
#define XB_XGEN(j)  (2304 + 64 * (j))
#define XB_TOP      3328
#define XB_TOPGEN   3392
#define XCD_BAR_WORDS 3456
#define XB_SPIN_CAP (1u << 18)

__device__ __forceinline__ unsigned xb_ld(unsigned* p)              { return __hip_atomic_load(p, __ATOMIC_RELAXED, __HIP_MEMORY_SCOPE_AGENT); }
__device__ __forceinline__ unsigned xb_add(unsigned* p, unsigned v) { return __hip_atomic_fetch_add(p, v, __ATOMIC_RELAXED, __HIP_MEMORY_SCOPE_AGENT); }
__device__ __forceinline__ unsigned xb_xcc_id() { return (unsigned)__builtin_amdgcn_s_getreg((3 << 11) | 20) & 0xFu; }
#define XB_SPIN(cond, bar) do { unsigned _sp = 0; while (cond) { __builtin_amdgcn_s_sleep(1); \
    if ((++_sp & 255u) == 0u) { if (xb_ld(&(bar)[XB_TMO])) break; if (_sp > XB_SPIN_CAP) { atomicAdd(&(bar)[XB_TMO], 1u); break; } } } } while (0)

struct XcdBarrier {
    unsigned* bar; unsigned x;
    volatile LAS unsigned* st;
};

__device__ __forceinline__ XcdBarrier xcd_barrier_post(unsigned* bar, volatile LAS unsigned* st) {
    XcdBarrier b; b.bar = bar; b.x = xb_xcc_id(); b.st = st;
    if (threadIdx.x == 0) (void)xb_add(&bar[XB_XCNT(b.x)], 1u);
    return b;
}
__device__ __forceinline__ void xcd_barrier_complete(unsigned* bar, unsigned x, unsigned& nloc, unsigned& nx) {
    const unsigned G = gridDim.x * gridDim.y * gridDim.z;
    unsigned sum, cnt, mine, sp = 0u;
    for (;;) {
        sum = 0u; cnt = 0u; mine = 0u;
#pragma unroll
        for (unsigned j = 0; j < 16; ++j) { const unsigned c = xb_ld(&bar[XB_XCNT(j)]); sum += c; cnt += (c > 0u) ? 1u : 0u; mine = (j == x) ? c : mine; }
        if (sum == G) break;
        __builtin_amdgcn_s_sleep(1);
        if ((++sp & 255u) == 0u) { if (xb_ld(&bar[XB_TMO])) break; if (sp > XB_SPIN_CAP) { atomicAdd(&bar[XB_TMO], 1u); break; } }
    }
    nloc = mine > 0u ? mine : 1u; nx = cnt > 0u ? cnt : 1u;
}

__device__ __forceinline__ void xcd_barrier(const XcdBarrier& b) {
    asm volatile("s_waitcnt vmcnt(0)" ::: "memory");
    __syncthreads();
    if (threadIdx.x == 0) {
        unsigned* bar = b.bar;
        __builtin_amdgcn_s_waitcnt(0);
        unsigned nloc = b.st[0], nx = b.st[1];
        if (nloc == 0u) { xcd_barrier_complete(bar, b.x, nloc, nx); b.st[0] = nloc; b.st[1] = nx; }
        const unsigned old = xb_add(&bar[XB_XSUB(b.x)], 1u);
        const unsigned gen = old / nloc;
        if (old + 1u == (gen + 1u) * nloc) {
            __builtin_amdgcn_fence(__ATOMIC_RELEASE, "agent");
            asm volatile("s_waitcnt vmcnt(0)" ::: "memory");
            const unsigned og = xb_add(&bar[XB_TOP], 1u);
            const unsigned tg = og / nx;
            if (og + 1u == (tg + 1u) * nx) xb_add(&bar[XB_TOPGEN], 1u);
            else XB_SPIN(xb_ld(&bar[XB_TOPGEN]) == tg, bar);
            __builtin_amdgcn_fence(__ATOMIC_ACQUIRE, "agent");
            xb_add(&bar[XB_XGEN(b.x)], 1u);
            asm volatile("s_waitcnt vmcnt(0)" ::: "memory");
        } else {
            XB_SPIN(xb_ld(&bar[XB_XGEN(b.x)]) == gen, bar);
            __builtin_amdgcn_fence(__ATOMIC_ACQUIRE, "agent");
            asm volatile("s_waitcnt vmcnt(0)" ::: "memory");
        }
    }
    __syncthreads();
}
namespace moba {
constexpr int D = 128;
constexpr float THR = 8.f;
constexpr bool WSKIP = false;
constexpr int QP = MHD, KVP = MHD, OP = MW;
template <class A, class Bt> struct same_t { static constexpr bool v = false; };
template <class A> struct same_t<A, A> { static constexpr bool v = true; };
constexpr float SCALE = 0.08838834764831845f;
constexpr int NW = 8, QBLK = 32, KVBLK = 64, QB = NW * QBLK;
constexpr int SHM_V = KVBLK * D * 2, SHM_K = KVBLK * D * 2;
constexpr int LDS_BYTES = 2 * SHM_V + 2 * SHM_K + NW * 64 * 4;
using bf16 = unsigned short;
typedef short bf16x8 __attribute__((ext_vector_type(8)));
typedef short s16x4 __attribute__((ext_vector_type(4)));
typedef float f32x16 __attribute__((ext_vector_type(16)));
typedef float f32x4 __attribute__((ext_vector_type(4)));
typedef unsigned u32x4 __attribute__((ext_vector_type(4)));
#define KSWZ(row, colB) ((row) * 256 + ((colB) ^ (((row) & 7) << 4)))
#define SBAR() __builtin_amdgcn_sched_barrier(0)
__device__ __forceinline__ int v_st(int k, int c) { const int kk = (k & ~0xC) | ((k & 4) << 1) | ((k & 8) >> 1); return ((kk >> 3) * 4 + (c >> 5)) * 512 + ((kk & 7) * 32 + (c & 31)) * 2; }
__device__ __forceinline__ int v_rd_base(int lane) { return ((lane & 3) << 3) | (((lane >> 2) & 3) << 6) | (((lane >> 4) & 1) << 5) | (((lane >> 5) & 1) << 8); }
constexpr int v_rd_off(int d0, int ks, int half) { return d0 * 512 + ks * 4096 + half * 2048; }
__device__ __forceinline__ int crow(int r, int hi) { return (r & 3) + 8 * (r >> 2) + 4 * hi; }
__device__ __forceinline__ unsigned cvtpk(float lo, float hi) {
    unsigned r; asm volatile("v_cvt_pk_bf16_f32 %0, %1, %2" : "=v"(r) : "v"(lo), "v"(hi)); return r;
}
__device__ __forceinline__ bf16x8 pack8(f32x4 a, f32x4 b) {
    u32x4 w = {cvtpk(a[0], a[1]), cvtpk(a[2], a[3]), cvtpk(b[0], b[1]), cvtpk(b[2], b[3])};
    return *reinterpret_cast<bf16x8*>(&w);
}
template <class T> __device__ __forceinline__ bf16x8 load8(const T* p) {
    if constexpr (same_t<T, float>::v) { return pack8(*(const f32x4*)p, *(const f32x4*)(p + 4)); }
    else { return *reinterpret_cast<const bf16x8*>(p); }
}
__device__ __forceinline__ void mask_tile(f32x16& p0, f32x16& p1, int dq, unsigned W) {
    const float NEG = -__builtin_inff();
#pragma unroll
    for (int r = 0; r < 16; ++r) {
        const int c = (r & 3) + 8 * (r >> 2);
        if ((unsigned)(dq - c) >= W) p0[r] = NEG;
        if ((unsigned)(dq - c - 32) >= W) p1[r] = NEG;
    }
}
__device__ __forceinline__ void partialSM(f32x16& p0, f32x16& p1, float& m_reg, float& mn, float& alpha) {
    float pmax = p0[0]; for (int r = 1; r < 16; ++r) pmax = fmaxf(pmax, p0[r]); for (int r = 0; r < 16; ++r) pmax = fmaxf(pmax, p1[r]);
    { auto rr = __builtin_amdgcn_permlane32_swap(__float_as_uint(pmax), __float_as_uint(pmax), false, false);
      pmax = fmaxf(__uint_as_float(rr[0]), __uint_as_float(rr[1])); }
    constexpr float C2 = 1.4426950408889634f * SCALE;
    if (__builtin_expect(__all((pmax - m_reg) * SCALE <= THR), 1)) { mn = m_reg; alpha = 1.f; }
    else { mn = fmaxf(m_reg, pmax); alpha = __builtin_amdgcn_exp2f((m_reg - mn) * C2); m_reg = mn; }
    const float mnL = -mn * C2;
    for (int r = 0; r < 16; ++r) p0[r] = fmaf(p0[r], C2, mnL); for (int r = 0; r < 16; ++r) p1[r] = fmaf(p1[r], C2, mnL);
    for (int r = 0; r < 16; ++r) p0[r] = __builtin_amdgcn_exp2f(p0[r]);
}
__device__ __forceinline__ void finishSM(f32x16& p0, f32x16& p1, float alpha, float& l_reg, bf16x8& pa0, bf16x8& pa1, bf16x8& pa2, bf16x8& pa3) {
    for (int r = 0; r < 16; ++r) p1[r] = __builtin_amdgcn_exp2f(p1[r]);
    float ps = 0; for (int r = 0; r < 16; ++r) ps += p0[r]; for (int r = 0; r < 16; ++r) ps += p1[r];
    { auto rr = __builtin_amdgcn_permlane32_swap(__float_as_uint(ps), __float_as_uint(ps), false, false);
      ps = __uint_as_float(rr[0]) + __uint_as_float(rr[1]); }
    l_reg = l_reg * alpha + ps;
#define PK4(P, B_, OUT) do { unsigned a0 = cvtpk(P[B_+0], P[B_+1]), a1 = cvtpk(P[B_+2], P[B_+3]);                          \
        unsigned b0 = cvtpk(P[B_+4], P[B_+5]), b1 = cvtpk(P[B_+6], P[B_+7]);                                             \
        auto r0 = __builtin_amdgcn_permlane32_swap(a0, b0, false, false); auto r1 = __builtin_amdgcn_permlane32_swap(a1, b1, false, false); \
        u32x4 w = {r0[0], r1[0], r0[1], r1[1]}; OUT = *reinterpret_cast<bf16x8*>(&w); } while (0)
    PK4(p0, 0, pa0); PK4(p0, 8, pa1); PK4(p1, 0, pa2); PK4(p1, 8, pa3);
#undef PK4
}
template <int KB, bool SK>
__device__ __forceinline__ void qkt(f32x16& p0, f32x16& p1, const char* K_lds, int r32, int hi, const bf16x8* qr, bool act) {
    if (SK && !act) { const float NEG = -__builtin_inff();
#pragma unroll
        for (int r = 0; r < 16; ++r) { p0[r] = NEG; p1[r] = NEG; } return; }
    p0 = f32x16{}; p1 = f32x16{};
    const char* kb[4];
#pragma unroll
    for (int dd = 0; dd < 4; ++dd) kb[dd] = K_lds + KB * SHM_K + KSWZ(r32, (dd * 16 + hi * 8) * 2);
#pragma unroll
    for (int d0 = 0; d0 < 8; ++d0) { const char* a = kb[d0 & 3] + (d0 >> 2) * 128;
        bf16x8 b0 = *reinterpret_cast<const bf16x8*>(a);
        bf16x8 b1 = *reinterpret_cast<const bf16x8*>(a + 32 * 256);
        p0 = __builtin_amdgcn_mfma_f32_32x32x16_bf16(b0, qr[d0], p0, 0, 0, 0);
        p1 = __builtin_amdgcn_mfma_f32_32x32x16_bf16(b1, qr[d0], p1, 0, 0, 0); }
}
template <int VB, bool SK>
__device__ __forceinline__ void pv_tile(f32x16* o, int vb0, bf16x8 pa0, bf16x8 pa1, bf16x8 pa2, bf16x8 pa3, bool act) {
    if (SK && !act) return;
#define TRRD(dst, off) asm volatile("ds_read_b64_tr_b16 %0, %1 offset:%2" : "=&v"(dst) : "v"(vb0), "i"(off) : "memory")
#define PV_D0(d0) do { s16x4 l0, l1, l2, l3, h0, h1, h2, h3; constexpr int b_ = VB * SHM_V + v_rd_off(d0, 0, 0);     \
        TRRD(l0, b_); TRRD(h0, b_ + 2048); TRRD(l1, b_ + 4096); TRRD(h1, b_ + 6144); TRRD(l2, b_ + 8192); TRRD(h2, b_ + 10240); TRRD(l3, b_ + 12288); TRRD(h3, b_ + 14336); \
        asm volatile("s_waitcnt lgkmcnt(0)" ::: "memory"); SBAR();                 \
        o[d0] = __builtin_amdgcn_mfma_f32_32x32x16_bf16(pa0, (bf16x8){l0[0], l0[1], l0[2], l0[3], h0[0], h0[1], h0[2], h0[3]}, o[d0], 0, 0, 0);   \
        o[d0] = __builtin_amdgcn_mfma_f32_32x32x16_bf16(pa1, (bf16x8){l1[0], l1[1], l1[2], l1[3], h1[0], h1[1], h1[2], h1[3]}, o[d0], 0, 0, 0);   \
        o[d0] = __builtin_amdgcn_mfma_f32_32x32x16_bf16(pa2, (bf16x8){l2[0], l2[1], l2[2], l2[3], h2[0], h2[1], h2[2], h2[3]}, o[d0], 0, 0, 0);   \
        o[d0] = __builtin_amdgcn_mfma_f32_32x32x16_bf16(pa3, (bf16x8){l3[0], l3[1], l3[2], l3[3], h3[0], h3[1], h3[2], h3[3]}, o[d0], 0, 0, 0); } while (0)
    PV_D0(0); PV_D0(1); PV_D0(2); PV_D0(3);
#undef PV_D0
#undef TRRD
}
__device__ __forceinline__ float bfv(short s) { return __builtin_bit_cast(float, ((unsigned)(unsigned short)s) << 16); }
__device__ __forceinline__ void sel_fill(f32x16& p0, f32x16& p1, bool ok) { const float NEG = -__builtin_inff();
#pragma unroll
    for (int r = 0; r < 16; ++r) { p0[r] = ok ? p0[r] : NEG; p1[r] = ok ? p1[r] : NEG; } }
template <class TIn, class TOut> struct BlockRef { const TIn* Q; const TIn* K; const TIn* V; TOut* O; int P0; const float* km; int qb; };
template <class TIn> struct Seam {
    bf16x8 qr[8];
    bf16x8 st_v0, st_v1, st_k0, st_k1; f32x4 sf0, sf1, sf2, sf3;
    f32x4 tq[16];
};
__device__ __forceinline__ int swa_jlo(int P0, int W) { const int lowk = P0 - W + 1; return lowk > 0 ? lowk / KVBLK : 0; }
#define ROW(p, k0, rr) ((p) + (size_t)((k0) + (rr)) * KVP + sc)
#define VMW() asm volatile("s_waitcnt vmcnt(0)" ::: "memory")
#define VMWN(n) asm volatile("s_waitcnt vmcnt(%0)" :: "i"(n) : "memory")
#define SLOAD_H(Kp, Vp, k0) do { S.st_v0 = load8<TIn>(ROW(Vp, k0, sr)); S.st_v1 = load8<TIn>(ROW(Vp, k0, 32 + sr));              \
                         S.st_k0 = load8<TIn>(ROW(Kp, k0, sr)); S.st_k1 = load8<TIn>(ROW(Kp, k0, 32 + sr)); } while (0)
#define SWRITE_HK(bf) do { *(bf16x8*)(K_lds + (bf) * SHM_K + kws) = S.st_k0; *(bf16x8*)(K_lds + (bf) * SHM_K + kws + 32 * 256) = S.st_k1; } while (0)
#define SWRITE_HV(bf) do { *(bf16x8*)(V_lds + (bf) * SHM_V + vst0) = S.st_v0; *(bf16x8*)(V_lds + (bf) * SHM_V + vst1) = S.st_v1; } while (0)
#define SWRITE_H(bf) do { SWRITE_HV(bf); SWRITE_HK(bf); } while (0)
#define SLOAD_F(p, k0) do { S.sf0 = *(const f32x4*)ROW(p, k0, sr); S.sf1 = *(const f32x4*)(ROW(p, k0, sr) + 4);                \
                            S.sf2 = *(const f32x4*)ROW(p, k0, 32 + sr); S.sf3 = *(const f32x4*)(ROW(p, k0, 32 + sr) + 4); } while (0)
#define SWRITE_KF(bf) do { *(bf16x8*)(K_lds + (bf) * SHM_K + kws) = pack8(S.sf0, S.sf1); *(bf16x8*)(K_lds + (bf) * SHM_K + kws + 32 * 256) = pack8(S.sf2, S.sf3); } while (0)
#define SWRITE_VF(bf) do { *(bf16x8*)(V_lds + (bf) * SHM_V + vst0) = pack8(S.sf0, S.sf1); *(bf16x8*)(V_lds + (bf) * SHM_V + vst1) = pack8(S.sf2, S.sf3); } while (0)
template <class TIn, class TOut>
__device__ __forceinline__ void causal_swa_prime(const BlockRef<TIn, TOut>& cur, int W, char* lds, Seam<TIn>& S) {
    constexpr bool F32 = same_t<TIn, float>::v;
    int tid_o = threadIdx.x; asm volatile("" : "+v"(tid_o));
    const int tid = tid_o, wid = __builtin_amdgcn_readfirstlane(tid >> 6), lane = tid & 63, r32 = lane & 31, hi = lane >> 5;
    const int sr = tid >> 4, sc = (tid & 15) * 8, kws = KSWZ(sr, sc * 2); char* K_lds = lds + 2 * SHM_V;
    const int kb0 = swa_jlo(cur.P0, W) * KVBLK;
    for (int d0 = 0; d0 < 8; ++d0) S.qr[d0] = load8<TIn>(cur.Q + (size_t)(wid * QBLK + r32) * QP + d0 * 16 + hi * 8);
    if constexpr (F32) { SLOAD_F((const float*)cur.K, kb0); VMW(); SWRITE_KF(0); SBAR(); SLOAD_F((const float*)cur.V, kb0); }
    else { SLOAD_H(cur.K, cur.V, kb0); VMW(); SWRITE_HK(0); }
    __syncthreads();
}
template <class TIn, class TOut>
__device__ __forceinline__ void causal_swa_block(const BlockRef<TIn, TOut>& cur, const BlockRef<TIn, TOut>& nxt, int skv, int W, char* lds, Seam<TIn>& S) {
    constexpr bool F32 = same_t<TIn, float>::v;
    int tid_o = threadIdx.x; asm volatile("" : "+v"(tid_o));
    const int tid = tid_o, wid = __builtin_amdgcn_readfirstlane(tid >> 6), lane = tid & 63, r32 = lane & 31, hi = lane >> 5;
    const int j_lo = swa_jlo(cur.P0, W);
    int j_hi = (cur.P0 + QB - 1) / KVBLK + 1; if (j_hi > skv / KVBLK) j_hi = skv / KVBLK;
    const int NT = j_hi - j_lo;
    const int kbn = swa_jlo(nxt.P0, W) * KVBLK;
    const int qlo = cur.P0 + wid * QBLK, qm = qlo + r32 - 4 * hi;
    char* V_lds = lds; char* K_lds = lds + 2 * SHM_V;
    float* ws = (float*)(lds + 2 * SHM_V + 2 * SHM_K) + wid * 64; float* li_l = ws, * al_l = ws + 32;
    float m_reg = -1e30f, l_reg = 0; f32x16 o[4] = {};
    unsigned selbits = 0u;
    if (cur.qb > 0) {
        float sc_[7];
#pragma unroll
        for (int j = 0; j < 7; ++j) { float a_ = 0.f;
            if (j < cur.qb) { const float* kmj = cur.km + j * 128 + hi * 8;
#pragma unroll
                for (int d0 = 0; d0 < 8; ++d0) { const f32x4 k0_ = *(const f32x4*)(kmj + d0 * 16), k1_ = *(const f32x4*)(kmj + d0 * 16 + 4); const bf16x8 q_ = S.qr[d0];
                    a_ += (bfv(q_[0]) * k0_[0] + bfv(q_[1]) * k0_[1]) + (bfv(q_[2]) * k0_[2] + bfv(q_[3]) * k0_[3]) + (bfv(q_[4]) * k1_[0] + bfv(q_[5]) * k1_[1]) + (bfv(q_[6]) * k1_[2] + bfv(q_[7]) * k1_[3]); }
                a_ += __shfl_xor(a_, 32); }
            sc_[j] = a_; }
#pragma unroll
        for (int j = 0; j < 7; ++j) { int rank_ = 0;
#pragma unroll
            for (int i = 0; i < 7; ++i) if (i != j) rank_ += (i < cur.qb && (sc_[i] > sc_[j] || (sc_[i] == sc_[j] && i < j))) ? 1 : 0;
            if (j < cur.qb && rank_ < 3) selbits |= 1u << j; }
    }
    const int sr = tid >> 4, sc = (tid & 15) * 8, vst0 = v_st(sr, sc), vst1 = v_st(32 + sr, sc), kws = KSWZ(sr, sc * 2);
    const int vb0 = (int)(uintptr_t)V_lds + v_rd_base(lane);
    const TIn* Kh = cur.K; const TIn* Vh = cur.V;
#define RESC(a) do { if (__any((a) < 1.f)) { if (hi == 0) al_l[r32] = (a); asm volatile("s_waitcnt lgkmcnt(0)" ::: "memory");              \
                     for (int d_ = 0; d_ < 4; ++d_) for (int r = 0; r < 16; ++r) o[d_][r] *= al_l[crow(r, hi)]; } } while (0)
#define KBASE(t) ((j_lo + (t)) * KVBLK)
#define ACT(t) (KBASE(t) <= qlo + QBLK - 1 && KBASE(t) + KVBLK - 1 >= qlo - W + 1)
#define MASKT(P0_, P1_, t) do { const int kb_ = KBASE(t); if (kb_ + KVBLK - 1 > qlo) mask_tile(P0_, P1_, qm - kb_, (unsigned)W); \
        else if ((t) < 4 * cur.qb) { const bool ok_ = ((selbits >> ((t) >> 2)) & 1u) != 0u; if (!__all(ok_)) sel_fill(P0_, P1_, ok_); } } while (0)
    constexpr int NQL = F32 ? 16 : 8;
    constexpr bool SK = WSKIP && !F32;
#define SEAM_K0() do { VMWN(NQL); if constexpr (F32) { SWRITE_KF(0); SBAR(); SLOAD_F((const float*)nxt.V, kbn); } else { SWRITE_HK(0); } SBAR(); } while (0)
    f32x16 pA0, pA1, pB0, pB1; float mnA, mnB, alA, alB; bf16x8 pa0, pa1, pa2, pa3;
    if constexpr (F32) { VMW(); SWRITE_VF(0); SBAR(); } else { SWRITE_HV(0); SBAR(); }
    if (NT > 1) { if constexpr (F32) SLOAD_F((const float*)Kh, KBASE(1)); else SLOAD_H(Kh, Vh, KBASE(1)); }
    SBAR(); qkt<0, SK>(pA0, pA1, K_lds, r32, hi, S.qr, ACT(0));
    if constexpr (F32) { if (NT > 1) { VMW(); SWRITE_KF(1); SBAR(); SLOAD_F((const float*)Vh, KBASE(1)); } }
    MASKT(pA0, pA1, 0); partialSM(pA0, pA1, m_reg, mnA, alA);
    if (NT > 1) { VMW(); if constexpr (F32) { SWRITE_VF(1); SBAR(); if (NT > 2) SLOAD_F((const float*)Kh, KBASE(2)); } else SWRITE_H(1); }
    __syncthreads();
#define HALF_STEP(PX0, PX1, mnX, alX, PY0, PY1, alY, t, KB, VB, SB) do {                                                      \
        SBAR(); qkt<KB, SK>(PX0, PX1, K_lds, r32, hi, S.qr, ACT(t));                                             \
        finishSM(PY0, PY1, alY, l_reg, pa0, pa1, pa2, pa3); SBAR();                                                           \
        if ((t) + 1 < NT) { if constexpr (F32) { VMW(); SWRITE_KF(SB); SBAR(); SLOAD_F((const float*)Vh, KBASE((t) + 1)); }  \
                            else { SLOAD_H(Kh, Vh, KBASE((t) + 1)); } SBAR(); }                                               \
        pv_tile<VB, SK>(o, vb0, pa0, pa1, pa2, pa3, ACT((t) - 1)); MASKT(PX0, PX1, (t)); partialSM(PX0, PX1, m_reg, mnX, alX);                                        \
        __syncthreads();                                                                                                      \
        if ((t) + 1 < NT) { VMW(); if constexpr (F32) { SWRITE_VF(SB); SBAR(); if ((t) + 2 < NT) SLOAD_F((const float*)Kh, KBASE((t) + 2)); } \
                            else { SWRITE_H(SB); } }                                                                          \
        RESC(alX); __syncthreads(); } while (0)
    for (int t = 1; t + 1 < NT; t += 2) {
        HALF_STEP(pB0, pB1, mnB, alB, pA0, pA1, alA, t, 1, 0, 0);
        HALF_STEP(pA0, pA1, mnA, alA, pB0, pB1, alB, t + 1, 0, 1, 1);
    }
    const bool even = (NT & 1) == 0;
    if (even) { SBAR(); qkt<1, SK>(pB0, pB1, K_lds, r32, hi, S.qr, ACT(NT - 1)); SBAR(); }
#define QROW(e) (nxt.Q + (size_t)(wid * QBLK + r32) * QP + ((e) >> 1) * 16 + hi * 8 + ((e) & 1) * 4)
    if constexpr (F32) { SLOAD_F((const float*)nxt.K, kbn); SBAR();
#pragma unroll
        for (int e = 0; e < 8; ++e) S.tq[e] = *(const f32x4*)QROW(e); }
    else { SLOAD_H(nxt.K, nxt.V, kbn); SBAR();
#pragma unroll
        for (int d0 = 0; d0 < 8; ++d0) S.qr[d0] = load8<TIn>(nxt.Q + (size_t)(wid * QBLK + r32) * QP + d0 * 16 + hi * 8); }
    SBAR();
    finishSM(pA0, pA1, alA, l_reg, pa0, pa1, pa2, pa3); SBAR();
    if constexpr (F32) {
#pragma unroll
        for (int e = 8; e < 16; ++e) S.tq[e] = *(const f32x4*)QROW(e); SBAR(); }
#undef QROW
    pv_tile<0, SK>(o, vb0, pa0, pa1, pa2, pa3, ACT(even ? NT - 2 : NT - 1));
    if (even) { MASKT(pB0, pB1, NT - 1); partialSM(pB0, pB1, m_reg, mnB, alB); __syncthreads(); RESC(alB);
        finishSM(pB0, pB1, alB, l_reg, pa0, pa1, pa2, pa3); SBAR(); pv_tile<1, SK>(o, vb0, pa0, pa1, pa2, pa3, ACT(NT - 1)); }
    SBAR(); SEAM_K0();
    if (hi == 0) li_l[r32] = l_reg; asm volatile("s_waitcnt lgkmcnt(0)" ::: "memory");
    float rli[16];
#pragma unroll
    for (int r = 0; r < 16; ++r) rli[r] = __builtin_amdgcn_rcpf(li_l[crow(r, hi)]);
    TOut* Ow = cur.O + (size_t)(wid * QBLK) * OP;
#pragma unroll
    for (int r = 0; r < 16; ++r) { const int orow = crow(r, hi);
#pragma unroll
        for (int d0 = 0; d0 < 4; ++d0) { const float v = o[d0][r] * rli[r];
            if constexpr (same_t<TOut, float>::v) { Ow[(size_t)orow * OP + d0 * 32 + r32] = v; }
            else { const float vn = __shfl_xor(v, 1);
                   if ((r32 & 1) == 0) *(unsigned*)(Ow + (size_t)orow * OP + d0 * 32 + r32) = cvtpk(v, vn); } } }
    if constexpr (F32) {
#pragma unroll
        for (int d0 = 0; d0 < 8; ++d0) S.qr[d0] = pack8(S.tq[2 * d0], S.tq[2 * d0 + 1]); }
    __syncthreads();
#undef RESC
#undef KBASE
#undef ACT
#undef MASKT
#undef SEAM_K0
#undef HALF_STEP
}
#undef ROW
#undef VMW
#undef VMWN
#undef SLOAD_H
#undef SWRITE_HK
#undef SWRITE_HV
#undef SWRITE_H
#undef SLOAD_F
#undef SWRITE_KF
#undef SWRITE_VF
}
namespace gla {
typedef float f32x16 __attribute__((ext_vector_type(16)));
typedef short s16x4 __attribute__((ext_vector_type(4)));
typedef float f32x2_t __attribute__((ext_vector_type(2)));
typedef __bf16 bf16x2_t __attribute__((ext_vector_type(2)));
__device__ __forceinline__ unsigned cvt2(float lo, float hi) { f32x2_t v = {lo, hi}; bf16x2_t b = __builtin_convertvector(v, bf16x2_t); return __builtin_bit_cast(unsigned, b); }
__device__ __forceinline__ float bfu(unsigned short s) { return __builtin_bit_cast(float, ((unsigned)s) << 16); }
constexpr int RS = 272, VS = 528, AS = 144;
constexpr int L_QT = 0, L_KT = 17408, L_KH = 34816, L_V = 52224, L_AT = 86016, L_GLR = 95232, L_DEC = 99328, L_SEG = 99840, L_RED = 101888, L_GN = 103936, L_END = 104960;
#define GLA_MFMA(a, b, c) __builtin_amdgcn_mfma_f32_32x32x16_bf16((a), (b), (c), 0, 0, 0)
#define GLA_LBAR() do { asm volatile("s_waitcnt lgkmcnt(0)" ::: "memory"); __builtin_amdgcn_s_barrier(); asm volatile("" ::: "memory"); } while (0)
#define GLA_TR(off) __builtin_amdgcn_ds_read_tr16_b64_v4i16((LAS s16x4*)(lds + (off)))

constexpr size_t WS_GQT = 710 * MiB, WS_GKH = 726 * MiB, WS_GA = 742 * MiB, WS_GDEC = 750 * MiB;

__device__ __forceinline__ void gla_pre_head(const Params& P, int l, int b, int c, int h, LAS unsigned char* lds, int tid) {
    const int lane = tid & 63, w = __builtin_amdgcn_readfirstlane(tid >> 6), r = lane & 31, hh = lane >> 5;
    const int sd = tid & 127, stq = tid >> 7, t0 = c * GCH, item = (b * GH + h) * (SEQ / GCH) + c;
    const bf16* gq = (const bf16*)(P.ws + WS_PROJ) + PJ_GQ + ((size_t)(b * GH + h) * SEQ + t0) * GDK; const bf16* gk = (const bf16*)(P.ws + WS_PROJ) + PJ_GK + ((size_t)(b * GH + h) * SEQ + t0) * GDK;
    float w2r[16];
#pragma unroll
    for (int j = 0; j < 16; ++j) w2r[j] = P.gate_w2[((size_t)l * GRANK + j) * GKW + h * GDK + sd];
    const float gbias = P.gate_b[(size_t)l * GKW + h * GDK + sd];
#pragma unroll
    for (int i = 0; i < 2; ++i) { const int idx = tid + 512 * i, row = idx >> 4, ch = idx & 15;
        *(LAS u32x4*)(lds + L_QT + row * RS + ch * 16) = *(const u32x4*)(gq + (size_t)row * GDK + ch * 8);
        *(LAS u32x4*)(lds + L_KT + row * RS + ch * 16) = *(const u32x4*)(gk + (size_t)row * GDK + ch * 8); }
    float bl[16]; float run = 0.f;
#pragma unroll
    for (int i = 0; i < 16; ++i) { const LAS f32x4* gr4 = (const LAS f32x4*)(lds + L_GLR + (16 * stq + i) * 64); float x = gbias;
#pragma unroll
        for (int j = 0; j < 4; ++j) { const f32x4 gv = gr4[j]; x += (gv[0] * w2r[4 * j] + gv[1] * w2r[4 * j + 1]) + (gv[2] * w2r[4 * j + 2] + gv[3] * w2r[4 * j + 3]); }
        run -= __logf(1.0f + __expf(-x)) * (1.0f / 16.0f); bl[i] = run; }
    *(LAS float*)(lds + L_SEG + (stq * 128 + sd) * 4) = run;
    __syncthreads();
    float prefix = 0.f, total = 0.f;
#pragma unroll
    for (int j = 0; j < 4; ++j) { const float sv = *(const LAS float*)(lds + L_SEG + (j * 128 + sd) * 4); total += sv; prefix += (j < stq) ? sv : 0.f; }
    const float etot = __expf(total);
#pragma unroll
    for (int i = 0; i < 16; ++i) { const int row = 16 * stq + i; const float bb = bl[i] + prefix; const float eb = __expf(bb), enb = __builtin_amdgcn_rcpf(eb), ekl = etot * enb;
        LAS unsigned short* qp = (LAS unsigned short*)(lds + L_QT + row * RS + sd * 2); LAS unsigned short* kp = (LAS unsigned short*)(lds + L_KT + row * RS + sd * 2);
        const float qv = bfu(*qp), kv = bfu(*kp);
        *qp = (unsigned short)f2bf(qv * eb); *kp = (unsigned short)f2bf(kv * enb); *(LAS unsigned short*)(lds + L_KH + row * RS + sd * 2) = (unsigned short)f2bf(kv * ekl); }
    if (stq == 0) ((float*)(P.ws + WS_GDEC))[(size_t)item * GDK + sd] = etot;
    __syncthreads();
#pragma unroll
    for (int i = 0; i < 2; ++i) { const int idx = tid + 512 * i, row = idx >> 4, ch = idx & 15; const size_t go = (size_t)(b * SEQ + t0 + row) * GKW + h * GDK + ch * 8;
        *(u32x4*)((bf16*)(P.ws + WS_GQT) + go) = *(const LAS u32x4*)(lds + L_QT + row * RS + ch * 16);
        *(u32x4*)((bf16*)(P.ws + WS_GKH) + go) = *(const LAS u32x4*)(lds + L_KH + row * RS + ch * 16); }
    if (w < 4) { const int ti = w >> 1, si = w & 1; f32x16 at;
#pragma unroll
        for (int i = 0; i < 16; ++i) at[i] = 0.f;
        if (si <= ti) {
#pragma unroll
            for (int kk = 0; kk < 8; ++kk) { const bf16x8 a = *(const LAS bf16x8*)(lds + L_KT + (32 * si + r) * RS + (16 * kk + 8 * hh) * 2); const bf16x8 bq = *(const LAS bf16x8*)(lds + L_QT + (32 * ti + r) * RS + (16 * kk + 8 * hh) * 2);
                at = GLA_MFMA(a, bq, at); } }
        const int t = 32 * ti + r; bf16* ag = (bf16*)(P.ws + WS_GA) + ((size_t)item * GCH + t) * GCH;
#pragma unroll
        for (int g = 0; g < 4; ++g) { const int s0 = 32 * si + 8 * g + 4 * hh; float v[4];
#pragma unroll
            for (int e = 0; e < 4; ++e) v[e] = (s0 + e <= t) ? at[4 * g + e] : 0.f;
            u32x2 pkd; pkd.x = cvt2(v[0], v[1]); pkd.y = cvt2(v[2], v[3]); *(u32x2*)(ag + s0) = pkd; } }
    __syncthreads();
}

template <int VAR>
__device__ __forceinline__ void gla_seq_unit(const Params& P, int l, int bh, LAS unsigned char* lds, int tid) {
    const int lane = tid & 63, w = __builtin_amdgcn_readfirstlane(tid >> 6), r = lane & 31, hh = lane >> 5;
    const int b = bh >> 2, h = bh & 3;
    const int blk = (lane >> 4) & 1, q4 = (lane & 15) >> 2, p4 = lane & 3;
    const char* ub_v = (const char*)((const bf16*)(P.ws + WS_PROJ) + PJ_GV + (size_t)bh * SEQ * GDV); const char* ub_gr = (const char*)((const bf16*)(P.ws + WS_PROJ) + PJ_GR + (size_t)bh * SEQ * GDV);
    const char* ub_qt = (const char*)((const bf16*)(P.ws + WS_GQT) + (size_t)(b * SEQ) * GKW + h * GDK); const char* ub_kh = (const char*)((const bf16*)(P.ws + WS_GKH) + (size_t)(b * SEQ) * GKW + h * GDK);
    const char* ub_a = (const char*)((const bf16*)(P.ws + WS_GA) + (size_t)bh * (SEQ / GCH) * GCH * GCH); const char* ub_dec = (const char*)((const float*)(P.ws + WS_GDEC) + (size_t)bh * (SEQ / GCH) * GDK);
    char* ub_og = (char*)((bf16*)(P.ws + (VAR ? (size_t)760 * MiB : WS_OGOM)) + (size_t)(b * SEQ) * GVW + h * GDV);
    const unsigned vo_qk = (unsigned)((tid >> 4) * GKW * 2 + (tid & 15) * 16), vo_v = (unsigned)((tid >> 5) * GDV * 2 + (tid & 31) * 16), vo_16 = (unsigned)(tid * 16);
    const unsigned vo_ogc = (unsigned)((tid >> 5) * GVW * 2 + (tid & 31) * 16);
    constexpr int SRS = 272, SKS = 320, SVS = 576, SAS = 144;
    constexpr int S_QT = 0, S_KH = S_QT + 64 * SRS, S_V = S_KH + 64 * SKS, S_AT = S_V + 64 * SVS, S_DEC = S_AT + 64 * SAS, S_RED = S_DEC + 512, S_GN = S_RED + 2048, S_OT = S_GN + 1024, S_END = S_OT + 64 * SVS;
    static_assert(S_END <= 131072, "GLA scan LDS map");
    const unsigned tr_v = S_V + (8 * hh + q4) * SVS + (32 * w + 16 * blk + 4 * p4) * 2;
    const unsigned tr_kh = S_KH + (8 * hh + q4) * SKS + (16 * blk + 4 * p4) * 2;
    if (tid < GDV) *(LAS float*)(lds + S_GN + tid * 4) = P.gla_norm_g[(size_t)l * GDV + tid];
    f32x16 S[4];
#pragma unroll
    for (int d = 0; d < 4; ++d)
#pragma unroll
        for (int i = 0; i < 16; ++i) S[d][i] = 0.f;
    u32x4 pq[2], pk[2], pv[4], pa; f32x4 pd = {0.f, 0.f, 0.f, 0.f};
#define GLA_LOAD(c_) do { const size_t tb_ = (size_t)(c_) * GCH; \
        _Pragma("unroll") for (int i = 0; i < 2; ++i) { pq[i] = *(const u32x4*)(ub_qt + (tb_ + 32 * i) * (GKW * 2) + vo_qk); pk[i] = *(const u32x4*)(ub_kh + (tb_ + 32 * i) * (GKW * 2) + vo_qk); } \
        _Pragma("unroll") for (int i = 0; i < 4; ++i) pv[i] = *(const u32x4*)(ub_v + (tb_ + 16 * i) * (GDV * 2) + vo_v); \
        pa = *(const u32x4*)(ub_a + (size_t)(c_) * (GCH * GCH * 2) + vo_16); \
        if (tid < 32) pd = *(const f32x4*)(ub_dec + (size_t)(c_) * (GDK * 4) + vo_16); } while (0)
    GLA_LOAD(0);
    for (int c = 0; c < SEQ / GCH; ++c) {
        const int t0 = c * GCH;
#pragma unroll
        for (int i = 0; i < 2; ++i) { const int idx = tid + 512 * i, row = idx >> 4, ch = idx & 15; *(LAS u32x4*)(lds + S_QT + row * SRS + ch * 16) = pq[i]; *(LAS u32x4*)(lds + S_KH + row * SKS + ch * 16) = pk[i]; }
#pragma unroll
        for (int i = 0; i < 4; ++i) { const int idx = tid + 512 * i, row = idx >> 5, ch = idx & 31; *(LAS u32x4*)(lds + S_V + row * SVS + ch * 16) = pv[i]; }
        *(LAS u32x4*)(lds + S_AT + (tid >> 3) * SAS + (tid & 7) * 16) = pa;
        if (tid < 32) *(LAS f32x4*)(lds + S_DEC + tid * 16) = pd;
        u32x4 sg[4];
#pragma unroll
        for (int i = 0; i < 4; ++i) { if (VAR & 1) sg[i] = (u32x4){0x3f803f80u, 0x3f803f80u, 0x3f803f80u, 0x3f803f80u}; else sg[i] = *(const u32x4*)(ub_gr + (size_t)(t0 + 16 * i) * (GDV * 2) + vo_v); }
        if (c + 1 < SEQ / GCH && !((VAR & 4) && c > 0)) GLA_LOAD(c + 1);
        GLA_LBAR();
        f32x16 ot[2];
#pragma unroll
        for (int ti = 0; ti < 2; ++ti)
#pragma unroll
            for (int i = 0; i < 16; ++i) ot[ti][i] = 0.f;
        if (!(VAR & 2)) {
        bf16x8 vf[4];
#pragma unroll
        for (int kk = 0; kk < 4; ++kk) { const s16x4 lo = GLA_TR(tr_v + kk * 16 * SVS), hi = GLA_TR(tr_v + kk * 16 * SVS + 4 * SVS); vf[kk] = __builtin_shufflevector(lo, hi, 0, 1, 2, 3, 4, 5, 6, 7); }
        s16x4 bq[2][8];
#define GLA_LDBQ(buf, dblk_) do { _Pragma("unroll") for (int s = 0; s < 2; ++s) _Pragma("unroll") for (int ti = 0; ti < 2; ++ti) { \
            const LAS unsigned char* qa = lds + S_QT + (32 * ti + r) * SRS + (32 * (dblk_) + 16 * s + 4 * hh) * 2; bq[buf][(s * 2 + ti) * 2] = *(const LAS s16x4*)qa; bq[buf][(s * 2 + ti) * 2 + 1] = *(const LAS s16x4*)(qa + 16); } } while (0)
        GLA_LDBQ(0, 0);
#pragma unroll
        for (int dblk = 0; dblk < 4; ++dblk) {
            if (dblk + 1 < 4) GLA_LDBQ((dblk + 1) & 1, dblk + 1);
#pragma unroll
            for (int s = 0; s < 2; ++s) { u32x4 pa_; pa_.x = cvt2(S[dblk][8 * s + 0], S[dblk][8 * s + 1]); pa_.y = cvt2(S[dblk][8 * s + 2], S[dblk][8 * s + 3]); pa_.z = cvt2(S[dblk][8 * s + 4], S[dblk][8 * s + 5]); pa_.w = cvt2(S[dblk][8 * s + 6], S[dblk][8 * s + 7]);
                const bf16x8 a = __builtin_bit_cast(bf16x8, pa_);
#pragma unroll
                for (int ti = 0; ti < 2; ++ti) { const bf16x8 bqv = __builtin_shufflevector(bq[dblk & 1][(s * 2 + ti) * 2], bq[dblk & 1][(s * 2 + ti) * 2 + 1], 0, 1, 2, 3, 4, 5, 6, 7); ot[ti] = GLA_MFMA(a, bqv, ot[ti]); } } }
#undef GLA_LDBQ
        s16x4 kf[2][8]; f32x4 dcv[2][4];
#define GLA_LDKF(buf, dblk_) do { _Pragma("unroll") for (int kk = 0; kk < 4; ++kk) { kf[buf][2 * kk] = GLA_TR(tr_kh + (dblk_) * 64 + kk * 16 * SKS); kf[buf][2 * kk + 1] = GLA_TR(tr_kh + (dblk_) * 64 + kk * 16 * SKS + 4 * SKS); } \
            _Pragma("unroll") for (int g = 0; g < 4; ++g) dcv[buf][g] = *(const LAS f32x4*)(lds + S_DEC + (32 * (dblk_) + 8 * g + 4 * hh) * 4); } while (0)
        GLA_LDKF(0, 0);
#pragma unroll
        for (int dblk = 0; dblk < 4; ++dblk) {
            if (dblk + 1 < 4) GLA_LDKF((dblk + 1) & 1, dblk + 1);
#pragma unroll
            for (int g = 0; g < 4; ++g)
#pragma unroll
                for (int e = 0; e < 4; ++e) S[dblk][4 * g + e] *= dcv[dblk & 1][g][e];
#pragma unroll
            for (int kk = 0; kk < 4; ++kk) { const bf16x8 a = __builtin_shufflevector(kf[dblk & 1][2 * kk], kf[dblk & 1][2 * kk + 1], 0, 1, 2, 3, 4, 5, 6, 7); S[dblk] = GLA_MFMA(a, vf[kk], S[dblk]); } }
#undef GLA_LDKF
        bf16x8 baf[6];
#pragma unroll
        for (int j = 0; j < 6; ++j) { const int ti = j < 2 ? 0 : 1, kk = j < 2 ? j : j - 2; baf[j] = *(const LAS bf16x8*)(lds + S_AT + (32 * ti + r) * SAS + (16 * kk + 8 * hh) * 2); }
#pragma unroll
        for (int j = 0; j < 6; ++j) { const int ti = j < 2 ? 0 : 1, kk = j < 2 ? j : j - 2; ot[ti] = GLA_MFMA(vf[kk], baf[j], ot[ti]); }
        }
#pragma unroll
        for (int ti = 0; ti < 2; ++ti) { float ss = 0.f;
#pragma unroll
            for (int i = 0; i < 16; ++i) ss += ot[ti][i] * ot[ti][i];
            ss += __shfl_xor(ss, 32); if (hh == 0) *(LAS float*)(lds + S_RED + (w * 64 + 32 * ti + r) * 4) = ss; }
        GLA_LBAR();
#pragma unroll
        for (int ti = 0; ti < 2; ++ti) { float tot = 0.f;
#pragma unroll
            for (int ww = 0; ww < 8; ++ww) tot += *(const LAS float*)(lds + S_RED + (ww * 64 + 32 * ti + r) * 4);
            const float rstd = rsqrtf(tot * (1.0f / GDV) + EPS);
#pragma unroll
            for (int g = 0; g < 4; ++g) { const f32x4 gg = *(const LAS f32x4*)(lds + S_GN + (32 * w + 4 * hh + 8 * g) * 4);
                u32x2 pkd; pkd.x = cvt2(ot[ti][4 * g + 0] * rstd * gg[0], ot[ti][4 * g + 1] * rstd * gg[1]); pkd.y = cvt2(ot[ti][4 * g + 2] * rstd * gg[2], ot[ti][4 * g + 3] * rstd * gg[3]);
                *(LAS u32x2*)(lds + S_OT + (32 * ti + r) * SVS + (32 * w + 8 * g + 4 * hh) * 2) = pkd; } }
        GLA_LBAR();
#pragma unroll
        for (int i = 0; i < 4; ++i) { const int idx = tid + 512 * i, row = idx >> 5, ch = idx & 31; const u32x4 ov = *(const LAS u32x4*)(lds + S_OT + row * SVS + ch * 16), sv = sg[i];
            u32x4 res; res.x = cvt2(pg8::bflo(ov.x) * pg8::bflo(sv.x), pg8::bfhi(ov.x) * pg8::bfhi(sv.x)); res.y = cvt2(pg8::bflo(ov.y) * pg8::bflo(sv.y), pg8::bfhi(ov.y) * pg8::bfhi(sv.y));
            res.z = cvt2(pg8::bflo(ov.z) * pg8::bflo(sv.z), pg8::bfhi(ov.z) * pg8::bfhi(sv.z)); res.w = cvt2(pg8::bflo(ov.w) * pg8::bflo(sv.w), pg8::bfhi(ov.w) * pg8::bfhi(sv.w));
            if (!(VAR & 1) || (c == SEQ / GCH - 1)) *(u32x4*)(ub_og + (size_t)(t0 + 16 * i) * (GVW * 2) + vo_ogc) = res; }
    }
#undef GLA_LOAD
}
#undef GLA_MFMA
#undef GLA_TR
#undef GLA_LBAR
}
constexpr int NWAVES = 8;
constexpr int RING_BYTES = 131072;
constexpr int LDSCTL_OFF = RING_BYTES, MISC_OFF = LDSCTL_OFF + 320;
constexpr int LDS_BYTES = 147456;
constexpr int CW_TMO = 0, CW_QUEUE = 64, CW_BAR = 4096;
constexpr int PH_P0A = 0, PH_P0B = 1, PH_P0C = 2, PH_L0 = 3, PH_PER_LAYER = 7, PH_FINAL = PH_L0 + DEPTH * PH_PER_LAYER, PH_COUNT = PH_FINAL + 1;
constexpr int PL_IN = 0, PL_PRE = 1, PL_MIX = 2, PL_UP = 3, PL_OUT = 4, PL_FFI = 5, PL_FFO = 6;

#ifndef EN_P0
#define EN_P0 1
#endif
#ifndef EN_IN
#define EN_IN 1
#endif
#ifndef EN_PRE
#define EN_PRE 1
#endif
#ifndef EN_MOBA
#define EN_MOBA 1
#endif
#ifndef EN_GLA
#define EN_GLA 1
#endif
#ifndef EN_UP
#define EN_UP 1
#endif
#ifndef EN_OUT
#define EN_OUT 1
#endif
#ifndef EN_FFI
#define EN_FFI 1
#endif
#ifndef EN_FFO
#define EN_FFO 1
#endif
struct Args { Params P; int ph_lo, ph_hi, li, pad; };

__device__ __forceinline__ void glr_unit(const Params& P, int l, const float* ssq, int rg64, int wave, int lane, LAS unsigned char* lds) {
    const bf16* A = (const bf16*)(P.ws + WS_ABUF); const bf16* W = wt_ptr(P, l, WT_GLR);
    const int rg = wave & 3, kh = wave >> 2, r16 = lane & 15, q = lane >> 4, row0 = rg64 * 64 + rg * 16;
    const bf16* ap = A + (size_t)(row0 + r16) * DM + kh * 1024 + 8 * q; const bf16* bp = W + (size_t)r16 * DM + kh * 1024 + 8 * q;
    f32x4 acc = {0.f, 0.f, 0.f, 0.f};
#pragma unroll 8
    for (int k0 = 0; k0 < 1024; k0 += 32) acc = __builtin_amdgcn_mfma_f32_16x16x32_bf16(*(const bf16x8*)(ap + k0), *(const bf16x8*)(bp + k0), acc, 0, 0, 0);
    LAS f32x4* part = (LAS f32x4*)lds;
    if (kh == 1) part[rg * 64 + lane] = acc;
    __syncthreads();
    if (kh == 0) { const f32x4 o = part[rg * 64 + lane];
        const float* shw = (const float*)(P.ws + WS_SHWGLR) + (size_t)l * 8 * GRANK;
#pragma unroll
        for (int j = 0; j < 4; ++j) { const int row = row0 + 4 * q + j, b = row / SEQ; *(LAS float*)(lds + gla::L_GLR + ((rg * 16 + 4 * q + j) * GRANK + r16) * 4) = rsqrtf(ssq[row] * (1.f / DM) + EPS) * (acc[j] + o[j]) + shw[b * GRANK + r16]; } }
    __syncthreads();
}
__device__ __forceinline__ void kmean_unit(const Params& P, int item, int tid, LAS unsigned char* lds) {
    const int blk = item % MNB, bh = item / MNB, b = bh / MH, h = bh % MH, c8 = tid & 15, rgp = tid >> 4;
    const bf16* p = (const bf16*)(P.ws + WS_PROJ) + PJ_MK + ((size_t)bh * SEQ + blk * MBLK + rgp) * MHD + 8 * c8;
    float s[8];
#pragma unroll
    for (int j = 0; j < 8; ++j) s[j] = 0.f;
#pragma unroll
    for (int i = 0; i < 8; ++i) { const u32x4 w = *(const u32x4*)(p + (size_t)(32 * i) * MHD);
        s[0] += pg8::bflo(w.x); s[1] += pg8::bfhi(w.x); s[2] += pg8::bflo(w.y); s[3] += pg8::bfhi(w.y); s[4] += pg8::bflo(w.z); s[5] += pg8::bfhi(w.z); s[6] += pg8::bflo(w.w); s[7] += pg8::bfhi(w.w); }
    LAS float* red = (LAS float*)lds;
#pragma unroll
    for (int j = 0; j < 8; ++j) red[rgp * 128 + 8 * c8 + j] = s[j];
    __syncthreads();
    if (tid < 128) { float a = 0.f;
#pragma unroll
        for (int r = 0; r < 32; ++r) a += red[r * 128 + tid];
        ((float*)(P.ws + WS_KMEAN))[((size_t)bh * MNB + blk) * MHD + tid] = a * (1.f / MBLK); }
    __syncthreads();
}
__device__ __forceinline__ void final_row(float* x, const float* g, int m, int lane) {
    f32x4* xr = (f32x4*)(x + (size_t)m * DM); float s = 0.f; f32x4 v[8];
#pragma unroll
    for (int j = 0; j < 8; ++j) { v[j] = xr[lane + 64 * j]; s += (v[j].x * v[j].x + v[j].y * v[j].y) + (v[j].z * v[j].z + v[j].w * v[j].w); }
    const float rstd = rsqrtf(wave_sum(s) * (1.f / DM) + EPS);
#pragma unroll
    for (int j = 0; j < 8; ++j) { const f32x4 gg = *(const f32x4*)(g + 4 * (lane + 64 * j)); xr[lane + 64 * j] = v[j] * rstd * gg; }
}

__device__ __forceinline__ void moba_phase(const Params& P, unsigned* queues  , char* ldsg, volatile LAS unsigned* qslot  , int tid) {
    const bf16* PROJ = (const bf16*)(P.ws + WS_PROJ); bf16* OM = (bf16*)(P.ws + WS_OGOM) + (size_t)MT * GVW; const float* KM = (const float*)(P.ws + WS_KMEAN);
    constexpr int W = 1 << 20; constexpr unsigned NONE = 0xffffffffu;
    const unsigned x0 = xb_xcc_id() & 7u; unsigned xo = 0u;
#define MOBA_POP(dst) do { unsigned u_ = NONE; while (xo < 8u) { const unsigned x_ = (x0 + xo) & 7u; const unsigned i_ = __hip_atomic_fetch_add(queues + 64 * x_, 1u, __ATOMIC_RELAXED, __HIP_MEMORY_SCOPE_AGENT); \
        if (i_ < 64u) { u_ = (x_ << 8) | i_; break; } ++xo; } (dst) = u_; } while (0)
#define MOBA_REF(ref, u_) do { const int i_ = (int)((u_) & 63u), x_ = (int)((u_) >> 8), qb_ = MNB - 1 - (i_ >> 3), bh_ = 8 * x_ + (i_ & 7);   \
        (ref).Q = PROJ + PJ_MQ + ((size_t)bh_ * SEQ + qb_ * MBLK) * MHD; (ref).K = PROJ + PJ_MK + (size_t)bh_ * SEQ * MHD; (ref).V = PROJ + PJ_MV + (size_t)bh_ * SEQ * MHD; \
        (ref).O = OM + (size_t)((bh_ >> 3) * SEQ + qb_ * MBLK) * MW + (bh_ & 7) * MHD; (ref).P0 = qb_ * MBLK; (ref).km = KM + (size_t)bh_ * MNB * MHD; (ref).qb = qb_; } while (0)
    if (tid == 0) { unsigned a_, b_; MOBA_POP(a_); MOBA_POP(b_); qslot[0] = a_; qslot[1] = b_; }
    __syncthreads();
    unsigned u = __builtin_amdgcn_readfirstlane(qslot[0]);
    if (u == NONE) return;
    moba::Seam<bf16> S; moba::BlockRef<bf16, bf16> cur, nxt;
    MOBA_REF(cur, u);
    moba::causal_swa_prime<bf16, bf16>(cur, W, ldsg, S);
    for (int it = 0;; ++it) {
        const unsigned un = __builtin_amdgcn_readfirstlane(qslot[(it + 1) % 3]);
        if (tid == 0) { unsigned c_; MOBA_POP(c_); qslot[(it + 2) % 3] = c_; }
        const bool last = un == NONE;
        if (last) nxt = cur; else MOBA_REF(nxt, un);
        moba::causal_swa_block<bf16, bf16>(cur, nxt, SEQ, W, ldsg, S);
        if (last) break;
        cur = nxt;
    }
#undef MOBA_POP
#undef MOBA_REF
}

__global__ void __launch_bounds__(NWAVES * 64, 2) mega(Args args) {
    extern __shared__ __attribute__((aligned(16))) unsigned char lds_raw[];
    LAS unsigned char* lds = (LAS unsigned char*)lds_raw;
    volatile LAS unsigned* MISC = (volatile LAS unsigned*)(lds + MISC_OFF);
    const Params& P = args.P;
    const int wave = __builtin_amdgcn_readfirstlane(threadIdx.x >> 6);
#define OTID(name) int name = threadIdx.x; asm volatile("" : "+v"(name))
    const int G = gridDim.x, bx = blockIdx.x, vcu = (G % 8 == 0) ? (bx % 8) * (G / 8) + bx / 8 : bx;
    const int gw = vcu * NWAVES + wave, ngw = G * NWAVES;
    unsigned* ctl = (unsigned*)(P.ws + WS_CTL);
    { OTID(t0); for (int u = t0; u < (LDS_BYTES - LDSCTL_OFF) / 4; u += NWAVES * 64) ((LAS unsigned*)(lds + LDSCTL_OFF))[u] = 0u; }
    __syncthreads();
    const int lo = args.ph_lo, hi = args.ph_hi;
    XcdBarrier bar; bar.bar = ctl + CW_BAR + args.li * XCD_BAR_WORDS; bar.x = 0; bar.st = nullptr;
    if (hi - lo > 1) bar = xcd_barrier_post(ctl + CW_BAR + args.li * XCD_BAR_WORDS, MISC + 8);
#define IN(k) (lo <= (k) && (k) < hi)
#if defined(PROBE_MASK)
#define PROBE_AT(k) PROBE_TY((k) < PH_L0 ? (k) : ((k) >= PH_FINAL ? 10 : PH_L0 + ((k) - PH_L0) % PH_PER_LAYER))
#define PROBE_TY(ty) do { if (blockIdx.x == 0 && threadIdx.x == 0) { const unsigned long long now_ = __builtin_amdgcn_s_memrealtime(); const int ty_ = (ty); \
        unsigned long long last_ = ((unsigned long long)MISC[21] << 32) | MISC[20], acc_ = ((unsigned long long)MISC[23] << 32) | MISC[22]; if ((PROBE_MASK >> ty_) & 1) acc_ += now_ - last_; \
        MISC[20] = (unsigned)now_; MISC[21] = (unsigned)(now_ >> 32); MISC[22] = (unsigned)acc_; MISC[23] = (unsigned)(acc_ >> 32); } } while (0)
#else
#define PROBE_AT(k) do { } while (0)
#endif
#define SEAM(k) do { if (IN(k) && IN((k) + 1)) xcd_barrier(bar); PROBE_AT(k); } while (0)
#if defined(PROBE_MASK)
    if (blockIdx.x == 0 && threadIdx.x == 0) { const unsigned long long now_ = __builtin_amdgcn_s_memrealtime(); MISC[20] = (unsigned)now_; MISC[21] = (unsigned)(now_ >> 32); MISC[22] = 0u; MISC[23] = 0u; }
#endif

    if (EN_P0 && IN(PH_P0A)) { OTID(t1); phase_p0a(P, gw, ngw, t1 & 63, (float*)(lds_raw + wave * 16384)); __syncthreads(); SEAM(PH_P0A); }
    if (EN_P0 && IN(PH_P0B)) { OTID(t1); phase_p0b(P, vcu * NWAVES * 64 + t1, G * NWAVES * 64); SEAM(PH_P0B); }
    if (EN_P0 && IN(PH_P0C)) {
        OTID(t1);
        for (int m = gw; m < MT; m += ngw) a1prep_row(P, m, t1 & 63);
        for (int combo = 0; combo < 4; ++combo) shw_combo(P, combo, wave, NWAVES, gw, ngw, t1, NWAVES * 64, t1 & 63, (float*)lds_raw);
        SEAM(PH_P0C);
    }
    for (int l = 0; l < DEPTH; ++l) {
        const int pb = PH_L0 + l * PH_PER_LAYER;
        bf16* ABUF = (bf16*)(P.ws + WS_ABUF); bf16* OGOM = (bf16*)(P.ws + WS_OGOM); bf16* PROJ = (bf16*)(P.ws + WS_PROJ); bf16* HID = PROJ;
        float* SSQA = (float*)(P.ws + WS_SSQ0); float* SSQB = (float*)(P.ws + WS_SSQ) + (size_t)l * MT; float* SSQN = (float*)(P.ws + WS_SSQ) + (size_t)(2 + l) * MT;
        const float* mv = (const float*)(P.ws + WS_MODV) + (size_t)l * 8 * 6 * DM;
        const float* mvn = (const float*)(P.ws + WS_MODV) + (size_t)(l + 1 < DEPTH ? l + 1 : l) * 8 * 6 * DM;
        const float* ssq_in = l == 0 ? SSQA : (const float*)(P.ws + WS_SSQ) + (size_t)(2 + l - 1) * MT;
        if (EN_IN && IN(pb + PL_IN)) {
            pg8::Gemm g{ABUF, wt_ptr(P, l, WT_IN), MT, NIN, DM}; pg8::StaticOrder S; S.init(MT, NIN, G, bx);
            pg8::EpiIn E{ssq_in, (const float*)(P.ws + WS_SHWIN) + (size_t)l * 8 * NIN, PROJ};
            pg8::gemm_phase<pg8::EpiIn, pg8::StaticOrder, true, true>(lds, g, S, E);
            SEAM(pb + PL_IN);
        }
        if (EN_PRE && IN(pb + PL_PRE)) {
            OTID(t2);
            for (int u = vcu; u < MT / 64; u += G) { glr_unit(P, l, ssq_in, u, wave, t2 & 63, lds);
                for (int h = 0; h < GH; ++h) gla::gla_pre_head(P, l, u >> 5, u & 31, h, lds, t2); }
            for (int it = vcu; it < NB * MH * MNB; it += G) kmean_unit(P, it, t2, lds);
            SEAM(pb + PL_PRE);
        }
        if (IN(pb + PL_MIX)) {
            if (EN_GLA && bx < NB * GH) { OTID(t3); gla::gla_seq_unit<0>(P, l, bx, lds, t3);
#if defined(GLA_PROBE_VAR)
                __syncthreads(); { OTID(t3b); gla::gla_seq_unit<GLA_PROBE_VAR>(P, l, bx, lds, t3b); }
#endif
            }
#if defined(PROBE_MASK) && defined(PROBE_SPLIT)
            xcd_barrier(bar); PROBE_TY(11);
#endif
            if (EN_MOBA) { OTID(t4); moba_phase(P, ctl + CW_QUEUE + 512 * l, (char*)lds_raw, MISC + 16, t4); }
            SEAM(pb + PL_MIX);
        }
        if (EN_UP && IN(pb + PL_UP)) {
            { pg8::Gemm g{OGOM, wt_ptr(P, l, WT_UPG), MT, DM, GVW};     pg8::StaticOrder S; S.init(MT, DM, G, bx); pg8::EpiUp<false> E{PROJ, GT_OFF, ABUF};
              pg8::gemm_phase<pg8::EpiUp<false>, pg8::StaticOrder, true, true>(lds, g, S, E); }
            { pg8::Gemm g{OGOM + (size_t)MT * GVW, wt_ptr(P, l, WT_UPM), MT, DM, MW};     pg8::StaticOrder S; S.init(MT, DM, G, bx); pg8::EpiUp<true> E{PROJ, GT_OFF + DM, ABUF};
              pg8::gemm_phase<pg8::EpiUp<true>, pg8::StaticOrder, true, true>(lds, g, S, E); }
            SEAM(pb + PL_UP);
        }
        if (EN_OUT && IN(pb + PL_OUT)) {
            pg8::Gemm g{ABUF, wt_ptr(P, l, WT_OUT), MT, DM, DM}; pg8::StaticOrder S; S.init(MT, DM, G, bx);
            pg8::EpiRes E{l == 0 ? P.x : P.out, P.out, mv + 2 * DM, mv + 4 * DM, OGOM, SSQB};
            pg8::gemm_phase<pg8::EpiRes, pg8::StaticOrder, true, true>(lds, g, S, E);
            SEAM(pb + PL_OUT);
        }
        if (EN_FFI && IN(pb + PL_FFI)) {
            pg8::Gemm g{OGOM, wt_ptr(P, l, WT_FFI), MT, NFFI, DM}; pg8::StaticOrder S; S.init(MT, NFFI, G, bx);
            pg8::EpiFfi E{SSQB, (const float*)(P.ws + WS_SHWFFI) + (size_t)l * 8 * NFFI, HID};
            pg8::gemm_phase<pg8::EpiFfi, pg8::StaticOrder, true, true>(lds, g, S, E);
            SEAM(pb + PL_FFI);
        }
        if (EN_FFO && IN(pb + PL_FFO)) {
            pg8::Gemm g{HID, wt_ptr(P, l, WT_FFO), MT, DM, DFF}; pg8::StaticOrder S; S.init(MT, DM, G, bx);
            pg8::EpiRes E{P.out, P.out, mv + 5 * DM, mvn + 1 * DM, l + 1 < DEPTH ? ABUF : nullptr, l + 1 < DEPTH ? SSQN : nullptr};
            pg8::gemm_phase<pg8::EpiRes, pg8::StaticOrder, true, true>(lds, g, S, E);
            SEAM(pb + PL_FFO);
        }
    }
    if (IN(PH_FINAL)) { OTID(t5); for (int m = gw; m < MT; m += ngw) final_row(P.out, P.final_g, m, t5 & 63); }
#if defined(PROBE_MASK)
    PROBE_AT(PH_FINAL);
    if (blockIdx.x == 0 && threadIdx.x == 0) { const unsigned long long acc_ = ((unsigned long long)MISC[23] << 32) | MISC[22]; const unsigned long long t_end = __builtin_amdgcn_s_memrealtime() + (unsigned long long)(PROBE_MULT) * acc_;
        while (__builtin_amdgcn_s_memrealtime() < t_end) __builtin_amdgcn_s_sleep(8); }
#endif
#undef IN
#undef SEAM
#undef OTID
}
template <int TN, class Epi>
__global__ __launch_bounds__(256) void k_naive_gemm(const bf16* A, int lda, const bf16* Bt, int ldb, int K, Epi E) {
    const int wave = threadIdx.x >> 6, lane = threadIdx.x & 63, r16 = lane & 15, q = lane >> 4;
    const int row0 = blockIdx.y * 64 + wave * 16, col0 = blockIdx.x * 16 * TN;
    f32x4 acc[TN];
#pragma unroll
    for (int t = 0; t < TN; ++t) acc[t] = (f32x4){0.f, 0.f, 0.f, 0.f};
    const bf16* ap = A + (size_t)(row0 + r16) * lda + 8 * q;
    const bf16* bp = Bt + (size_t)(col0 + r16) * ldb + 8 * q;
    for (int k0 = 0; k0 < K; k0 += 32) {
        const bf16x8 a = *(const bf16x8*)(ap + k0);
#pragma unroll
        for (int t = 0; t < TN; ++t) { const bf16x8 b = *(const bf16x8*)(bp + (size_t)t * 16 * ldb + k0);
            acc[t] = __builtin_amdgcn_mfma_f32_16x16x32_bf16(a, b, acc[t], 0, 0, 0); }
    }
#pragma unroll
    for (int t = 0; t < TN; ++t)
#pragma unroll
        for (int j = 0; j < 4; ++j) E(row0 + 4 * q + j, col0 + t * 16 + r16, acc[t][j]);
}
struct NEpiIn {
    const float* ssq; const float* shw; bf16* proj;
    __device__ void operator()(int row, int col, float a) const {
        const int b = row / SEQ; const float rstd = rsqrtf(ssq[row] * (1.f / DM) + EPS);
        float v = rstd * a + shw[(size_t)b * NIN + col];
        if (col < GK_OFF) v *= 0.08838834764831845f;
        else if (col >= GR_OFF && col < MQ_OFF) v = siluf_(v);
        else if (col >= GT_OFF) v = sigmoidf_(v);
        proj[(size_t)row * NIN + col] = (bf16)f2bf(v);
    }
};
struct NEpiGlr { const float* ssq; const float* shw; float* glr;
    __device__ void operator()(int row, int col, float a) const { const int b = row / SEQ; glr[(size_t)row * GRANK + col] = rsqrtf(ssq[row] * (1.f / DM) + EPS) * a + shw[b * GRANK + col]; } };
struct NEpiUp1 { const bf16* proj; bf16* mg;
    __device__ void operator()(int row, int col, float a) const { mg[(size_t)row * DM + col] = (bf16)f2bf(bf2f(proj[(size_t)row * NIN + GT_OFF + col]) * a); } };
struct NEpiUp2 { const bf16* proj; bf16* mg;
    __device__ void operator()(int row, int col, float a) const { const size_t i = (size_t)row * DM + col; mg[i] = (bf16)f2bf(bf2f(mg[i]) + bf2f(proj[(size_t)row * NIN + GT_OFF + DM + col]) * a); } };
struct NEpiRes {
    const float* xin; float* xout; const float* gate; const float* gm; bf16* aout;
    __device__ void operator()(int row, int col, float a) const { const int b = row / SEQ; const size_t i = (size_t)row * DM + col;
        const float v = xin[i] + gate[(size_t)b * 6 * DM + col] * a; xout[i] = v; if (aout) aout[i] = (bf16)f2bf(v * gm[(size_t)b * 6 * DM + col]); } };
struct NEpiFfi {
    const float* ssq; const float* shw; bf16* hid;
    __device__ void operator()(int row, int col, float a) const { (void)row; (void)col; (void)a; } };
__global__ __launch_bounds__(256) void k_naive_ffi(const bf16* A, const bf16* Bt, const float* ssq, const float* shw, bf16* hid) {
    const int wave = threadIdx.x >> 6, lane = threadIdx.x & 63, r16 = lane & 15, q = lane >> 4;
    const int row0 = blockIdx.y * 64 + wave * 16, j0 = blockIdx.x * 16;
    const int pn = j0 >> 7, c = j0 & 127, ra = pn * 256 + c, ru = ra + 128;
    f32x4 aa = {0.f, 0.f, 0.f, 0.f}, au = {0.f, 0.f, 0.f, 0.f};
    const bf16* ap = A + (size_t)(row0 + r16) * DM + 8 * q;
    const bf16* bpa = Bt + (size_t)(ra + r16) * DM + 8 * q; const bf16* bpu = Bt + (size_t)(ru + r16) * DM + 8 * q;
    for (int k0 = 0; k0 < DM; k0 += 32) { const bf16x8 a = *(const bf16x8*)(ap + k0);
        aa = __builtin_amdgcn_mfma_f32_16x16x32_bf16(a, *(const bf16x8*)(bpa + k0), aa, 0, 0, 0);
        au = __builtin_amdgcn_mfma_f32_16x16x32_bf16(a, *(const bf16x8*)(bpu + k0), au, 0, 0, 0); }
#pragma unroll
    for (int j = 0; j < 4; ++j) { const int row = row0 + 4 * q + j, b = row / SEQ; const float rstd = rsqrtf(ssq[row] * (1.f / DM) + EPS);
        const float va = rstd * aa[j] + shw[(size_t)b * NFFI + ra + r16], vu = rstd * au[j] + shw[(size_t)b * NFFI + ru + r16];
        hid[(size_t)row * DFF + j0 + r16] = (bf16)f2bf(siluf_(va) * vu); }
}
__global__ __launch_bounds__(256) void k_rowssq(const float* x, float* ssq) {
    const int m = blockIdx.x * 4 + (threadIdx.x >> 6), lane = threadIdx.x & 63; const f32x4* xr = (const f32x4*)(x + (size_t)m * DM); float s = 0.f;
#pragma unroll
    for (int j = 0; j < 8; ++j) { const f32x4 v = xr[lane + 64 * j]; s += (v.x * v.x + v.y * v.y) + (v.z * v.z + v.w * v.w); }
    s = wave_sum(s); if (lane == 0) ssq[m] = s;
}
__global__ __launch_bounds__(256) void k_final(float* x, const float* g) {
    const int m = blockIdx.x * 4 + (threadIdx.x >> 6), lane = threadIdx.x & 63; f32x4* xr = (f32x4*)(x + (size_t)m * DM); float s = 0.f; f32x4 v[8];
#pragma unroll
    for (int j = 0; j < 8; ++j) { v[j] = xr[lane + 64 * j]; s += (v[j].x * v[j].x + v[j].y * v[j].y) + (v[j].z * v[j].z + v[j].w * v[j].w); }
    const float rstd = rsqrtf(wave_sum(s) * (1.f / DM) + EPS);
#pragma unroll
    for (int j = 0; j < 8; ++j) { const f32x4 gg = *(const f32x4*)(g + 4 * (lane + 64 * j)); xr[lane + 64 * j] = v[j] * rstd * gg; }
}
__global__ __launch_bounds__(128) void k_kmean(const bf16* proj, float* kmean) {
    const int blk = blockIdx.x % MNB, bh = blockIdx.x / MNB, b = bh / MH, h = bh % MH, d = threadIdx.x;
    const bf16* p = proj + (size_t)(b * SEQ + blk * MBLK) * NIN + MK_OFF + h * MHD + d; float s = 0.f;
    for (int r = 0; r < MBLK; ++r) s += bf2f(p[(size_t)r * NIN]);
    kmean[((size_t)bh * MNB + blk) * MHD + d] = s * (1.f / MBLK);
}
__global__ __launch_bounds__(512) void k_gla_g(const float* glr, const float* w2, const float* gb, float* g) {
    const int m = blockIdx.x, d = threadIdx.x; float a = gb[d];
#pragma unroll
    for (int r = 0; r < GRANK; ++r) a += glr[(size_t)m * GRANK + r] * w2[r * GKW + d];
    g[(size_t)m * GKW + d] = logsigmoidf_(a) * (1.f / 16.f);
}
__global__ __launch_bounds__(256) void k_gla_rec(const bf16* proj, const float* g, float* oraw) {
    const int bh = blockIdx.x, b = bh / GH, h = bh % GH, dv = threadIdx.x;
    float S[GDK];
#pragma unroll
    for (int d = 0; d < GDK; ++d) S[d] = 0.f;
    for (int t = 0; t < SEQ; ++t) { const size_t m = (size_t)b * SEQ + t; const bf16* pr = proj + m * NIN;
        const float v = bf2f(pr[GV_OFF + h * GDV + dv]); float o = 0.f;
#pragma unroll
        for (int d = 0; d < GDK; ++d) { const float dec = __expf(g[m * GKW + h * GDK + d]); S[d] = dec * S[d] + bf2f(pr[GK_OFF + h * GDK + d]) * v; o += bf2f(pr[GQ_OFF + h * GDK + d]) * S[d]; }
        oraw[m * GVW + h * GDV + dv] = o; }
}
__global__ __launch_bounds__(256) void k_gla_norm(const float* oraw, const bf16* proj, const float* gn, bf16* og) {
    const int idx = blockIdx.x * 4 + (threadIdx.x >> 6), lane = threadIdx.x & 63, m = idx / GH, h = idx % GH;
    const f32x4 v = *(const f32x4*)(oraw + (size_t)m * GVW + h * GDV + 4 * lane);
    const float rstd = rsqrtf(wave_sum((v.x * v.x + v.y * v.y) + (v.z * v.z + v.w * v.w)) * (1.f / GDV) + EPS);
    const f32x4 gg = *(const f32x4*)(gn + 4 * lane); const bf16* sg = proj + (size_t)m * NIN + GR_OFF + h * GDV + 4 * lane;
    u32x2 w; w.x = pk2(v.x * rstd * gg.x * bf2f(sg[0]), v.y * rstd * gg.y * bf2f(sg[1])); w.y = pk2(v.z * rstd * gg.z * bf2f(sg[2]), v.w * rstd * gg.w * bf2f(sg[3]));
    *(u32x2*)(og + (size_t)m * GVW + h * GDV + 4 * lane) = w;
}
__global__ __launch_bounds__(128) void k_moba_naive(const bf16* proj, const float* kmean, bf16* om) {
    __shared__ float qs[MHD]; __shared__ float sc[SEQ / 2 + MBLK]; __shared__ float red[128]; __shared__ float bsc[8]; __shared__ int selb;
    const int t = blockIdx.x % SEQ, bh = blockIdx.x / SEQ, b = bh / MH, h = bh % MH, tid = threadIdx.x, qb = t / MBLK;
    const size_t m = (size_t)b * SEQ + t;
    qs[tid] = bf2f(proj[m * NIN + MQ_OFF + h * MHD + tid]);
    __syncthreads();
    if (tid < 8) { float s = -INFINITY; if (tid < qb) { s = 0.f; const float* km = kmean + ((size_t)bh * MNB + tid) * MHD; for (int d = 0; d < MHD; ++d) s += qs[d] * km[d]; } bsc[tid] = s; }
    __syncthreads();
    if (tid == 0) { int bits = 0;
        for (int r = 0; r < MTOPK; ++r) { int best = -1; float bv = -INFINITY; for (int j = 0; j < qb; ++j) if (!((bits >> j) & 1) && (best < 0 || bsc[j] > bv)) { best = j; bv = bsc[j]; } if (best >= 0) bits |= 1 << best; }
        selb = bits; }
    __syncthreads();
    const int bits = selb;
    const int nsel = __popc(bits);
    const int nown = t - qb * MBLK + 1, ncand = nsel * MBLK + nown;
#define KEY_OF(i, key) do { const int sblk_ = (i) / MBLK; if (sblk_ >= nsel) key = qb * MBLK + ((i) - nsel * MBLK); else { int cnt_ = 0, blk_ = 0; for (int j_ = 0; j_ < 8; ++j_) if ((bits >> j_) & 1) { if (cnt_ == sblk_) blk_ = j_; ++cnt_; } key = blk_ * MBLK + ((i) % MBLK); } } while (0)
    float mx = -INFINITY;
    for (int i = tid; i < ncand; i += 128) { int key; KEY_OF(i, key);
        const bf16* kr = proj + ((size_t)b * SEQ + key) * NIN + MK_OFF + h * MHD; float s = 0.f;
        for (int d8 = 0; d8 < MHD / 8; ++d8) { const u32x4 w = *(const u32x4*)(kr + 8 * d8); const float* qq = qs + 8 * d8;
            s += qq[0] * bf2f(w.x & 0xffff) + qq[1] * bf2f(w.x >> 16) + qq[2] * bf2f(w.y & 0xffff) + qq[3] * bf2f(w.y >> 16) + qq[4] * bf2f(w.z & 0xffff) + qq[5] * bf2f(w.z >> 16) + qq[6] * bf2f(w.w & 0xffff) + qq[7] * bf2f(w.w >> 16); }
        s *= 0.08838834764831845f; sc[i] = s; mx = fmaxf(mx, s); }
    red[tid] = mx; __syncthreads();
    for (int o = 64; o > 0; o >>= 1) { if (tid < o) red[tid] = fmaxf(red[tid], red[tid + o]); __syncthreads(); }
    mx = red[0]; __syncthreads();
    float sum = 0.f;
    for (int i = tid; i < ncand; i += 128) { const float p = __expf(sc[i] - mx); sc[i] = p; sum += p; }
    red[tid] = sum; __syncthreads();
    for (int o = 64; o > 0; o >>= 1) { if (tid < o) red[tid] += red[tid + o]; __syncthreads(); }
    sum = red[0];
    float o = 0.f;
    for (int i = 0; i < ncand; ++i) { int key; KEY_OF(i, key);
        o += sc[i] * bf2f(proj[((size_t)b * SEQ + key) * NIN + MV_OFF + h * MHD + tid]); }
    om[m * MW + h * MHD + tid] = (bf16)f2bf(o / sum);
}

#ifndef FAST_P0
#define FAST_P0 1
#endif
#ifndef FAST_IN
#define FAST_IN 1
#endif
#ifndef FAST_PRE
#define FAST_PRE 1
#endif
#ifndef FAST_MIX
#define FAST_MIX 0
#endif
#ifndef FAST_UP
#define FAST_UP 1
#endif
#ifndef FAST_OUT
#define FAST_OUT 1
#endif
#ifndef FAST_FFI
#define FAST_FFI 1
#endif
#ifndef FAST_FFO
#define FAST_FFO 1
#endif
#ifndef FAST_FINAL
#define FAST_FINAL 1
#endif
#ifndef ONE_LAUNCH
#define ONE_LAUNCH 1
#endif
#ifndef HYBRID_BAR
#define HYBRID_BAR 1
#endif
extern "C" void kernel_launch(void* const* d_in, const int* in_sizes, int n_in, void* d_out, int out_size, void* d_ws, size_t ws_size, hipStream_t stream) {
    static int grid = 0;
    if (grid == 0) {
        if (n_in != 16 || in_sizes[0] != MT * DM || out_size != MT * DM || ws_size < WS_DBG_END) { fprintf(stderr, "kernel_launch: unexpected shapes/ws (n_in %d, ws %zu, need %zu)\n", n_in, ws_size, (size_t)WS_DBG_END); grid = -1; return; }
        int dev = 0, cus = 0, per_cu = 0;
        if (hipGetDevice(&dev) != hipSuccess || hipDeviceGetAttribute(&cus, hipDeviceAttributeMultiprocessorCount, dev) != hipSuccess) { grid = -1; return; }
        if (hipFuncSetAttribute((const void*)mega, hipFuncAttributeMaxDynamicSharedMemorySize, LDS_BYTES) != hipSuccess) { fprintf(stderr, "kernel_launch: hipFuncSetAttribute failed\n"); grid = -1; return; }
        if (hipOccupancyMaxActiveBlocksPerMultiprocessor(&per_cu, (const void*)mega, NWAVES * 64, LDS_BYTES) != hipSuccess || per_cu < 1) fprintf(stderr, "kernel_launch: occupancy query says %d\n", per_cu);
        (void)hipGetLastError();
        grid = cus;
    }
    if (grid < 0) return;
    Args a{};
    Params& P = a.P;
    P.x = (const float*)d_in[0]; P.c = (const float*)d_in[1]; P.ada_w = (const float*)d_in[2]; P.ada_b = (const float*)d_in[3]; P.norm1_g = (const float*)d_in[4]; P.w_in = (const float*)d_in[5];
    P.gate_w2 = (const float*)d_in[6]; P.gate_b = (const float*)d_in[7]; P.gla_norm_g = (const float*)d_in[8]; P.w_up_gla = (const float*)d_in[9]; P.w_up_moba = (const float*)d_in[10];
    P.w_out = (const float*)d_in[11]; P.norm2_g = (const float*)d_in[12]; P.w_ffn_in = (const float*)d_in[13]; P.w_ffn_out = (const float*)d_in[14]; P.final_g = (const float*)d_in[15];
    P.out = (float*)d_out; P.ws = (unsigned char*)d_ws;
    unsigned char* ws = (unsigned char*)d_ws;
    (void)hipMemsetAsync(ws + WS_CTL, 0, CTL_ZERO_BYTES, stream);
#define MEGA(lo_, hi_) do { a.ph_lo = (lo_); a.ph_hi = (hi_); a.li = 0; hipLaunchKernelGGL(mega, dim3(grid), dim3(NWAVES * 64), LDS_BYTES, stream, a); } while (0)
#define MEGAB(lo_, hi_, li_) do { a.ph_lo = (lo_); a.ph_hi = (hi_); a.li = (li_); hipLaunchKernelGGL(mega, dim3(grid), dim3(NWAVES * 64), LDS_BYTES, stream, a); } while (0)
#if ONE_LAUNCH
    MEGA(0, PH_COUNT);
#elif HYBRID_BAR
    {
        bf16* OGOM = (bf16*)(ws + WS_OGOM); bf16* PROJ = (bf16*)(ws + WS_PROJ); float* GLR = (float*)(ws + WS_GLR); float* KMEAN = (float*)(ws + WS_KMEAN);
        float* DBG_G = (float*)(ws + WS_DBG_G); float* DBG_O = (float*)(ws + WS_DBG_O);
        const int resume = EN_MOBA ? PL_MIX : PL_UP;
        for (int l = 0; l < DEPTH; ++l) {
            const int pb = PH_L0 + l * PH_PER_LAYER;
            MEGAB(l == 0 ? 0 : PH_L0 + (l - 1) * PH_PER_LAYER + resume, pb + PL_PRE + 1, l);
            if (!EN_GLA) {
                k_gla_g<<<MT, 512, 0, stream>>>(GLR, P.gate_w2 + (size_t)l * GRANK * GKW, P.gate_b + (size_t)l * GKW, DBG_G);
                k_gla_rec<<<NB * GH, 256, 0, stream>>>(PROJ, DBG_G, DBG_O);
                k_gla_norm<<<MT * GH / 4, 256, 0, stream>>>(DBG_O, PROJ, P.gla_norm_g + (size_t)l * GDV, OGOM); }
            if (!EN_MOBA) k_moba_naive<<<NB * MH * SEQ, 128, 0, stream>>>(PROJ, KMEAN, OGOM + (size_t)MT * GVW);
        }
        MEGAB(PH_L0 + (DEPTH - 1) * PH_PER_LAYER + resume, PH_COUNT, DEPTH);
    }
#else
    bf16* ABUF = (bf16*)(ws + WS_ABUF); bf16* OGOM = (bf16*)(ws + WS_OGOM); bf16* PROJ = (bf16*)(ws + WS_PROJ); bf16* HID = PROJ;
    float* GLR = (float*)(ws + WS_GLR); float* KMEAN = (float*)(ws + WS_KMEAN);
    float* DBG_G = (float*)(ws + WS_DBG_G); float* DBG_O = (float*)(ws + WS_DBG_O);
    const float* MODV = (const float*)(ws + WS_MODV);
    float* xs = (float*)d_out;
    MEGA(PH_P0A, PH_P0A + 1); MEGA(PH_P0B, PH_P0B + 1); MEGA(PH_P0C, PH_P0C + 1);
    for (int l = 0; l < DEPTH; ++l) {
        const int pb = PH_L0 + l * PH_PER_LAYER;
        const bf16* Win = (const bf16*)(ws + WS_WT + (size_t)l * WT_LAYER + WT_IN); const bf16* Wglr = (const bf16*)(ws + WS_WT + (size_t)l * WT_LAYER + WT_GLR);
        const bf16* Wupg = (const bf16*)(ws + WS_WT + (size_t)l * WT_LAYER + WT_UPG); const bf16* Wupm = (const bf16*)(ws + WS_WT + (size_t)l * WT_LAYER + WT_UPM);
        const bf16* Wout = (const bf16*)(ws + WS_WT + (size_t)l * WT_LAYER + WT_OUT); const bf16* Wffi = (const bf16*)(ws + WS_WT + (size_t)l * WT_LAYER + WT_FFI); const bf16* Wffo = (const bf16*)(ws + WS_WT + (size_t)l * WT_LAYER + WT_FFO);
        const float* shwin = (const float*)(ws + WS_SHWIN) + (size_t)l * 8 * NIN; const float* shwglr = (const float*)(ws + WS_SHWGLR) + (size_t)l * 8 * GRANK; const float* shwffi = (const float*)(ws + WS_SHWFFI) + (size_t)l * 8 * NFFI;
        const float* mv = MODV + (size_t)l * 8 * 6 * DM; const float* mvn = MODV + (size_t)(l + 1 < DEPTH ? l + 1 : l) * 8 * 6 * DM;
        float* SSQB = (float*)(ws + WS_SSQ) + (size_t)l * MT; float* SSQN = (float*)(ws + WS_SSQ) + (size_t)(2 + l) * MT;
        const float* ssq_in = l == 0 ? (const float*)(ws + WS_SSQ0) : (const float*)(ws + WS_SSQ) + (size_t)(2 + l - 1) * MT;
        if (FAST_IN) MEGA(pb + PL_IN, pb + PL_IN + 1);
        else k_naive_gemm<4, NEpiIn><<<dim3(NIN / 64, MT / 64), 256, 0, stream>>>(ABUF, DM, Win, DM, DM, NEpiIn{ssq_in, shwin, PROJ});
        if (FAST_PRE) MEGA(pb + PL_PRE, pb + PL_PRE + 1);
        else { k_naive_gemm<1, NEpiGlr><<<dim3(1, MT / 64), 256, 0, stream>>>(ABUF, DM, Wglr, DM, DM, NEpiGlr{ssq_in, shwglr, GLR});
               k_kmean<<<NB * MH * MNB, 128, 0, stream>>>(PROJ, KMEAN); }
        if (FAST_MIX) MEGA(pb + PL_MIX, pb + PL_MIX + 1);
        else { k_gla_g<<<MT, 512, 0, stream>>>(GLR, P.gate_w2 + (size_t)l * GRANK * GKW, P.gate_b + (size_t)l * GKW, DBG_G);
               k_gla_rec<<<NB * GH, 256, 0, stream>>>(PROJ, DBG_G, DBG_O);
               k_gla_norm<<<MT * GH / 4, 256, 0, stream>>>(DBG_O, PROJ, P.gla_norm_g + (size_t)l * GDV, OGOM);
               k_moba_naive<<<NB * MH * SEQ, 128, 0, stream>>>(PROJ, KMEAN, OGOM + (size_t)MT * GVW); }
        if (FAST_UP) MEGA(pb + PL_UP, pb + PL_UP + 1);
        else { k_naive_gemm<4, NEpiUp1><<<dim3(DM / 64, MT / 64), 256, 0, stream>>>(OGOM, GVW, Wupg, GVW, GVW, NEpiUp1{PROJ, ABUF});
               k_naive_gemm<4, NEpiUp2><<<dim3(DM / 64, MT / 64), 256, 0, stream>>>(OGOM + (size_t)MT * GVW, MW, Wupm, MW, MW, NEpiUp2{PROJ, ABUF}); }
        if (FAST_OUT) MEGA(pb + PL_OUT, pb + PL_OUT + 1);
        else { k_naive_gemm<4, NEpiRes><<<dim3(DM / 64, MT / 64), 256, 0, stream>>>(ABUF, DM, Wout, DM, DM, NEpiRes{l == 0 ? P.x : xs, xs, mv + 2 * DM, mv + 4 * DM, OGOM});
               k_rowssq<<<MT / 4, 256, 0, stream>>>(xs, SSQB); }
        if (FAST_FFI) MEGA(pb + PL_FFI, pb + PL_FFI + 1);
        else k_naive_ffi<<<dim3(DFF / 16, MT / 64), 256, 0, stream>>>(OGOM, Wffi, SSQB, shwffi, HID);
        if (FAST_FFO) MEGA(pb + PL_FFO, pb + PL_FFO + 1);
        else { k_naive_gemm<4, NEpiRes><<<dim3(DM / 64, MT / 64), 256, 0, stream>>>(HID, DFF, Wffo, DFF, DFF, NEpiRes{xs, xs, mv + 5 * DM, mvn + 1 * DM, l + 1 < DEPTH ? ABUF : nullptr});
               k_rowssq<<<MT / 4, 256, 0, stream>>>(xs, SSQN); }
    }
    if (FAST_FINAL) MEGA(PH_FINAL, PH_FINAL + 1);
    else k_final<<<MT / 4, 256, 0, stream>>>(xs, P.final_g);
#endif
#undef MEGA
#undef MEGAB
}
```

```cpp
#include <hip/hip_runtime.h>
#include <cstdio>
#include <cstdint>

constexpr int NB = 8, SEQ = 2048, DM = 2048, MT = NB * SEQ, DEPTH = 2;
constexpr int GH = 4, GDK = 128, GDV = 256, GKW = 512, GVW = 1024, GRANK = 16, GCH = 64;
constexpr int MH = 8, MHD = 128, MW = 1024, MBLK = 256, MNB = SEQ / MBLK, MTOPK = 3;
constexpr int DFF = 5632, NFFI = 2 * DFF;
constexpr int NINSRC = 10256, NIN = 10240;
constexpr float EPS = 1e-6f;
constexpr int GQ_OFF = 0, GK_OFF = 512, GV_OFF = 1024, GR_OFF = 2048, MQ_OFF = 3072, MK_OFF = 4096, MV_OFF = 5120, GT_OFF = 6144;
constexpr int GLR_SRC = 3072;
constexpr size_t PJ_GQ = 0, PJ_GK = (size_t)MT * 512, PJ_GV = (size_t)MT * 1024, PJ_GR = (size_t)MT * 2048, PJ_MQ = (size_t)MT * 3072, PJ_MK = (size_t)MT * 4096, PJ_MV = (size_t)MT * 5120, PJ_GT = (size_t)MT * 6144;

constexpr size_t MiB = 1u << 20;
constexpr size_t WS_CTL = 0, CTL_ZERO_BYTES = 2 * MiB;
constexpr size_t WS_SSQ = 1 * MiB;
constexpr size_t WS_MODP = 2 * MiB;
constexpr size_t WS_MODV = 8 * MiB;
constexpr size_t WS_SHWIN = 9 * MiB;
constexpr size_t WS_SHWFFI = 10 * MiB;
constexpr size_t WS_SHWGLR = 11 * MiB;
constexpr size_t WS_GLR = 12 * MiB;
constexpr size_t WS_KMEAN = 13 * MiB;
constexpr size_t WS_SSQ0 = 14 * MiB;
constexpr size_t WS_WT = 16 * MiB, WT_LAYER = 123 * MiB;
constexpr size_t WT_IN = 0, WT_GLR = 40 * MiB, WT_UPG = 41 * MiB, WT_UPM = 45 * MiB, WT_OUT = 49 * MiB, WT_FFI = 57 * MiB, WT_FFO = 101 * MiB;
constexpr size_t WS_ABUF = 262 * MiB;
constexpr size_t WS_OGOM = 326 * MiB;
constexpr size_t WS_PROJ = 390 * MiB;
constexpr size_t WS_END = 710 * MiB;
constexpr size_t WS_DBG_G = 710 * MiB;
constexpr size_t WS_DBG_O = 742 * MiB;
constexpr size_t WS_DBG_END = 806 * MiB;
constexpr size_t WS_NEED = 752 * MiB;

typedef unsigned short bf16;
typedef short bf16x8 __attribute__((ext_vector_type(8)));
typedef float f32x4 __attribute__((ext_vector_type(4)));
typedef unsigned u32x4 __attribute__((ext_vector_type(4)));
typedef unsigned u32x2 __attribute__((ext_vector_type(2)));

struct Params {
    const float* x; const float* c; const float* ada_w; const float* ada_b; const float* norm1_g; const float* w_in;
    const float* gate_w2; const float* gate_b; const float* gla_norm_g; const float* w_up_gla; const float* w_up_moba;
    const float* w_out; const float* norm2_g; const float* w_ffn_in; const float* w_ffn_out; const float* final_g;
    float* out; unsigned char* ws;
};

__device__ __forceinline__ unsigned f2bf(float f) { unsigned u = __builtin_bit_cast(unsigned, f); return (u + 0x7fffu + ((u >> 16) & 1u)) >> 16; }
__device__ __forceinline__ unsigned pk2(float lo, float hi) { return f2bf(lo) | (f2bf(hi) << 16); }
__device__ __forceinline__ float bf2f(unsigned short b) { return __builtin_bit_cast(float, ((unsigned)b) << 16); }
__device__ __forceinline__ float wave_sum(float v) {
#pragma unroll
    for (int o = 1; o < 64; o <<= 1) v += __shfl_xor(v, o);
    return v;
}
__device__ __forceinline__ float sigmoidf_(float v) { return 1.0f / (1.0f + __expf(-v)); }
__device__ __forceinline__ float siluf_(float v) { return v / (1.0f + __expf(-v)); }
__device__ __forceinline__ float logsigmoidf_(float v) { return fminf(v, 0.f) - log1pf(__expf(-fabsf(v))); }

__device__ __forceinline__ const bf16* wt_ptr(const Params& P, int l, size_t off) { return (const bf16*)(P.ws + WS_WT + (size_t)l * WT_LAYER + off); }
__device__ __forceinline__ int in_src_col(int n) { return n < 3072 ? n : n + 16; }
__device__ __forceinline__ int ffi_src_col(int r) { const int pn = r >> 8, c = r & 255; return c < 128 ? pn * 128 + c : DFF + pn * 128 + (c - 128); }

__device__ __forceinline__ void ada_item(const Params& P, int item, int lane, float* scr) {
    const int cg = item % 96, kc = (item / 96) % 8, l = item / 768;
    const int k0 = kc * 256;
    for (int i = 0; i < 32; ++i) { const int idx = lane + 64 * i, b = idx >> 8, kk = idx & 255; scr[idx] = siluf_(P.c[b * DM + k0 + kk]); }
    __builtin_amdgcn_s_waitcnt(0);
    const float* W = P.ada_w + (size_t)l * DM * (6 * DM) + (size_t)k0 * (6 * DM) + cg * 128 + 2 * lane;
    float a0[8], a1[8];
#pragma unroll
    for (int b = 0; b < 8; ++b) { a0[b] = 0.f; a1[b] = 0.f; }
#pragma unroll 8
    for (int kk = 0; kk < 256; ++kk) {
        const float2 w = *(const float2*)(W + (size_t)kk * (6 * DM));
#pragma unroll
        for (int b = 0; b < 8; ++b) { const float cv = scr[b * 256 + kk]; a0[b] += cv * w.x; a1[b] += cv * w.y; }
    }
    float* MP = (float*)(P.ws + WS_MODP) + ((size_t)(kc * 2 + l) * 8) * (6 * DM) + cg * 128 + 2 * lane;
#pragma unroll
    for (int b = 0; b < 8; ++b) *(float2*)(MP + (size_t)b * (6 * DM)) = make_float2(a0[b], a1[b]);
    __builtin_amdgcn_s_waitcnt(0);
}
__device__ __forceinline__ void transpose_item(const float* W, int Nsrc, int src_col0, int K, int k0, bf16* WT, int dst_row0, float* scr, int lane) {
    f32x4 v[8];
    const float* src = W + (size_t)(k0 + (lane >> 3)) * Nsrc + src_col0 + 4 * (lane & 7);
#pragma unroll
    for (int i = 0; i < 8; ++i) v[i] = *(const f32x4*)(src + (size_t)(8 * i) * Nsrc);
#pragma unroll
    for (int i = 0; i < 8; ++i) { float* d = scr + (8 * i + (lane >> 3)) * 33 + 4 * (lane & 7); d[0] = v[i][0]; d[1] = v[i][1]; d[2] = v[i][2]; d[3] = v[i][3]; }
    __builtin_amdgcn_s_waitcnt(0);
    const int c = lane & 7;
#pragma unroll
    for (int j = 0; j < 4; ++j) { const int n = (lane >> 3) + 8 * j; const float* s = scr + (8 * c) * 33 + n;
        u32x4 o; o.x = pk2(s[0 * 33], s[1 * 33]); o.y = pk2(s[2 * 33], s[3 * 33]); o.z = pk2(s[4 * 33], s[5 * 33]); o.w = pk2(s[6 * 33], s[7 * 33]);
        *(u32x4*)(WT + (size_t)(dst_row0 + n) * K + k0 + 8 * c) = o; }
    __builtin_amdgcn_s_waitcnt(0);
}
constexpr int TI_IN = (DM / 64) * (NIN / 32), TI_UP = (GVW / 64) * (DM / 32), TI_OUT = (DM / 64) * (DM / 32), TI_FFI = (DM / 64) * (NFFI / 32), TI_FFO = (DFF / 64) * (DM / 32), TI_GLR = DM / 64;
constexpr int TI_LAYER = TI_IN + 2 * TI_UP + TI_OUT + TI_FFI + TI_FFO + TI_GLR;
__device__ __forceinline__ void wconv_item(const Params& P, int item, int lane, float* scr) {
    const int l = item / TI_LAYER; int r = item % TI_LAYER;
    unsigned char* wl = P.ws + WS_WT + (size_t)l * WT_LAYER;
    if (r < TI_IN) { const int nb = r % (NIN / 32), kb = r / (NIN / 32);
        transpose_item(P.w_in + (size_t)l * DM * NINSRC, NINSRC, in_src_col(nb * 32), DM, kb * 64, (bf16*)(wl + WT_IN), nb * 32, scr, lane); return; } r -= TI_IN;
    if (r < TI_UP) { const int nb = r % (DM / 32), kb = r / (DM / 32);
        transpose_item(P.w_up_gla + (size_t)l * GVW * DM, DM, nb * 32, GVW, kb * 64, (bf16*)(wl + WT_UPG), nb * 32, scr, lane); return; } r -= TI_UP;
    if (r < TI_UP) { const int nb = r % (DM / 32), kb = r / (DM / 32);
        transpose_item(P.w_up_moba + (size_t)l * MW * DM, DM, nb * 32, MW, kb * 64, (bf16*)(wl + WT_UPM), nb * 32, scr, lane); return; } r -= TI_UP;
    if (r < TI_OUT) { const int nb = r % (DM / 32), kb = r / (DM / 32);
        transpose_item(P.w_out + (size_t)l * DM * DM, DM, nb * 32, DM, kb * 64, (bf16*)(wl + WT_OUT), nb * 32, scr, lane); return; } r -= TI_OUT;
    if (r < TI_FFI) { const int nb = r % (NFFI / 32), kb = r / (NFFI / 32);
        transpose_item(P.w_ffn_in + (size_t)l * DM * NFFI, NFFI, ffi_src_col(nb * 32), DM, kb * 64, (bf16*)(wl + WT_FFI), nb * 32, scr, lane); return; } r -= TI_FFI;
    if (r < TI_FFO) { const int nb = r % (DM / 32), kb = r / (DM / 32);
        transpose_item(P.w_ffn_out + (size_t)l * DFF * DM, DM, nb * 32, DFF, kb * 64, (bf16*)(wl + WT_FFO), nb * 32, scr, lane); return; } r -= TI_FFO;
    { const int k0 = r * 64, j = lane & 15, kq = lane >> 4; bf16* G = (bf16*)(wl + WT_GLR); const float* W = P.w_in + (size_t)l * DM * NINSRC;
        for (int kk = 0; kk < 16; ++kk) { const int k = k0 + kq * 16 + kk; G[(size_t)j * DM + k] = (bf16)f2bf(W[(size_t)k * NINSRC + GLR_SRC + j]); } }
}
__device__ __forceinline__ void phase_p0a(const Params& P, int gw, int ngw, int lane, float* scr) {
    constexpr int NADA = 2 * 8 * 96;
    for (int it = gw; it < NADA; it += ngw) ada_item(P, it, lane, scr);
    for (int it = gw; it < DEPTH * TI_LAYER; it += ngw) wconv_item(P, it, lane, scr);
}
__device__ __forceinline__ void phase_p0b(const Params& P, int gtid, int ngt) {
    const float* MP = (const float*)(P.ws + WS_MODP); float* MV = (float*)(P.ws + WS_MODV);
    for (int i = gtid; i < 2 * 8 * DM; i += ngt) {
        const int j = i % DM, b = (i / DM) % 8, l = i / (8 * DM);
        float m[6];
#pragma unroll
        for (int s = 0; s < 6; ++s) { float a = P.ada_b[l * 6 * DM + s * DM + j];
            for (int kc = 0; kc < 8; ++kc) a += MP[((size_t)(kc * 2 + l) * 8 + b) * (6 * DM) + s * DM + j]; m[s] = a; }
        float* o = MV + ((size_t)(l * 8 + b) * 6) * DM + j;
        o[0 * DM] = m[0]; o[1 * DM] = P.norm1_g[l * DM + j] * (1.f + m[1]); o[2 * DM] = m[2];
        o[3 * DM] = m[3]; o[4 * DM] = P.norm2_g[l * DM + j] * (1.f + m[4]); o[5 * DM] = m[5];
    }
}
__device__ __forceinline__ void a1prep_row(const Params& P, int m0, int lane) {
    f32x4 v[2][8];
#pragma unroll
    for (int rr = 0; rr < 2; ++rr) { const f32x4* xr = (const f32x4*)(P.x + (size_t)(m0 + rr * (MT / 2)) * DM);
#pragma unroll
        for (int j = 0; j < 8; ++j) v[rr][j] = xr[lane + 64 * j]; }
#pragma unroll
    for (int rr = 0; rr < 2; ++rr) { const int m = m0 + rr * (MT / 2), b = m / SEQ; const float* gm = (const float*)(P.ws + WS_MODV) + ((size_t)(0 * 8 + b) * 6 + 1) * DM;
        bf16* A = (bf16*)(P.ws + WS_ABUF) + (size_t)m * DM; float s = 0.f;
#pragma unroll
        for (int j = 0; j < 8; ++j) { const f32x4 x4 = v[rr][j]; const f32x4 g = *(const f32x4*)(gm + 4 * (lane + 64 * j));
            s += (x4.x * x4.x + x4.y * x4.y) + (x4.z * x4.z + x4.w * x4.w);
            u32x2 w; w.x = pk2(x4.x * g.x, x4.y * g.y); w.y = pk2(x4.z * g.z, x4.w * g.w); *(u32x2*)(A + 4 * (lane + 64 * j)) = w; }
        s = wave_sum(s);
        if (lane == 0) ((float*)(P.ws + WS_SSQ0))[m] = s; }
}
constexpr int SHW_T_IN = (NIN + GRANK) / 16, SHW_T_FFI = NFFI / 16, SHW_TILES = DEPTH * (SHW_T_IN + SHW_T_FFI);
__device__ __forceinline__ void shw_all(const Params& P, int gw, int ngw, int lane) {
    const float* MV = (const float*)(P.ws + WS_MODV); const int r16 = lane & 15, q = lane >> 4;
    for (int item = gw; item < SHW_TILES; item += ngw) {
        const int l = item / (SHW_T_IN + SHW_T_FFI), rr = item % (SHW_T_IN + SHW_T_FFI), which = rr >= SHW_T_IN ? 1 : 0, n0 = (which ? rr - SHW_T_IN : rr) * 16;
        const bf16* rows = which ? wt_ptr(P, l, WT_FFI) + (size_t)n0 * DM : (n0 < NIN ? wt_ptr(P, l, WT_IN) + (size_t)n0 * DM : wt_ptr(P, l, WT_GLR));
        const bf16* bp = rows + (size_t)r16 * DM + 8 * q; const float* ap = MV + ((size_t)(l * 8 + (r16 & 7)) * 6 + (which ? 3 : 0)) * DM + 8 * q;
        f32x4 acc = {0.f, 0.f, 0.f, 0.f};
#pragma unroll 1
        for (int kb = 0; kb < DM; kb += 256) { bf16x8 bw[8]; f32x4 a0[8], a1[8];
#pragma unroll
            for (int j = 0; j < 8; ++j) { bw[j] = *(const bf16x8*)(bp + kb + 32 * j); a0[j] = *(const f32x4*)(ap + kb + 32 * j); a1[j] = *(const f32x4*)(ap + kb + 32 * j + 4); }
#pragma unroll
            for (int j = 0; j < 8; ++j) { u32x4 aw; aw.x = pk2(a0[j].x, a0[j].y); aw.y = pk2(a0[j].z, a0[j].w); aw.z = pk2(a1[j].x, a1[j].y); aw.w = pk2(a1[j].z, a1[j].w);
                acc = __builtin_amdgcn_mfma_f32_16x16x32_bf16(__builtin_bit_cast(bf16x8, aw), bw[j], acc, 0, 0, 0); } }
        if (q < 2) {
#pragma unroll
            for (int j = 0; j < 4; ++j) { const int b = 4 * q + j, n = n0 + r16;
                if (which) ((float*)(P.ws + WS_SHWFFI))[((size_t)l * 8 + b) * NFFI + n] = acc[j];
                else if (n0 < NIN) ((float*)(P.ws + WS_SHWIN))[((size_t)l * 8 + b) * NIN + n] = acc[j];
                else ((float*)(P.ws + WS_SHWGLR))[((size_t)l * 8 + b) * GRANK + (n - NIN)] = acc[j]; } }
    }
}

namespace pg8 {
#define PG8_LAS __attribute__((address_space(3)))
typedef unsigned short bf16_t;
typedef short bf16x8 __attribute__((ext_vector_type(8)));
typedef float f32x4 __attribute__((ext_vector_type(4)));
typedef unsigned u32x4 __attribute__((ext_vector_type(4)));
constexpr int BM = 256, BK = 64, HALF = 128, HTB = HALF * BK * 2  , STAGE_BYTES = 8 * HTB, NXCD = 8, WGM = 8;

__host__ __device__ __forceinline__ int lds_byte(int r, int c) { const int st = (r >> 4) * 2 + (c >> 5), rr = r & 15, cc = c & 31, ob = rr * 64 + cc * 2; return st * 1024 + (ob ^ (((ob >> 9) & 1) << 5)); }
__host__ __device__ __forceinline__ void stage_rc(int b, int& R, int& C) { const int st = b / 1024, sb = b % 1024, swz = sb ^ (((sb >> 9) & 1) << 5); R = (st >> 1) * 16 + swz / 64; C = (st & 1) * 32 + (swz % 64) / 2; }
__host__ __device__ __forceinline__ int perm32(int rho) { const int n = rho >> 4, i = rho & 15; return 8 * (i >> 2) + 4 * n + (i & 3); }

struct Unit { int pm, pn; };
struct Gemm { const bf16_t* A; const bf16_t* Bt; int M, N, K; };

struct StaticOrder {
    int nM, nN, nwg, G, c;
    __host__ __device__ void init(int M, int N, int G_, int c_) { nM = M / BM; nN = N / BM; nwg = nM * nN; G = G_; c = c_; }
    __host__ __device__ bool next(int i, Unit& u) const {
        const long L = (long)i * G + c; if (L >= nwg) return false;
        int wgid = (int)L; { const int q = nwg / NXCD, r = nwg % NXCD, xcd = wgid % NXCD, off = wgid / NXCD; wgid = (xcd < r ? xcd * (q + 1) : r * (q + 1) + (xcd - r) * q) + off; }
        const int nig = WGM * nN, gid = wgid / nig, fm = gid * WGM, gsz = (nM - fm) < WGM ? (nM - fm) : WGM;
        u.pm = fm + ((wgid % nig) % gsz); u.pn = (wgid % nig) / gsz; return true;
    }
    __device__ __forceinline__ void a_ready(const Unit&) const {}
    __device__ __forceinline__ void done(const Unit&) const {}
};
__device__ __forceinline__ unsigned cvt_pk_bf16(float lo, float hi) { unsigned r; asm volatile("v_cvt_pk_bf16_f32 %0, %1, %2" : "=v"(r) : "v"(lo), "v"(hi)); return r; }
typedef float f32x2 __attribute__((ext_vector_type(2)));
__device__ __forceinline__ float fsig(float v) { return __builtin_amdgcn_rcpf(1.0f + __builtin_amdgcn_exp2f(-1.4426950408889634f * v)); }
__device__ __forceinline__ float bflo(unsigned w) { return __builtin_bit_cast(float, w << 16); }
__device__ __forceinline__ float bfhi(unsigned w) { return __builtin_bit_cast(float, w & 0xffff0000u); }
struct EpiIn {
    static constexpr bool PERM = true, AFTER_DRAIN = false;
    const float* ssq; const float* shw; bf16_t* proj;
    __device__ __forceinline__ void operator()(const f32x4 (&acc)[2][2][4][2], const Unit& u, int wr, int wc, int fr, int fq) const {
        const int row0 = u.pm * BM + wr * 64 + fr, col0 = u.pn * BM + wc * 32 + 8 * fq, b = u.pm >> 3, t0 = (u.pm & 7) * BM + wr * 64 + fr;
        const int mode = u.pn < 2 ? 1 : ((u.pn >= 8 && u.pn < 12) ? 2 : (u.pn >= 24 ? 3 : 0));
        size_t off[2]; int stride;
        if (u.pn >= 24) { stride = 4096; off[0] = PJ_GT + (size_t)b * SEQ * 4096 + (u.pn * BM - GT_OFF) + wc * 32 + 8 * fq; off[1] = off[0] + HALF; }
        else { const int seg = u.pn < 2 ? 0 : u.pn < 4 ? 1 : u.pn < 8 ? 2 : u.pn < 12 ? 3 : u.pn < 16 ? 4 : u.pn < 20 ? 5 : 6;
            const size_t base = seg == 0 ? PJ_GQ : seg == 1 ? PJ_GK : seg == 2 ? PJ_GV : seg == 3 ? PJ_GR : seg == 4 ? PJ_MQ : seg == 5 ? PJ_MK : PJ_MV;
            const int c0 = seg == 0 ? GQ_OFF : seg == 1 ? GK_OFF : seg == 2 ? GV_OFF : seg == 3 ? GR_OFF : seg == 4 ? MQ_OFF : seg == 5 ? MK_OFF : MV_OFF;
            const bool wide = (seg == 2 || seg == 3); const int nh = seg >= 4 ? MH : GH; stride = wide ? 256 : 128;
#pragma unroll
            for (int bj = 0; bj < 2; ++bj) { const int cs = u.pn * BM - c0 + bj * HALF, head = wide ? (cs >> 8) : (cs >> 7), d = (wide ? (cs & 255) : 0) + wc * 32 + 8 * fq;
                off[bj] = base + ((size_t)(b * nh + head) * SEQ) * stride + d; } }
        f32x4 bv[2][2];
#pragma unroll
        for (int bj = 0; bj < 2; ++bj)
#pragma unroll
            for (int n = 0; n < 2; ++n) bv[bj][n] = *(const f32x4*)(shw + (size_t)b * NIN + col0 + bj * HALF + 4 * n);
#pragma unroll
        for (int ai = 0; ai < 2; ++ai)
#pragma unroll
            for (int m = 0; m < 4; ++m) { const int r = row0 + ai * HALF + m * 16, t = t0 + ai * HALF + m * 16; const float rstd = rsqrtf(ssq[r] * (1.0f / DM) + EPS);
#pragma unroll
                for (int bj = 0; bj < 2; ++bj) { f32x4 v0 = acc[ai][bj][m][0] * rstd + bv[bj][0], v1 = acc[ai][bj][m][1] * rstd + bv[bj][1];
                    if (mode == 1) { v0 = v0 * 0.08838834764831845f; v1 = v1 * 0.08838834764831845f; }
                    else if (mode == 2) {
#pragma unroll
                        for (int j = 0; j < 4; ++j) { v0[j] = v0[j] * fsig(v0[j]); v1[j] = v1[j] * fsig(v1[j]); } }
                    else if (mode == 3) {
#pragma unroll
                        for (int j = 0; j < 4; ++j) { v0[j] = fsig(v0[j]); v1[j] = fsig(v1[j]); } }
                    u32x4 w; w.x = cvt_pk_bf16(v0[0], v0[1]); w.y = cvt_pk_bf16(v0[2], v0[3]); w.z = cvt_pk_bf16(v1[0], v1[1]); w.w = cvt_pk_bf16(v1[2], v1[3]);
                    *(u32x4*)(proj + off[bj] + (size_t)t * stride) = w; } }
    }
};
struct EpiFfi {
    static constexpr bool PERM = true, AFTER_DRAIN = false;
    const float* ssq; const float* shw; bf16_t* hid;
    __device__ __forceinline__ void operator()(const f32x4 (&acc)[2][2][4][2], const Unit& u, int wr, int wc, int fr, int fq) const {
        const int row0 = u.pm * BM + wr * 64 + fr, bcol0 = u.pn * BM + wc * 32 + 8 * fq, hcol0 = u.pn * HALF + wc * 32 + 8 * fq, b = u.pm >> 3;
        f32x4 bv[2][2];
#pragma unroll
        for (int bj = 0; bj < 2; ++bj)
#pragma unroll
            for (int n = 0; n < 2; ++n) bv[bj][n] = *(const f32x4*)(shw + (size_t)b * NFFI + bcol0 + bj * HALF + 4 * n);
#pragma unroll
        for (int ai = 0; ai < 2; ++ai)
#pragma unroll
            for (int m = 0; m < 4; ++m) { const int r = row0 + ai * HALF + m * 16; const float rstd = rsqrtf(ssq[r] * (1.0f / DM) + EPS);
                f32x4 a0 = acc[ai][0][m][0] * rstd + bv[0][0], a1 = acc[ai][0][m][1] * rstd + bv[0][1];
                const f32x4 u0 = acc[ai][1][m][0] * rstd + bv[1][0], u1 = acc[ai][1][m][1] * rstd + bv[1][1];
#pragma unroll
                for (int j = 0; j < 4; ++j) { a0[j] = a0[j] * fsig(a0[j]) * u0[j]; a1[j] = a1[j] * fsig(a1[j]) * u1[j]; }
                u32x4 w; w.x = cvt_pk_bf16(a0[0], a0[1]); w.y = cvt_pk_bf16(a0[2], a0[3]); w.z = cvt_pk_bf16(a1[0], a1[1]); w.w = cvt_pk_bf16(a1[2], a1[3]);
                *(u32x4*)(hid + (size_t)r * DFF + hcol0) = w; }
    }
};
template <bool SECOND> struct EpiUp {
    static constexpr bool PERM = true, AFTER_DRAIN = false;
    const bf16_t* proj; int goff; bf16_t* mg;
    __device__ __forceinline__ void operator()(const f32x4 (&acc)[2][2][4][2], const Unit& u, int wr, int wc, int fr, int fq) const {
        const int row0 = u.pm * BM + wr * 64 + fr, col0 = u.pn * BM + wc * 32 + 8 * fq;
#pragma unroll
        for (int ai = 0; ai < 2; ++ai)
#pragma unroll
            for (int m = 0; m < 4; ++m) { const int r = row0 + ai * HALF + m * 16;
#pragma unroll
                for (int bj = 0; bj < 2; ++bj) { const u32x4 g = *(const u32x4*)(proj + PJ_GT + (size_t)r * 4096 + (goff - GT_OFF) + col0 + bj * HALF);
                    bf16_t* op = mg + (size_t)r * DM + col0 + bj * HALF;
                    f32x4 v0 = acc[ai][bj][m][0], v1 = acc[ai][bj][m][1];
                    v0[0] *= bflo(g.x); v0[1] *= bfhi(g.x); v0[2] *= bflo(g.y); v0[3] *= bfhi(g.y); v1[0] *= bflo(g.z); v1[1] *= bfhi(g.z); v1[2] *= bflo(g.w); v1[3] *= bfhi(g.w);
                    if (SECOND) { const u32x4 t = *(const u32x4*)op;
                        v0[0] += bflo(t.x); v0[1] += bfhi(t.x); v0[2] += bflo(t.y); v0[3] += bfhi(t.y); v1[0] += bflo(t.z); v1[1] += bfhi(t.z); v1[2] += bflo(t.w); v1[3] += bfhi(t.w); }
                    u32x4 w; w.x = cvt_pk_bf16(v0[0], v0[1]); w.y = cvt_pk_bf16(v0[2], v0[3]); w.z = cvt_pk_bf16(v1[0], v1[1]); w.w = cvt_pk_bf16(v1[2], v1[3]);
                    *(u32x4*)op = w; }
                asm volatile("" ::: "memory"); }
    }
};
struct EpiRes {
    static constexpr bool PERM = false, AFTER_DRAIN = false;
    const float* xin; float* xout; const float* gate; const float* gm; bf16_t* aout; float* ssq;
    __device__ __forceinline__ void operator()(const f32x4 (&acc)[2][2][4][2], const Unit& u, int wr, int wc, int fr, int fq) const {
        const int row0 = u.pm * BM + wr * 64 + fr, col0 = u.pn * BM + wc * 32 + 4 * fq, b = u.pm >> 3;
        f32x4 gv[2][2], mv[2][2];
#pragma unroll
        for (int bj = 0; bj < 2; ++bj)
#pragma unroll
            for (int n = 0; n < 2; ++n) { gv[bj][n] = *(const f32x4*)(gate + (size_t)b * 6 * DM + col0 + bj * HALF + n * 16);
                mv[bj][n] = aout ? *(const f32x4*)(gm + (size_t)b * 6 * DM + col0 + bj * HALF + n * 16) : (f32x4){0.f, 0.f, 0.f, 0.f}; }
#pragma unroll
        for (int ai = 0; ai < 2; ++ai)
#pragma unroll
            for (int m = 0; m < 4; ++m) { const int r = row0 + ai * HALF + m * 16; const size_t off = (size_t)r * DM + col0; float s = 0.f;
#pragma unroll
                for (int bj = 0; bj < 2; ++bj)
#pragma unroll
                    for (int n = 0; n < 2; ++n) { const f32x4 xv = *(const f32x4*)(xin + off + bj * HALF + n * 16); const f32x4 o = xv + gv[bj][n] * acc[ai][bj][m][n];
                        *(f32x4*)(xout + off + bj * HALF + n * 16) = o; s += (o[0] * o[0] + o[1] * o[1]) + (o[2] * o[2] + o[3] * o[3]);
                        if (aout) { const f32x4 a = o * mv[bj][n]; u32x2 w; w.x = cvt_pk_bf16(a[0], a[1]); w.y = cvt_pk_bf16(a[2], a[3]); *(u32x2*)(aout + off + bj * HALF + n * 16) = w; } }
                if (ssq) { s += __shfl_xor(s, 16); s += __shfl_xor(s, 32); if (fq == 0) __hip_atomic_fetch_add(ssq + r, s, __ATOMIC_RELAXED, __HIP_MEMORY_SCOPE_AGENT); }
                asm volatile("" ::: "memory"); }
    }
};
template <class Epi, class Sched, bool ALIGN_EPI = false, bool SP2 = false>
__device__ __forceinline__ void gemm_phase(PG8_LAS unsigned char* lds, const Gemm g, const Sched& S, const Epi& E) {
    int tid_ = threadIdx.x; asm volatile("" : "+v"(tid_));
    const int tid = tid_, wid = __builtin_amdgcn_readfirstlane(tid >> 6), lane = tid & 63, wr = wid >> 2, wc = wid & 3, fr = lane & 15, fq = lane >> 4;
    const int K = g.K, nt = K / BK;
    unsigned voffA[2], voffB[2];
#pragma unroll
    for (int i = 0; i < 2; ++i) { int R, C; stage_rc(tid * 16 + i * 8192, R, C); const int Rb = Epi::PERM ? ((R & ~31) + perm32(R & 31)) : R;
        voffA[i] = (unsigned)(R * K + C) * 2u; voffB[i] = (unsigned)(Rb * K + C) * 2u; }
    const size_t kstep = (size_t)(BK * 2);
    const size_t hstep = (size_t)HALF * K * 2;
    const size_t tstep = 2 * hstep;
    const unsigned ldsw = (unsigned)wid * 1024u;
    const int aoff = lds_byte(wr * 64 + fr, fq * 8), boff = lds_byte(wc * 32 + fr, fq * 8);
#define PG8_SA(b, h) (((b) * 2 + (h)) * HTB)
#define PG8_SB(b, h) ((4 + (b) * 2 + (h)) * HTB)
#define PG8_STAGE(bufoff, gbase, voff) do { _Pragma("unroll") for (int _i = 0; _i < 2; ++_i) \
        __builtin_amdgcn_global_load_lds((const unsigned*)((const char*)(gbase) + (voff)[_i]), (PG8_LAS unsigned*)(lds + (bufoff) + ldsw + _i * 8192), 16, 0, 0); } while (0)
#define PG8_LDA(dst, b, h) do { _Pragma("unroll") for (int m = 0; m < 4; ++m) _Pragma("unroll") for (int k = 0; k < 2; ++k) dst[m][k] = *(const PG8_LAS bf16x8*)(lds + PG8_SA(b, h) + aoff + m * 2048 + k * 1024); } while (0)
#define PG8_LDB(dst, b, h) do { _Pragma("unroll") for (int n = 0; n < 2; ++n) _Pragma("unroll") for (int k = 0; k < 2; ++k) dst[n][k] = *(const PG8_LAS bf16x8*)(lds + PG8_SB(b, h) + boff + n * 2048 + k * 1024); } while (0)
#define PG8_MMA(ai, bj, At, Bt) do { __builtin_amdgcn_s_setprio(1); _Pragma("unroll") for (int m = 0; m < 4; ++m) _Pragma("unroll") for (int n = 0; n < 2; ++n) _Pragma("unroll") for (int k = 0; k < 2; ++k) \
        acc[ai][bj][m][n] = __builtin_amdgcn_mfma_f32_16x16x32_bf16(Bt[n][k], At[m][k], acc[ai][bj][m][n], 0, 0, 0); __builtin_amdgcn_s_setprio(0); } while (0)
#define PG8_WAIT_V(n) asm volatile("s_waitcnt vmcnt(" #n ")" ::: "memory")
#define PG8_WAIT_L(n) asm volatile("s_waitcnt lgkmcnt(" #n ")" ::: "memory")
#define PG8_BAR __builtin_amdgcn_s_barrier()
#define PG8_SCHED __builtin_amdgcn_sched_barrier(0)
    Unit cur, nxt; int ui = 0;
    if (!S.next(0, cur)) return;
    f32x4 acc[2][2][4][2];
#pragma unroll
    for (int a = 0; a < 2; ++a)
#pragma unroll
        for (int b = 0; b < 2; ++b)
#pragma unroll
            for (int m = 0; m < 4; ++m)
#pragma unroll
                for (int n = 0; n < 2; ++n) acc[a][b][m][n] = (f32x4){0.f, 0.f, 0.f, 0.f};
    bf16x8 At[4][2], B0[2][2], B1[2][2];
    const char* cA = (const char*)g.A + (size_t)cur.pm * tstep; const char* cB = (const char*)g.Bt + (size_t)cur.pn * tstep;
    S.a_ready(cur);
    if constexpr (SP2) {
        PG8_STAGE(PG8_SB(0, 0), cB, voffB); PG8_STAGE(PG8_SB(0, 1), cB + hstep, voffB); PG8_STAGE(PG8_SA(0, 0), cA, voffA); PG8_STAGE(PG8_SA(0, 1), cA + hstep, voffA);
        if (wr == 1) PG8_BAR;
        PG8_WAIT_V(2); PG8_BAR;
        PG8_STAGE(PG8_SB(1, 0), cB + kstep, voffB); PG8_STAGE(PG8_SA(1, 0), cA + kstep, voffA); PG8_STAGE(PG8_SB(1, 1), cB + hstep + kstep, voffB);
        PG8_WAIT_V(6); PG8_BAR;
    } else {
        PG8_STAGE(PG8_SB(0, 0), cB, voffB); PG8_STAGE(PG8_SA(0, 0), cA, voffA); PG8_STAGE(PG8_SB(0, 1), cB + hstep, voffB); PG8_STAGE(PG8_SA(0, 1), cA + hstep, voffA);
        if (wr == 1) PG8_BAR;
        PG8_WAIT_V(4); PG8_BAR;
        PG8_STAGE(PG8_SB(1, 0), cB + kstep, voffB); PG8_STAGE(PG8_SA(1, 0), cA + kstep, voffA); PG8_STAGE(PG8_SB(1, 1), cB + hstep + kstep, voffB);
        PG8_WAIT_V(6); PG8_BAR;
    }
    for (;;) {
        const bool has_next = S.next(ui + 1, nxt);
        const char* nA = has_next ? (const char*)g.A + (size_t)nxt.pm * tstep : cA; const char* nB = has_next ? (const char*)g.Bt + (size_t)nxt.pn * tstep : cB;
        for (int t = 0; t < nt; t += 2) {
            const bool last = (t == nt - 2);
            const char* a1 = cA + (size_t)(t + 1) * kstep;
            const char* a2 = last ? nA : cA + (size_t)(t + 2) * kstep; const char* b2 = last ? nB : cB + (size_t)(t + 2) * kstep;
            const char* a3 = a2 + kstep; const char* b3 = b2 + kstep;
            if (last && has_next) S.a_ready(nxt);
            if constexpr (SP2) {
            PG8_LDB(B0, 0, 0); PG8_LDB(B1, 0, 1); PG8_SCHED; PG8_LDA(At, 0, 0); PG8_STAGE(PG8_SA(1, 1), a1 + hstep, voffA);
            PG8_WAIT_V(8); PG8_WAIT_L(0); PG8_BAR; PG8_MMA(0, 0, At, B0); PG8_MMA(0, 1, At, B1); PG8_BAR; PG8_SCHED;
            PG8_LDA(At, 0, 1); PG8_STAGE(PG8_SB(0, 0), b2, voffB); PG8_STAGE(PG8_SB(0, 1), b2 + hstep, voffB); PG8_STAGE(PG8_SA(0, 0), a2, voffA);
            PG8_WAIT_V(8); PG8_WAIT_L(0); PG8_BAR; PG8_MMA(1, 0, At, B0); PG8_MMA(1, 1, At, B1); PG8_BAR; PG8_SCHED;
            PG8_LDB(B0, 1, 0); PG8_LDB(B1, 1, 1); PG8_SCHED; PG8_LDA(At, 1, 0); PG8_STAGE(PG8_SA(0, 1), a2 + hstep, voffA);
            PG8_WAIT_V(8); PG8_WAIT_L(0); PG8_BAR; PG8_MMA(0, 0, At, B0); PG8_MMA(0, 1, At, B1); PG8_BAR; PG8_SCHED;
            PG8_LDA(At, 1, 1); PG8_STAGE(PG8_SB(1, 0), b3, voffB); PG8_STAGE(PG8_SB(1, 1), b3 + hstep, voffB); PG8_STAGE(PG8_SA(1, 0), a3, voffA);
            PG8_WAIT_V(8); PG8_WAIT_L(0); PG8_BAR; PG8_MMA(1, 0, At, B0); PG8_MMA(1, 1, At, B1); PG8_BAR; PG8_SCHED;
            } else {
            PG8_LDB(B0, 0, 0); PG8_SCHED; PG8_LDA(At, 0, 0); PG8_STAGE(PG8_SA(1, 1), a1 + hstep, voffA);
            PG8_WAIT_L(8); PG8_BAR; PG8_WAIT_L(0); PG8_MMA(0, 0, At, B0); PG8_BAR; PG8_SCHED;
            PG8_LDB(B1, 0, 1); PG8_STAGE(PG8_SB(0, 0), b2, voffB);
            PG8_BAR; PG8_WAIT_L(0); PG8_MMA(0, 1, At, B1); PG8_BAR;
            PG8_LDA(At, 0, 1); PG8_STAGE(PG8_SA(0, 0), a2, voffA);
            PG8_BAR; PG8_WAIT_L(0); PG8_MMA(1, 0, At, B0); PG8_BAR; PG8_SCHED;
            PG8_STAGE(PG8_SB(0, 1), b2 + hstep, voffB);
            PG8_WAIT_V(6); PG8_BAR; PG8_MMA(1, 1, At, B1); PG8_BAR;
            PG8_LDB(B0, 1, 0); PG8_SCHED; PG8_LDA(At, 1, 0); PG8_STAGE(PG8_SA(0, 1), a2 + hstep, voffA);
            PG8_WAIT_L(8); PG8_BAR; PG8_WAIT_L(0); PG8_MMA(0, 0, At, B0); PG8_BAR; PG8_SCHED;
            PG8_LDB(B1, 1, 1); PG8_STAGE(PG8_SB(1, 0), b3, voffB);
            PG8_BAR; PG8_WAIT_L(0); PG8_MMA(0, 1, At, B1); PG8_BAR;
            PG8_LDA(At, 1, 1); PG8_STAGE(PG8_SA(1, 0), a3, voffA);
            PG8_BAR; PG8_WAIT_L(0); PG8_MMA(1, 0, At, B0); PG8_BAR; PG8_SCHED;
            PG8_STAGE(PG8_SB(1, 1), b3 + hstep, voffB);
            PG8_WAIT_V(6); PG8_BAR; PG8_MMA(1, 1, At, B1); PG8_BAR;
            }
        }
        if constexpr (ALIGN_EPI) { if (wr == 0) PG8_BAR; }
        if constexpr (!Epi::AFTER_DRAIN) { E(acc, cur, wr, wc, fr, fq); S.done(cur); }
        if (!has_next) break;
#pragma unroll
        for (int a = 0; a < 2; ++a)
#pragma unroll
            for (int b = 0; b < 2; ++b)
#pragma unroll
                for (int m = 0; m < 4; ++m)
#pragma unroll
                    for (int n = 0; n < 2; ++n) acc[a][b][m][n] = (f32x4){0.f, 0.f, 0.f, 0.f};
        cur = nxt; cA = nA; cB = nB; ++ui;
        if constexpr (ALIGN_EPI) { if (wr == 1) PG8_BAR; }
    }
    PG8_WAIT_V(0);
    if constexpr (!ALIGN_EPI) { if (wr == 0) PG8_BAR; }
    PG8_BAR;
    if constexpr (Epi::AFTER_DRAIN) { E.fused(acc, cur, wr, wc, fr, fq, lds, wid, lane); S.done(cur); }
#undef PG8_SA
#undef PG8_SB
#undef PG8_STAGE
#undef PG8_LDA
#undef PG8_LDB
#undef PG8_MMA
#undef PG8_WAIT_V
#undef PG8_WAIT_L
#undef PG8_BAR
#undef PG8_SCHED
}
}
#define LAS __attribute__((address_space(3)))
#define XB_TMO      128
#define XB_XCNT(j)  (256  + 64 * (j))
#define XB_XSUB(j)  (1280 + 64 * (j))
#define XB_XGEN(j)  (2304 + 64 * (j))
#define XB_TOP      3328
#define XB_TOPGEN   3392
#define XCD_BAR_WORDS 3456
#define XB_SPIN_CAP (1u << 18)

__device__ __forceinline__ unsigned xb_ld(unsigned* p)              { return __hip_atomic_load(p, __ATOMIC_RELAXED, __HIP_MEMORY_SCOPE_AGENT); }
__device__ __forceinline__ unsigned xb_add(unsigned* p, unsigned v) { return __hip_atomic_fetch_add(p, v, __ATOMIC_RELAXED, __HIP_MEMORY_SCOPE_AGENT); }
__device__ __forceinline__ unsigned xb_xcc_id() { return (unsigned)__builtin_amdgcn_s_getreg((3 << 11) | 20) & 0xFu; }
#define XB_SPIN(cond, bar) do { unsigned _sp = 0; while (cond) { __builtin_amdgcn_s_sleep(1); \
    if ((++_sp & 255u) == 0u) { if (xb_ld(&(bar)[XB_TMO])) break; if (_sp > XB_SPIN_CAP) { atomicAdd(&(bar)[XB_TMO], 1u); break; } } } } while (0)

struct XcdBarrier {
    unsigned* bar; unsigned x;
    volatile LAS unsigned* st;
};

__device__ __forceinline__ XcdBarrier xcd_barrier_post(unsigned* bar, volatile LAS unsigned* st) {
    XcdBarrier b; b.bar = bar; b.x = xb_xcc_id(); b.st = st;
    if (threadIdx.x == 0) (void)xb_add(&bar[XB_XCNT(b.x)], 1u);
    return b;
}
__device__ __forceinline__ void xcd_barrier_complete(unsigned* bar, unsigned x, unsigned& nloc, unsigned& nx) {
    const unsigned G = gridDim.x * gridDim.y * gridDim.z;
    unsigned sum, cnt, mine, sp = 0u;
    for (;;) {
        sum = 0u; cnt = 0u; mine = 0u;
#pragma unroll
        for (unsigned j = 0; j < 16; ++j) { const unsigned c = xb_ld(&bar[XB_XCNT(j)]); sum += c; cnt += (c > 0u) ? 1u : 0u; mine = (j == x) ? c : mine; }
        if (sum == G) break;
        __builtin_amdgcn_s_sleep(1);
        if ((++sp & 255u) == 0u) { if (xb_ld(&bar[XB_TMO])) break; if (sp > XB_SPIN_CAP) { atomicAdd(&bar[XB_TMO], 1u); break; } }
    }
    nloc = mine > 0u ? mine : 1u; nx = cnt > 0u ? cnt : 1u;
}

__device__ __forceinline__ void xcd_barrier(const XcdBarrier& b) {
    asm volatile("s_waitcnt vmcnt(0)" ::: "memory");
    __syncthreads();
    if (threadIdx.x == 0) {
        unsigned* bar = b.bar;
        __builtin_amdgcn_s_waitcnt(0);
        unsigned nloc = b.st[0], nx = b.st[1];
        if (nloc == 0u) { xcd_barrier_complete(bar, b.x, nloc, nx); b.st[0] = nloc; b.st[1] = nx; }
        const unsigned old = xb_add(&bar[XB_XSUB(b.x)], 1u);
        const unsigned gen = old / nloc;
        if (old + 1u == (gen + 1u) * nloc) {
            __builtin_amdgcn_fence(__ATOMIC_RELEASE, "agent");
            asm volatile("s_waitcnt vmcnt(0)" ::: "memory");
            const unsigned og = xb_add(&bar[XB_TOP], 1u);
            const unsigned tg = og / nx;
            if (og + 1u == (tg + 1u) * nx) xb_add(&bar[XB_TOPGEN], 1u);
            else XB_SPIN(xb_ld(&bar[XB_TOPGEN]) == tg, bar);
            __builtin_amdgcn_fence(__ATOMIC_ACQUIRE, "agent");
            xb_add(&bar[XB_XGEN(b.x)], 1u);
            asm volatile("s_waitcnt vmcnt(0)" ::: "memory");
        } else {
            XB_SPIN(xb_ld(&bar[XB_XGEN(b.x)]) == gen, bar);
            __builtin_amdgcn_fence(__ATOMIC_ACQUIRE, "agent");
            asm volatile("s_waitcnt vmcnt(0)" ::: "memory");
        }
    }
    __syncthreads();
}
namespace moba {
constexpr int D = 128;
constexpr float THR = 8.f;
constexpr bool WSKIP = false;
constexpr int QP = MHD, KVP = MHD, OP = MW;
template <class A, class Bt> struct same_t { static constexpr bool v = false; };
template <class A> struct same_t<A, A> { static constexpr bool v = true; };
constexpr float SCALE = 0.08838834764831845f;
constexpr int NW = 8, QBLK = 32, KVBLK = 64, QB = NW * QBLK;
constexpr int SHM_V = KVBLK * D * 2, SHM_K = KVBLK * D * 2;
constexpr int LDS_BYTES = 2 * SHM_V + 2 * SHM_K + NW * 64 * 4;
using bf16 = unsigned short;
typedef short bf16x8 __attribute__((ext_vector_type(8)));
typedef short s16x4 __attribute__((ext_vector_type(4)));
typedef float f32x16 __attribute__((ext_vector_type(16)));
typedef float f32x4 __attribute__((ext_vector_type(4)));
typedef unsigned u32x4 __attribute__((ext_vector_type(4)));
#define KSWZ(row, colB) ((row) * 256 + ((colB) ^ (((row) & 7) << 4)))
#define SBAR() __builtin_amdgcn_sched_barrier(0)
__device__ __forceinline__ int v_st(int k, int c) { const int kk = (k & ~0xC) | ((k & 4) << 1) | ((k & 8) >> 1); return ((kk >> 3) * 4 + (c >> 5)) * 512 + ((kk & 7) * 32 + (c & 31)) * 2; }
__device__ __forceinline__ int v_rd_base(int lane) { return ((lane & 3) << 3) | (((lane >> 2) & 3) << 6) | (((lane >> 4) & 1) << 5) | (((lane >> 5) & 1) << 8); }
constexpr int v_rd_off(int d0, int ks, int half) { return d0 * 512 + ks * 4096 + half * 2048; }
__device__ __forceinline__ int crow(int r, int hi) { return (r & 3) + 8 * (r >> 2) + 4 * hi; }
__device__ __forceinline__ unsigned cvtpk(float lo, float hi) {
    unsigned r; asm volatile("v_cvt_pk_bf16_f32 %0, %1, %2" : "=v"(r) : "v"(lo), "v"(hi)); return r;
}
__device__ __forceinline__ bf16x8 pack8(f32x4 a, f32x4 b) {
    u32x4 w = {cvtpk(a[0], a[1]), cvtpk(a[2], a[3]), cvtpk(b[0], b[1]), cvtpk(b[2], b[3])};
    return *reinterpret_cast<bf16x8*>(&w);
}
template <class T> __device__ __forceinline__ bf16x8 load8(const T* p) {
    if constexpr (same_t<T, float>::v) { return pack8(*(const f32x4*)p, *(const f32x4*)(p + 4)); }
    else { return *reinterpret_cast<const bf16x8*>(p); }
}
__device__ __forceinline__ void mask_tile(f32x16& p0, f32x16& p1, int dq, unsigned W) {
    const float NEG = -__builtin_inff();
#pragma unroll
    for (int r = 0; r < 16; ++r) {
        const int c = (r & 3) + 8 * (r >> 2);
        if ((unsigned)(dq - c) >= W) p0[r] = NEG;
        if ((unsigned)(dq - c - 32) >= W) p1[r] = NEG;
    }
}
__device__ __forceinline__ void partialSM(f32x16& p0, f32x16& p1, float& m_reg, float& mn, float& alpha) {
    float pmax = p0[0]; for (int r = 1; r < 16; ++r) pmax = fmaxf(pmax, p0[r]); for (int r = 0; r < 16; ++r) pmax = fmaxf(pmax, p1[r]);
    { auto rr = __builtin_amdgcn_permlane32_swap(__float_as_uint(pmax), __float_as_uint(pmax), false, false);
      pmax = fmaxf(__uint_as_float(rr[0]), __uint_as_float(rr[1])); }
    constexpr float C2 = 1.4426950408889634f * SCALE;
    if (__builtin_expect(__all((pmax - m_reg) * SCALE <= THR), 1)) { mn = m_reg; alpha = 1.f; }
    else { mn = fmaxf(m_reg, pmax); alpha = __builtin_amdgcn_exp2f((m_reg - mn) * C2); m_reg = mn; }
    const float mnL = -mn * C2;
    for (int r = 0; r < 16; ++r) p0[r] = fmaf(p0[r], C2, mnL); for (int r = 0; r < 16; ++r) p1[r] = fmaf(p1[r], C2, mnL);
    for (int r = 0; r < 16; ++r) p0[r] = __builtin_amdgcn_exp2f(p0[r]);
}
__device__ __forceinline__ void finishSM(f32x16& p0, f32x16& p1, float alpha, float& l_reg, bf16x8& pa0, bf16x8& pa1, bf16x8& pa2, bf16x8& pa3) {
    for (int r = 0; r < 16; ++r) p1[r] = __builtin_amdgcn_exp2f(p1[r]);
    float ps = 0; for (int r = 0; r < 16; ++r) ps += p0[r]; for (int r = 0; r < 16; ++r) ps += p1[r];
    { auto rr = __builtin_amdgcn_permlane32_swap(__float_as_uint(ps), __float_as_uint(ps), false, false);
      ps = __uint_as_float(rr[0]) + __uint_as_float(rr[1]); }
    l_reg = l_reg * alpha + ps;
#define PK4(P, B_, OUT) do { unsigned a0 = cvtpk(P[B_+0], P[B_+1]), a1 = cvtpk(P[B_+2], P[B_+3]);                          \
        unsigned b0 = cvtpk(P[B_+4], P[B_+5]), b1 = cvtpk(P[B_+6], P[B_+7]);                                             \
        auto r0 = __builtin_amdgcn_permlane32_swap(a0, b0, false, false); auto r1 = __builtin_amdgcn_permlane32_swap(a1, b1, false, false); \
        u32x4 w = {r0[0], r1[0], r0[1], r1[1]}; OUT = *reinterpret_cast<bf16x8*>(&w); } while (0)
    PK4(p0, 0, pa0); PK4(p0, 8, pa1); PK4(p1, 0, pa2); PK4(p1, 8, pa3);
#undef PK4
}
template <int KB, bool SK>
__device__ __forceinline__ void qkt(f32x16& p0, f32x16& p1, const char* K_lds, int r32, int hi, const bf16x8* qr, bool act) {
    if (SK && !act) { const float NEG = -__builtin_inff();
#pragma unroll
        for (int r = 0; r < 16; ++r) { p0[r] = NEG; p1[r] = NEG; } return; }
    p0 = f32x16{}; p1 = f32x16{};
    const char* kb[4];
#pragma unroll
    for (int dd = 0; dd < 4; ++dd) kb[dd] = K_lds + KB * SHM_K + KSWZ(r32, (dd * 16 + hi * 8) * 2);
#pragma unroll
    for (int d0 = 0; d0 < 8; ++d0) { const char* a = kb[d0 & 3] + (d0 >> 2) * 128;
        bf16x8 b0 = *reinterpret_cast<const bf16x8*>(a);
        bf16x8 b1 = *reinterpret_cast<const bf16x8*>(a + 32 * 256);
        p0 = __builtin_amdgcn_mfma_f32_32x32x16_bf16(b0, qr[d0], p0, 0, 0, 0);
        p1 = __builtin_amdgcn_mfma_f32_32x32x16_bf16(b1, qr[d0], p1, 0, 0, 0); }
}
template <int VB, bool SK>
__device__ __forceinline__ void pv_tile(f32x16* o, int vb0, bf16x8 pa0, bf16x8 pa1, bf16x8 pa2, bf16x8 pa3, bool act) {
    if (SK && !act) return;
#define TRRD(dst, off) asm volatile("ds_read_b64_tr_b16 %0, %1 offset:%2" : "=&v"(dst) : "v"(vb0), "i"(off) : "memory")
#define PV_D0(d0) do { s16x4 l0, l1, l2, l3, h0, h1, h2, h3; constexpr int b_ = VB * SHM_V + v_rd_off(d0, 0, 0);     \
        TRRD(l0, b_); TRRD(h0, b_ + 2048); TRRD(l1, b_ + 4096); TRRD(h1, b_ + 6144); TRRD(l2, b_ + 8192); TRRD(h2, b_ + 10240); TRRD(l3, b_ + 12288); TRRD(h3, b_ + 14336); \
        asm volatile("s_waitcnt lgkmcnt(0)" ::: "memory"); SBAR();                 \
        o[d0] = __builtin_amdgcn_mfma_f32_32x32x16_bf16(pa0, (bf16x8){l0[0], l0[1], l0[2], l0[3], h0[0], h0[1], h0[2], h0[3]}, o[d0], 0, 0, 0);   \
        o[d0] = __builtin_amdgcn_mfma_f32_32x32x16_bf16(pa1, (bf16x8){l1[0], l1[1], l1[2], l1[3], h1[0], h1[1], h1[2], h1[3]}, o[d0], 0, 0, 0);   \
        o[d0] = __builtin_amdgcn_mfma_f32_32x32x16_bf16(pa2, (bf16x8){l2[0], l2[1], l2[2], l2[3], h2[0], h2[1], h2[2], h2[3]}, o[d0], 0, 0, 0);   \
        o[d0] = __builtin_amdgcn_mfma_f32_32x32x16_bf16(pa3, (bf16x8){l3[0], l3[1], l3[2], l3[3], h3[0], h3[1], h3[2], h3[3]}, o[d0], 0, 0, 0); } while (0)
    PV_D0(0); PV_D0(1); PV_D0(2); PV_D0(3);
#undef PV_D0
#undef TRRD
}
__device__ __forceinline__ float bfv(short s) { return __builtin_bit_cast(float, ((unsigned)(unsigned short)s) << 16); }
__device__ __forceinline__ void sel_fill(f32x16& p0, f32x16& p1, bool ok) { const float NEG = -__builtin_inff();
#pragma unroll
    for (int r = 0; r < 16; ++r) { p0[r] = ok ? p0[r] : NEG; p1[r] = ok ? p1[r] : NEG; } }
template <class TIn, class TOut> struct BlockRef { const TIn* Q; const TIn* K; const TIn* V; TOut* O; int P0; const float* km; int qb; };
template <class TIn> struct Seam {
    bf16x8 qr[8];
    bf16x8 st_v0, st_v1, st_k0, st_k1; f32x4 sf0, sf1, sf2, sf3;
    f32x4 tq[16];
};
__device__ __forceinline__ int swa_jlo(int P0, int W) { const int lowk = P0 - W + 1; return lowk > 0 ? lowk / KVBLK : 0; }
#define ROW(p, k0, rr) ((p) + (size_t)((k0) + (rr)) * KVP + sc)
#define VMW() asm volatile("s_waitcnt vmcnt(0)" ::: "memory")
#define VMWN(n) asm volatile("s_waitcnt vmcnt(%0)" :: "i"(n) : "memory")
#define SLOAD_H(Kp, Vp, k0) do { S.st_v0 = load8<TIn>(ROW(Vp, k0, sr)); S.st_v1 = load8<TIn>(ROW(Vp, k0, 32 + sr));              \
                         S.st_k0 = load8<TIn>(ROW(Kp, k0, sr)); S.st_k1 = load8<TIn>(ROW(Kp, k0, 32 + sr)); } while (0)
#define SWRITE_HK(bf) do { *(bf16x8*)(K_lds + (bf) * SHM_K + kws) = S.st_k0; *(bf16x8*)(K_lds + (bf) * SHM_K + kws + 32 * 256) = S.st_k1; } while (0)
#define SWRITE_HV(bf) do { *(bf16x8*)(V_lds + (bf) * SHM_V + vst0) = S.st_v0; *(bf16x8*)(V_lds + (bf) * SHM_V + vst1) = S.st_v1; } while (0)
#define SWRITE_H(bf) do { SWRITE_HV(bf); SWRITE_HK(bf); } while (0)
#define SLOAD_F(p, k0) do { S.sf0 = *(const f32x4*)ROW(p, k0, sr); S.sf1 = *(const f32x4*)(ROW(p, k0, sr) + 4);                \
                            S.sf2 = *(const f32x4*)ROW(p, k0, 32 + sr); S.sf3 = *(const f32x4*)(ROW(p, k0, 32 + sr) + 4); } while (0)
#define SWRITE_KF(bf) do { *(bf16x8*)(K_lds + (bf) * SHM_K + kws) = pack8(S.sf0, S.sf1); *(bf16x8*)(K_lds + (bf) * SHM_K + kws + 32 * 256) = pack8(S.sf2, S.sf3); } while (0)
#define SWRITE_VF(bf) do { *(bf16x8*)(V_lds + (bf) * SHM_V + vst0) = pack8(S.sf0, S.sf1); *(bf16x8*)(V_lds + (bf) * SHM_V + vst1) = pack8(S.sf2, S.sf3); } while (0)
template <class TIn, class TOut>
__device__ __forceinline__ void causal_swa_prime(const BlockRef<TIn, TOut>& cur, int W, char* lds, Seam<TIn>& S) {
    constexpr bool F32 = same_t<TIn, float>::v;
    int tid_o = threadIdx.x; asm volatile("" : "+v"(tid_o));
    const int tid = tid_o, wid = __builtin_amdgcn_readfirstlane(tid >> 6), lane = tid & 63, r32 = lane & 31, hi = lane >> 5;
    const int sr = tid >> 4, sc = (tid & 15) * 8, kws = KSWZ(sr, sc * 2); char* K_lds = lds + 2 * SHM_V;
    const int kb0 = swa_jlo(cur.P0, W) * KVBLK;
    for (int d0 = 0; d0 < 8; ++d0) S.qr[d0] = load8<TIn>(cur.Q + (size_t)(wid * QBLK + r32) * QP + d0 * 16 + hi * 8);
    if constexpr (F32) { SLOAD_F((const float*)cur.K, kb0); VMW(); SWRITE_KF(0); SBAR(); SLOAD_F((const float*)cur.V, kb0); }
    else { SLOAD_H(cur.K, cur.V, kb0); VMW(); SWRITE_HK(0); }
    __syncthreads();
}
template <class TIn, class TOut, int FK = 0>
__device__ __forceinline__ void causal_swa_block(const BlockRef<TIn, TOut>& cur, const BlockRef<TIn, TOut>& nxt, int skv, int W, char* lds, Seam<TIn>& S) {
    constexpr bool F32 = same_t<TIn, float>::v;
    int tid_o = threadIdx.x; asm volatile("" : "+v"(tid_o));
    const int tid = tid_o, wid = __builtin_amdgcn_readfirstlane(tid >> 6), lane = tid & 63, r32 = lane & 31, hi = lane >> 5;
    const int j_lo = swa_jlo(cur.P0, W);
    int j_hi = (cur.P0 + QB - 1) / KVBLK + 1; if (j_hi > skv / KVBLK) j_hi = skv / KVBLK;
    const int NT = j_hi - j_lo;
    const int kbn = swa_jlo(nxt.P0, W) * KVBLK;
    const int qlo = cur.P0 + wid * QBLK, qm = qlo + r32 - 4 * hi;
    char* V_lds = lds; char* K_lds = lds + 2 * SHM_V;
    float* ws = (float*)(lds + 2 * SHM_V + 2 * SHM_K) + wid * 64; float* li_l = ws, * al_l = ws + 32;
    float m_reg = -1e30f, l_reg = 0; f32x16 o[4] = {};
    unsigned selbits = 0u;
    if (cur.qb > 0) {
        float sc_[7];
#pragma unroll
        for (int j = 0; j < 7; ++j) { float a_ = 0.f;
            if (j < cur.qb) { const float* kmj = cur.km + j * 128 + hi * 8;
#pragma unroll
                for (int d0 = 0; d0 < 8; ++d0) { const f32x4 k0_ = *(const f32x4*)(kmj + d0 * 16), k1_ = *(const f32x4*)(kmj + d0 * 16 + 4); const bf16x8 q_ = S.qr[d0];
                    a_ += (bfv(q_[0]) * k0_[0] + bfv(q_[1]) * k0_[1]) + (bfv(q_[2]) * k0_[2] + bfv(q_[3]) * k0_[3]) + (bfv(q_[4]) * k1_[0] + bfv(q_[5]) * k1_[1]) + (bfv(q_[6]) * k1_[2] + bfv(q_[7]) * k1_[3]); }
                a_ += __shfl_xor(a_, 32); }
            sc_[j] = a_; }
#pragma unroll
        for (int j = 0; j < 7; ++j) { int rank_ = 0;
#pragma unroll
            for (int i = 0; i < 7; ++i) if (i != j) rank_ += (i < cur.qb && (sc_[i] > sc_[j] || (sc_[i] == sc_[j] && i < j))) ? 1 : 0;
            if (j < cur.qb && rank_ < 3) selbits |= 1u << j; }
    }
    const int sr = tid >> 4, sc = (tid & 15) * 8, vst0 = v_st(sr, sc), vst1 = v_st(32 + sr, sc), kws = KSWZ(sr, sc * 2);
    const int vb0 = (int)(uintptr_t)V_lds + v_rd_base(lane);
    const TIn* Kh = cur.K; const TIn* Vh = cur.V;
#define RESC(a) do { if (__any((a) < 1.f)) { if (hi == 0) al_l[r32] = (a); asm volatile("s_waitcnt lgkmcnt(0)" ::: "memory");              \
                     for (int d_ = 0; d_ < 4; ++d_) for (int r = 0; r < 16; ++r) o[d_][r] *= al_l[crow(r, hi)]; } } while (0)
#define KBASE(t) ((j_lo + (t)) * KVBLK)
#define ACT(t) (KBASE(t) <= qlo + QBLK - 1 && KBASE(t) + KVBLK - 1 >= qlo - W + 1)
#define MASKT(P0_, P1_, t) do { const int kb_ = KBASE(t); if (kb_ + KVBLK - 1 > qlo) mask_tile(P0_, P1_, qm - kb_, (unsigned)W); \
        else if ((t) < 4 * cur.qb) { const bool ok_ = ((selbits >> ((t) >> 2)) & 1u) != 0u; if (!__all(ok_)) sel_fill(P0_, P1_, ok_); } } while (0)
    constexpr int NQL = F32 ? 16 : 8;
    constexpr bool SK = WSKIP && !F32;
#define SEAM_K0() do { VMWN(NQL); if constexpr (F32) { SWRITE_KF(0); SBAR(); SLOAD_F((const float*)nxt.V, kbn); } else { SWRITE_HK(0); } SBAR(); } while (0)
    f32x16 pA0, pA1, pB0, pB1; float mnA, mnB, alA, alB; bf16x8 pa0, pa1, pa2, pa3;
    if constexpr (F32) { VMW(); SWRITE_VF(0); SBAR(); } else { SWRITE_HV(0); SBAR(); }
    if (NT > 1) { if constexpr (F32) SLOAD_F((const float*)Kh, KBASE(1)); else SLOAD_H(Kh, Vh, (FK == 1) ? 0 : KBASE(1)); }
    SBAR(); qkt<0, SK>(pA0, pA1, K_lds, r32, hi, S.qr, ACT(0));
    if constexpr (F32) { if (NT > 1) { VMW(); SWRITE_KF(1); SBAR(); SLOAD_F((const float*)Vh, KBASE(1)); } }
    MASKT(pA0, pA1, 0); partialSM(pA0, pA1, m_reg, mnA, alA);
    if (NT > 1) { VMW(); if constexpr (F32) { SWRITE_VF(1); SBAR(); if (NT > 2) SLOAD_F((const float*)Kh, KBASE(2)); } else SWRITE_H(1); }
    __syncthreads();
#define HALF_STEP(PX0, PX1, mnX, alX, PY0, PY1, alY, t, KB, VB, SB) do {                                                      \
        SBAR(); qkt<KB, SK>(PX0, PX1, K_lds, r32, hi, S.qr, ACT(t));                                             \
        finishSM(PY0, PY1, alY, l_reg, pa0, pa1, pa2, pa3); SBAR();                                                           \
        if ((t) + 1 < NT) { if constexpr (F32) { VMW(); SWRITE_KF(SB); SBAR(); SLOAD_F((const float*)Vh, KBASE((t) + 1)); }  \
                            else { SLOAD_H(Kh, Vh, (FK == 1) ? 0 : KBASE((t) + 1)); } SBAR(); }                                               \
        pv_tile<VB, SK>(o, vb0, pa0, pa1, pa2, pa3, ACT((t) - 1)); MASKT(PX0, PX1, (t)); partialSM(PX0, PX1, m_reg, mnX, alX);                                        \
        __syncthreads();                                                                                                      \
        if ((t) + 1 < NT) { VMW(); if constexpr (F32) { SWRITE_VF(SB); SBAR(); if ((t) + 2 < NT) SLOAD_F((const float*)Kh, KBASE((t) + 2)); } \
                            else { SWRITE_H(SB); } }                                                                          \
        RESC(alX); __syncthreads(); } while (0)
    for (int t = 1; t + 1 < NT; t += 2) {
        HALF_STEP(pB0, pB1, mnB, alB, pA0, pA1, alA, t, 1, 0, 0);
        HALF_STEP(pA0, pA1, mnA, alA, pB0, pB1, alB, t + 1, 0, 1, 1);
    }
    const bool even = (NT & 1) == 0;
    if (even) { SBAR(); qkt<1, SK>(pB0, pB1, K_lds, r32, hi, S.qr, ACT(NT - 1)); SBAR(); }
#define QROW(e) (nxt.Q + (size_t)(wid * QBLK + r32) * QP + ((e) >> 1) * 16 + hi * 8 + ((e) & 1) * 4)
    if constexpr (F32) { SLOAD_F((const float*)nxt.K, kbn); SBAR();
#pragma unroll
        for (int e = 0; e < 8; ++e) S.tq[e] = *(const f32x4*)QROW(e); }
    else { SLOAD_H(nxt.K, nxt.V, kbn); SBAR();
#pragma unroll
        for (int d0 = 0; d0 < 8; ++d0) S.qr[d0] = load8<TIn>(nxt.Q + (size_t)(wid * QBLK + r32) * QP + d0 * 16 + hi * 8); }
    SBAR();
    finishSM(pA0, pA1, alA, l_reg, pa0, pa1, pa2, pa3); SBAR();
    if constexpr (F32) {
#pragma unroll
        for (int e = 8; e < 16; ++e) S.tq[e] = *(const f32x4*)QROW(e); SBAR(); }
#undef QROW
    pv_tile<0, SK>(o, vb0, pa0, pa1, pa2, pa3, ACT(even ? NT - 2 : NT - 1));
    if (even) { MASKT(pB0, pB1, NT - 1); partialSM(pB0, pB1, m_reg, mnB, alB); __syncthreads(); RESC(alB);
        finishSM(pB0, pB1, alB, l_reg, pa0, pa1, pa2, pa3); SBAR(); pv_tile<1, SK>(o, vb0, pa0, pa1, pa2, pa3, ACT(NT - 1)); }
    SBAR(); SEAM_K0();
    if (hi == 0) li_l[r32] = l_reg; asm volatile("s_waitcnt lgkmcnt(0)" ::: "memory");
    float rli[16];
#pragma unroll
    for (int r = 0; r < 16; ++r) rli[r] = __builtin_amdgcn_rcpf(li_l[crow(r, hi)]);
    TOut* Ow = cur.O + (size_t)(wid * QBLK) * OP;
#pragma unroll
    for (int r = 0; r < 16; ++r) { const int orow = crow(r, hi);
#pragma unroll
        for (int d0 = 0; d0 < 4; ++d0) { const float v = o[d0][r] * rli[r];
            if constexpr (same_t<TOut, float>::v) { Ow[(size_t)orow * OP + d0 * 32 + r32] = v; }
            else { const float vn = __shfl_xor(v, 1);
                   if ((r32 & 1) == 0) *(unsigned*)(Ow + (size_t)orow * OP + d0 * 32 + r32) = cvtpk(v, vn); } } }
    if constexpr (F32) {
#pragma unroll
        for (int d0 = 0; d0 < 8; ++d0) S.qr[d0] = pack8(S.tq[2 * d0], S.tq[2 * d0 + 1]); }
    __syncthreads();
#undef RESC
#undef KBASE
#undef ACT
#undef MASKT
#undef SEAM_K0
#undef HALF_STEP
}
#undef ROW
#undef VMW
#undef VMWN
#undef SLOAD_H
#undef SWRITE_HK
#undef SWRITE_HV
#undef SWRITE_H
#undef SLOAD_F
#undef SWRITE_KF
#undef SWRITE_VF
}
namespace gla {
typedef float f32x16 __attribute__((ext_vector_type(16)));
typedef short s16x4 __attribute__((ext_vector_type(4)));
typedef float f32x2_t __attribute__((ext_vector_type(2)));
typedef __bf16 bf16x2_t __attribute__((ext_vector_type(2)));
__device__ __forceinline__ unsigned cvt2(float lo, float hi) { f32x2_t v = {lo, hi}; bf16x2_t b = __builtin_convertvector(v, bf16x2_t); return __builtin_bit_cast(unsigned, b); }
__device__ __forceinline__ float bfu(unsigned short s) { return __builtin_bit_cast(float, ((unsigned)s) << 16); }
constexpr int RS = 272, VS = 528, AS = 144;
constexpr int L_QT = 0, L_KT = 17408, L_KH = 34816, L_V = 52224, L_AT = 86016, L_GLR = 95232, L_DEC = 99328, L_SEG = 99840, L_RED = 101888, L_GN = 103936, L_END = 104960;
#define GLA_MFMA(a, b, c) __builtin_amdgcn_mfma_f32_32x32x16_bf16((a), (b), (c), 0, 0, 0)
#define GLA_LBAR() do { asm volatile("s_waitcnt lgkmcnt(0)" ::: "memory"); __builtin_amdgcn_s_barrier(); asm volatile("" ::: "memory"); } while (0)
#define GLA_TR(off) __builtin_amdgcn_ds_read_tr16_b64_v4i16((LAS s16x4*)(lds + (off)))

constexpr size_t WS_GQT = 710 * MiB, WS_GKH = 726 * MiB, WS_GA = 742 * MiB, WS_GDEC = 750 * MiB;

__device__ __forceinline__ void gla_pre_head(const Params& P, int l, int b, int c, int h, LAS unsigned char* lds, int tid) {
    const int lane = tid & 63, w = __builtin_amdgcn_readfirstlane(tid >> 6), r = lane & 31, hh = lane >> 5;
    const int sd = tid & 127, stq = tid >> 7, t0 = c * GCH, item = (b * GH + h) * (SEQ / GCH) + c;
    const bf16* gq = (const bf16*)(P.ws + WS_PROJ) + PJ_GQ + ((size_t)(b * GH + h) * SEQ + t0) * GDK; const bf16* gk = (const bf16*)(P.ws + WS_PROJ) + PJ_GK + ((size_t)(b * GH + h) * SEQ + t0) * GDK;
    float w2r[16];
#pragma unroll
    for (int j = 0; j < 16; ++j) w2r[j] = P.gate_w2[((size_t)l * GRANK + j) * GKW + h * GDK + sd];
    const float gbias = P.gate_b[(size_t)l * GKW + h * GDK + sd];
#pragma unroll
    for (int i = 0; i < 2; ++i) { const int idx = tid + 512 * i, row = idx >> 4, ch = idx & 15;
        *(LAS u32x4*)(lds + L_QT + row * RS + ch * 16) = *(const u32x4*)(gq + (size_t)row * GDK + ch * 8);
        *(LAS u32x4*)(lds + L_KT + row * RS + ch * 16) = *(const u32x4*)(gk + (size_t)row * GDK + ch * 8); }
    float bl[16]; float run = 0.f;
#pragma unroll
    for (int i = 0; i < 16; ++i) { const LAS f32x4* gr4 = (const LAS f32x4*)(lds + L_GLR + (16 * stq + i) * 64); float x = gbias;
#pragma unroll
        for (int j = 0; j < 4; ++j) { const f32x4 gv = gr4[j]; x += (gv[0] * w2r[4 * j] + gv[1] * w2r[4 * j + 1]) + (gv[2] * w2r[4 * j + 2] + gv[3] * w2r[4 * j + 3]); }
        run -= __logf(1.0f + __expf(-x)) * (1.0f / 16.0f); bl[i] = run; }
    *(LAS float*)(lds + L_SEG + (stq * 128 + sd) * 4) = run;
    __syncthreads();
    float prefix = 0.f, total = 0.f;
#pragma unroll
    for (int j = 0; j < 4; ++j) { const float sv = *(const LAS float*)(lds + L_SEG + (j * 128 + sd) * 4); total += sv; prefix += (j < stq) ? sv : 0.f; }
    const float etot = __expf(total);
#pragma unroll
    for (int i = 0; i < 16; ++i) { const int row = 16 * stq + i; const float bb = bl[i] + prefix; const float eb = __expf(bb), enb = __builtin_amdgcn_rcpf(eb), ekl = etot * enb;
        LAS unsigned short* qp = (LAS unsigned short*)(lds + L_QT + row * RS + sd * 2); LAS unsigned short* kp = (LAS unsigned short*)(lds + L_KT + row * RS + sd * 2);
        const float qv = bfu(*qp), kv = bfu(*kp);
        *qp = (unsigned short)f2bf(qv * eb); *kp = (unsigned short)f2bf(kv * enb); *(LAS unsigned short*)(lds + L_KH + row * RS + sd * 2) = (unsigned short)f2bf(kv * ekl); }
    if (stq == 0) ((float*)(P.ws + WS_GDEC))[(size_t)item * GDK + sd] = etot;
    __syncthreads();
#pragma unroll
    for (int i = 0; i < 2; ++i) { const int idx = tid + 512 * i, row = idx >> 4, ch = idx & 15; const size_t go = (size_t)(b * SEQ + t0 + row) * GKW + h * GDK + ch * 8;
        *(u32x4*)((bf16*)(P.ws + WS_GQT) + go) = *(const LAS u32x4*)(lds + L_QT + row * RS + ch * 16);
        *(u32x4*)((bf16*)(P.ws + WS_GKH) + go) = *(const LAS u32x4*)(lds + L_KH + row * RS + ch * 16); }
    if (w < 4) { const int ti = w >> 1, si = w & 1; f32x16 at;
#pragma unroll
        for (int i = 0; i < 16; ++i) at[i] = 0.f;
        if (si <= ti) {
#pragma unroll
            for (int kk = 0; kk < 8; ++kk) { const bf16x8 a = *(const LAS bf16x8*)(lds + L_KT + (32 * si + r) * RS + (16 * kk + 8 * hh) * 2); const bf16x8 bq = *(const LAS bf16x8*)(lds + L_QT + (32 * ti + r) * RS + (16 * kk + 8 * hh) * 2);
                at = GLA_MFMA(a, bq, at); } }
        const int t = 32 * ti + r; bf16* ag = (bf16*)(P.ws + WS_GA) + ((size_t)item * GCH + t) * GCH;
#pragma unroll
        for (int g = 0; g < 4; ++g) { const int s0 = 32 * si + 8 * g + 4 * hh; float v[4];
#pragma unroll
            for (int e = 0; e < 4; ++e) v[e] = (s0 + e <= t) ? at[4 * g + e] : 0.f;
            u32x2 pkd; pkd.x = cvt2(v[0], v[1]); pkd.y = cvt2(v[2], v[3]); *(u32x2*)(ag + s0) = pkd; } }
    __syncthreads();
}

template <int VAR>
__device__ __forceinline__ void gla_seq_unit(const Params& P, int l, int bh, LAS unsigned char* lds, int tid) {
    const int lane = tid & 63, w = __builtin_amdgcn_readfirstlane(tid >> 6), r = lane & 31, hh = lane >> 5;
    const int b = bh >> 2, h = bh & 3;
    const int blk = (lane >> 4) & 1, q4 = (lane & 15) >> 2, p4 = lane & 3;
    const char* ub_v = (const char*)((const bf16*)(P.ws + WS_PROJ) + PJ_GV + (size_t)bh * SEQ * GDV); const char* ub_gr = (const char*)((const bf16*)(P.ws + WS_PROJ) + PJ_GR + (size_t)bh * SEQ * GDV);
    const char* ub_qt = (const char*)((const bf16*)(P.ws + WS_GQT) + (size_t)(b * SEQ) * GKW + h * GDK); const char* ub_kh = (const char*)((const bf16*)(P.ws + WS_GKH) + (size_t)(b * SEQ) * GKW + h * GDK);
    const char* ub_a = (const char*)((const bf16*)(P.ws + WS_GA) + (size_t)bh * (SEQ / GCH) * GCH * GCH); const char* ub_dec = (const char*)((const float*)(P.ws + WS_GDEC) + (size_t)bh * (SEQ / GCH) * GDK);
    char* ub_og = (char*)((bf16*)(P.ws + (VAR ? (size_t)760 * MiB : WS_OGOM)) + (size_t)(b * SEQ) * GVW + h * GDV);
    const unsigned vo_qk = (unsigned)((tid >> 4) * GKW * 2 + (tid & 15) * 16), vo_v = (unsigned)((tid >> 5) * GDV * 2 + (tid & 31) * 16), vo_16 = (unsigned)(tid * 16);
    const unsigned vo_ogc = (unsigned)((tid >> 5) * GVW * 2 + (tid & 31) * 16);
    constexpr int SRS = 272, SKS = 320, SVS = 576, SAS = 144;
    constexpr int S_QT = 0, S_KH = S_QT + 64 * SRS, S_V = S_KH + 64 * SKS, S_AT = S_V + 64 * SVS, S_DEC = S_AT + 64 * SAS, S_RED = S_DEC + 512, S_GN = S_RED + 2048, S_OT = S_GN + 1024, S_END = S_OT + 64 * SVS;
    static_assert(S_END <= 131072, "GLA scan LDS map");
    const unsigned tr_v = S_V + (8 * hh + q4) * SVS + (32 * w + 16 * blk + 4 * p4) * 2;
    const unsigned tr_kh = S_KH + (8 * hh + q4) * SKS + (16 * blk + 4 * p4) * 2;
    if (tid < GDV) *(LAS float*)(lds + S_GN + tid * 4) = P.gla_norm_g[(size_t)l * GDV + tid];
    f32x16 S[4];
#pragma unroll
    for (int d = 0; d < 4; ++d)
#pragma unroll
        for (int i = 0; i < 16; ++i) S[d][i] = 0.f;
    u32x4 pq[2], pk[2], pv[4], pa; f32x4 pd = {0.f, 0.f, 0.f, 0.f};
#define GLA_LOAD(c_) do { const size_t tb_ = (size_t)(c_) * GCH; \
        _Pragma("unroll") for (int i = 0; i < 2; ++i) { pq[i] = *(const u32x4*)(ub_qt + (tb_ + 32 * i) * (GKW * 2) + vo_qk); pk[i] = *(const u32x4*)(ub_kh + (tb_ + 32 * i) * (GKW * 2) + vo_qk); } \
        _Pragma("unroll") for (int i = 0; i < 4; ++i) pv[i] = *(const u32x4*)(ub_v + (tb_ + 16 * i) * (GDV * 2) + vo_v); \
        pa = *(const u32x4*)(ub_a + (size_t)(c_) * (GCH * GCH * 2) + vo_16); \
        if (tid < 32) pd = *(const f32x4*)(ub_dec + (size_t)(c_) * (GDK * 4) + vo_16); } while (0)
    GLA_LOAD(0);
    for (int c = 0; c < SEQ / GCH; ++c) {
        const int t0 = c * GCH;
#pragma unroll
        for (int i = 0; i < 2; ++i) { const int idx = tid + 512 * i, row = idx >> 4, ch = idx & 15; *(LAS u32x4*)(lds + S_QT + row * SRS + ch * 16) = pq[i]; *(LAS u32x4*)(lds + S_KH + row * SKS + ch * 16) = pk[i]; }
#pragma unroll
        for (int i = 0; i < 4; ++i) { const int idx = tid + 512 * i, row = idx >> 5, ch = idx & 31; *(LAS u32x4*)(lds + S_V + row * SVS + ch * 16) = pv[i]; }
        *(LAS u32x4*)(lds + S_AT + (tid >> 3) * SAS + (tid & 7) * 16) = pa;
        if (tid < 32) *(LAS f32x4*)(lds + S_DEC + tid * 16) = pd;
        u32x4 sg[4];
#pragma unroll
        for (int i = 0; i < 4; ++i) { if (VAR & 1) sg[i] = (u32x4){0x3f803f80u, 0x3f803f80u, 0x3f803f80u, 0x3f803f80u}; else sg[i] = *(const u32x4*)(ub_gr + (size_t)(t0 + 16 * i) * (GDV * 2) + vo_v); }
        if (c + 1 < SEQ / GCH && !((VAR & 4) && c > 0)) GLA_LOAD(c + 1);
        GLA_LBAR();
        f32x16 ot[2];
#pragma unroll
        for (int ti = 0; ti < 2; ++ti)
#pragma unroll
            for (int i = 0; i < 16; ++i) ot[ti][i] = 0.f;
        if (!(VAR & 2)) {
        bf16x8 vf[4];
#pragma unroll
        for (int kk = 0; kk < 4; ++kk) { const s16x4 lo = GLA_TR(tr_v + kk * 16 * SVS), hi = GLA_TR(tr_v + kk * 16 * SVS + 4 * SVS); vf[kk] = __builtin_shufflevector(lo, hi, 0, 1, 2, 3, 4, 5, 6, 7); }
        s16x4 bq[2][8];
#define GLA_LDBQ(buf, dblk_) do { _Pragma("unroll") for (int s = 0; s < 2; ++s) _Pragma("unroll") for (int ti = 0; ti < 2; ++ti) { \
            const LAS unsigned char* qa = lds + S_QT + (32 * ti + r) * SRS + (32 * (dblk_) + 16 * s + 4 * hh) * 2; bq[buf][(s * 2 + ti) * 2] = *(const LAS s16x4*)qa; bq[buf][(s * 2 + ti) * 2 + 1] = *(const LAS s16x4*)(qa + 16); } } while (0)
        GLA_LDBQ(0, 0);
#pragma unroll
        for (int dblk = 0; dblk < 4; ++dblk) {
            if (dblk + 1 < 4) GLA_LDBQ((dblk + 1) & 1, dblk + 1);
#pragma unroll
            for (int s = 0; s < 2; ++s) { u32x4 pa_; pa_.x = cvt2(S[dblk][8 * s + 0], S[dblk][8 * s + 1]); pa_.y = cvt2(S[dblk][8 * s + 2], S[dblk][8 * s + 3]); pa_.z = cvt2(S[dblk][8 * s + 4], S[dblk][8 * s + 5]); pa_.w = cvt2(S[dblk][8 * s + 6], S[dblk][8 * s + 7]);
                const bf16x8 a = __builtin_bit_cast(bf16x8, pa_);
#pragma unroll
                for (int ti = 0; ti < 2; ++ti) { const bf16x8 bqv = __builtin_shufflevector(bq[dblk & 1][(s * 2 + ti) * 2], bq[dblk & 1][(s * 2 + ti) * 2 + 1], 0, 1, 2, 3, 4, 5, 6, 7); ot[ti] = GLA_MFMA(a, bqv, ot[ti]); } } }
#undef GLA_LDBQ
        s16x4 kf[2][8]; f32x4 dcv[2][4];
#define GLA_LDKF(buf, dblk_) do { _Pragma("unroll") for (int kk = 0; kk < 4; ++kk) { kf[buf][2 * kk] = GLA_TR(tr_kh + (dblk_) * 64 + kk * 16 * SKS); kf[buf][2 * kk + 1] = GLA_TR(tr_kh + (dblk_) * 64 + kk * 16 * SKS + 4 * SKS); } \
            _Pragma("unroll") for (int g = 0; g < 4; ++g) dcv[buf][g] = *(const LAS f32x4*)(lds + S_DEC + (32 * (dblk_) + 8 * g + 4 * hh) * 4); } while (0)
        GLA_LDKF(0, 0);
#pragma unroll
        for (int dblk = 0; dblk < 4; ++dblk) {
            if (dblk + 1 < 4) GLA_LDKF((dblk + 1) & 1, dblk + 1);
#pragma unroll
            for (int g = 0; g < 4; ++g)
#pragma unroll
                for (int e = 0; e < 4; ++e) S[dblk][4 * g + e] *= dcv[dblk & 1][g][e];
#pragma unroll
            for (int kk = 0; kk < 4; ++kk) { const bf16x8 a = __builtin_shufflevector(kf[dblk & 1][2 * kk], kf[dblk & 1][2 * kk + 1], 0, 1, 2, 3, 4, 5, 6, 7); S[dblk] = GLA_MFMA(a, vf[kk], S[dblk]); } }
#undef GLA_LDKF
        bf16x8 baf[6];
#pragma unroll
        for (int j = 0; j < 6; ++j) { const int ti = j < 2 ? 0 : 1, kk = j < 2 ? j : j - 2; baf[j] = *(const LAS bf16x8*)(lds + S_AT + (32 * ti + r) * SAS + (16 * kk + 8 * hh) * 2); }
#pragma unroll
        for (int j = 0; j < 6; ++j) { const int ti = j < 2 ? 0 : 1, kk = j < 2 ? j : j - 2; ot[ti] = GLA_MFMA(vf[kk], baf[j], ot[ti]); }
        }
#pragma unroll
        for (int ti = 0; ti < 2; ++ti) { float ss = 0.f;
#pragma unroll
            for (int i = 0; i < 16; ++i) ss += ot[ti][i] * ot[ti][i];
            ss += __shfl_xor(ss, 32); if (hh == 0) *(LAS float*)(lds + S_RED + (w * 64 + 32 * ti + r) * 4) = ss; }
        GLA_LBAR();
#pragma unroll
        for (int ti = 0; ti < 2; ++ti) { float tot = 0.f;
#pragma unroll
            for (int ww = 0; ww < 8; ++ww) tot += *(const LAS float*)(lds + S_RED + (ww * 64 + 32 * ti + r) * 4);
            const float rstd = rsqrtf(tot * (1.0f / GDV) + EPS);
#pragma unroll
            for (int g = 0; g < 4; ++g) { const f32x4 gg = *(const LAS f32x4*)(lds + S_GN + (32 * w + 4 * hh + 8 * g) * 4);
                u32x2 pkd; pkd.x = cvt2(ot[ti][4 * g + 0] * rstd * gg[0], ot[ti][4 * g + 1] * rstd * gg[1]); pkd.y = cvt2(ot[ti][4 * g + 2] * rstd * gg[2], ot[ti][4 * g + 3] * rstd * gg[3]);
                *(LAS u32x2*)(lds + S_OT + (32 * ti + r) * SVS + (32 * w + 8 * g + 4 * hh) * 2) = pkd; } }
        GLA_LBAR();
#pragma unroll
        for (int i = 0; i < 4; ++i) { const int idx = tid + 512 * i, row = idx >> 5, ch = idx & 31; const u32x4 ov = *(const LAS u32x4*)(lds + S_OT + row * SVS + ch * 16), sv = sg[i];
            u32x4 res; res.x = cvt2(pg8::bflo(ov.x) * pg8::bflo(sv.x), pg8::bfhi(ov.x) * pg8::bfhi(sv.x)); res.y = cvt2(pg8::bflo(ov.y) * pg8::bflo(sv.y), pg8::bfhi(ov.y) * pg8::bfhi(sv.y));
            res.z = cvt2(pg8::bflo(ov.z) * pg8::bflo(sv.z), pg8::bfhi(ov.z) * pg8::bfhi(sv.z)); res.w = cvt2(pg8::bflo(ov.w) * pg8::bflo(sv.w), pg8::bfhi(ov.w) * pg8::bfhi(sv.w));
            if (!(VAR & 1) || (c == SEQ / GCH - 1)) *(u32x4*)(ub_og + (size_t)(t0 + 16 * i) * (GVW * 2) + vo_ogc) = res; }
    }
#undef GLA_LOAD
}
#undef GLA_MFMA
#undef GLA_TR
#undef GLA_LBAR
}
constexpr int NWAVES = 8;
constexpr int RING_BYTES = 131072;
constexpr int LDSCTL_OFF = RING_BYTES, MISC_OFF = LDSCTL_OFF + 320;
constexpr int LDS_BYTES = 147456;
constexpr int CW_TMO = 0, CW_QUEUE = 64, CW_BAR = 4096;
constexpr int PH_P0A = 0, PH_P0B = 1, PH_P0C = 2, PH_L0 = 3, PH_PER_LAYER = 7, PH_FINAL = PH_L0 + DEPTH * PH_PER_LAYER, PH_COUNT = PH_FINAL + 1;
constexpr int PL_IN = 0, PL_PRE = 1, PL_MIX = 2, PL_UP = 3, PL_OUT = 4, PL_FFI = 5, PL_FFO = 6;

#ifndef EN_P0
#define EN_P0 1
#endif
#ifndef EN_IN
#define EN_IN 1
#endif
#ifndef EN_PRE
#define EN_PRE 1
#endif
#ifndef EN_MOBA
#define EN_MOBA 1
#endif
#ifndef EN_GLA
#define EN_GLA 1
#endif
#ifndef EN_UP
#define EN_UP 1
#endif
#ifndef EN_OUT
#define EN_OUT 1
#endif
#ifndef EN_FFI
#define EN_FFI 1
#endif
#ifndef EN_FFO
#define EN_FFO 1
#endif
struct Args { Params P; int ph_lo, ph_hi, li, pad; };

__device__ __forceinline__ void glr_unit(const Params& P, int l, const float* ssq, int rg64, int wave, int lane, LAS unsigned char* lds) {
    const bf16* A = (const bf16*)(P.ws + WS_ABUF); const bf16* W = wt_ptr(P, l, WT_GLR);
    const int rg = wave & 3, kh = wave >> 2, r16 = lane & 15, q = lane >> 4, row0 = rg64 * 64 + rg * 16;
    const bf16* ap = A + (size_t)(row0 + r16) * DM + kh * 1024 + 8 * q; const bf16* bp = W + (size_t)r16 * DM + kh * 1024 + 8 * q;
    f32x4 acc = {0.f, 0.f, 0.f, 0.f};
#pragma unroll 8
    for (int k0 = 0; k0 < 1024; k0 += 32) acc = __builtin_amdgcn_mfma_f32_16x16x32_bf16(*(const bf16x8*)(ap + k0), *(const bf16x8*)(bp + k0), acc, 0, 0, 0);
    LAS f32x4* part = (LAS f32x4*)lds;
    if (kh == 1) part[rg * 64 + lane] = acc;
    __syncthreads();
    if (kh == 0) { const f32x4 o = part[rg * 64 + lane];
        const float* shw = (const float*)(P.ws + WS_SHWGLR) + (size_t)l * 8 * GRANK;
#pragma unroll
        for (int j = 0; j < 4; ++j) { const int row = row0 + 4 * q + j, b = row / SEQ; *(LAS float*)(lds + gla::L_GLR + ((rg * 16 + 4 * q + j) * GRANK + r16) * 4) = rsqrtf(ssq[row] * (1.f / DM) + EPS) * (acc[j] + o[j]) + shw[b * GRANK + r16]; } }
    __syncthreads();
}
__device__ __forceinline__ void kmean_unit(const Params& P, int item, int tid, LAS unsigned char* lds) {
    const int blk = item % MNB, bh = item / MNB, b = bh / MH, h = bh % MH, c8 = tid & 15, rgp = tid >> 4;
    const bf16* p = (const bf16*)(P.ws + WS_PROJ) + PJ_MK + ((size_t)bh * SEQ + blk * MBLK + rgp) * MHD + 8 * c8;
    float s[8];
#pragma unroll
    for (int j = 0; j < 8; ++j) s[j] = 0.f;
#pragma unroll
    for (int i = 0; i < 8; ++i) { const u32x4 w = *(const u32x4*)(p + (size_t)(32 * i) * MHD);
        s[0] += pg8::bflo(w.x); s[1] += pg8::bfhi(w.x); s[2] += pg8::bflo(w.y); s[3] += pg8::bfhi(w.y); s[4] += pg8::bflo(w.z); s[5] += pg8::bfhi(w.z); s[6] += pg8::bflo(w.w); s[7] += pg8::bfhi(w.w); }
    LAS float* red = (LAS float*)lds;
#pragma unroll
    for (int j = 0; j < 8; ++j) red[rgp * 128 + 8 * c8 + j] = s[j];
    __syncthreads();
    if (tid < 128) { float a = 0.f;
#pragma unroll
        for (int r = 0; r < 32; ++r) a += red[r * 128 + tid];
        ((float*)(P.ws + WS_KMEAN))[((size_t)bh * MNB + blk) * MHD + tid] = a * (1.f / MBLK); }
    __syncthreads();
}
__device__ __forceinline__ void final_row(float* x, const float* g, int m, int lane) {
    f32x4* xr = (f32x4*)(x + (size_t)m * DM); float s = 0.f; f32x4 v[8];
#pragma unroll
    for (int j = 0; j < 8; ++j) { v[j] = xr[lane + 64 * j]; s += (v[j].x * v[j].x + v[j].y * v[j].y) + (v[j].z * v[j].z + v[j].w * v[j].w); }
    const float rstd = rsqrtf(wave_sum(s) * (1.f / DM) + EPS);
#pragma unroll
    for (int j = 0; j < 8; ++j) { const f32x4 gg = *(const f32x4*)(g + 4 * (lane + 64 * j)); xr[lane + 64 * j] = v[j] * rstd * gg; }
}

template <int FK>
__device__ __forceinline__ void moba_phase(const Params& P, unsigned* queues  , char* ldsg, volatile LAS unsigned* qslot  , int tid) {
    const bf16* PROJ = (const bf16*)(P.ws + WS_PROJ); bf16* OM = FK ? (bf16*)(P.ws + (size_t)768 * MiB) : (bf16*)(P.ws + WS_OGOM) + (size_t)MT * GVW; const float* KM = (const float*)(P.ws + WS_KMEAN);
    constexpr int W = 1 << 20; constexpr unsigned NONE = 0xffffffffu;
    const unsigned x0 = xb_xcc_id() & 7u; unsigned xo = 0u;
#define MOBA_POP(dst) do { unsigned u_ = NONE; while (xo < 8u) { const unsigned x_ = (x0 + xo) & 7u; const unsigned i_ = __hip_atomic_fetch_add(queues + 64 * x_, 1u, __ATOMIC_RELAXED, __HIP_MEMORY_SCOPE_AGENT); \
        if (i_ < 64u) { u_ = (x_ << 8) | i_; break; } ++xo; } (dst) = u_; } while (0)
#define MOBA_REF(ref, u_) do { const int i_ = (int)((u_) & 63u), x_ = (int)((u_) >> 8), qb_ = MNB - 1 - (i_ >> 3), bh_ = 8 * x_ + (i_ & 7);   \
        (ref).Q = PROJ + PJ_MQ + ((size_t)bh_ * SEQ + qb_ * MBLK) * MHD; (ref).K = PROJ + PJ_MK + (size_t)bh_ * SEQ * MHD; (ref).V = PROJ + PJ_MV + (size_t)bh_ * SEQ * MHD; \
        (ref).O = OM + (size_t)((bh_ >> 3) * SEQ + qb_ * MBLK) * MW + (bh_ & 7) * MHD; (ref).P0 = qb_ * MBLK; (ref).km = KM + (size_t)bh_ * MNB * MHD; (ref).qb = qb_; } while (0)
    if (tid == 0) { unsigned a_, b_; MOBA_POP(a_); MOBA_POP(b_); qslot[0] = a_; qslot[1] = b_; }
    __syncthreads();
    unsigned u = __builtin_amdgcn_readfirstlane(qslot[0]);
    if (u == NONE) return;
    moba::Seam<bf16> S; moba::BlockRef<bf16, bf16> cur, nxt;
    MOBA_REF(cur, u);
    moba::causal_swa_prime<bf16, bf16>(cur, W, ldsg, S);
    for (int it = 0;; ++it) {
        const unsigned un = __builtin_amdgcn_readfirstlane(qslot[(it + 1) % 3]);
        if (tid == 0) { unsigned c_; MOBA_POP(c_); qslot[(it + 2) % 3] = c_; }
        const bool last = un == NONE;
        if (last) nxt = cur; else MOBA_REF(nxt, un);
        moba::causal_swa_block<bf16, bf16, FK>(cur, nxt, SEQ, W, ldsg, S);
        if (last) break;
        cur = nxt;
    }
#undef MOBA_POP
#undef MOBA_REF
}

__global__ void __launch_bounds__(NWAVES * 64, 2) mega(Args args) {
    extern __shared__ __attribute__((aligned(16))) unsigned char lds_raw[];
    LAS unsigned char* lds = (LAS unsigned char*)lds_raw;
    volatile LAS unsigned* MISC = (volatile LAS unsigned*)(lds + MISC_OFF);
    const Params& P = args.P;
    const int wave = __builtin_amdgcn_readfirstlane(threadIdx.x >> 6);
#define OTID(name) int name = threadIdx.x; asm volatile("" : "+v"(name))
    const int G = gridDim.x, bx = blockIdx.x, vcu = (G % 8 == 0) ? (bx % 8) * (G / 8) + bx / 8 : bx;
    const int gw = vcu * NWAVES + wave, ngw = G * NWAVES;
    unsigned* ctl = (unsigned*)(P.ws + WS_CTL);
    { OTID(t0); for (int u = t0; u < (LDS_BYTES - LDSCTL_OFF) / 4; u += NWAVES * 64) ((LAS unsigned*)(lds + LDSCTL_OFF))[u] = 0u; }
    __syncthreads();
    const int lo = args.ph_lo, hi = args.ph_hi;
    XcdBarrier bar; bar.bar = ctl + CW_BAR + args.li * XCD_BAR_WORDS; bar.x = 0; bar.st = nullptr;
    if (hi - lo > 1) bar = xcd_barrier_post(ctl + CW_BAR + args.li * XCD_BAR_WORDS, MISC + 8);
#define IN(k) (lo <= (k) && (k) < hi)
#if defined(PROBE_MASK)
#define PROBE_AT(k) PROBE_TY((k) < PH_L0 ? (k) : ((k) >= PH_FINAL ? 10 : PH_L0 + ((k) - PH_L0) % PH_PER_LAYER))
#define PROBE_TY(ty) do { if (blockIdx.x == 0 && threadIdx.x == 0) { const unsigned long long now_ = __builtin_amdgcn_s_memrealtime(); const int ty_ = (ty); \
        unsigned long long last_ = ((unsigned long long)MISC[21] << 32) | MISC[20], acc_ = ((unsigned long long)MISC[23] << 32) | MISC[22]; if ((PROBE_MASK >> ty_) & 1) acc_ += now_ - last_; \
        MISC[20] = (unsigned)now_; MISC[21] = (unsigned)(now_ >> 32); MISC[22] = (unsigned)acc_; MISC[23] = (unsigned)(acc_ >> 32); } } while (0)
#else
#define PROBE_AT(k) do { } while (0)
#endif
#define SEAM(k) do { if (IN(k) && IN((k) + 1)) xcd_barrier(bar); PROBE_AT(k); } while (0)
#if defined(PROBE_MASK)
    if (blockIdx.x == 0 && threadIdx.x == 0) { const unsigned long long now_ = __builtin_amdgcn_s_memrealtime(); MISC[20] = (unsigned)now_; MISC[21] = (unsigned)(now_ >> 32); MISC[22] = 0u; MISC[23] = 0u; }
#endif

    if (EN_P0 && IN(PH_P0A)) { OTID(t1); phase_p0a(P, gw, ngw, t1 & 63, (float*)(lds_raw + wave * 16384)); __syncthreads(); SEAM(PH_P0A); }
    if (EN_P0 && IN(PH_P0B)) { OTID(t1); phase_p0b(P, vcu * NWAVES * 64 + t1, G * NWAVES * 64); SEAM(PH_P0B); }
    if (EN_P0 && IN(PH_P0C)) {
        OTID(t1);
        for (int m = gw; m < MT / 2; m += ngw) a1prep_row(P, m, t1 & 63);
        shw_all(P, gw, ngw, t1 & 63);
        SEAM(PH_P0C);
    }
    for (int l = 0; l < DEPTH; ++l) {
        const int pb = PH_L0 + l * PH_PER_LAYER;
        bf16* ABUF = (bf16*)(P.ws + WS_ABUF); bf16* OGOM = (bf16*)(P.ws + WS_OGOM); bf16* PROJ = (bf16*)(P.ws + WS_PROJ); bf16* HID = PROJ;
        float* SSQA = (float*)(P.ws + WS_SSQ0); float* SSQB = (float*)(P.ws + WS_SSQ) + (size_t)l * MT; float* SSQN = (float*)(P.ws + WS_SSQ) + (size_t)(2 + l) * MT;
        const float* mv = (const float*)(P.ws + WS_MODV) + (size_t)l * 8 * 6 * DM;
        const float* mvn = (const float*)(P.ws + WS_MODV) + (size_t)(l + 1 < DEPTH ? l + 1 : l) * 8 * 6 * DM;
        const float* ssq_in = l == 0 ? SSQA : (const float*)(P.ws + WS_SSQ) + (size_t)(2 + l - 1) * MT;
        if (EN_IN && IN(pb + PL_IN)) {
            pg8::Gemm g{ABUF, wt_ptr(P, l, WT_IN), MT, NIN, DM}; pg8::StaticOrder S; S.init(MT, NIN, G, bx);
            pg8::EpiIn E{ssq_in, (const float*)(P.ws + WS_SHWIN) + (size_t)l * 8 * NIN, PROJ};
            pg8::gemm_phase<pg8::EpiIn, pg8::StaticOrder, true, true>(lds, g, S, E);
            SEAM(pb + PL_IN);
        }
        if (EN_PRE && IN(pb + PL_PRE)) {
            OTID(t2);
            for (int u = vcu; u < MT / 64; u += G) { glr_unit(P, l, ssq_in, u, wave, t2 & 63, lds);
                for (int h = 0; h < GH; ++h) gla::gla_pre_head(P, l, u >> 5, u & 31, h, lds, t2); }
            for (int it = vcu; it < NB * MH * MNB; it += G) kmean_unit(P, it, t2, lds);
            SEAM(pb + PL_PRE);
        }
        if (IN(pb + PL_MIX)) {
            if (EN_GLA && bx < NB * GH) { OTID(t3); gla::gla_seq_unit<0>(P, l, bx, lds, t3);
#if defined(GLA_PROBE_VAR)
                __syncthreads(); { OTID(t3b); gla::gla_seq_unit<GLA_PROBE_VAR>(P, l, bx, lds, t3b); }
#endif
            }
#if defined(PROBE_MASK) && defined(PROBE_SPLIT)
            xcd_barrier(bar); PROBE_TY(11);
#endif
            if (EN_MOBA) { OTID(t4); moba_phase<0>(P, ctl + CW_QUEUE + 512 * l, (char*)lds_raw, MISC + 16, t4); }
#if defined(MOBA_PROBE_VAR)
            __syncthreads(); { OTID(t4b); moba_phase<MOBA_PROBE_VAR>(P, ctl + CW_QUEUE + 1024 + 512 * l, (char*)lds_raw, MISC + 24, t4b); }
#endif
            SEAM(pb + PL_MIX);
        }
        if (EN_UP && IN(pb + PL_UP)) {
            { pg8::Gemm g{OGOM, wt_ptr(P, l, WT_UPG), MT, DM, GVW};     pg8::StaticOrder S; S.init(MT, DM, G, bx); pg8::EpiUp<false> E{PROJ, GT_OFF, ABUF};
              pg8::gemm_phase<pg8::EpiUp<false>, pg8::StaticOrder, true, true>(lds, g, S, E); }
            { pg8::Gemm g{OGOM + (size_t)MT * GVW, wt_ptr(P, l, WT_UPM), MT, DM, MW};     pg8::StaticOrder S; S.init(MT, DM, G, bx); pg8::EpiUp<true> E{PROJ, GT_OFF + DM, ABUF};
              pg8::gemm_phase<pg8::EpiUp<true>, pg8::StaticOrder, true, true>(lds, g, S, E); }
            SEAM(pb + PL_UP);
        }
        if (EN_OUT && IN(pb + PL_OUT)) {
            pg8::Gemm g{ABUF, wt_ptr(P, l, WT_OUT), MT, DM, DM}; pg8::StaticOrder S; S.init(MT, DM, G, bx);
            pg8::EpiRes E{l == 0 ? P.x : P.out, P.out, mv + 2 * DM, mv + 4 * DM, OGOM, SSQB};
            pg8::gemm_phase<pg8::EpiRes, pg8::StaticOrder, true, true>(lds, g, S, E);
            SEAM(pb + PL_OUT);
        }
        if (EN_FFI && IN(pb + PL_FFI)) {
            pg8::Gemm g{OGOM, wt_ptr(P, l, WT_FFI), MT, NFFI, DM}; pg8::StaticOrder S; S.init(MT, NFFI, G, bx);
            pg8::EpiFfi E{SSQB, (const float*)(P.ws + WS_SHWFFI) + (size_t)l * 8 * NFFI, HID};
            pg8::gemm_phase<pg8::EpiFfi, pg8::StaticOrder, true, true>(lds, g, S, E);
            SEAM(pb + PL_FFI);
        }
        if (EN_FFO && IN(pb + PL_FFO)) {
            pg8::Gemm g{HID, wt_ptr(P, l, WT_FFO), MT, DM, DFF}; pg8::StaticOrder S; S.init(MT, DM, G, bx);
            pg8::EpiRes E{P.out, P.out, mv + 5 * DM, mvn + 1 * DM, l + 1 < DEPTH ? ABUF : nullptr, l + 1 < DEPTH ? SSQN : nullptr};
            pg8::gemm_phase<pg8::EpiRes, pg8::StaticOrder, true, true>(lds, g, S, E);
            SEAM(pb + PL_FFO);
        }
    }
    if (IN(PH_FINAL)) { OTID(t5); for (int m = gw; m < MT; m += ngw) final_row(P.out, P.final_g, m, t5 & 63); }
#if defined(PROBE_MASK)
    PROBE_AT(PH_FINAL);
    if (blockIdx.x == 0 && threadIdx.x == 0) { const unsigned long long acc_ = ((unsigned long long)MISC[23] << 32) | MISC[22]; const unsigned long long t_end = __builtin_amdgcn_s_memrealtime() + (unsigned long long)(PROBE_MULT) * acc_;
        while (__builtin_amdgcn_s_memrealtime() < t_end) __builtin_amdgcn_s_sleep(8); }
#endif
#undef IN
#undef SEAM
#undef OTID
}
extern "C" void kernel_launch(void* const* d_in, const int* in_sizes, int n_in, void* d_out, int out_size, void* d_ws, size_t ws_size, hipStream_t stream) {
    static int grid = 0;
    if (grid == 0) {
        if (n_in != 16 || in_sizes[0] != MT * DM || out_size != MT * DM || ws_size < WS_NEED) { fprintf(stderr, "kernel_launch: unexpected shapes/ws (n_in %d, ws %zu, need %zu)\n", n_in, ws_size, (size_t)WS_NEED); grid = -1; return; }
        int dev = 0, cus = 0, per_cu = 0;
        if (hipGetDevice(&dev) != hipSuccess || hipDeviceGetAttribute(&cus, hipDeviceAttributeMultiprocessorCount, dev) != hipSuccess) { grid = -1; return; }
        if (hipFuncSetAttribute((const void*)mega, hipFuncAttributeMaxDynamicSharedMemorySize, LDS_BYTES) != hipSuccess) { fprintf(stderr, "kernel_launch: hipFuncSetAttribute failed\n"); grid = -1; return; }
        if (hipOccupancyMaxActiveBlocksPerMultiprocessor(&per_cu, (const void*)mega, NWAVES * 64, LDS_BYTES) != hipSuccess || per_cu < 1) fprintf(stderr, "kernel_launch: occupancy query says %d\n", per_cu);
        (void)hipGetLastError();
        grid = cus;
    }
    if (grid < 0) return;
    Args a{};
    Params& P = a.P;
    P.x = (const float*)d_in[0]; P.c = (const float*)d_in[1]; P.ada_w = (const float*)d_in[2]; P.ada_b = (const float*)d_in[3]; P.norm1_g = (const float*)d_in[4]; P.w_in = (const float*)d_in[5];
    P.gate_w2 = (const float*)d_in[6]; P.gate_b = (const float*)d_in[7]; P.gla_norm_g = (const float*)d_in[8]; P.w_up_gla = (const float*)d_in[9]; P.w_up_moba = (const float*)d_in[10];
    P.w_out = (const float*)d_in[11]; P.norm2_g = (const float*)d_in[12]; P.w_ffn_in = (const float*)d_in[13]; P.w_ffn_out = (const float*)d_in[14]; P.final_g = (const float*)d_in[15];
    P.out = (float*)d_out; P.ws = (unsigned char*)d_ws;
    unsigned char* ws = (unsigned char*)d_ws;
    (void)hipMemsetAsync(ws + WS_CTL, 0, CTL_ZERO_BYTES, stream);
#define MEGA(lo_, hi_) do { a.ph_lo = (lo_); a.ph_hi = (hi_); a.li = 0; hipLaunchKernelGGL(mega, dim3(grid), dim3(NWAVES * 64), LDS_BYTES, stream, a); } while (0)
    MEGA(0, PH_COUNT);
#undef MEGA
}
```

```cpp
#include <hip/hip_runtime.h>
#include <cstdio>
#include <cstdint>

constexpr int NB = 8, SEQ = 2048, DM = 2048, MT = NB * SEQ, DEPTH = 2;
constexpr int GH = 4, GDK = 128, GDV = 256, GKW = 512, GVW = 1024, GRANK = 16, GCH = 64;
constexpr int MH = 8, MHD = 128, MW = 1024, MBLK = 256, MNB = SEQ / MBLK, MTOPK = 3;
constexpr int DFF = 5632, NFFI = 2 * DFF;
constexpr int NINSRC = 10256, NIN = 10240;
constexpr float EPS = 1e-6f;
constexpr int GQ_OFF = 0, GK_OFF = 512, GV_OFF = 1024, GR_OFF = 2048, MQ_OFF = 3072, MK_OFF = 4096, MV_OFF = 5120, GT_OFF = 6144;
constexpr int GLR_SRC = 3072;
constexpr size_t PJ_GQ = 0, PJ_GK = (size_t)MT * 512, PJ_GV = (size_t)MT * 1024, PJ_GR = (size_t)MT * 2048, PJ_MQ = (size_t)MT * 3072, PJ_MK = (size_t)MT * 4096, PJ_MV = (size_t)MT * 5120, PJ_GT = (size_t)MT * 6144;

constexpr size_t MiB = 1u << 20;
constexpr size_t WS_CTL = 0, CTL_ZERO_BYTES = 2 * MiB;
constexpr size_t WS_SSQ = 1 * MiB;
constexpr size_t WS_MODP = 2 * MiB;
constexpr size_t WS_MODV = 8 * MiB;
constexpr size_t WS_SHWIN = 9 * MiB;
constexpr size_t WS_SHWFFI = 10 * MiB;
constexpr size_t WS_SHWGLR = 11 * MiB;
constexpr size_t WS_GLR = 12 * MiB;
constexpr size_t WS_KMEAN = 13 * MiB;
constexpr size_t WS_SSQ0 = 14 * MiB;
constexpr size_t WS_WT = 16 * MiB, WT_LAYER = 123 * MiB;
constexpr size_t WT_IN = 0, WT_GLR = 40 * MiB, WT_UPG = 41 * MiB, WT_UPM = 45 * MiB, WT_OUT = 49 * MiB, WT_FFI = 57 * MiB, WT_FFO = 101 * MiB;
constexpr size_t WS_ABUF = 262 * MiB;
constexpr size_t WS_OGOM = 326 * MiB;
constexpr size_t WS_PROJ = 390 * MiB;
constexpr size_t WS_END = 710 * MiB;
constexpr size_t WS_DBG_G = 710 * MiB;
constexpr size_t WS_DBG_O = 742 * MiB;
constexpr size_t WS_DBG_END = 806 * MiB;
constexpr size_t WS_NEED = 752 * MiB;

typedef unsigned short bf16;
typedef short bf16x8 __attribute__((ext_vector_type(8)));
typedef float f32x4 __attribute__((ext_vector_type(4)));
typedef unsigned u32x4 __attribute__((ext_vector_type(4)));
typedef unsigned u32x2 __attribute__((ext_vector_type(2)));

struct Params {
    const float* x; const float* c; const float* ada_w; const float* ada_b; const float* norm1_g; const float* w_in;
    const float* gate_w2; const float* gate_b; const float* gla_norm_g; const float* w_up_gla; const float* w_up_moba;
    const float* w_out; const float* norm2_g; const float* w_ffn_in; const float* w_ffn_out; const float* final_g;
    float* out; unsigned char* ws;
};

__device__ __forceinline__ unsigned f2bf(float f) { unsigned u = __builtin_bit_cast(unsigned, f); return (u + 0x7fffu + ((u >> 16) & 1u)) >> 16; }
__device__ __forceinline__ unsigned pk2(float lo, float hi) { return f2bf(lo) | (f2bf(hi) << 16); }
__device__ __forceinline__ float bf2f(unsigned short b) { return __builtin_bit_cast(float, ((unsigned)b) << 16); }
__device__ __forceinline__ float wave_sum(float v) {
#pragma unroll
    for (int o = 1; o < 64; o <<= 1) v += __shfl_xor(v, o);
    return v;
}
__device__ __forceinline__ float sigmoidf_(float v) { return 1.0f / (1.0f + __expf(-v)); }
__device__ __forceinline__ float siluf_(float v) { return v / (1.0f + __expf(-v)); }
__device__ __forceinline__ float logsigmoidf_(float v) { return fminf(v, 0.f) - log1pf(__expf(-fabsf(v))); }

__device__ __forceinline__ const bf16* wt_ptr(const Params& P, int l, size_t off) { return (const bf16*)(P.ws + WS_WT + (size_t)l * WT_LAYER + off); }
__device__ __forceinline__ int in_src_col(int n) { return n < 3072 ? n : n + 16; }
__device__ __forceinline__ int ffi_src_col(int r) { const int pn = r >> 8, c = r & 255; return c < 128 ? pn * 128 + c : DFF + pn * 128 + (c - 128); }

__device__ __forceinline__ void ada_item(const Params& P, int item, int lane, float* scr) {
    const int cg = item % 96, kc = (item / 96) % 8, l = item / 768;
    const int k0 = kc * 256;
    for (int i = 0; i < 32; ++i) { const int idx = lane + 64 * i, b = idx >> 8, kk = idx & 255; scr[idx] = siluf_(P.c[b * DM + k0 + kk]); }
    __builtin_amdgcn_s_waitcnt(0);
    const float* W = P.ada_w + (size_t)l * DM * (6 * DM) + (size_t)k0 * (6 * DM) + cg * 128 + 2 * lane;
    float a0[8], a1[8];
#pragma unroll
    for (int b = 0; b < 8; ++b) { a0[b] = 0.f; a1[b] = 0.f; }
#pragma unroll 8
    for (int kk = 0; kk < 256; ++kk) {
        typedef float f32x2n __attribute__((ext_vector_type(2))); const f32x2n w = __builtin_nontemporal_load((const f32x2n*)(W + (size_t)kk * (6 * DM)));
#pragma unroll
        for (int b = 0; b < 8; ++b) { const float cv = scr[b * 256 + kk]; a0[b] += cv * w.x; a1[b] += cv * w.y; }
    }
    float* MP = (float*)(P.ws + WS_MODP) + ((size_t)(kc * 2 + l) * 8) * (6 * DM) + cg * 128 + 2 * lane;
#pragma unroll
    for (int b = 0; b < 8; ++b) *(float2*)(MP + (size_t)b * (6 * DM)) = make_float2(a0[b], a1[b]);
    __builtin_amdgcn_s_waitcnt(0);
}
__device__ __forceinline__ void transpose_item(const float* W, int Nsrc, int src_col0, int K, int k0, bf16* WT, int dst_row0, float* scr, int lane) {
    f32x4 v[8];
    const float* src = W + (size_t)(k0 + (lane >> 3)) * Nsrc + src_col0 + 4 * (lane & 7);
#pragma unroll
    for (int i = 0; i < 8; ++i) v[i] = __builtin_nontemporal_load((const f32x4*)(src + (size_t)(8 * i) * Nsrc));
#pragma unroll
    for (int i = 0; i < 8; ++i) { float* d = scr + (8 * i + (lane >> 3)) * 33 + 4 * (lane & 7); d[0] = v[i][0]; d[1] = v[i][1]; d[2] = v[i][2]; d[3] = v[i][3]; }
    __builtin_amdgcn_s_waitcnt(0);
    const int c = lane & 7;
#pragma unroll
    for (int j = 0; j < 4; ++j) { const int n = (lane >> 3) + 8 * j; const float* s = scr + (8 * c) * 33 + n;
        u32x4 o; o.x = pk2(s[0 * 33], s[1 * 33]); o.y = pk2(s[2 * 33], s[3 * 33]); o.z = pk2(s[4 * 33], s[5 * 33]); o.w = pk2(s[6 * 33], s[7 * 33]);
        *(u32x4*)(WT + (size_t)(dst_row0 + n) * K + k0 + 8 * c) = o; }
    __builtin_amdgcn_s_waitcnt(0);
}
constexpr int TI_IN = (DM / 64) * (NIN / 32), TI_UP = (GVW / 64) * (DM / 32), TI_OUT = (DM / 64) * (DM / 32), TI_FFI = (DM / 64) * (NFFI / 32), TI_FFO = (DFF / 64) * (DM / 32), TI_GLR = DM / 64;
constexpr int TI_LAYER = TI_IN + 2 * TI_UP + TI_OUT + TI_FFI + TI_FFO + TI_GLR;
__device__ __forceinline__ void wconv_item(const Params& P, int item, int lane, float* scr) {
    const int l = item / TI_LAYER; int r = item % TI_LAYER;
    unsigned char* wl = P.ws + WS_WT + (size_t)l * WT_LAYER;
    if (r < TI_IN) { const int nb = r % (NIN / 32), kb = r / (NIN / 32);
        transpose_item(P.w_in + (size_t)l * DM * NINSRC, NINSRC, in_src_col(nb * 32), DM, kb * 64, (bf16*)(wl + WT_IN), nb * 32, scr, lane); return; } r -= TI_IN;
    if (r < TI_UP) { const int nb = r % (DM / 32), kb = r / (DM / 32);
        transpose_item(P.w_up_gla + (size_t)l * GVW * DM, DM, nb * 32, GVW, kb * 64, (bf16*)(wl + WT_UPG), nb * 32, scr, lane); return; } r -= TI_UP;
    if (r < TI_UP) { const int nb = r % (DM / 32), kb = r / (DM / 32);
        transpose_item(P.w_up_moba + (size_t)l * MW * DM, DM, nb * 32, MW, kb * 64, (bf16*)(wl + WT_UPM), nb * 32, scr, lane); return; } r -= TI_UP;
    if (r < TI_OUT) { const int nb = r % (DM / 32), kb = r / (DM / 32);
        transpose_item(P.w_out + (size_t)l * DM * DM, DM, nb * 32, DM, kb * 64, (bf16*)(wl + WT_OUT), nb * 32, scr, lane); return; } r -= TI_OUT;
    if (r < TI_FFI) { const int nb = r % (NFFI / 32), kb = r / (NFFI / 32);
        transpose_item(P.w_ffn_in + (size_t)l * DM * NFFI, NFFI, ffi_src_col(nb * 32), DM, kb * 64, (bf16*)(wl + WT_FFI), nb * 32, scr, lane); return; } r -= TI_FFI;
    if (r < TI_FFO) { const int nb = r % (DM / 32), kb = r / (DM / 32);
        transpose_item(P.w_ffn_out + (size_t)l * DFF * DM, DM, nb * 32, DFF, kb * 64, (bf16*)(wl + WT_FFO), nb * 32, scr, lane); return; } r -= TI_FFO;
    { const int k0 = r * 64, j = lane & 15, kq = lane >> 4; bf16* G = (bf16*)(wl + WT_GLR); const float* W = P.w_in + (size_t)l * DM * NINSRC;
        for (int kk = 0; kk < 16; ++kk) { const int k = k0 + kq * 16 + kk; G[(size_t)j * DM + k] = (bf16)f2bf(W[(size_t)k * NINSRC + GLR_SRC + j]); } }
}
__device__ __forceinline__ void phase_p0a(const Params& P, int gw, int ngw, int lane, float* scr) {
    constexpr int NADA = 2 * 8 * 96;
    for (int it = gw; it < NADA; it += ngw) ada_item(P, it, lane, scr);
    for (int it = gw; it < DEPTH * TI_LAYER; it += ngw) wconv_item(P, it, lane, scr);
}
__device__ __forceinline__ void phase_p0b(const Params& P, int gtid, int ngt) {
    const float* MP = (const float*)(P.ws + WS_MODP); float* MV = (float*)(P.ws + WS_MODV);
    for (int i = gtid; i < 2 * 8 * DM; i += ngt) {
        const int j = i % DM, b = (i / DM) % 8, l = i / (8 * DM);
        float m[6];
#pragma unroll
        for (int s = 0; s < 6; ++s) { float a = P.ada_b[l * 6 * DM + s * DM + j];
            for (int kc = 0; kc < 8; ++kc) a += MP[((size_t)(kc * 2 + l) * 8 + b) * (6 * DM) + s * DM + j]; m[s] = a; }
        float* o = MV + ((size_t)(l * 8 + b) * 6) * DM + j;
        o[0 * DM] = m[0]; o[1 * DM] = P.norm1_g[l * DM + j] * (1.f + m[1]); o[2 * DM] = m[2];
        o[3 * DM] = m[3]; o[4 * DM] = P.norm2_g[l * DM + j] * (1.f + m[4]); o[5 * DM] = m[5];
    }
}
__device__ __forceinline__ void a1prep_row(const Params& P, int m0, int lane) {
    f32x4 v[2][8];
#pragma unroll
    for (int rr = 0; rr < 2; ++rr) { const f32x4* xr = (const f32x4*)(P.x + (size_t)(m0 + rr * (MT / 2)) * DM);
#pragma unroll
        for (int j = 0; j < 8; ++j) v[rr][j] = xr[lane + 64 * j]; }
#pragma unroll
    for (int rr = 0; rr < 2; ++rr) { const int m = m0 + rr * (MT / 2), b = m / SEQ; const float* gm = (const float*)(P.ws + WS_MODV) + ((size_t)(0 * 8 + b) * 6 + 1) * DM;
        bf16* A = (bf16*)(P.ws + WS_ABUF) + (size_t)m * DM; float s = 0.f;
#pragma unroll
        for (int j = 0; j < 8; ++j) { const f32x4 x4 = v[rr][j]; const f32x4 g = *(const f32x4*)(gm + 4 * (lane + 64 * j));
            s += (x4.x * x4.x + x4.y * x4.y) + (x4.z * x4.z + x4.w * x4.w);
            u32x2 w; w.x = pk2(x4.x * g.x, x4.y * g.y); w.y = pk2(x4.z * g.z, x4.w * g.w); *(u32x2*)(A + 4 * (lane + 64 * j)) = w; }
        s = wave_sum(s);
        if (lane == 0) ((float*)(P.ws + WS_SSQ0))[m] = s; }
}
constexpr int SHW_T_IN = (NIN + GRANK) / 16, SHW_T_FFI = NFFI / 16, SHW_TILES = DEPTH * (SHW_T_IN + SHW_T_FFI);
__device__ __forceinline__ void shw_all(const Params& P, int gw, int ngw, int lane) {
    const float* MV = (const float*)(P.ws + WS_MODV); const int r16 = lane & 15, q = lane >> 4;
    for (int item = gw; item < SHW_TILES; item += ngw) {
        const int l = item / (SHW_T_IN + SHW_T_FFI), rr = item % (SHW_T_IN + SHW_T_FFI), which = rr >= SHW_T_IN ? 1 : 0, n0 = (which ? rr - SHW_T_IN : rr) * 16;
        const bf16* rows = which ? wt_ptr(P, l, WT_FFI) + (size_t)n0 * DM : (n0 < NIN ? wt_ptr(P, l, WT_IN) + (size_t)n0 * DM : wt_ptr(P, l, WT_GLR));
        const bf16* bp = rows + (size_t)r16 * DM + 8 * q; const float* ap = MV + ((size_t)(l * 8 + (r16 & 7)) * 6 + (which ? 3 : 0)) * DM + 8 * q;
        f32x4 acc = {0.f, 0.f, 0.f, 0.f};
#pragma unroll 1
        for (int kb = 0; kb < DM; kb += 256) { bf16x8 bw[8]; f32x4 a0[8], a1[8];
#pragma unroll
            for (int j = 0; j < 8; ++j) { bw[j] = *(const bf16x8*)(bp + kb + 32 * j); a0[j] = *(const f32x4*)(ap + kb + 32 * j); a1[j] = *(const f32x4*)(ap + kb + 32 * j + 4); }
#pragma unroll
            for (int j = 0; j < 8; ++j) { u32x4 aw; aw.x = pk2(a0[j].x, a0[j].y); aw.y = pk2(a0[j].z, a0[j].w); aw.z = pk2(a1[j].x, a1[j].y); aw.w = pk2(a1[j].z, a1[j].w);
                acc = __builtin_amdgcn_mfma_f32_16x16x32_bf16(__builtin_bit_cast(bf16x8, aw), bw[j], acc, 0, 0, 0); } }
        if (q < 2) {
#pragma unroll
            for (int j = 0; j < 4; ++j) { const int b = 4 * q + j, n = n0 + r16;
                if (which) ((float*)(P.ws + WS_SHWFFI))[((size_t)l * 8 + b) * NFFI + n] = acc[j];
                else if (n0 < NIN) ((float*)(P.ws + WS_SHWIN))[((size_t)l * 8 + b) * NIN + n] = acc[j];
                else ((float*)(P.ws + WS_SHWGLR))[((size_t)l * 8 + b) * GRANK + (n - NIN)] = acc[j]; } }
    }
}

namespace pg8 {
#define PG8_LAS __attribute__((address_space(3)))
typedef unsigned short bf16_t;
typedef short bf16x8 __attribute__((ext_vector_type(8)));
typedef float f32x4 __attribute__((ext_vector_type(4)));
typedef unsigned u32x4 __attribute__((ext_vector_type(4)));
constexpr int BM = 256, BK = 64, HALF = 128, HTB = HALF * BK * 2  , STAGE_BYTES = 8 * HTB, NXCD = 8, WGM = 8;

__host__ __device__ __forceinline__ int lds_byte(int r, int c) { const int st = (r >> 4) * 2 + (c >> 5), rr = r & 15, cc = c & 31, ob = rr * 64 + cc * 2; return st * 1024 + (ob ^ (((ob >> 9) & 1) << 5)); }
__host__ __device__ __forceinline__ void stage_rc(int b, int& R, int& C) { const int st = b / 1024, sb = b % 1024, swz = sb ^ (((sb >> 9) & 1) << 5); R = (st >> 1) * 16 + swz / 64; C = (st & 1) * 32 + (swz % 64) / 2; }
__host__ __device__ __forceinline__ int perm32(int rho) { const int n = rho >> 4, i = rho & 15; return 8 * (i >> 2) + 4 * n + (i & 3); }

struct Unit { int pm, pn; };
struct Gemm { const bf16_t* A; const bf16_t* Bt; int M, N, K; };

struct StaticOrder {
    int nM, nN, nwg, G, c;
    __host__ __device__ void init(int M, int N, int G_, int c_) { nM = M / BM; nN = N / BM; nwg = nM * nN; G = G_; c = c_; }
    __host__ __device__ bool next(int i, Unit& u) const {
        const long L = (long)i * G + c; if (L >= nwg) return false;
        int wgid = (int)L; { const int q = nwg / NXCD, r = nwg % NXCD, xcd = wgid % NXCD, off = wgid / NXCD; wgid = (xcd < r ? xcd * (q + 1) : r * (q + 1) + (xcd - r) * q) + off; }
        const int nig = WGM * nN, gid = wgid / nig, fm = gid * WGM, gsz = (nM - fm) < WGM ? (nM - fm) : WGM;
        u.pm = fm + ((wgid % nig) % gsz); u.pn = (wgid % nig) / gsz; return true;
    }
    __device__ __forceinline__ void a_ready(const Unit&) const {}
    __device__ __forceinline__ void done(const Unit&) const {}
};
__device__ __forceinline__ unsigned cvt_pk_bf16(float lo, float hi) { unsigned r; asm volatile("v_cvt_pk_bf16_f32 %0, %1, %2" : "=v"(r) : "v"(lo), "v"(hi)); return r; }
typedef float f32x2 __attribute__((ext_vector_type(2)));
__device__ __forceinline__ float fsig(float v) { return __builtin_amdgcn_rcpf(1.0f + __builtin_amdgcn_exp2f(-1.4426950408889634f * v)); }
__device__ __forceinline__ float bflo(unsigned w) { return __builtin_bit_cast(float, w << 16); }
__device__ __forceinline__ float bfhi(unsigned w) { return __builtin_bit_cast(float, w & 0xffff0000u); }
struct EpiIn {
    static constexpr bool PERM = true, AFTER_DRAIN = false;
    const float* ssq; const float* shw; bf16_t* proj;
    __device__ __forceinline__ void operator()(const f32x4 (&acc)[2][2][4][2], const Unit& u, int wr, int wc, int fr, int fq) const {
        const int row0 = u.pm * BM + wr * 64 + fr, col0 = u.pn * BM + wc * 32 + 8 * fq, b = u.pm >> 3, t0 = (u.pm & 7) * BM + wr * 64 + fr;
        const int mode = u.pn < 2 ? 1 : ((u.pn >= 8 && u.pn < 12) ? 2 : (u.pn >= 24 ? 3 : 0));
        size_t off[2]; int stride;
        if (u.pn >= 24) { stride = 4096; off[0] = PJ_GT + (size_t)b * SEQ * 4096 + (u.pn * BM - GT_OFF) + wc * 32 + 8 * fq; off[1] = off[0] + HALF; }
        else { const int seg = u.pn < 2 ? 0 : u.pn < 4 ? 1 : u.pn < 8 ? 2 : u.pn < 12 ? 3 : u.pn < 16 ? 4 : u.pn < 20 ? 5 : 6;
            const size_t base = seg == 0 ? PJ_GQ : seg == 1 ? PJ_GK : seg == 2 ? PJ_GV : seg == 3 ? PJ_GR : seg == 4 ? PJ_MQ : seg == 5 ? PJ_MK : PJ_MV;
            const int c0 = seg == 0 ? GQ_OFF : seg == 1 ? GK_OFF : seg == 2 ? GV_OFF : seg == 3 ? GR_OFF : seg == 4 ? MQ_OFF : seg == 5 ? MK_OFF : MV_OFF;
            const bool wide = (seg == 2 || seg == 3); const int nh = seg >= 4 ? MH : GH; stride = wide ? 256 : 128;
#pragma unroll
            for (int bj = 0; bj < 2; ++bj) { const int cs = u.pn * BM - c0 + bj * HALF, head = wide ? (cs >> 8) : (cs >> 7), d = (wide ? (cs & 255) : 0) + wc * 32 + 8 * fq;
                off[bj] = base + ((size_t)(b * nh + head) * SEQ) * stride + d; } }
        f32x4 bv[2][2];
#pragma unroll
        for (int bj = 0; bj < 2; ++bj)
#pragma unroll
            for (int n = 0; n < 2; ++n) bv[bj][n] = *(const f32x4*)(shw + (size_t)b * NIN + col0 + bj * HALF + 4 * n);
#pragma unroll
        for (int ai = 0; ai < 2; ++ai)
#pragma unroll
            for (int m = 0; m < 4; ++m) { const int r = row0 + ai * HALF + m * 16, t = t0 + ai * HALF + m * 16; const float rstd = rsqrtf(ssq[r] * (1.0f / DM) + EPS);
#pragma unroll
                for (int bj = 0; bj < 2; ++bj) { f32x4 v0 = acc[ai][bj][m][0] * rstd + bv[bj][0], v1 = acc[ai][bj][m][1] * rstd + bv[bj][1];
                    if (mode == 1) { v0 = v0 * 0.08838834764831845f; v1 = v1 * 0.08838834764831845f; }
                    else if (mode == 2) {
#pragma unroll
                        for (int j = 0; j < 4; ++j) { v0[j] = v0[j] * fsig(v0[j]); v1[j] = v1[j] * fsig(v1[j]); } }
                    else if (mode == 3) {
#pragma unroll
                        for (int j = 0; j < 4; ++j) { v0[j] = fsig(v0[j]); v1[j] = fsig(v1[j]); } }
                    u32x4 w; w.x = cvt_pk_bf16(v0[0], v0[1]); w.y = cvt_pk_bf16(v0[2], v0[3]); w.z = cvt_pk_bf16(v1[0], v1[1]); w.w = cvt_pk_bf16(v1[2], v1[3]);
                    *(u32x4*)(proj + off[bj] + (size_t)t * stride) = w; } }
    }
};
struct EpiFfi {
    static constexpr bool PERM = true, AFTER_DRAIN = false;
    const float* ssq; const float* shw; bf16_t* hid;
    __device__ __forceinline__ void operator()(const f32x4 (&acc)[2][2][4][2], const Unit& u, int wr, int wc, int fr, int fq) const {
        const int row0 = u.pm * BM + wr * 64 + fr, bcol0 = u.pn * BM + wc * 32 + 8 * fq, hcol0 = u.pn * HALF + wc * 32 + 8 * fq, b = u.pm >> 3;
        f32x4 bv[2][2];
#pragma unroll
        for (int bj = 0; bj < 2; ++bj)
#pragma unroll
            for (int n = 0; n < 2; ++n) bv[bj][n] = *(const f32x4*)(shw + (size_t)b * NFFI + bcol0 + bj * HALF + 4 * n);
#pragma unroll
        for (int ai = 0; ai < 2; ++ai)
#pragma unroll
            for (int m = 0; m < 4; ++m) { const int r = row0 + ai * HALF + m * 16; const float rstd = rsqrtf(ssq[r] * (1.0f / DM) + EPS);
                f32x4 a0 = acc[ai][0][m][0] * rstd + bv[0][0], a1 = acc[ai][0][m][1] * rstd + bv[0][1];
                const f32x4 u0 = acc[ai][1][m][0] * rstd + bv[1][0], u1 = acc[ai][1][m][1] * rstd + bv[1][1];
#pragma unroll
                for (int j = 0; j < 4; ++j) { a0[j] = a0[j] * fsig(a0[j]) * u0[j]; a1[j] = a1[j] * fsig(a1[j]) * u1[j]; }
                u32x4 w; w.x = cvt_pk_bf16(a0[0], a0[1]); w.y = cvt_pk_bf16(a0[2], a0[3]); w.z = cvt_pk_bf16(a1[0], a1[1]); w.w = cvt_pk_bf16(a1[2], a1[3]);
                *(u32x4*)(hid + (size_t)r * DFF + hcol0) = w; }
    }
};
template <bool SECOND> struct EpiUp {
    static constexpr bool PERM = true, AFTER_DRAIN = false;
    const bf16_t* proj; int goff; bf16_t* mg;
    __device__ __forceinline__ void operator()(const f32x4 (&acc)[2][2][4][2], const Unit& u, int wr, int wc, int fr, int fq) const {
        const int row0 = u.pm * BM + wr * 64 + fr, col0 = u.pn * BM + wc * 32 + 8 * fq;
#pragma unroll
        for (int ai = 0; ai < 2; ++ai)
#pragma unroll
            for (int m = 0; m < 4; ++m) { const int r = row0 + ai * HALF + m * 16;
#pragma unroll
                for (int bj = 0; bj < 2; ++bj) { const u32x4 g = *(const u32x4*)(proj + PJ_GT + (size_t)r * 4096 + (goff - GT_OFF) + col0 + bj * HALF);
                    bf16_t* op = mg + (size_t)r * DM + col0 + bj * HALF;
                    f32x4 v0 = acc[ai][bj][m][0], v1 = acc[ai][bj][m][1];
                    v0[0] *= bflo(g.x); v0[1] *= bfhi(g.x); v0[2] *= bflo(g.y); v0[3] *= bfhi(g.y); v1[0] *= bflo(g.z); v1[1] *= bfhi(g.z); v1[2] *= bflo(g.w); v1[3] *= bfhi(g.w);
                    if (SECOND) { const u32x4 t = *(const u32x4*)op;
                        v0[0] += bflo(t.x); v0[1] += bfhi(t.x); v0[2] += bflo(t.y); v0[3] += bfhi(t.y); v1[0] += bflo(t.z); v1[1] += bfhi(t.z); v1[2] += bflo(t.w); v1[3] += bfhi(t.w); }
                    u32x4 w; w.x = cvt_pk_bf16(v0[0], v0[1]); w.y = cvt_pk_bf16(v0[2], v0[3]); w.z = cvt_pk_bf16(v1[0], v1[1]); w.w = cvt_pk_bf16(v1[2], v1[3]);
                    *(u32x4*)op = w; }
                asm volatile("" ::: "memory"); }
    }
};
struct EpiRes {
    static constexpr bool PERM = false, AFTER_DRAIN = false;
    const float* xin; float* xout; const float* gate; const float* gm; bf16_t* aout; float* ssq;
    __device__ __forceinline__ void operator()(const f32x4 (&acc)[2][2][4][2], const Unit& u, int wr, int wc, int fr, int fq) const {
        const int row0 = u.pm * BM + wr * 64 + fr, col0 = u.pn * BM + wc * 32 + 4 * fq, b = u.pm >> 3;
        f32x4 gv[2][2], mv[2][2];
#pragma unroll
        for (int bj = 0; bj < 2; ++bj)
#pragma unroll
            for (int n = 0; n < 2; ++n) { gv[bj][n] = *(const f32x4*)(gate + (size_t)b * 6 * DM + col0 + bj * HALF + n * 16);
                mv[bj][n] = aout ? *(const f32x4*)(gm + (size_t)b * 6 * DM + col0 + bj * HALF + n * 16) : (f32x4){0.f, 0.f, 0.f, 0.f}; }
#pragma unroll
        for (int ai = 0; ai < 2; ++ai)
#pragma unroll
            for (int m = 0; m < 4; ++m) { const int r = row0 + ai * HALF + m * 16; const size_t off = (size_t)r * DM + col0; float s = 0.f;
#pragma unroll
                for (int bj = 0; bj < 2; ++bj)
#pragma unroll
                    for (int n = 0; n < 2; ++n) { const f32x4 xv = *(const f32x4*)(xin + off + bj * HALF + n * 16); const f32x4 o = xv + gv[bj][n] * acc[ai][bj][m][n];
                        *(f32x4*)(xout + off + bj * HALF + n * 16) = o; s += (o[0] * o[0] + o[1] * o[1]) + (o[2] * o[2] + o[3] * o[3]);
                        if (aout) { const f32x4 a = o * mv[bj][n]; u32x2 w; w.x = cvt_pk_bf16(a[0], a[1]); w.y = cvt_pk_bf16(a[2], a[3]); *(u32x2*)(aout + off + bj * HALF + n * 16) = w; } }
                if (ssq) { s += __shfl_xor(s, 16); s += __shfl_xor(s, 32); if (fq == 0) __hip_atomic_fetch_add(ssq + r, s, __ATOMIC_RELAXED, __HIP_MEMORY_SCOPE_AGENT); }
                asm volatile("" ::: "memory"); }
    }
};
template <class Epi, class Sched, bool ALIGN_EPI = false, bool SP2 = false>
__device__ __forceinline__ void gemm_phase(PG8_LAS unsigned char* lds, const Gemm g, const Sched& S, const Epi& E) {
    int tid_ = threadIdx.x; asm volatile("" : "+v"(tid_));
    const int tid = tid_, wid = __builtin_amdgcn_readfirstlane(tid >> 6), lane = tid & 63, wr = wid >> 2, wc = wid & 3, fr = lane & 15, fq = lane >> 4;
    const int K = g.K, nt = K / BK;
    unsigned voffA[2], voffB[2];
#pragma unroll
    for (int i = 0; i < 2; ++i) { int R, C; stage_rc(tid * 16 + i * 8192, R, C); const int Rb = Epi::PERM ? ((R & ~31) + perm32(R & 31)) : R;
        voffA[i] = (unsigned)(R * K + C) * 2u; voffB[i] = (unsigned)(Rb * K + C) * 2u; }
    const size_t kstep = (size_t)(BK * 2);
    const size_t hstep = (size_t)HALF * K * 2;
    const size_t tstep = 2 * hstep;
    const unsigned ldsw = (unsigned)wid * 1024u;
    const int aoff = lds_byte(wr * 64 + fr, fq * 8), boff = lds_byte(wc * 32 + fr, fq * 8);
#define PG8_SA(b, h) (((b) * 2 + (h)) * HTB)
#define PG8_SB(b, h) ((4 + (b) * 2 + (h)) * HTB)
#define PG8_STAGE(bufoff, gbase, voff) do { _Pragma("unroll") for (int _i = 0; _i < 2; ++_i) \
        __builtin_amdgcn_global_load_lds((const unsigned*)((const char*)(gbase) + (voff)[_i]), (PG8_LAS unsigned*)(lds + (bufoff) + ldsw + _i * 8192), 16, 0, 0); } while (0)
#define PG8_LDA(dst, b, h) do { _Pragma("unroll") for (int m = 0; m < 4; ++m) _Pragma("unroll") for (int k = 0; k < 2; ++k) dst[m][k] = *(const PG8_LAS bf16x8*)(lds + PG8_SA(b, h) + aoff + m * 2048 + k * 1024); } while (0)
#define PG8_LDB(dst, b, h) do { _Pragma("unroll") for (int n = 0; n < 2; ++n) _Pragma("unroll") for (int k = 0; k < 2; ++k) dst[n][k] = *(const PG8_LAS bf16x8*)(lds + PG8_SB(b, h) + boff + n * 2048 + k * 1024); } while (0)
#define PG8_MMA(ai, bj, At, Bt) do { __builtin_amdgcn_s_setprio(1); _Pragma("unroll") for (int m = 0; m < 4; ++m) _Pragma("unroll") for (int n = 0; n < 2; ++n) _Pragma("unroll") for (int k = 0; k < 2; ++k) \
        acc[ai][bj][m][n] = __builtin_amdgcn_mfma_f32_16x16x32_bf16(Bt[n][k], At[m][k], acc[ai][bj][m][n], 0, 0, 0); __builtin_amdgcn_s_setprio(0); } while (0)
#define PG8_WAIT_V(n) asm volatile("s_waitcnt vmcnt(" #n ")" ::: "memory")
#define PG8_WAIT_L(n) asm volatile("s_waitcnt lgkmcnt(" #n ")" ::: "memory")
#define PG8_BAR __builtin_amdgcn_s_barrier()
#define PG8_SCHED __builtin_amdgcn_sched_barrier(0)
    Unit cur, nxt; int ui = 0;
    if (!S.next(0, cur)) return;
    f32x4 acc[2][2][4][2];
#pragma unroll
    for (int a = 0; a < 2; ++a)
#pragma unroll
        for (int b = 0; b < 2; ++b)
#pragma unroll
            for (int m = 0; m < 4; ++m)
#pragma unroll
                for (int n = 0; n < 2; ++n) acc[a][b][m][n] = (f32x4){0.f, 0.f, 0.f, 0.f};
    bf16x8 At[4][2], B0[2][2], B1[2][2];
    const char* cA = (const char*)g.A + (size_t)cur.pm * tstep; const char* cB = (const char*)g.Bt + (size_t)cur.pn * tstep;
    S.a_ready(cur);
    if constexpr (SP2) {
        PG8_STAGE(PG8_SB(0, 0), cB, voffB); PG8_STAGE(PG8_SB(0, 1), cB + hstep, voffB); PG8_STAGE(PG8_SA(0, 0), cA, voffA); PG8_STAGE(PG8_SA(0, 1), cA + hstep, voffA);
        if (wr == 1) PG8_BAR;
        PG8_WAIT_V(2); PG8_BAR;
        PG8_STAGE(PG8_SB(1, 0), cB + kstep, voffB); PG8_STAGE(PG8_SA(1, 0), cA + kstep, voffA); PG8_STAGE(PG8_SB(1, 1), cB + hstep + kstep, voffB);
        PG8_WAIT_V(6); PG8_BAR;
    } else {
        PG8_STAGE(PG8_SB(0, 0), cB, voffB); PG8_STAGE(PG8_SA(0, 0), cA, voffA); PG8_STAGE(PG8_SB(0, 1), cB + hstep, voffB); PG8_STAGE(PG8_SA(0, 1), cA + hstep, voffA);
        if (wr == 1) PG8_BAR;
        PG8_WAIT_V(4); PG8_BAR;
        PG8_STAGE(PG8_SB(1, 0), cB + kstep, voffB); PG8_STAGE(PG8_SA(1, 0), cA + kstep, voffA); PG8_STAGE(PG8_SB(1, 1), cB + hstep + kstep, voffB);
        PG8_WAIT_V(6); PG8_BAR;
    }
    for (;;) {
        const bool has_next = S.next(ui + 1, nxt);
        const char* nA = has_next ? (const char*)g.A + (size_t)nxt.pm * tstep : cA; const char* nB = has_next ? (const char*)g.Bt + (size_t)nxt.pn * tstep : cB;
        for (int t = 0; t < nt; t += 2) {
            const bool last = (t == nt - 2);
            const char* a1 = cA + (size_t)(t + 1) * kstep;
            const char* a2 = last ? nA : cA + (size_t)(t + 2) * kstep; const char* b2 = last ? nB : cB + (size_t)(t + 2) * kstep;
            const char* a3 = a2 + kstep; const char* b3 = b2 + kstep;
            if (last && has_next) S.a_ready(nxt);
            if constexpr (SP2) {
            PG8_LDB(B0, 0, 0); PG8_LDB(B1, 0, 1); PG8_SCHED; PG8_LDA(At, 0, 0); PG8_STAGE(PG8_SA(1, 1), a1 + hstep, voffA);
            PG8_WAIT_V(8); PG8_WAIT_L(0); PG8_BAR; PG8_MMA(0, 0, At, B0); PG8_MMA(0, 1, At, B1); PG8_BAR; PG8_SCHED;
            PG8_LDA(At, 0, 1); PG8_STAGE(PG8_SB(0, 0), b2, voffB); PG8_STAGE(PG8_SB(0, 1), b2 + hstep, voffB); PG8_STAGE(PG8_SA(0, 0), a2, voffA);
            PG8_WAIT_V(8); PG8_WAIT_L(0); PG8_BAR; PG8_MMA(1, 0, At, B0); PG8_MMA(1, 1, At, B1); PG8_BAR; PG8_SCHED;
            PG8_LDB(B0, 1, 0); PG8_LDB(B1, 1, 1); PG8_SCHED; PG8_LDA(At, 1, 0); PG8_STAGE(PG8_SA(0, 1), a2 + hstep, voffA);
            PG8_WAIT_V(8); PG8_WAIT_L(0); PG8_BAR; PG8_MMA(0, 0, At, B0); PG8_MMA(0, 1, At, B1); PG8_BAR; PG8_SCHED;
            PG8_LDA(At, 1, 1); PG8_STAGE(PG8_SB(1, 0), b3, voffB); PG8_STAGE(PG8_SB(1, 1), b3 + hstep, voffB); PG8_STAGE(PG8_SA(1, 0), a3, voffA);
            PG8_WAIT_V(8); PG8_WAIT_L(0); PG8_BAR; PG8_MMA(1, 0, At, B0); PG8_MMA(1, 1, At, B1); PG8_BAR; PG8_SCHED;
            } else {
            PG8_LDB(B0, 0, 0); PG8_SCHED; PG8_LDA(At, 0, 0); PG8_STAGE(PG8_SA(1, 1), a1 + hstep, voffA);
            PG8_WAIT_L(8); PG8_BAR; PG8_WAIT_L(0); PG8_MMA(0, 0, At, B0); PG8_BAR; PG8_SCHED;
            PG8_LDB(B1, 0, 1); PG8_STAGE(PG8_SB(0, 0), b2, voffB);
            PG8_BAR; PG8_WAIT_L(0); PG8_MMA(0, 1, At, B1); PG8_BAR;
            PG8_LDA(At, 0, 1); PG8_STAGE(PG8_SA(0, 0), a2, voffA);
            PG8_BAR; PG8_WAIT_L(0); PG8_MMA(1, 0, At, B0); PG8_BAR; PG8_SCHED;
            PG8_STAGE(PG8_SB(0, 1), b2 + hstep, voffB);
            PG8_WAIT_V(6); PG8_BAR; PG8_MMA(1, 1, At, B1); PG8_BAR;
            PG8_LDB(B0, 1, 0); PG8_SCHED; PG8_LDA(At, 1, 0); PG8_STAGE(PG8_SA(0, 1), a2 + hstep, voffA);
            PG8_WAIT_L(8); PG8_BAR; PG8_WAIT_L(0); PG8_MMA(0, 0, At, B0); PG8_BAR; PG8_SCHED;
            PG8_LDB(B1, 1, 1); PG8_STAGE(PG8_SB(1, 0), b3, voffB);
            PG8_BAR; PG8_WAIT_L(0); PG8_MMA(0, 1, At, B1); PG8_BAR;
            PG8_LDA(At, 1, 1); PG8_STAGE(PG8_SA(1, 0), a3, voffA);
            PG8_BAR; PG8_WAIT_L(0); PG8_MMA(1, 0, At, B0); PG8_BAR; PG8_SCHED;
            PG8_STAGE(PG8_SB(1, 1), b3 + hstep, voffB);
            PG8_WAIT_V(6); PG8_BAR; PG8_MMA(1, 1, At, B1); PG8_BAR;
            }
        }
        if constexpr (ALIGN_EPI) { if (wr == 0) PG8_BAR; }
        if constexpr (!Epi::AFTER_DRAIN) { E(acc, cur, wr, wc, fr, fq); S.done(cur); }
        if (!has_next) break;
#pragma unroll
        for (int a = 0; a < 2; ++a)
#pragma unroll
            for (int b = 0; b < 2; ++b)
#pragma unroll
                for (int m = 0; m < 4; ++m)
#pragma unroll
                    for (int n = 0; n < 2; ++n) acc[a][b][m][n] = (f32x4){0.f, 0.f, 0.f, 0.f};
        cur = nxt; cA = nA; cB = nB; ++ui;
        if constexpr (ALIGN_EPI) { if (wr == 1) PG8_BAR; }
    }
    PG8_WAIT_V(0);
    if constexpr (!ALIGN_EPI) { if (wr == 0) PG8_BAR; }
    PG8_BAR;
    if constexpr (Epi::AFTER_DRAIN) { E.fused(acc, cur, wr, wc, fr, fq, lds, wid, lane); S.done(cur); }
#undef PG8_SA
#undef PG8_SB
#undef PG8_STAGE
#undef PG8_LDA
#undef PG8_LDB
#undef PG8_MMA
#undef PG8_WAIT_V
#undef PG8_WAIT_L
#undef PG8_BAR
#undef PG8_SCHED
}
}
#define LAS __attribute__((address_space(3)))
#define XB_TMO      128
#define XB_XCNT(j)  (256  + 64 * (j))
#define XB_XSUB(j)  (1280 + 64 * (j))
#define XB_XGEN(j)  (2304 + 64 * (j))
#define XB_TOP      3328
#define XB_TOPGEN   3392
#define XCD_BAR_WORDS 3456
#define XB_SPIN_CAP (1u << 18)

__device__ __forceinline__ unsigned xb_ld(unsigned* p)              { return __hip_atomic_load(p, __ATOMIC_RELAXED, __HIP_MEMORY_SCOPE_AGENT); }
__device__ __forceinline__ unsigned xb_add(unsigned* p, unsigned v) { return __hip_atomic_fetch_add(p, v, __ATOMIC_RELAXED, __HIP_MEMORY_SCOPE_AGENT); }
__device__ __forceinline__ unsigned xb_xcc_id() { return (unsigned)__builtin_amdgcn_s_getreg((3 << 11) | 20) & 0xFu; }
#define XB_SPIN(cond, bar) do { unsigned _sp = 0; while (cond) { __builtin_amdgcn_s_sleep(1); \
    if ((++_sp & 255u) == 0u) { if (xb_ld(&(bar)[XB_TMO])) break; if (_sp > XB_SPIN_CAP) { atomicAdd(&(bar)[XB_TMO], 1u); break; } } } } while (0)

struct XcdBarrier {
    unsigned* bar; unsigned x;
    volatile LAS unsigned* st;
};

__device__ __forceinline__ XcdBarrier xcd_barrier_post(unsigned* bar, volatile LAS unsigned* st) {
    XcdBarrier b; b.bar = bar; b.x = xb_xcc_id(); b.st = st;
    if (threadIdx.x == 0) (void)xb_add(&bar[XB_XCNT(b.x)], 1u);
    return b;
}
__device__ __forceinline__ void xcd_barrier_complete(unsigned* bar, unsigned x, unsigned& nloc, unsigned& nx) {
    const unsigned G = gridDim.x * gridDim.y * gridDim.z;
    unsigned sum, cnt, mine, sp = 0u;
    for (;;) {
        sum = 0u; cnt = 0u; mine = 0u;
#pragma unroll
        for (unsigned j = 0; j < 16; ++j) { const unsigned c = xb_ld(&bar[XB_XCNT(j)]); sum += c; cnt += (c > 0u) ? 1u : 0u; mine = (j == x) ? c : mine; }
        if (sum == G) break;
        __builtin_amdgcn_s_sleep(1);
        if ((++sp & 255u) == 0u) { if (xb_ld(&bar[XB_TMO])) break; if (sp > XB_SPIN_CAP) { atomicAdd(&bar[XB_TMO], 1u); break; } }
    }
    nloc = mine > 0u ? mine : 1u; nx = cnt > 0u ? cnt : 1u;
}

__device__ __forceinline__ void xcd_barrier(const XcdBarrier& b) {
    asm volatile("s_waitcnt vmcnt(0)" ::: "memory");
    __syncthreads();
    if (threadIdx.x == 0) {
        unsigned* bar = b.bar;
        __builtin_amdgcn_s_waitcnt(0);
        unsigned nloc = b.st[0], nx = b.st[1];
        if (nloc == 0u) { xcd_barrier_complete(bar, b.x, nloc, nx); b.st[0] = nloc; b.st[1] = nx; }
        const unsigned old = xb_add(&bar[XB_XSUB(b.x)], 1u);
        const unsigned gen = old / nloc;
        if (old + 1u == (gen + 1u) * nloc) {
            __builtin_amdgcn_fence(__ATOMIC_RELEASE, "agent");
            asm volatile("s_waitcnt vmcnt(0)" ::: "memory");
            const unsigned og = xb_add(&bar[XB_TOP], 1u);
            const unsigned tg = og / nx;
            if (og + 1u == (tg + 1u) * nx) xb_add(&bar[XB_TOPGEN], 1u);
            else XB_SPIN(xb_ld(&bar[XB_TOPGEN]) == tg, bar);
            __builtin_amdgcn_fence(__ATOMIC_ACQUIRE, "agent");
            xb_add(&bar[XB_XGEN(b.x)], 1u);
            asm volatile("s_waitcnt vmcnt(0)" ::: "memory");
        } else {
            XB_SPIN(xb_ld(&bar[XB_XGEN(b.x)]) == gen, bar);
            __builtin_amdgcn_fence(__ATOMIC_ACQUIRE, "agent");
            asm volatile("s_waitcnt vmcnt(0)" ::: "memory");
        }
    }
    __syncthreads();
}
namespace moba {
constexpr int D = 128;
constexpr float THR = 8.f;
constexpr bool WSKIP = false;
constexpr int QP = MHD, KVP = MHD, OP = MW;
template <class A, class Bt> struct same_t { static constexpr bool v = false; };
template <class A> struct same_t<A, A> { static constexpr bool v = true; };
constexpr float SCALE = 0.08838834764831845f;
constexpr int NW = 8, QBLK = 32, KVBLK = 64, QB = NW * QBLK;
constexpr int SHM_V = KVBLK * D * 2, SHM_K = KVBLK * D * 2;
constexpr int LDS_BYTES = 2 * SHM_V + 2 * SHM_K + NW * 64 * 4;
using bf16 = unsigned short;
typedef short bf16x8 __attribute__((ext_vector_type(8)));
typedef short s16x4 __attribute__((ext_vector_type(4)));
typedef float f32x16 __attribute__((ext_vector_type(16)));
typedef float f32x4 __attribute__((ext_vector_type(4)));
typedef unsigned u32x4 __attribute__((ext_vector_type(4)));
#define KSWZ(row, colB) ((row) * 256 + ((colB) ^ (((row) & 7) << 4)))
#define SBAR() __builtin_amdgcn_sched_barrier(0)
__device__ __forceinline__ int v_st(int k, int c) { const int kk = (k & ~0xC) | ((k & 4) << 1) | ((k & 8) >> 1); return ((kk >> 3) * 4 + (c >> 5)) * 512 + ((kk & 7) * 32 + (c & 31)) * 2; }
__device__ __forceinline__ int v_rd_base(int lane) { return ((lane & 3) << 3) | (((lane >> 2) & 3) << 6) | (((lane >> 4) & 1) << 5) | (((lane >> 5) & 1) << 8); }
constexpr int v_rd_off(int d0, int ks, int half) { return d0 * 512 + ks * 4096 + half * 2048; }
__device__ __forceinline__ int crow(int r, int hi) { return (r & 3) + 8 * (r >> 2) + 4 * hi; }
__device__ __forceinline__ unsigned cvtpk(float lo, float hi) {
    unsigned r; asm volatile("v_cvt_pk_bf16_f32 %0, %1, %2" : "=v"(r) : "v"(lo), "v"(hi)); return r;
}
__device__ __forceinline__ bf16x8 pack8(f32x4 a, f32x4 b) {
    u32x4 w = {cvtpk(a[0], a[1]), cvtpk(a[2], a[3]), cvtpk(b[0], b[1]), cvtpk(b[2], b[3])};
    return *reinterpret_cast<bf16x8*>(&w);
}
template <class T> __device__ __forceinline__ bf16x8 load8(const T* p) {
    if constexpr (same_t<T, float>::v) { return pack8(*(const f32x4*)p, *(const f32x4*)(p + 4)); }
    else { return *reinterpret_cast<const bf16x8*>(p); }
}
__device__ __forceinline__ void mask_tile(f32x16& p0, f32x16& p1, int dq, unsigned W) {
    const float NEG = -__builtin_inff();
#pragma unroll
    for (int r = 0; r < 16; ++r) {
        const int c = (r & 3) + 8 * (r >> 2);
        if ((unsigned)(dq - c) >= W) p0[r] = NEG;
        if ((unsigned)(dq - c - 32) >= W) p1[r] = NEG;
    }
}
__device__ __forceinline__ void partialSM(f32x16& p0, f32x16& p1, float& m_reg, float& mn, float& alpha) {
    float pmax = p0[0]; for (int r = 1; r < 16; ++r) pmax = fmaxf(pmax, p0[r]); for (int r = 0; r < 16; ++r) pmax = fmaxf(pmax, p1[r]);
    { auto rr = __builtin_amdgcn_permlane32_swap(__float_as_uint(pmax), __float_as_uint(pmax), false, false);
      pmax = fmaxf(__uint_as_float(rr[0]), __uint_as_float(rr[1])); }
    constexpr float C2 = 1.4426950408889634f * SCALE;
    if (__builtin_expect(__all((pmax - m_reg) * SCALE <= THR), 1)) { mn = m_reg; alpha = 1.f; }
    else { mn = fmaxf(m_reg, pmax); alpha = __builtin_amdgcn_exp2f((m_reg - mn) * C2); m_reg = mn; }
    const float mnL = -mn * C2;
    for (int r = 0; r < 16; ++r) p0[r] = fmaf(p0[r], C2, mnL); for (int r = 0; r < 16; ++r) p1[r] = fmaf(p1[r], C2, mnL);
    for (int r = 0; r < 16; ++r) p0[r] = __builtin_amdgcn_exp2f(p0[r]);
}
__device__ __forceinline__ void finishSM(f32x16& p0, f32x16& p1, float alpha, float& l_reg, bf16x8& pa0, bf16x8& pa1, bf16x8& pa2, bf16x8& pa3) {
    for (int r = 0; r < 16; ++r) p1[r] = __builtin_amdgcn_exp2f(p1[r]);
    float ps = 0; for (int r = 0; r < 16; ++r) ps += p0[r]; for (int r = 0; r < 16; ++r) ps += p1[r];
    { auto rr = __builtin_amdgcn_permlane32_swap(__float_as_uint(ps), __float_as_uint(ps), false, false);
      ps = __uint_as_float(rr[0]) + __uint_as_float(rr[1]); }
    l_reg = l_reg * alpha + ps;
#define PK4(P, B_, OUT) do { unsigned a0 = cvtpk(P[B_+0], P[B_+1]), a1 = cvtpk(P[B_+2], P[B_+3]);                          \
        unsigned b0 = cvtpk(P[B_+4], P[B_+5]), b1 = cvtpk(P[B_+6], P[B_+7]);                                             \
        auto r0 = __builtin_amdgcn_permlane32_swap(a0, b0, false, false); auto r1 = __builtin_amdgcn_permlane32_swap(a1, b1, false, false); \
        u32x4 w = {r0[0], r1[0], r0[1], r1[1]}; OUT = *reinterpret_cast<bf16x8*>(&w); } while (0)
    PK4(p0, 0, pa0); PK4(p0, 8, pa1); PK4(p1, 0, pa2); PK4(p1, 8, pa3);
#undef PK4
}
template <int KB, bool SK>
__device__ __forceinline__ void qkt(f32x16& p0, f32x16& p1, const char* K_lds, int r32, int hi, const bf16x8* qr, bool act) {
    if (SK && !act) { const float NEG = -__builtin_inff();
#pragma unroll
        for (int r = 0; r < 16; ++r) { p0[r] = NEG; p1[r] = NEG; } return; }
    p0 = f32x16{}; p1 = f32x16{};
    const char* kb[4];
#pragma unroll
    for (int dd = 0; dd < 4; ++dd) kb[dd] = K_lds + KB * SHM_K + KSWZ(r32, (dd * 16 + hi * 8) * 2);
#pragma unroll
    for (int d0 = 0; d0 < 8; ++d0) { const char* a = kb[d0 & 3] + (d0 >> 2) * 128;
        bf16x8 b0 = *reinterpret_cast<const bf16x8*>(a);
        bf16x8 b1 = *reinterpret_cast<const bf16x8*>(a + 32 * 256);
        p0 = __builtin_amdgcn_mfma_f32_32x32x16_bf16(b0, qr[d0], p0, 0, 0, 0);
        p1 = __builtin_amdgcn_mfma_f32_32x32x16_bf16(b1, qr[d0], p1, 0, 0, 0); }
}
template <int VB, bool SK>
__device__ __forceinline__ void pv_tile(f32x16* o, int vb0, bf16x8 pa0, bf16x8 pa1, bf16x8 pa2, bf16x8 pa3, bool act) {
    if (SK && !act) return;
#define TRRD(dst, off) asm volatile("ds_read_b64_tr_b16 %0, %1 offset:%2" : "=&v"(dst) : "v"(vb0), "i"(off) : "memory")
#define PV_D0(d0) do { s16x4 l0, l1, l2, l3, h0, h1, h2, h3; constexpr int b_ = VB * SHM_V + v_rd_off(d0, 0, 0);     \
        TRRD(l0, b_); TRRD(h0, b_ + 2048); TRRD(l1, b_ + 4096); TRRD(h1, b_ + 6144); TRRD(l2, b_ + 8192); TRRD(h2, b_ + 10240); TRRD(l3, b_ + 12288); TRRD(h3, b_ + 14336); \
        asm volatile("s_waitcnt lgkmcnt(0)" ::: "memory"); SBAR();                 \
        o[d0] = __builtin_amdgcn_mfma_f32_32x32x16_bf16(pa0, (bf16x8){l0[0], l0[1], l0[2], l0[3], h0[0], h0[1], h0[2], h0[3]}, o[d0], 0, 0, 0);   \
        o[d0] = __builtin_amdgcn_mfma_f32_32x32x16_bf16(pa1, (bf16x8){l1[0], l1[1], l1[2], l1[3], h1[0], h1[1], h1[2], h1[3]}, o[d0], 0, 0, 0);   \
        o[d0] = __builtin_amdgcn_mfma_f32_32x32x16_bf16(pa2, (bf16x8){l2[0], l2[1], l2[2], l2[3], h2[0], h2[1], h2[2], h2[3]}, o[d0], 0, 0, 0);   \
        o[d0] = __builtin_amdgcn_mfma_f32_32x32x16_bf16(pa3, (bf16x8){l3[0], l3[1], l3[2], l3[3], h3[0], h3[1], h3[2], h3[3]}, o[d0], 0, 0, 0); } while (0)
    PV_D0(0); PV_D0(1); PV_D0(2); PV_D0(3);
#undef PV_D0
#undef TRRD
}
__device__ __forceinline__ float bfv(short s) { return __builtin_bit_cast(float, ((unsigned)(unsigned short)s) << 16); }
__device__ __forceinline__ void sel_fill(f32x16& p0, f32x16& p1, bool ok) { const float NEG = -__builtin_inff();
#pragma unroll
    for (int r = 0; r < 16; ++r) { p0[r] = ok ? p0[r] : NEG; p1[r] = ok ? p1[r] : NEG; } }
template <class TIn, class TOut> struct BlockRef { const TIn* Q; const TIn* K; const TIn* V; TOut* O; int P0; const float* km; int qb; };
template <class TIn> struct Seam {
    bf16x8 qr[8];
    bf16x8 st_v0, st_v1, st_k0, st_k1; f32x4 sf0, sf1, sf2, sf3;
    f32x4 tq[16];
};
__device__ __forceinline__ int swa_jlo(int P0, int W) { const int lowk = P0 - W + 1; return lowk > 0 ? lowk / KVBLK : 0; }
#define ROW(p, k0, rr) ((p) + (size_t)((k0) + (rr)) * KVP + sc)
#define VMW() asm volatile("s_waitcnt vmcnt(0)" ::: "memory")
#define VMWN(n) asm volatile("s_waitcnt vmcnt(%0)" :: "i"(n) : "memory")
#define SLOAD_H(Kp, Vp, k0) do { S.st_v0 = load8<TIn>(ROW(Vp, k0, sr)); S.st_v1 = load8<TIn>(ROW(Vp, k0, 32 + sr));              \
                         S.st_k0 = load8<TIn>(ROW(Kp, k0, sr)); S.st_k1 = load8<TIn>(ROW(Kp, k0, 32 + sr)); } while (0)
#define SWRITE_HK(bf) do { *(bf16x8*)(K_lds + (bf) * SHM_K + kws) = S.st_k0; *(bf16x8*)(K_lds + (bf) * SHM_K + kws + 32 * 256) = S.st_k1; } while (0)
#define SWRITE_HV(bf) do { *(bf16x8*)(V_lds + (bf) * SHM_V + vst0) = S.st_v0; *(bf16x8*)(V_lds + (bf) * SHM_V + vst1) = S.st_v1; } while (0)
#define SWRITE_H(bf) do { SWRITE_HV(bf); SWRITE_HK(bf); } while (0)
#define SLOAD_F(p, k0) do { S.sf0 = *(const f32x4*)ROW(p, k0, sr); S.sf1 = *(const f32x4*)(ROW(p, k0, sr) + 4);                \
                            S.sf2 = *(const f32x4*)ROW(p, k0, 32 + sr); S.sf3 = *(const f32x4*)(ROW(p, k0, 32 + sr) + 4); } while (0)
#define SWRITE_KF(bf) do { *(bf16x8*)(K_lds + (bf) * SHM_K + kws) = pack8(S.sf0, S.sf1); *(bf16x8*)(K_lds + (bf) * SHM_K + kws + 32 * 256) = pack8(S.sf2, S.sf3); } while (0)
#define SWRITE_VF(bf) do { *(bf16x8*)(V_lds + (bf) * SHM_V + vst0) = pack8(S.sf0, S.sf1); *(bf16x8*)(V_lds + (bf) * SHM_V + vst1) = pack8(S.sf2, S.sf3); } while (0)
template <class TIn, class TOut>
__device__ __forceinline__ void causal_swa_prime(const BlockRef<TIn, TOut>& cur, int W, char* lds, Seam<TIn>& S) {
    constexpr bool F32 = same_t<TIn, float>::v;
    int tid_o = threadIdx.x; asm volatile("" : "+v"(tid_o));
    const int tid = tid_o, wid = __builtin_amdgcn_readfirstlane(tid >> 6), lane = tid & 63, r32 = lane & 31, hi = lane >> 5;
    const int sr = tid >> 4, sc = (tid & 15) * 8, kws = KSWZ(sr, sc * 2); char* K_lds = lds + 2 * SHM_V;
    const int kb0 = swa_jlo(cur.P0, W) * KVBLK;
    for (int d0 = 0; d0 < 8; ++d0) S.qr[d0] = load8<TIn>(cur.Q + (size_t)(wid * QBLK + r32) * QP + d0 * 16 + hi * 8);
    if constexpr (F32) { SLOAD_F((const float*)cur.K, kb0); VMW(); SWRITE_KF(0); SBAR(); SLOAD_F((const float*)cur.V, kb0); }
    else { SLOAD_H(cur.K, cur.V, kb0); VMW(); SWRITE_HK(0); }
    __syncthreads();
}
template <class TIn, class TOut, int FK = 0>
__device__ __forceinline__ void causal_swa_block(const BlockRef<TIn, TOut>& cur, const BlockRef<TIn, TOut>& nxt, int skv, int W, char* lds, Seam<TIn>& S) {
    constexpr bool F32 = same_t<TIn, float>::v;
    int tid_o = threadIdx.x; asm volatile("" : "+v"(tid_o));
    const int tid = tid_o, wid = __builtin_amdgcn_readfirstlane(tid >> 6), lane = tid & 63, r32 = lane & 31, hi = lane >> 5;
    const int j_lo = swa_jlo(cur.P0, W);
    int j_hi = (cur.P0 + QB - 1) / KVBLK + 1; if (j_hi > skv / KVBLK) j_hi = skv / KVBLK;
    const int NT = j_hi - j_lo;
    const int kbn = swa_jlo(nxt.P0, W) * KVBLK;
    const int qlo = cur.P0 + wid * QBLK, qm = qlo + r32 - 4 * hi;
    char* V_lds = lds; char* K_lds = lds + 2 * SHM_V;
    float* ws = (float*)(lds + 2 * SHM_V + 2 * SHM_K) + wid * 64; float* li_l = ws, * al_l = ws + 32;
    float m_reg = -1e30f, l_reg = 0; f32x16 o[4] = {};
    unsigned selbits = 0u;
    if (cur.qb > 0) {
        float sc_[7];
#pragma unroll
        for (int j = 0; j < 7; ++j) { float a_ = 0.f;
            if (j < cur.qb) { const float* kmj = cur.km + j * 128 + hi * 8;
#pragma unroll
                for (int d0 = 0; d0 < 8; ++d0) { const f32x4 k0_ = *(const f32x4*)(kmj + d0 * 16), k1_ = *(const f32x4*)(kmj + d0 * 16 + 4); const bf16x8 q_ = S.qr[d0];
                    a_ += (bfv(q_[0]) * k0_[0] + bfv(q_[1]) * k0_[1]) + (bfv(q_[2]) * k0_[2] + bfv(q_[3]) * k0_[3]) + (bfv(q_[4]) * k1_[0] + bfv(q_[5]) * k1_[1]) + (bfv(q_[6]) * k1_[2] + bfv(q_[7]) * k1_[3]); }
                a_ += __shfl_xor(a_, 32); }
            sc_[j] = a_; }
#pragma unroll
        for (int j = 0; j < 7; ++j) { int rank_ = 0;
#pragma unroll
            for (int i = 0; i < 7; ++i) if (i != j) rank_ += (i < cur.qb && (sc_[i] > sc_[j] || (sc_[i] == sc_[j] && i < j))) ? 1 : 0;
            if (j < cur.qb && rank_ < 3) selbits |= 1u << j; }
    }
    const int sr = tid >> 4, sc = (tid & 15) * 8, vst0 = v_st(sr, sc), vst1 = v_st(32 + sr, sc), kws = KSWZ(sr, sc * 2);
    const int vb0 = (int)(uintptr_t)V_lds + v_rd_base(lane);
    const TIn* Kh = cur.K; const TIn* Vh = cur.V;
#define RESC(a) do { if (__any((a) < 1.f)) { if (hi == 0) al_l[r32] = (a); asm volatile("s_waitcnt lgkmcnt(0)" ::: "memory");              \
                     for (int d_ = 0; d_ < 4; ++d_) for (int r = 0; r < 16; ++r) o[d_][r] *= al_l[crow(r, hi)]; } } while (0)
#define KBASE(t) ((j_lo + (t)) * KVBLK)
#define ACT(t) (KBASE(t) <= qlo + QBLK - 1 && KBASE(t) + KVBLK - 1 >= qlo - W + 1)
#define MASKT(P0_, P1_, t) do { const int kb_ = KBASE(t); if (kb_ + KVBLK - 1 > qlo) mask_tile(P0_, P1_, qm - kb_, (unsigned)W); \
        else if ((t) < 4 * cur.qb) { const bool ok_ = ((selbits >> ((t) >> 2)) & 1u) != 0u; if (!__all(ok_)) sel_fill(P0_, P1_, ok_); } } while (0)
    constexpr int NQL = F32 ? 16 : 8;
    constexpr bool SK = WSKIP && !F32;
#define SEAM_K0() do { VMWN(NQL); if constexpr (F32) { SWRITE_KF(0); SBAR(); SLOAD_F((const float*)nxt.V, kbn); } else { SWRITE_HK(0); } SBAR(); } while (0)
    f32x16 pA0, pA1, pB0, pB1; float mnA, mnB, alA, alB; bf16x8 pa0, pa1, pa2, pa3;
    if constexpr (F32) { VMW(); SWRITE_VF(0); SBAR(); } else { SWRITE_HV(0); SBAR(); }
    if (NT > 1) { if constexpr (F32) SLOAD_F((const float*)Kh, KBASE(1)); else SLOAD_H(Kh, Vh, (FK == 1) ? 0 : KBASE(1)); }
    SBAR(); qkt<0, SK>(pA0, pA1, K_lds, r32, hi, S.qr, ACT(0));
    if constexpr (F32) { if (NT > 1) { VMW(); SWRITE_KF(1); SBAR(); SLOAD_F((const float*)Vh, KBASE(1)); } }
    MASKT(pA0, pA1, 0); partialSM(pA0, pA1, m_reg, mnA, alA);
    if (NT > 1) { VMW(); if constexpr (F32) { SWRITE_VF(1); SBAR(); if (NT > 2) SLOAD_F((const float*)Kh, KBASE(2)); } else SWRITE_H(1); }
    __syncthreads();
#define HALF_STEP(PX0, PX1, mnX, alX, PY0, PY1, alY, t, KB, VB, SB) do {                                                      \
        SBAR(); qkt<KB, SK>(PX0, PX1, K_lds, r32, hi, S.qr, ACT(t));                                             \
        finishSM(PY0, PY1, alY, l_reg, pa0, pa1, pa2, pa3); SBAR();                                                           \
        if ((t) + 1 < NT) { if constexpr (F32) { VMW(); SWRITE_KF(SB); SBAR(); SLOAD_F((const float*)Vh, KBASE((t) + 1)); }  \
                            else { SLOAD_H(Kh, Vh, (FK == 1) ? 0 : KBASE((t) + 1)); } SBAR(); }                                               \
        pv_tile<VB, SK>(o, vb0, pa0, pa1, pa2, pa3, ACT((t) - 1)); MASKT(PX0, PX1, (t)); partialSM(PX0, PX1, m_reg, mnX, alX);                                        \
        __syncthreads();                                                                                                      \
        if ((t) + 1 < NT) { VMW(); if constexpr (F32) { SWRITE_VF(SB); SBAR(); if ((t) + 2 < NT) SLOAD_F((const float*)Kh, KBASE((t) + 2)); } \
                            else { SWRITE_H(SB); } }                                                                          \
        RESC(alX); __syncthreads(); } while (0)
    for (int t = 1; t + 1 < NT; t += 2) {
        HALF_STEP(pB0, pB1, mnB, alB, pA0, pA1, alA, t, 1, 0, 0);
        HALF_STEP(pA0, pA1, mnA, alA, pB0, pB1, alB, t + 1, 0, 1, 1);
    }
    const bool even = (NT & 1) == 0;
    if (even) { SBAR(); qkt<1, SK>(pB0, pB1, K_lds, r32, hi, S.qr, ACT(NT - 1)); SBAR(); }
#define QROW(e) (nxt.Q + (size_t)(wid * QBLK + r32) * QP + ((e) >> 1) * 16 + hi * 8 + ((e) & 1) * 4)
    if constexpr (F32) { SLOAD_F((const float*)nxt.K, kbn); SBAR();
#pragma unroll
        for (int e = 0; e < 8; ++e) S.tq[e] = *(const f32x4*)QROW(e); }
    else { SLOAD_H(nxt.K, nxt.V, kbn); SBAR();
#pragma unroll
        for (int d0 = 0; d0 < 8; ++d0) S.qr[d0] = load8<TIn>(nxt.Q + (size_t)(wid * QBLK + r32) * QP + d0 * 16 + hi * 8); }
    SBAR();
    finishSM(pA0, pA1, alA, l_reg, pa0, pa1, pa2, pa3); SBAR();
    if constexpr (F32) {
#pragma unroll
        for (int e = 8; e < 16; ++e) S.tq[e] = *(const f32x4*)QROW(e); SBAR(); }
#undef QROW
    pv_tile<0, SK>(o, vb0, pa0, pa1, pa2, pa3, ACT(even ? NT - 2 : NT - 1));
    if (even) { MASKT(pB0, pB1, NT - 1); partialSM(pB0, pB1, m_reg, mnB, alB); __syncthreads(); RESC(alB);
        finishSM(pB0, pB1, alB, l_reg, pa0, pa1, pa2, pa3); SBAR(); pv_tile<1, SK>(o, vb0, pa0, pa1, pa2, pa3, ACT(NT - 1)); }
    SBAR(); SEAM_K0();
    if (hi == 0) li_l[r32] = l_reg; asm volatile("s_waitcnt lgkmcnt(0)" ::: "memory");
    float rli[16];
#pragma unroll
    for (int r = 0; r < 16; ++r) rli[r] = __builtin_amdgcn_rcpf(li_l[crow(r, hi)]);
    TOut* Ow = cur.O + (size_t)(wid * QBLK) * OP;
#pragma unroll
    for (int r = 0; r < 16; ++r) { const int orow = crow(r, hi);
#pragma unroll
        for (int d0 = 0; d0 < 4; ++d0) { const float v = o[d0][r] * rli[r];
            if constexpr (same_t<TOut, float>::v) { Ow[(size_t)orow * OP + d0 * 32 + r32] = v; }
            else { const float vn = __shfl_xor(v, 1);
                   if ((r32 & 1) == 0) *(unsigned*)(Ow + (size_t)orow * OP + d0 * 32 + r32) = cvtpk(v, vn); } } }
    if constexpr (F32) {
#pragma unroll
        for (int d0 = 0; d0 < 8; ++d0) S.qr[d0] = pack8(S.tq[2 * d0], S.tq[2 * d0 + 1]); }
    __syncthreads();
#undef RESC
#undef KBASE
#undef ACT
#undef MASKT
#undef SEAM_K0
#undef HALF_STEP
}
#undef ROW
#undef VMW
#undef VMWN
#undef SLOAD_H
#undef SWRITE_HK
#undef SWRITE_HV
#undef SWRITE_H
#undef SLOAD_F
#undef SWRITE_KF
#undef SWRITE_VF
}
namespace gla {
typedef float f32x16 __attribute__((ext_vector_type(16)));
typedef short s16x4 __attribute__((ext_vector_type(4)));
typedef float f32x2_t __attribute__((ext_vector_type(2)));
typedef __bf16 bf16x2_t __attribute__((ext_vector_type(2)));
__device__ __forceinline__ unsigned cvt2(float lo, float hi) { f32x2_t v = {lo, hi}; bf16x2_t b = __builtin_convertvector(v, bf16x2_t); return __builtin_bit_cast(unsigned, b); }
__device__ __forceinline__ float bfu(unsigned short s) { return __builtin_bit_cast(float, ((unsigned)s) << 16); }
constexpr int RS = 272, VS = 528, AS = 144;
constexpr int L_QT = 0, L_KT = 17408, L_KH = 34816, L_V = 52224, L_AT = 86016, L_GLR = 95232, L_DEC = 99328, L_SEG = 99840, L_RED = 101888, L_GN = 103936, L_END = 104960;
#define GLA_MFMA(a, b, c) __builtin_amdgcn_mfma_f32_32x32x16_bf16((a), (b), (c), 0, 0, 0)
#define GLA_LBAR() do { asm volatile("s_waitcnt lgkmcnt(0)" ::: "memory"); __builtin_amdgcn_s_barrier(); asm volatile("" ::: "memory"); } while (0)
#define GLA_TR(off) __builtin_amdgcn_ds_read_tr16_b64_v4i16((LAS s16x4*)(lds + (off)))

constexpr size_t WS_GQT = 710 * MiB, WS_GKH = 726 * MiB, WS_GA = 742 * MiB, WS_GDEC = 750 * MiB;

__device__ __forceinline__ void gla_pre_head(const Params& P, int l, int b, int c, int h, LAS unsigned char* lds, int tid) {
    const int lane = tid & 63, w = __builtin_amdgcn_readfirstlane(tid >> 6), r = lane & 31, hh = lane >> 5;
    const int sd = tid & 127, stq = tid >> 7, t0 = c * GCH, item = (b * GH + h) * (SEQ / GCH) + c;
    const bf16* gq = (const bf16*)(P.ws + WS_PROJ) + PJ_GQ + ((size_t)(b * GH + h) * SEQ + t0) * GDK; const bf16* gk = (const bf16*)(P.ws + WS_PROJ) + PJ_GK + ((size_t)(b * GH + h) * SEQ + t0) * GDK;
    float w2r[16];
#pragma unroll
    for (int j = 0; j < 16; ++j) w2r[j] = P.gate_w2[((size_t)l * GRANK + j) * GKW + h * GDK + sd];
    const float gbias = P.gate_b[(size_t)l * GKW + h * GDK + sd];
#pragma unroll
    for (int i = 0; i < 2; ++i) { const int idx = tid + 512 * i, row = idx >> 4, ch = idx & 15;
        *(LAS u32x4*)(lds + L_QT + row * RS + ch * 16) = *(const u32x4*)(gq + (size_t)row * GDK + ch * 8);
        *(LAS u32x4*)(lds + L_KT + row * RS + ch * 16) = *(const u32x4*)(gk + (size_t)row * GDK + ch * 8); }
    float bl[16]; float run = 0.f;
#pragma unroll
    for (int i = 0; i < 16; ++i) { const LAS f32x4* gr4 = (const LAS f32x4*)(lds + L_GLR + (16 * stq + i) * 64); float x = gbias;
#pragma unroll
        for (int j = 0; j < 4; ++j) { const f32x4 gv = gr4[j]; x += (gv[0] * w2r[4 * j] + gv[1] * w2r[4 * j + 1]) + (gv[2] * w2r[4 * j + 2] + gv[3] * w2r[4 * j + 3]); }
        run -= __logf(1.0f + __expf(-x)) * (1.0f / 16.0f); bl[i] = run; }
    *(LAS float*)(lds + L_SEG + (stq * 128 + sd) * 4) = run;
    __syncthreads();
    float prefix = 0.f, total = 0.f;
#pragma unroll
    for (int j = 0; j < 4; ++j) { const float sv = *(const LAS float*)(lds + L_SEG + (j * 128 + sd) * 4); total += sv; prefix += (j < stq) ? sv : 0.f; }
    const float etot = __expf(total);
#pragma unroll
    for (int i = 0; i < 16; ++i) { const int row = 16 * stq + i; const float bb = bl[i] + prefix; const float eb = __expf(bb), enb = __builtin_amdgcn_rcpf(eb), ekl = etot * enb;
        LAS unsigned short* qp = (LAS unsigned short*)(lds + L_QT + row * RS + sd * 2); LAS unsigned short* kp = (LAS unsigned short*)(lds + L_KT + row * RS + sd * 2);
        const float qv = bfu(*qp), kv = bfu(*kp);
        *qp = (unsigned short)f2bf(qv * eb); *kp = (unsigned short)f2bf(kv * enb); *(LAS unsigned short*)(lds + L_KH + row * RS + sd * 2) = (unsigned short)f2bf(kv * ekl); }
    if (stq == 0) ((float*)(P.ws + WS_GDEC))[(size_t)item * GDK + sd] = etot;
    __syncthreads();
#pragma unroll
    for (int i = 0; i < 2; ++i) { const int idx = tid + 512 * i, row = idx >> 4, ch = idx & 15; const size_t go = (size_t)(b * SEQ + t0 + row) * GKW + h * GDK + ch * 8;
        *(u32x4*)((bf16*)(P.ws + WS_GQT) + go) = *(const LAS u32x4*)(lds + L_QT + row * RS + ch * 16);
        *(u32x4*)((bf16*)(P.ws + WS_GKH) + go) = *(const LAS u32x4*)(lds + L_KH + row * RS + ch * 16); }
    if (w < 4) { const int ti = w >> 1, si = w & 1; f32x16 at;
#pragma unroll
        for (int i = 0; i < 16; ++i) at[i] = 0.f;
        if (si <= ti) {
#pragma unroll
            for (int kk = 0; kk < 8; ++kk) { const bf16x8 a = *(const LAS bf16x8*)(lds + L_KT + (32 * si + r) * RS + (16 * kk + 8 * hh) * 2); const bf16x8 bq = *(const LAS bf16x8*)(lds + L_QT + (32 * ti + r) * RS + (16 * kk + 8 * hh) * 2);
                at = GLA_MFMA(a, bq, at); } }
        const int t = 32 * ti + r; bf16* ag = (bf16*)(P.ws + WS_GA) + ((size_t)item * GCH + t) * GCH;
#pragma unroll
        for (int g = 0; g < 4; ++g) { const int s0 = 32 * si + 8 * g + 4 * hh; float v[4];
#pragma unroll
            for (int e = 0; e < 4; ++e) v[e] = (s0 + e <= t) ? at[4 * g + e] : 0.f;
            u32x2 pkd; pkd.x = cvt2(v[0], v[1]); pkd.y = cvt2(v[2], v[3]); *(u32x2*)(ag + s0) = pkd; } }
    __syncthreads();
}

template <int VAR>
__device__ __forceinline__ void gla_seq_unit(const Params& P, int l, int bh, LAS unsigned char* lds, int tid) {
    const int lane = tid & 63, w = __builtin_amdgcn_readfirstlane(tid >> 6), r = lane & 31, hh = lane >> 5;
    const int b = bh >> 2, h = bh & 3;
    const int blk = (lane >> 4) & 1, q4 = (lane & 15) >> 2, p4 = lane & 3;
    const char* ub_v = (const char*)((const bf16*)(P.ws + WS_PROJ) + PJ_GV + (size_t)bh * SEQ * GDV); const char* ub_gr = (const char*)((const bf16*)(P.ws + WS_PROJ) + PJ_GR + (size_t)bh * SEQ * GDV);
    const char* ub_qt = (const char*)((const bf16*)(P.ws + WS_GQT) + (size_t)(b * SEQ) * GKW + h * GDK); const char* ub_kh = (const char*)((const bf16*)(P.ws + WS_GKH) + (size_t)(b * SEQ) * GKW + h * GDK);
    const char* ub_a = (const char*)((const bf16*)(P.ws + WS_GA) + (size_t)bh * (SEQ / GCH) * GCH * GCH); const char* ub_dec = (const char*)((const float*)(P.ws + WS_GDEC) + (size_t)bh * (SEQ / GCH) * GDK);
    char* ub_og = (char*)((bf16*)(P.ws + (VAR ? (size_t)760 * MiB : WS_OGOM)) + (size_t)(b * SEQ) * GVW + h * GDV);
    const unsigned vo_qk = (unsigned)((tid >> 4) * GKW * 2 + (tid & 15) * 16), vo_v = (unsigned)((tid >> 5) * GDV * 2 + (tid & 31) * 16), vo_16 = (unsigned)(tid * 16);
    const unsigned vo_ogc = (unsigned)((tid >> 5) * GVW * 2 + (tid & 31) * 16);
    constexpr int SRS = 272, SKS = 320, SVS = 576, SAS = 144;
    constexpr int S_QT = 0, S_KH = S_QT + 64 * SRS, S_V = S_KH + 64 * SKS, S_AT = S_V + 64 * SVS, S_DEC = S_AT + 64 * SAS, S_RED = S_DEC + 512, S_GN = S_RED + 2048, S_OT = S_GN + 1024, S_END = S_OT + 64 * SVS;
    static_assert(S_END <= 131072, "GLA scan LDS map");
    const unsigned tr_v = S_V + (8 * hh + q4) * SVS + (32 * w + 16 * blk + 4 * p4) * 2;
    const unsigned tr_kh = S_KH + (8 * hh + q4) * SKS + (16 * blk + 4 * p4) * 2;
    if (tid < GDV) *(LAS float*)(lds + S_GN + tid * 4) = P.gla_norm_g[(size_t)l * GDV + tid];
    f32x16 S[4];
#pragma unroll
    for (int d = 0; d < 4; ++d)
#pragma unroll
        for (int i = 0; i < 16; ++i) S[d][i] = 0.f;
    u32x4 pq[2], pk[2], pv[4], pa; f32x4 pd = {0.f, 0.f, 0.f, 0.f};
#define GLA_LOAD(c_) do { const size_t tb_ = (size_t)(c_) * GCH; \
        _Pragma("unroll") for (int i = 0; i < 2; ++i) { pq[i] = *(const u32x4*)(ub_qt + (tb_ + 32 * i) * (GKW * 2) + vo_qk); pk[i] = *(const u32x4*)(ub_kh + (tb_ + 32 * i) * (GKW * 2) + vo_qk); } \
        _Pragma("unroll") for (int i = 0; i < 4; ++i) pv[i] = *(const u32x4*)(ub_v + (tb_ + 16 * i) * (GDV * 2) + vo_v); \
        pa = *(const u32x4*)(ub_a + (size_t)(c_) * (GCH * GCH * 2) + vo_16); \
        if (tid < 32) pd = *(const f32x4*)(ub_dec + (size_t)(c_) * (GDK * 4) + vo_16); } while (0)
    GLA_LOAD(0);
    for (int c = 0; c < SEQ / GCH; ++c) {
        const int t0 = c * GCH;
#pragma unroll
        for (int i = 0; i < 2; ++i) { const int idx = tid + 512 * i, row = idx >> 4, ch = idx & 15; *(LAS u32x4*)(lds + S_QT + row * SRS + ch * 16) = pq[i]; *(LAS u32x4*)(lds + S_KH + row * SKS + ch * 16) = pk[i]; }
#pragma unroll
        for (int i = 0; i < 4; ++i) { const int idx = tid + 512 * i, row = idx >> 5, ch = idx & 31; *(LAS u32x4*)(lds + S_V + row * SVS + ch * 16) = pv[i]; }
        *(LAS u32x4*)(lds + S_AT + (tid >> 3) * SAS + (tid & 7) * 16) = pa;
        if (tid < 32) *(LAS f32x4*)(lds + S_DEC + tid * 16) = pd;
        u32x4 sg[4];
#pragma unroll
        for (int i = 0; i < 4; ++i) { if (VAR & 1) sg[i] = (u32x4){0x3f803f80u, 0x3f803f80u, 0x3f803f80u, 0x3f803f80u}; else sg[i] = *(const u32x4*)(ub_gr + (size_t)(t0 + 16 * i) * (GDV * 2) + vo_v); }
        if (c + 1 < SEQ / GCH && !((VAR & 4) && c > 0)) GLA_LOAD(c + 1);
        GLA_LBAR();
        f32x16 ot[2];
#pragma unroll
        for (int ti = 0; ti < 2; ++ti)
#pragma unroll
            for (int i = 0; i < 16; ++i) ot[ti][i] = 0.f;
        if (!(VAR & 2)) {
        bf16x8 vf[4];
#pragma unroll
        for (int kk = 0; kk < 4; ++kk) { const s16x4 lo = GLA_TR(tr_v + kk * 16 * SVS), hi = GLA_TR(tr_v + kk * 16 * SVS + 4 * SVS); vf[kk] = __builtin_shufflevector(lo, hi, 0, 1, 2, 3, 4, 5, 6, 7); }
        s16x4 bq[2][8];
#define GLA_LDBQ(buf, dblk_) do { _Pragma("unroll") for (int s = 0; s < 2; ++s) _Pragma("unroll") for (int ti = 0; ti < 2; ++ti) { \
            const LAS unsigned char* qa = lds + S_QT + (32 * ti + r) * SRS + (32 * (dblk_) + 16 * s + 4 * hh) * 2; bq[buf][(s * 2 + ti) * 2] = *(const LAS s16x4*)qa; bq[buf][(s * 2 + ti) * 2 + 1] = *(const LAS s16x4*)(qa + 16); } } while (0)
        GLA_LDBQ(0, 0);
#pragma unroll
        for (int dblk = 0; dblk < 4; ++dblk) {
            if (dblk + 1 < 4) GLA_LDBQ((dblk + 1) & 1, dblk + 1);
#pragma unroll
            for (int s = 0; s < 2; ++s) { u32x4 pa_; pa_.x = cvt2(S[dblk][8 * s + 0], S[dblk][8 * s + 1]); pa_.y = cvt2(S[dblk][8 * s + 2], S[dblk][8 * s + 3]); pa_.z = cvt2(S[dblk][8 * s + 4], S[dblk][8 * s + 5]); pa_.w = cvt2(S[dblk][8 * s + 6], S[dblk][8 * s + 7]);
                const bf16x8 a = __builtin_bit_cast(bf16x8, pa_);
#pragma unroll
                for (int ti = 0; ti < 2; ++ti) { const bf16x8 bqv = __builtin_shufflevector(bq[dblk & 1][(s * 2 + ti) * 2], bq[dblk & 1][(s * 2 + ti) * 2 + 1], 0, 1, 2, 3, 4, 5, 6, 7); ot[ti] = GLA_MFMA(a, bqv, ot[ti]); } } }
#undef GLA_LDBQ
        s16x4 kf[2][8]; f32x4 dcv[2][4];
#define GLA_LDKF(buf, dblk_) do { _Pragma("unroll") for (int kk = 0; kk < 4; ++kk) { kf[buf][2 * kk] = GLA_TR(tr_kh + (dblk_) * 64 + kk * 16 * SKS); kf[buf][2 * kk + 1] = GLA_TR(tr_kh + (dblk_) * 64 + kk * 16 * SKS + 4 * SKS); } \
            _Pragma("unroll") for (int g = 0; g < 4; ++g) dcv[buf][g] = *(const LAS f32x4*)(lds + S_DEC + (32 * (dblk_) + 8 * g + 4 * hh) * 4); } while (0)
        GLA_LDKF(0, 0);
#pragma unroll
        for (int dblk = 0; dblk < 4; ++dblk) {
            if (dblk + 1 < 4) GLA_LDKF((dblk + 1) & 1, dblk + 1);
#pragma unroll
            for (int g = 0; g < 4; ++g)
#pragma unroll
                for (int e = 0; e < 4; ++e) S[dblk][4 * g + e] *= dcv[dblk & 1][g][e];
#pragma unroll
            for (int kk = 0; kk < 4; ++kk) { const bf16x8 a = __builtin_shufflevector(kf[dblk & 1][2 * kk], kf[dblk & 1][2 * kk + 1], 0, 1, 2, 3, 4, 5, 6, 7); S[dblk] = GLA_MFMA(a, vf[kk], S[dblk]); } }
#undef GLA_LDKF
        bf16x8 baf[6];
#pragma unroll
        for (int j = 0; j < 6; ++j) { const int ti = j < 2 ? 0 : 1, kk = j < 2 ? j : j - 2; baf[j] = *(const LAS bf16x8*)(lds + S_AT + (32 * ti + r) * SAS + (16 * kk + 8 * hh) * 2); }
#pragma unroll
        for (int j = 0; j < 6; ++j) { const int ti = j < 2 ? 0 : 1, kk = j < 2 ? j : j - 2; ot[ti] = GLA_MFMA(vf[kk], baf[j], ot[ti]); }
        }
#pragma unroll
        for (int ti = 0; ti < 2; ++ti) { float ss = 0.f;
#pragma unroll
            for (int i = 0; i < 16; ++i) ss += ot[ti][i] * ot[ti][i];
            ss += __shfl_xor(ss, 32); if (hh == 0) *(LAS float*)(lds + S_RED + (w * 64 + 32 * ti + r) * 4) = ss; }
        GLA_LBAR();
#pragma unroll
        for (int ti = 0; ti < 2; ++ti) { float tot = 0.f;
#pragma unroll
            for (int ww = 0; ww < 8; ++ww) tot += *(const LAS float*)(lds + S_RED + (ww * 64 + 32 * ti + r) * 4);
            const float rstd = rsqrtf(tot * (1.0f / GDV) + EPS);
#pragma unroll
            for (int g = 0; g < 4; ++g) { const f32x4 gg = *(const LAS f32x4*)(lds + S_GN + (32 * w + 4 * hh + 8 * g) * 4);
                u32x2 pkd; pkd.x = cvt2(ot[ti][4 * g + 0] * rstd * gg[0], ot[ti][4 * g + 1] * rstd * gg[1]); pkd.y = cvt2(ot[ti][4 * g + 2] * rstd * gg[2], ot[ti][4 * g + 3] * rstd * gg[3]);
                *(LAS u32x2*)(lds + S_OT + (32 * ti + r) * SVS + (32 * w + 8 * g + 4 * hh) * 2) = pkd; } }
        GLA_LBAR();
#pragma unroll
        for (int i = 0; i < 4; ++i) { const int idx = tid + 512 * i, row = idx >> 5, ch = idx & 31; const u32x4 ov = *(const LAS u32x4*)(lds + S_OT + row * SVS + ch * 16), sv = sg[i];
            u32x4 res; res.x = cvt2(pg8::bflo(ov.x) * pg8::bflo(sv.x), pg8::bfhi(ov.x) * pg8::bfhi(sv.x)); res.y = cvt2(pg8::bflo(ov.y) * pg8::bflo(sv.y), pg8::bfhi(ov.y) * pg8::bfhi(sv.y));
            res.z = cvt2(pg8::bflo(ov.z) * pg8::bflo(sv.z), pg8::bfhi(ov.z) * pg8::bfhi(sv.z)); res.w = cvt2(pg8::bflo(ov.w) * pg8::bflo(sv.w), pg8::bfhi(ov.w) * pg8::bfhi(sv.w));
            if (!(VAR & 1) || (c == SEQ / GCH - 1)) *(u32x4*)(ub_og + (size_t)(t0 + 16 * i) * (GVW * 2) + vo_ogc) = res; }
    }
#undef GLA_LOAD
}
#undef GLA_MFMA
#undef GLA_TR
#undef GLA_LBAR
}
constexpr int NWAVES = 8;
constexpr int RING_BYTES = 131072;
constexpr int LDSCTL_OFF = RING_BYTES, MISC_OFF = LDSCTL_OFF + 320;
constexpr int LDS_BYTES = 147456;
constexpr int CW_TMO = 0, CW_QUEUE = 64, CW_BAR = 4096;
constexpr int PH_P0A = 0, PH_P0B = 1, PH_P0C = 2, PH_L0 = 3, PH_PER_LAYER = 7, PH_FINAL = PH_L0 + DEPTH * PH_PER_LAYER, PH_COUNT = PH_FINAL + 1;
constexpr int PL_IN = 0, PL_PRE = 1, PL_MIX = 2, PL_UP = 3, PL_OUT = 4, PL_FFI = 5, PL_FFO = 6;

#ifndef EN_P0
#define EN_P0 1
#endif
#ifndef EN_IN
#define EN_IN 1
#endif
#ifndef EN_PRE
#define EN_PRE 1
#endif
#ifndef EN_MOBA
#define EN_MOBA 1
#endif
#ifndef EN_GLA
#define EN_GLA 1
#endif
#ifndef EN_UP
#define EN_UP 1
#endif
#ifndef EN_OUT
#define EN_OUT 1
#endif
#ifndef EN_FFI
#define EN_FFI 1
#endif
#ifndef EN_FFO
#define EN_FFO 1
#endif
struct Args { Params P; int ph_lo, ph_hi, li, pad; };

__device__ __forceinline__ void glr_unit(const Params& P, int l, const float* ssq, int rg64, int wave, int lane, LAS unsigned char* lds) {
    const bf16* A = (const bf16*)(P.ws + WS_ABUF); const bf16* W = wt_ptr(P, l, WT_GLR);
    const int rg = wave & 3, kh = wave >> 2, r16 = lane & 15, q = lane >> 4, row0 = rg64 * 64 + rg * 16;
    const bf16* ap = A + (size_t)(row0 + r16) * DM + kh * 1024 + 8 * q; const bf16* bp = W + (size_t)r16 * DM + kh * 1024 + 8 * q;
    f32x4 acc = {0.f, 0.f, 0.f, 0.f};
#pragma unroll 8
    for (int k0 = 0; k0 < 1024; k0 += 32) acc = __builtin_amdgcn_mfma_f32_16x16x32_bf16(*(const bf16x8*)(ap + k0), *(const bf16x8*)(bp + k0), acc, 0, 0, 0);
    LAS f32x4* part = (LAS f32x4*)lds;
    if (kh == 1) part[rg * 64 + lane] = acc;
    __syncthreads();
    if (kh == 0) { const f32x4 o = part[rg * 64 + lane];
        const float* shw = (const float*)(P.ws + WS_SHWGLR) + (size_t)l * 8 * GRANK;
#pragma unroll
        for (int j = 0; j < 4; ++j) { const int row = row0 + 4 * q + j, b = row / SEQ; *(LAS float*)(lds + gla::L_GLR + ((rg * 16 + 4 * q + j) * GRANK + r16) * 4) = rsqrtf(ssq[row] * (1.f / DM) + EPS) * (acc[j] + o[j]) + shw[b * GRANK + r16]; } }
    __syncthreads();
}
__device__ __forceinline__ void kmean_unit(const Params& P, int item, int tid, LAS unsigned char* lds) {
    const int blk = item % MNB, bh = item / MNB, b = bh / MH, h = bh % MH, c8 = tid & 15, rgp = tid >> 4;
    const bf16* p = (const bf16*)(P.ws + WS_PROJ) + PJ_MK + ((size_t)bh * SEQ + blk * MBLK + rgp) * MHD + 8 * c8;
    float s[8];
#pragma unroll
    for (int j = 0; j < 8; ++j) s[j] = 0.f;
#pragma unroll
    for (int i = 0; i < 8; ++i) { const u32x4 w = *(const u32x4*)(p + (size_t)(32 * i) * MHD);
        s[0] += pg8::bflo(w.x); s[1] += pg8::bfhi(w.x); s[2] += pg8::bflo(w.y); s[3] += pg8::bfhi(w.y); s[4] += pg8::bflo(w.z); s[5] += pg8::bfhi(w.z); s[6] += pg8::bflo(w.w); s[7] += pg8::bfhi(w.w); }
    LAS float* red = (LAS float*)lds;
#pragma unroll
    for (int j = 0; j < 8; ++j) red[rgp * 128 + 8 * c8 + j] = s[j];
    __syncthreads();
    if (tid < 128) { float a = 0.f;
#pragma unroll
        for (int r = 0; r < 32; ++r) a += red[r * 128 + tid];
        ((float*)(P.ws + WS_KMEAN))[((size_t)bh * MNB + blk) * MHD + tid] = a * (1.f / MBLK); }
    __syncthreads();
}
__device__ __forceinline__ void final_row(float* x, const float* g, int m, int lane) {
    f32x4* xr = (f32x4*)(x + (size_t)m * DM); float s = 0.f; f32x4 v[8];
#pragma unroll
    for (int j = 0; j < 8; ++j) { v[j] = xr[lane + 64 * j]; s += (v[j].x * v[j].x + v[j].y * v[j].y) + (v[j].z * v[j].z + v[j].w * v[j].w); }
    const float rstd = rsqrtf(wave_sum(s) * (1.f / DM) + EPS);
#pragma unroll
    for (int j = 0; j < 8; ++j) { const f32x4 gg = *(const f32x4*)(g + 4 * (lane + 64 * j)); xr[lane + 64 * j] = v[j] * rstd * gg; }
}

template <int FK>
__device__ __forceinline__ void moba_phase(const Params& P, unsigned* queues  , char* ldsg, volatile LAS unsigned* qslot  , int tid) {
    const bf16* PROJ = (const bf16*)(P.ws + WS_PROJ); bf16* OM = FK ? (bf16*)(P.ws + (size_t)768 * MiB) : (bf16*)(P.ws + WS_OGOM) + (size_t)MT * GVW; const float* KM = (const float*)(P.ws + WS_KMEAN);
    constexpr int W = 1 << 20; constexpr unsigned NONE = 0xffffffffu;
    const unsigned x0 = xb_xcc_id() & 7u; unsigned xo = 0u;
#define MOBA_POP(dst) do { unsigned u_ = NONE; while (xo < 8u) { const unsigned x_ = (x0 + xo) & 7u; const unsigned i_ = __hip_atomic_fetch_add(queues + 64 * x_, 1u, __ATOMIC_RELAXED, __HIP_MEMORY_SCOPE_AGENT); \
        if (i_ < 64u) { u_ = (x_ << 8) | i_; break; } ++xo; } (dst) = u_; } while (0)
#define MOBA_REF(ref, u_) do { const int i_ = (int)((u_) & 63u), x_ = (int)((u_) >> 8), qb_ = MNB - 1 - (i_ >> 3), bh_ = 8 * x_ + (i_ & 7);   \
        (ref).Q = PROJ + PJ_MQ + ((size_t)bh_ * SEQ + qb_ * MBLK) * MHD; (ref).K = PROJ + PJ_MK + (size_t)bh_ * SEQ * MHD; (ref).V = PROJ + PJ_MV + (size_t)bh_ * SEQ * MHD; \
        (ref).O = OM + (size_t)((bh_ >> 3) * SEQ + qb_ * MBLK) * MW + (bh_ & 7) * MHD; (ref).P0 = qb_ * MBLK; (ref).km = KM + (size_t)bh_ * MNB * MHD; (ref).qb = qb_; } while (0)
    if (tid == 0) { unsigned a_, b_; MOBA_POP(a_); MOBA_POP(b_); qslot[0] = a_; qslot[1] = b_; }
    __syncthreads();
    unsigned u = __builtin_amdgcn_readfirstlane(qslot[0]);
    if (u == NONE) return;
    moba::Seam<bf16> S; moba::BlockRef<bf16, bf16> cur, nxt;
    MOBA_REF(cur, u);
    moba::causal_swa_prime<bf16, bf16>(cur, W, ldsg, S);
    for (int it = 0;; ++it) {
        const unsigned un = __builtin_amdgcn_readfirstlane(qslot[(it + 1) % 3]);
        if (tid == 0) { unsigned c_; MOBA_POP(c_); qslot[(it + 2) % 3] = c_; }
        const bool last = un == NONE;
        if (last) nxt = cur; else MOBA_REF(nxt, un);
        moba::causal_swa_block<bf16, bf16, FK>(cur, nxt, SEQ, W, ldsg, S);
        if (last) break;
        cur = nxt;
    }
#undef MOBA_POP
#undef MOBA_REF
}

__global__ void __launch_bounds__(NWAVES * 64, 2) mega(Args args) {
    extern __shared__ __attribute__((aligned(16))) unsigned char lds_raw[];
    LAS unsigned char* lds = (LAS unsigned char*)lds_raw;
    volatile LAS unsigned* MISC = (volatile LAS unsigned*)(lds + MISC_OFF);
    const Params& P = args.P;
    const int wave = __builtin_amdgcn_readfirstlane(threadIdx.x >> 6);
#define OTID(name) int name = threadIdx.x; asm volatile("" : "+v"(name))
    const int G = gridDim.x, bx = blockIdx.x, vcu = (G % 8 == 0) ? (bx % 8) * (G / 8) + bx / 8 : bx;
    const int gw = vcu * NWAVES + wave, ngw = G * NWAVES;
    unsigned* ctl = (unsigned*)(P.ws + WS_CTL);
    { OTID(t0); for (int u = t0; u < (LDS_BYTES - LDSCTL_OFF) / 4; u += NWAVES * 64) ((LAS unsigned*)(lds + LDSCTL_OFF))[u] = 0u; }
    __syncthreads();
    const int lo = args.ph_lo, hi = args.ph_hi;
    XcdBarrier bar; bar.bar = ctl + CW_BAR + args.li * XCD_BAR_WORDS; bar.x = 0; bar.st = nullptr;
    if (hi - lo > 1) bar = xcd_barrier_post(ctl + CW_BAR + args.li * XCD_BAR_WORDS, MISC + 8);
#define IN(k) (lo <= (k) && (k) < hi)
#if defined(PROBE_MASK)
#define PROBE_AT(k) PROBE_TY((k) < PH_L0 ? (k) : ((k) >= PH_FINAL ? 10 : PH_L0 + ((k) - PH_L0) % PH_PER_LAYER))
#define PROBE_TY(ty) do { if (blockIdx.x == 0 && threadIdx.x == 0) { const unsigned long long now_ = __builtin_amdgcn_s_memrealtime(); const int ty_ = (ty); \
        unsigned long long last_ = ((unsigned long long)MISC[21] << 32) | MISC[20], acc_ = ((unsigned long long)MISC[23] << 32) | MISC[22]; if ((PROBE_MASK >> ty_) & 1) acc_ += now_ - last_; \
        MISC[20] = (unsigned)now_; MISC[21] = (unsigned)(now_ >> 32); MISC[22] = (unsigned)acc_; MISC[23] = (unsigned)(acc_ >> 32); } } while (0)
#else
#define PROBE_AT(k) do { } while (0)
#endif
#define SEAM(k) do { if (IN(k) && IN((k) + 1)) xcd_barrier(bar); PROBE_AT(k); } while (0)
#if defined(PROBE_MASK)
    if (blockIdx.x == 0 && threadIdx.x == 0) { const unsigned long long now_ = __builtin_amdgcn_s_memrealtime(); MISC[20] = (unsigned)now_; MISC[21] = (unsigned)(now_ >> 32); MISC[22] = 0u; MISC[23] = 0u; }
#endif

    if (EN_P0 && IN(PH_P0A)) { OTID(t1); phase_p0a(P, gw, ngw, t1 & 63, (float*)(lds_raw + wave * 16384)); __syncthreads(); SEAM(PH_P0A); }
    if (EN_P0 && IN(PH_P0B)) { OTID(t1); phase_p0b(P, vcu * NWAVES * 64 + t1, G * NWAVES * 64); SEAM(PH_P0B); }
    if (EN_P0 && IN(PH_P0C)) {
        OTID(t1);
        for (int m = gw; m < MT / 2; m += ngw) a1prep_row(P, m, t1 & 63);
        shw_all(P, gw, ngw, t1 & 63);
        SEAM(PH_P0C);
    }
    for (int l = 0; l < DEPTH; ++l) {
        const int pb = PH_L0 + l * PH_PER_LAYER;
        bf16* ABUF = (bf16*)(P.ws + WS_ABUF); bf16* OGOM = (bf16*)(P.ws + WS_OGOM); bf16* PROJ = (bf16*)(P.ws + WS_PROJ); bf16* HID = PROJ;
        float* SSQA = (float*)(P.ws + WS_SSQ0); float* SSQB = (float*)(P.ws + WS_SSQ) + (size_t)l * MT; float* SSQN = (float*)(P.ws + WS_SSQ) + (size_t)(2 + l) * MT;
        const float* mv = (const float*)(P.ws + WS_MODV) + (size_t)l * 8 * 6 * DM;
        const float* mvn = (const float*)(P.ws + WS_MODV) + (size_t)(l + 1 < DEPTH ? l + 1 : l) * 8 * 6 * DM;
        const float* ssq_in = l == 0 ? SSQA : (const float*)(P.ws + WS_SSQ) + (size_t)(2 + l - 1) * MT;
        if (EN_IN && IN(pb + PL_IN)) {
            pg8::Gemm g{ABUF, wt_ptr(P, l, WT_IN), MT, NIN, DM}; pg8::StaticOrder S; S.init(MT, NIN, G, bx);
            pg8::EpiIn E{ssq_in, (const float*)(P.ws + WS_SHWIN) + (size_t)l * 8 * NIN, PROJ};
            pg8::gemm_phase<pg8::EpiIn, pg8::StaticOrder, true, true>(lds, g, S, E);
            SEAM(pb + PL_IN);
        }
        if (EN_PRE && IN(pb + PL_PRE)) {
            OTID(t2);
            for (int u = vcu; u < MT / 64; u += G) { glr_unit(P, l, ssq_in, u, wave, t2 & 63, lds);
                for (int h = 0; h < GH; ++h) gla::gla_pre_head(P, l, u >> 5, u & 31, h, lds, t2); }
            for (int it = vcu; it < NB * MH * MNB; it += G) kmean_unit(P, it, t2, lds);
            SEAM(pb + PL_PRE);
        }
        if (IN(pb + PL_MIX)) {
            if (EN_GLA && bx < NB * GH) { OTID(t3); gla::gla_seq_unit<0>(P, l, bx, lds, t3);
#if defined(GLA_PROBE_VAR)
                __syncthreads(); { OTID(t3b); gla::gla_seq_unit<GLA_PROBE_VAR>(P, l, bx, lds, t3b); }
#endif
            }
#if defined(PROBE_MASK) && defined(PROBE_SPLIT)
            xcd_barrier(bar); PROBE_TY(11);
#endif
            if (EN_MOBA) { OTID(t4); moba_phase<0>(P, ctl + CW_QUEUE + 512 * l, (char*)lds_raw, MISC + 16, t4); }
#if defined(MOBA_PROBE_VAR)
            __syncthreads(); { OTID(t4b); moba_phase<MOBA_PROBE_VAR>(P, ctl + CW_QUEUE + 1024 + 512 * l, (char*)lds_raw, MISC + 24, t4b); }
#endif
            SEAM(pb + PL_MIX);
        }
        if (EN_UP && IN(pb + PL_UP)) {
            { pg8::Gemm g{OGOM, wt_ptr(P, l, WT_UPG), MT, DM, GVW};     pg8::StaticOrder S; S.init(MT, DM, G, bx); pg8::EpiUp<false> E{PROJ, GT_OFF, ABUF};
              pg8::gemm_phase<pg8::EpiUp<false>, pg8::StaticOrder, true, true>(lds, g, S, E); }
            { pg8::Gemm g{OGOM + (size_t)MT * GVW, wt_ptr(P, l, WT_UPM), MT, DM, MW};     pg8::StaticOrder S; S.init(MT, DM, G, bx); pg8::EpiUp<true> E{PROJ, GT_OFF + DM, ABUF};
              pg8::gemm_phase<pg8::EpiUp<true>, pg8::StaticOrder, true, true>(lds, g, S, E); }
            SEAM(pb + PL_UP);
        }
        if (EN_OUT && IN(pb + PL_OUT)) {
            pg8::Gemm g{ABUF, wt_ptr(P, l, WT_OUT), MT, DM, DM}; pg8::StaticOrder S; S.init(MT, DM, G, bx);
            pg8::EpiRes E{l == 0 ? P.x : P.out, P.out, mv + 2 * DM, mv + 4 * DM, OGOM, SSQB};
            pg8::gemm_phase<pg8::EpiRes, pg8::StaticOrder, true, true>(lds, g, S, E);
            SEAM(pb + PL_OUT);
        }
        if (EN_FFI && IN(pb + PL_FFI)) {
            pg8::Gemm g{OGOM, wt_ptr(P, l, WT_FFI), MT, NFFI, DM}; pg8::StaticOrder S; S.init(MT, NFFI, G, bx);
            pg8::EpiFfi E{SSQB, (const float*)(P.ws + WS_SHWFFI) + (size_t)l * 8 * NFFI, HID};
            pg8::gemm_phase<pg8::EpiFfi, pg8::StaticOrder, true, true>(lds, g, S, E);
            SEAM(pb + PL_FFI);
        }
        if (EN_FFO && IN(pb + PL_FFO)) {
            pg8::Gemm g{HID, wt_ptr(P, l, WT_FFO), MT, DM, DFF}; pg8::StaticOrder S; S.init(MT, DM, G, bx);
            pg8::EpiRes E{P.out, P.out, mv + 5 * DM, mvn + 1 * DM, l + 1 < DEPTH ? ABUF : nullptr, l + 1 < DEPTH ? SSQN : nullptr};
            pg8::gemm_phase<pg8::EpiRes, pg8::StaticOrder, true, true>(lds, g, S, E);
            SEAM(pb + PL_FFO);
        }
    }
    if (IN(PH_FINAL)) { OTID(t5); for (int m = gw; m < MT; m += ngw) final_row(P.out, P.final_g, m, t5 & 63); }
#if defined(PROBE_MASK)
    PROBE_AT(PH_FINAL);
    if (blockIdx.x == 0 && threadIdx.x == 0) { const unsigned long long acc_ = ((unsigned long long)MISC[23] << 32) | MISC[22]; const unsigned long long t_end = __builtin_amdgcn_s_memrealtime() + (unsigned long long)(PROBE_MULT) * acc_;
        while (__builtin_amdgcn_s_memrealtime() < t_end) __builtin_amdgcn_s_sleep(8); }
#endif
#undef IN
#undef SEAM
#undef OTID
}
extern "C" void kernel_launch(void* const* d_in, const int* in_sizes, int n_in, void* d_out, int out_size, void* d_ws, size_t ws_size, hipStream_t stream) {
    static int grid = 0;
    if (grid == 0) {
        if (n_in != 16 || in_sizes[0] != MT * DM || out_size != MT * DM || ws_size < WS_NEED) { fprintf(stderr, "kernel_launch: unexpected shapes/ws (n_in %d, ws %zu, need %zu)\n", n_in, ws_size, (size_t)WS_NEED); grid = -1; return; }
        int dev = 0, cus = 0, per_cu = 0;
        if (hipGetDevice(&dev) != hipSuccess || hipDeviceGetAttribute(&cus, hipDeviceAttributeMultiprocessorCount, dev) != hipSuccess) { grid = -1; return; }
        if (hipFuncSetAttribute((const void*)mega, hipFuncAttributeMaxDynamicSharedMemorySize, LDS_BYTES) != hipSuccess) { fprintf(stderr, "kernel_launch: hipFuncSetAttribute failed\n"); grid = -1; return; }
        if (hipOccupancyMaxActiveBlocksPerMultiprocessor(&per_cu, (const void*)mega, NWAVES * 64, LDS_BYTES) != hipSuccess || per_cu < 1) fprintf(stderr, "kernel_launch: occupancy query says %d\n", per_cu);
        (void)hipGetLastError();
        grid = cus;
    }
    if (grid < 0) return;
    Args a{};
    Params& P = a.P;
    P.x = (const float*)d_in[0]; P.c = (const float*)d_in[1]; P.ada_w = (const float*)d_in[2]; P.ada_b = (const float*)d_in[3]; P.norm1_g = (const float*)d_in[4]; P.w_in = (const float*)d_in[5];
    P.gate_w2 = (const float*)d_in[6]; P.gate_b = (const float*)d_in[7]; P.gla_norm_g = (const float*)d_in[8]; P.w_up_gla = (const float*)d_in[9]; P.w_up_moba = (const float*)d_in[10];
    P.w_out = (const float*)d_in[11]; P.norm2_g = (const float*)d_in[12]; P.w_ffn_in = (const float*)d_in[13]; P.w_ffn_out = (const float*)d_in[14]; P.final_g = (const float*)d_in[15];
    P.out = (float*)d_out; P.ws = (unsigned char*)d_ws;
    unsigned char* ws = (unsigned char*)d_ws;
    (void)hipMemsetAsync(ws + WS_CTL, 0, CTL_ZERO_BYTES, stream);
#define MEGA(lo_, hi_) do { a.ph_lo = (lo_); a.ph_hi = (hi_); a.li = 0; hipLaunchKernelGGL(mega, dim3(grid), dim3(NWAVES * 64), LDS_BYTES, stream, a); } while (0)
    MEGA(0, PH_COUNT);
#undef MEGA
}
```

```cpp
#include <hip/hip_runtime.h>
#include <cstdio>
#include <cstdint>

constexpr int NB = 8, SEQ = 2048, DM = 2048, MT = NB * SEQ, DEPTH = 2;
constexpr int GH = 4, GDK = 128, GDV = 256, GKW = 512, GVW = 1024, GRANK = 16, GCH = 64;
constexpr int MH = 8, MHD = 128, MW = 1024, MBLK = 256, MNB = SEQ / MBLK, MTOPK = 3;
constexpr int DFF = 5632, NFFI = 2 * DFF;
constexpr int NINSRC = 10256, NIN = 10240;
constexpr float EPS = 1e-6f;
constexpr int GQ_OFF = 0, GK_OFF = 512, GV_OFF = 1024, GR_OFF = 2048, MQ_OFF = 3072, MK_OFF = 4096, MV_OFF = 5120, GT_OFF = 6144;
constexpr int GLR_SRC = 3072;
constexpr size_t PJ_GQ = 0, PJ_GK = (size_t)MT * 512, PJ_GV = (size_t)MT * 1024, PJ_GR = (size_t)MT * 2048, PJ_MQ = (size_t)MT * 3072, PJ_MK = (size_t)MT * 4096, PJ_MV = (size_t)MT * 5120, PJ_GT = (size_t)MT * 6144;

constexpr size_t MiB = 1u << 20;
constexpr size_t WS_CTL = 0, CTL_ZERO_BYTES = 2 * MiB;
constexpr size_t WS_SSQ = 1 * MiB;
constexpr size_t WS_MODP = 2 * MiB;
constexpr size_t WS_MODV = 8 * MiB;
constexpr size_t WS_SHWIN = 9 * MiB;
constexpr size_t WS_SHWFFI = 10 * MiB;
constexpr size_t WS_SHWGLR = 11 * MiB;
constexpr size_t WS_GLR = 12 * MiB;
constexpr size_t WS_KMEAN = 13 * MiB;
constexpr size_t WS_SSQ0 = 14 * MiB;
constexpr size_t WS_WT = 16 * MiB, WT_LAYER = 123 * MiB;
constexpr size_t WT_IN = 0, WT_GLR = 40 * MiB, WT_UPG = 41 * MiB, WT_UPM = 45 * MiB, WT_OUT = 49 * MiB, WT_FFI = 57 * MiB, WT_FFO = 101 * MiB;
constexpr size_t WS_ABUF = 262 * MiB;
constexpr size_t WS_OGOM = 326 * MiB;
constexpr size_t WS_PROJ = 390 * MiB;
constexpr size_t WS_END = 710 * MiB;
constexpr size_t WS_DBG_G = 710 * MiB;
constexpr size_t WS_DBG_O = 742 * MiB;
constexpr size_t WS_DBG_END = 806 * MiB;
constexpr size_t WS_NEED = 752 * MiB;

typedef unsigned short bf16;
typedef short bf16x8 __attribute__((ext_vector_type(8)));
typedef float f32x4 __attribute__((ext_vector_type(4)));
typedef unsigned u32x4 __attribute__((ext_vector_type(4)));
typedef unsigned u32x2 __attribute__((ext_vector_type(2)));

struct Params {
    const float* x; const float* c; const float* ada_w; const float* ada_b; const float* norm1_g; const float* w_in;
    const float* gate_w2; const float* gate_b; const float* gla_norm_g; const float* w_up_gla; const float* w_up_moba;
    const float* w_out; const float* norm2_g; const float* w_ffn_in; const float* w_ffn_out; const float* final_g;
    float* out; unsigned char* ws;
};

__device__ __forceinline__ unsigned f2bf(float f) { unsigned u = __builtin_bit_cast(unsigned, f); return (u + 0x7fffu + ((u >> 16) & 1u)) >> 16; }
__device__ __forceinline__ unsigned pk2(float lo, float hi) { return f2bf(lo) | (f2bf(hi) << 16); }
__device__ __forceinline__ float bf2f(unsigned short b) { return __builtin_bit_cast(float, ((unsigned)b) << 16); }
__device__ __forceinline__ float wave_sum(float v) {
#pragma unroll
    for (int o = 1; o < 64; o <<= 1) v += __shfl_xor(v, o);
    return v;
}
__device__ __forceinline__ float sigmoidf_(float v) { return 1.0f / (1.0f + __expf(-v)); }
__device__ __forceinline__ float siluf_(float v) { return v / (1.0f + __expf(-v)); }
__device__ __forceinline__ float logsigmoidf_(float v) { return fminf(v, 0.f) - log1pf(__expf(-fabsf(v))); }

__device__ __forceinline__ const bf16* wt_ptr(const Params& P, int l, size_t off) { return (const bf16*)(P.ws + WS_WT + (size_t)l * WT_LAYER + off); }
__device__ __forceinline__ int in_src_col(int n) { return n < 3072 ? n : n + 16; }
__device__ __forceinline__ int ffi_src_col(int r) { const int pn = r >> 8, c = r & 255; return c < 128 ? pn * 128 + c : DFF + pn * 128 + (c - 128); }

__device__ __forceinline__ void ada_item(const Params& P, int item, int lane, float* scr) {
    const int cg = item % 96, kc = (item / 96) % 8, l = item / 768;
    const int k0 = kc * 256;
    for (int i = 0; i < 32; ++i) { const int idx = lane + 64 * i, b = idx >> 8, kk = idx & 255; scr[idx] = siluf_(P.c[b * DM + k0 + kk]); }
    __builtin_amdgcn_s_waitcnt(0);
    const float* W = P.ada_w + (size_t)l * DM * (6 * DM) + (size_t)k0 * (6 * DM) + cg * 128 + 2 * lane;
    float a0[8], a1[8];
#pragma unroll
    for (int b = 0; b < 8; ++b) { a0[b] = 0.f; a1[b] = 0.f; }
#pragma unroll 8
    for (int kk = 0; kk < 256; ++kk) {
        typedef float f32x2n __attribute__((ext_vector_type(2))); const f32x2n w = __builtin_nontemporal_load((const f32x2n*)(W + (size_t)kk * (6 * DM)));
#pragma unroll
        for (int b = 0; b < 8; ++b) { const float cv = scr[b * 256 + kk]; a0[b] += cv * w.x; a1[b] += cv * w.y; }
    }
    float* MP = (float*)(P.ws + WS_MODP) + ((size_t)(kc * 2 + l) * 8) * (6 * DM) + cg * 128 + 2 * lane;
#pragma unroll
    for (int b = 0; b < 8; ++b) *(float2*)(MP + (size_t)b * (6 * DM)) = make_float2(a0[b], a1[b]);
    __builtin_amdgcn_s_waitcnt(0);
}
__device__ __forceinline__ void transpose_item(const float* W, int Nsrc, int src_col0, int K, int k0, bf16* WT, int dst_row0, float* scr, int lane) {
    f32x4 v[8];
    const float* src = W + (size_t)(k0 + (lane >> 3)) * Nsrc + src_col0 + 4 * (lane & 7);
#pragma unroll
    for (int i = 0; i < 8; ++i) v[i] = __builtin_nontemporal_load((const f32x4*)(src + (size_t)(8 * i) * Nsrc));
#pragma unroll
    for (int i = 0; i < 8; ++i) { float* d = scr + (8 * i + (lane >> 3)) * 33 + 4 * (lane & 7); d[0] = v[i][0]; d[1] = v[i][1]; d[2] = v[i][2]; d[3] = v[i][3]; }
    __builtin_amdgcn_s_waitcnt(0);
    const int c = lane & 7;
#pragma unroll
    for (int j = 0; j < 4; ++j) { const int n = (lane >> 3) + 8 * j; const float* s = scr + (8 * c) * 33 + n;
        u32x4 o; o.x = pk2(s[0 * 33], s[1 * 33]); o.y = pk2(s[2 * 33], s[3 * 33]); o.z = pk2(s[4 * 33], s[5 * 33]); o.w = pk2(s[6 * 33], s[7 * 33]);
        *(u32x4*)(WT + (size_t)(dst_row0 + n) * K + k0 + 8 * c) = o; }
    __builtin_amdgcn_s_waitcnt(0);
}
constexpr int TI_IN = (DM / 64) * (NIN / 32), TI_UP = (GVW / 64) * (DM / 32), TI_OUT = (DM / 64) * (DM / 32), TI_FFI = (DM / 64) * (NFFI / 32), TI_FFO = (DFF / 64) * (DM / 32), TI_GLR = DM / 64;
constexpr int TI_LAYER = TI_IN + 2 * TI_UP + TI_OUT + TI_FFI + TI_FFO + TI_GLR;
__device__ __forceinline__ void wconv_item(const Params& P, int item, int lane, float* scr) {
    const int l = item / TI_LAYER; int r = item % TI_LAYER;
    unsigned char* wl = P.ws + WS_WT + (size_t)l * WT_LAYER;
    if (r < TI_IN) { const int nb = r % (NIN / 32), kb = r / (NIN / 32);
        transpose_item(P.w_in + (size_t)l * DM * NINSRC, NINSRC, in_src_col(nb * 32), DM, kb * 64, (bf16*)(wl + WT_IN), nb * 32, scr, lane); return; } r -= TI_IN;
    if (r < TI_UP) { const int nb = r % (DM / 32), kb = r / (DM / 32);
        transpose_item(P.w_up_gla + (size_t)l * GVW * DM, DM, nb * 32, GVW, kb * 64, (bf16*)(wl + WT_UPG), nb * 32, scr, lane); return; } r -= TI_UP;
    if (r < TI_UP) { const int nb = r % (DM / 32), kb = r / (DM / 32);
        transpose_item(P.w_up_moba + (size_t)l * MW * DM, DM, nb * 32, MW, kb * 64, (bf16*)(wl + WT_UPM), nb * 32, scr, lane); return; } r -= TI_UP;
    if (r < TI_OUT) { const int nb = r % (DM / 32), kb = r / (DM / 32);
        transpose_item(P.w_out + (size_t)l * DM * DM, DM, nb * 32, DM, kb * 64, (bf16*)(wl + WT_OUT), nb * 32, scr, lane); return; } r -= TI_OUT;
    if (r < TI_FFI) { const int nb = r % (NFFI / 32), kb = r / (NFFI / 32);
        transpose_item(P.w_ffn_in + (size_t)l * DM * NFFI, NFFI, ffi_src_col(nb * 32), DM, kb * 64, (bf16*)(wl + WT_FFI), nb * 32, scr, lane); return; } r -= TI_FFI;
    if (r < TI_FFO) { const int nb = r % (DM / 32), kb = r / (DM / 32);
        transpose_item(P.w_ffn_out + (size_t)l * DFF * DM, DM, nb * 32, DFF, kb * 64, (bf16*)(wl + WT_FFO), nb * 32, scr, lane); return; } r -= TI_FFO;
    { const int k0 = r * 64, j = lane & 15, kq = lane >> 4; bf16* G = (bf16*)(wl + WT_GLR); const float* W = P.w_in + (size_t)l * DM * NINSRC;
        for (int kk = 0; kk < 16; ++kk) { const int k = k0 + kq * 16 + kk; G[(size_t)j * DM + k] = (bf16)f2bf(W[(size_t)k * NINSRC + GLR_SRC + j]); } }
}
__device__ __forceinline__ void phase_p0a(const Params& P, int gw, int ngw, int lane, float* scr) {
    constexpr int NADA = 2 * 8 * 96;
    for (int it = gw; it < NADA; it += ngw) ada_item(P, it, lane, scr);
    for (int it = gw; it < DEPTH * TI_LAYER; it += ngw) wconv_item(P, it, lane, scr);
}
__device__ __forceinline__ void phase_p0b(const Params& P, int gtid, int ngt) {
    const float* MP = (const float*)(P.ws + WS_MODP); float* MV = (float*)(P.ws + WS_MODV);
    for (int i = gtid; i < 2 * 8 * DM; i += ngt) {
        const int j = i % DM, b = (i / DM) % 8, l = i / (8 * DM);
        float m[6];
#pragma unroll
        for (int s = 0; s < 6; ++s) { float a = P.ada_b[l * 6 * DM + s * DM + j];
            for (int kc = 0; kc < 8; ++kc) a += MP[((size_t)(kc * 2 + l) * 8 + b) * (6 * DM) + s * DM + j]; m[s] = a; }
        float* o = MV + ((size_t)(l * 8 + b) * 6) * DM + j;
        o[0 * DM] = m[0]; o[1 * DM] = P.norm1_g[l * DM + j] * (1.f + m[1]); o[2 * DM] = m[2];
        o[3 * DM] = m[3]; o[4 * DM] = P.norm2_g[l * DM + j] * (1.f + m[4]); o[5 * DM] = m[5];
    }
}
__device__ __forceinline__ void a1prep_row(const Params& P, int m0, int lane) {
    f32x4 v[2][8];
#pragma unroll
    for (int rr = 0; rr < 2; ++rr) { const f32x4* xr = (const f32x4*)(P.x + (size_t)(m0 + rr * (MT / 2)) * DM);
#pragma unroll
        for (int j = 0; j < 8; ++j) v[rr][j] = xr[lane + 64 * j]; }
#pragma unroll
    for (int rr = 0; rr < 2; ++rr) { const int m = m0 + rr * (MT / 2), b = m / SEQ; const float* gm = (const float*)(P.ws + WS_MODV) + ((size_t)(0 * 8 + b) * 6 + 1) * DM;
        bf16* A = (bf16*)(P.ws + WS_ABUF) + (size_t)m * DM; float s = 0.f;
#pragma unroll
        for (int j = 0; j < 8; ++j) { const f32x4 x4 = v[rr][j]; const f32x4 g = *(const f32x4*)(gm + 4 * (lane + 64 * j));
            s += (x4.x * x4.x + x4.y * x4.y) + (x4.z * x4.z + x4.w * x4.w);
            u32x2 w; w.x = pk2(x4.x * g.x, x4.y * g.y); w.y = pk2(x4.z * g.z, x4.w * g.w); *(u32x2*)(A + 4 * (lane + 64 * j)) = w; }
        s = wave_sum(s);
        if (lane == 0) ((float*)(P.ws + WS_SSQ0))[m] = s; }
}
constexpr int SHW_T_IN = (NIN + GRANK) / 16, SHW_T_FFI = NFFI / 16, SHW_TILES = DEPTH * (SHW_T_IN + SHW_T_FFI);
__device__ __forceinline__ void shw_all(const Params& P, int gw, int ngw, int lane) {
    const float* MV = (const float*)(P.ws + WS_MODV); const int r16 = lane & 15, q = lane >> 4;
    for (int item = gw; item < SHW_TILES; item += ngw) {
        const int l = item / (SHW_T_IN + SHW_T_FFI), rr = item % (SHW_T_IN + SHW_T_FFI), which = rr >= SHW_T_IN ? 1 : 0, n0 = (which ? rr - SHW_T_IN : rr) * 16;
        const bf16* rows = which ? wt_ptr(P, l, WT_FFI) + (size_t)n0 * DM : (n0 < NIN ? wt_ptr(P, l, WT_IN) + (size_t)n0 * DM : wt_ptr(P, l, WT_GLR));
        const bf16* bp = rows + (size_t)r16 * DM + 8 * q; const float* ap = MV + ((size_t)(l * 8 + (r16 & 7)) * 6 + (which ? 3 : 0)) * DM + 8 * q;
        f32x4 acc = {0.f, 0.f, 0.f, 0.f};
#pragma unroll 1
        for (int kb = 0; kb < DM; kb += 256) { bf16x8 bw[8]; f32x4 a0[8], a1[8];
#pragma unroll
            for (int j = 0; j < 8; ++j) { bw[j] = *(const bf16x8*)(bp + kb + 32 * j); a0[j] = *(const f32x4*)(ap + kb + 32 * j); a1[j] = *(const f32x4*)(ap + kb + 32 * j + 4); }
#pragma unroll
            for (int j = 0; j < 8; ++j) { u32x4 aw; aw.x = pk2(a0[j].x, a0[j].y); aw.y = pk2(a0[j].z, a0[j].w); aw.z = pk2(a1[j].x, a1[j].y); aw.w = pk2(a1[j].z, a1[j].w);
                acc = __builtin_amdgcn_mfma_f32_16x16x32_bf16(__builtin_bit_cast(bf16x8, aw), bw[j], acc, 0, 0, 0); } }
        if (q < 2) {
#pragma unroll
            for (int j = 0; j < 4; ++j) { const int b = 4 * q + j, n = n0 + r16;
                if (which) ((float*)(P.ws + WS_SHWFFI))[((size_t)l * 8 + b) * NFFI + n] = acc[j];
                else if (n0 < NIN) ((float*)(P.ws + WS_SHWIN))[((size_t)l * 8 + b) * NIN + n] = acc[j];
                else ((float*)(P.ws + WS_SHWGLR))[((size_t)l * 8 + b) * GRANK + (n - NIN)] = acc[j]; } }
    }
}

namespace pg8 {
#define PG8_LAS __attribute__((address_space(3)))
typedef unsigned short bf16_t;
typedef short bf16x8 __attribute__((ext_vector_type(8)));
typedef float f32x4 __attribute__((ext_vector_type(4)));
typedef unsigned u32x4 __attribute__((ext_vector_type(4)));
constexpr int BM = 256, BK = 64, HALF = 128, HTB = HALF * BK * 2  , STAGE_BYTES = 8 * HTB, NXCD = 8, WGM = 8;

__host__ __device__ __forceinline__ int lds_byte(int r, int c) { const int st = (r >> 4) * 2 + (c >> 5), rr = r & 15, cc = c & 31, ob = rr * 64 + cc * 2; return st * 1024 + (ob ^ (((ob >> 9) & 1) << 5)); }
__host__ __device__ __forceinline__ void stage_rc(int b, int& R, int& C) { const int st = b / 1024, sb = b % 1024, swz = sb ^ (((sb >> 9) & 1) << 5); R = (st >> 1) * 16 + swz / 64; C = (st & 1) * 32 + (swz % 64) / 2; }
__host__ __device__ __forceinline__ int perm32(int rho) { const int n = rho >> 4, i = rho & 15; return 8 * (i >> 2) + 4 * n + (i & 3); }

struct Unit { int pm, pn; };
struct Gemm { const bf16_t* A; const bf16_t* Bt; int M, N, K; };

struct StaticOrder {
    int nM, nN, nwg, G, c;
    __host__ __device__ void init(int M, int N, int G_, int c_) { nM = M / BM; nN = N / BM; nwg = nM * nN; G = G_; c = c_; }
    __host__ __device__ bool next(int i, Unit& u) const {
        const long L = (long)i * G + c; if (L >= nwg) return false;
        int wgid = (int)L; { const int q = nwg / NXCD, r = nwg % NXCD, xcd = wgid % NXCD, off = wgid / NXCD; wgid = (xcd < r ? xcd * (q + 1) : r * (q + 1) + (xcd - r) * q) + off; }
        const int nig = WGM * nN, gid = wgid / nig, fm = gid * WGM, gsz = (nM - fm) < WGM ? (nM - fm) : WGM;
        u.pm = fm + ((wgid % nig) % gsz); u.pn = (wgid % nig) / gsz; return true;
    }
    __device__ __forceinline__ void a_ready(const Unit&) const {}
    __device__ __forceinline__ void done(const Unit&) const {}
};
__device__ __forceinline__ unsigned cvt_pk_bf16(float lo, float hi) { unsigned r; asm volatile("v_cvt_pk_bf16_f32 %0, %1, %2" : "=v"(r) : "v"(lo), "v"(hi)); return r; }
typedef float f32x2 __attribute__((ext_vector_type(2)));
__device__ __forceinline__ float fsig(float v) { return __builtin_amdgcn_rcpf(1.0f + __builtin_amdgcn_exp2f(-1.4426950408889634f * v)); }
__device__ __forceinline__ float bflo(unsigned w) { return __builtin_bit_cast(float, w << 16); }
__device__ __forceinline__ float bfhi(unsigned w) { return __builtin_bit_cast(float, w & 0xffff0000u); }
struct EpiIn {
    static constexpr bool PERM = true, AFTER_DRAIN = false;
    const float* ssq; const float* shw; bf16_t* proj;
    __device__ __forceinline__ void operator()(const f32x4 (&acc)[2][2][4][2], const Unit& u, int wr, int wc, int fr, int fq) const {
        const int row0 = u.pm * BM + wr * 64 + fr, col0 = u.pn * BM + wc * 32 + 8 * fq, b = u.pm >> 3, t0 = (u.pm & 7) * BM + wr * 64 + fr;
        const int mode = u.pn < 2 ? 1 : ((u.pn >= 8 && u.pn < 12) ? 2 : (u.pn >= 24 ? 3 : 0));
        size_t off[2]; int stride;
        if (u.pn >= 24) { stride = 4096; off[0] = PJ_GT + (size_t)b * SEQ * 4096 + (u.pn * BM - GT_OFF) + wc * 32 + 8 * fq; off[1] = off[0] + HALF; }
        else { const int seg = u.pn < 2 ? 0 : u.pn < 4 ? 1 : u.pn < 8 ? 2 : u.pn < 12 ? 3 : u.pn < 16 ? 4 : u.pn < 20 ? 5 : 6;
            const size_t base = seg == 0 ? PJ_GQ : seg == 1 ? PJ_GK : seg == 2 ? PJ_GV : seg == 3 ? PJ_GR : seg == 4 ? PJ_MQ : seg == 5 ? PJ_MK : PJ_MV;
            const int c0 = seg == 0 ? GQ_OFF : seg == 1 ? GK_OFF : seg == 2 ? GV_OFF : seg == 3 ? GR_OFF : seg == 4 ? MQ_OFF : seg == 5 ? MK_OFF : MV_OFF;
            const bool wide = (seg == 2 || seg == 3); const int nh = seg >= 4 ? MH : GH; stride = wide ? 256 : 128;
#pragma unroll
            for (int bj = 0; bj < 2; ++bj) { const int cs = u.pn * BM - c0 + bj * HALF, head = wide ? (cs >> 8) : (cs >> 7), d = (wide ? (cs & 255) : 0) + wc * 32 + 8 * fq;
                off[bj] = base + ((size_t)(b * nh + head) * SEQ) * stride + d; } }
        f32x4 bv[2][2];
#pragma unroll
        for (int bj = 0; bj < 2; ++bj)
#pragma unroll
            for (int n = 0; n < 2; ++n) bv[bj][n] = *(const f32x4*)(shw + (size_t)b * NIN + col0 + bj * HALF + 4 * n);
#pragma unroll
        for (int ai = 0; ai < 2; ++ai)
#pragma unroll
            for (int m = 0; m < 4; ++m) { const int r = row0 + ai * HALF + m * 16, t = t0 + ai * HALF + m * 16; const float rstd = rsqrtf(ssq[r] * (1.0f / DM) + EPS);
#pragma unroll
                for (int bj = 0; bj < 2; ++bj) { f32x4 v0 = acc[ai][bj][m][0] * rstd + bv[bj][0], v1 = acc[ai][bj][m][1] * rstd + bv[bj][1];
                    if (mode == 1) { v0 = v0 * 0.08838834764831845f; v1 = v1 * 0.08838834764831845f; }
                    else if (mode == 2) {
#pragma unroll
                        for (int j = 0; j < 4; ++j) { v0[j] = v0[j] * fsig(v0[j]); v1[j] = v1[j] * fsig(v1[j]); } }
                    else if (mode == 3) {
#pragma unroll
                        for (int j = 0; j < 4; ++j) { v0[j] = fsig(v0[j]); v1[j] = fsig(v1[j]); } }
                    u32x4 w; w.x = cvt_pk_bf16(v0[0], v0[1]); w.y = cvt_pk_bf16(v0[2], v0[3]); w.z = cvt_pk_bf16(v1[0], v1[1]); w.w = cvt_pk_bf16(v1[2], v1[3]);
                    *(u32x4*)(proj + off[bj] + (size_t)t * stride) = w; } }
    }
};
struct EpiFfi {
    static constexpr bool PERM = true, AFTER_DRAIN = false;
    const float* ssq; const float* shw; bf16_t* hid;
    __device__ __forceinline__ void operator()(const f32x4 (&acc)[2][2][4][2], const Unit& u, int wr, int wc, int fr, int fq) const {
        const int row0 = u.pm * BM + wr * 64 + fr, bcol0 = u.pn * BM + wc * 32 + 8 * fq, hcol0 = u.pn * HALF + wc * 32 + 8 * fq, b = u.pm >> 3;
        f32x4 bv[2][2];
#pragma unroll
        for (int bj = 0; bj < 2; ++bj)
#pragma unroll
            for (int n = 0; n < 2; ++n) bv[bj][n] = *(const f32x4*)(shw + (size_t)b * NFFI + bcol0 + bj * HALF + 4 * n);
#pragma unroll
        for (int ai = 0; ai < 2; ++ai)
#pragma unroll
            for (int m = 0; m < 4; ++m) { const int r = row0 + ai * HALF + m * 16; const float rstd = rsqrtf(ssq[r] * (1.0f / DM) + EPS);
                f32x4 a0 = acc[ai][0][m][0] * rstd + bv[0][0], a1 = acc[ai][0][m][1] * rstd + bv[0][1];
                const f32x4 u0 = acc[ai][1][m][0] * rstd + bv[1][0], u1 = acc[ai][1][m][1] * rstd + bv[1][1];
#pragma unroll
                for (int j = 0; j < 4; ++j) { a0[j] = a0[j] * fsig(a0[j]) * u0[j]; a1[j] = a1[j] * fsig(a1[j]) * u1[j]; }
                u32x4 w; w.x = cvt_pk_bf16(a0[0], a0[1]); w.y = cvt_pk_bf16(a0[2], a0[3]); w.z = cvt_pk_bf16(a1[0], a1[1]); w.w = cvt_pk_bf16(a1[2], a1[3]);
                *(u32x4*)(hid + (size_t)r * DFF + hcol0) = w; }
    }
};
template <bool SECOND> struct EpiUp {
    static constexpr bool PERM = true, AFTER_DRAIN = false;
    const bf16_t* proj; int goff; bf16_t* mg;
    __device__ __forceinline__ void operator()(const f32x4 (&acc)[2][2][4][2], const Unit& u, int wr, int wc, int fr, int fq) const {
        const int row0 = u.pm * BM + wr * 64 + fr, col0 = u.pn * BM + wc * 32 + 8 * fq;
#pragma unroll
        for (int ai = 0; ai < 2; ++ai) {
            u32x4 gt[4][2], tp[4][2];
#pragma unroll
            for (int m = 0; m < 4; ++m)
#pragma unroll
                for (int bj = 0; bj < 2; ++bj) { const int r = row0 + ai * HALF + m * 16;
                    gt[m][bj] = *(const u32x4*)(proj + PJ_GT + (size_t)r * 4096 + (goff - GT_OFF) + col0 + bj * HALF);
                    if (SECOND) tp[m][bj] = *(const u32x4*)(mg + (size_t)r * DM + col0 + bj * HALF); }
#pragma unroll
            for (int m = 0; m < 4; ++m) { const int r = row0 + ai * HALF + m * 16;
#pragma unroll
                for (int bj = 0; bj < 2; ++bj) { const u32x4 g = gt[m][bj]; bf16_t* op = mg + (size_t)r * DM + col0 + bj * HALF;
                    f32x4 v0 = acc[ai][bj][m][0], v1 = acc[ai][bj][m][1];
                    v0[0] *= bflo(g.x); v0[1] *= bfhi(g.x); v0[2] *= bflo(g.y); v0[3] *= bfhi(g.y); v1[0] *= bflo(g.z); v1[1] *= bfhi(g.z); v1[2] *= bflo(g.w); v1[3] *= bfhi(g.w);
                    if (SECOND) { const u32x4 t = tp[m][bj];
                        v0[0] += bflo(t.x); v0[1] += bfhi(t.x); v0[2] += bflo(t.y); v0[3] += bfhi(t.y); v1[0] += bflo(t.z); v1[1] += bfhi(t.z); v1[2] += bflo(t.w); v1[3] += bfhi(t.w); }
                    u32x4 w; w.x = cvt_pk_bf16(v0[0], v0[1]); w.y = cvt_pk_bf16(v0[2], v0[3]); w.z = cvt_pk_bf16(v1[0], v1[1]); w.w = cvt_pk_bf16(v1[2], v1[3]);
                    *(u32x4*)op = w; } }
            asm volatile("" ::: "memory"); }
    }
};
struct EpiRes {
    static constexpr bool PERM = false, AFTER_DRAIN = false;
    const float* xin; float* xout; const float* gate; const float* gm; bf16_t* aout; float* ssq;
    __device__ __forceinline__ void operator()(const f32x4 (&acc)[2][2][4][2], const Unit& u, int wr, int wc, int fr, int fq) const {
        const int row0 = u.pm * BM + wr * 64 + fr, col0 = u.pn * BM + wc * 32 + 4 * fq, b = u.pm >> 3;
        f32x4 gv[2][2], mv[2][2];
#pragma unroll
        for (int bj = 0; bj < 2; ++bj)
#pragma unroll
            for (int n = 0; n < 2; ++n) { gv[bj][n] = *(const f32x4*)(gate + (size_t)b * 6 * DM + col0 + bj * HALF + n * 16);
                mv[bj][n] = aout ? *(const f32x4*)(gm + (size_t)b * 6 * DM + col0 + bj * HALF + n * 16) : (f32x4){0.f, 0.f, 0.f, 0.f}; }
#pragma unroll
        for (int ap = 0; ap < 4; ++ap) { const int ai = ap >> 1, mb = (ap & 1) * 2;
            f32x4 xv[2][2][2];
#pragma unroll
            for (int mm = 0; mm < 2; ++mm)
#pragma unroll
                for (int bj = 0; bj < 2; ++bj)
#pragma unroll
                    for (int n = 0; n < 2; ++n) xv[mm][bj][n] = *(const f32x4*)(xin + (size_t)(row0 + ai * HALF + (mb + mm) * 16) * DM + col0 + bj * HALF + n * 16);
#pragma unroll
            for (int mm = 0; mm < 2; ++mm) { const int m = mb + mm, r = row0 + ai * HALF + m * 16; const size_t off = (size_t)r * DM + col0; float s = 0.f;
#pragma unroll
                for (int bj = 0; bj < 2; ++bj)
#pragma unroll
                    for (int n = 0; n < 2; ++n) { const f32x4 o = xv[mm][bj][n] + gv[bj][n] * acc[ai][bj][m][n];
                        *(f32x4*)(xout + off + bj * HALF + n * 16) = o; s += (o[0] * o[0] + o[1] * o[1]) + (o[2] * o[2] + o[3] * o[3]);
                        if (aout) { const f32x4 a = o * mv[bj][n]; u32x2 w; w.x = cvt_pk_bf16(a[0], a[1]); w.y = cvt_pk_bf16(a[2], a[3]); *(u32x2*)(aout + off + bj * HALF + n * 16) = w; } }
                if (ssq) { s += __shfl_xor(s, 16); s += __shfl_xor(s, 32); if (fq == 0) __hip_atomic_fetch_add(ssq + r, s, __ATOMIC_RELAXED, __HIP_MEMORY_SCOPE_AGENT); } }
            asm volatile("" ::: "memory"); }
    }
};
template <class Epi, class Sched, bool ALIGN_EPI = false, bool SP2 = false>
__device__ __forceinline__ void gemm_phase(PG8_LAS unsigned char* lds, const Gemm g, const Sched& S, const Epi& E) {
    int tid_ = threadIdx.x; asm volatile("" : "+v"(tid_));
    const int tid = tid_, wid = __builtin_amdgcn_readfirstlane(tid >> 6), lane = tid & 63, wr = wid >> 2, wc = wid & 3, fr = lane & 15, fq = lane >> 4;
    const int K = g.K, nt = K / BK;
    unsigned voffA[2], voffB[2];
#pragma unroll
    for (int i = 0; i < 2; ++i) { int R, C; stage_rc(tid * 16 + i * 8192, R, C); const int Rb = Epi::PERM ? ((R & ~31) + perm32(R & 31)) : R;
        voffA[i] = (unsigned)(R * K + C) * 2u; voffB[i] = (unsigned)(Rb * K + C) * 2u; }
    const size_t kstep = (size_t)(BK * 2);
    const size_t hstep = (size_t)HALF * K * 2;
    const size_t tstep = 2 * hstep;
    const unsigned ldsw = (unsigned)wid * 1024u;
    const int aoff = lds_byte(wr * 64 + fr, fq * 8), boff = lds_byte(wc * 32 + fr, fq * 8);
#define PG8_SA(b, h) (((b) * 2 + (h)) * HTB)
#define PG8_SB(b, h) ((4 + (b) * 2 + (h)) * HTB)
#define PG8_STAGE(bufoff, gbase, voff) do { _Pragma("unroll") for (int _i = 0; _i < 2; ++_i) \
        __builtin_amdgcn_global_load_lds((const unsigned*)((const char*)(gbase) + (voff)[_i]), (PG8_LAS unsigned*)(lds + (bufoff) + ldsw + _i * 8192), 16, 0, 0); } while (0)
#define PG8_LDA(dst, b, h) do { _Pragma("unroll") for (int m = 0; m < 4; ++m) _Pragma("unroll") for (int k = 0; k < 2; ++k) dst[m][k] = *(const PG8_LAS bf16x8*)(lds + PG8_SA(b, h) + aoff + m * 2048 + k * 1024); } while (0)
#define PG8_LDB(dst, b, h) do { _Pragma("unroll") for (int n = 0; n < 2; ++n) _Pragma("unroll") for (int k = 0; k < 2; ++k) dst[n][k] = *(const PG8_LAS bf16x8*)(lds + PG8_SB(b, h) + boff + n * 2048 + k * 1024); } while (0)
#define PG8_MMA(ai, bj, At, Bt) do { __builtin_amdgcn_s_setprio(1); _Pragma("unroll") for (int m = 0; m < 4; ++m) _Pragma("unroll") for (int n = 0; n < 2; ++n) _Pragma("unroll") for (int k = 0; k < 2; ++k) \
        acc[ai][bj][m][n] = __builtin_amdgcn_mfma_f32_16x16x32_bf16(Bt[n][k], At[m][k], acc[ai][bj][m][n], 0, 0, 0); __builtin_amdgcn_s_setprio(0); } while (0)
#define PG8_WAIT_V(n) asm volatile("s_waitcnt vmcnt(" #n ")" ::: "memory")
#define PG8_WAIT_L(n) asm volatile("s_waitcnt lgkmcnt(" #n ")" ::: "memory")
#define PG8_BAR __builtin_amdgcn_s_barrier()
#define PG8_SCHED __builtin_amdgcn_sched_barrier(0)
    Unit cur, nxt; int ui = 0;
    if (!S.next(0, cur)) return;
    f32x4 acc[2][2][4][2];
#pragma unroll
    for (int a = 0; a < 2; ++a)
#pragma unroll
        for (int b = 0; b < 2; ++b)
#pragma unroll
            for (int m = 0; m < 4; ++m)
#pragma unroll
                for (int n = 0; n < 2; ++n) acc[a][b][m][n] = (f32x4){0.f, 0.f, 0.f, 0.f};
    bf16x8 At[4][2], B0[2][2], B1[2][2];
    const char* cA = (const char*)g.A + (size_t)cur.pm * tstep; const char* cB = (const char*)g.Bt + (size_t)cur.pn * tstep;
    S.a_ready(cur);
    if constexpr (SP2) {
        PG8_STAGE(PG8_SB(0, 0), cB, voffB); PG8_STAGE(PG8_SB(0, 1), cB + hstep, voffB); PG8_STAGE(PG8_SA(0, 0), cA, voffA); PG8_STAGE(PG8_SA(0, 1), cA + hstep, voffA);
        if (wr == 1) PG8_BAR;
        PG8_WAIT_V(2); PG8_BAR;
        PG8_STAGE(PG8_SB(1, 0), cB + kstep, voffB); PG8_STAGE(PG8_SA(1, 0), cA + kstep, voffA); PG8_STAGE(PG8_SB(1, 1), cB + hstep + kstep, voffB);
        PG8_WAIT_V(6); PG8_BAR;
    } else {
        PG8_STAGE(PG8_SB(0, 0), cB, voffB); PG8_STAGE(PG8_SA(0, 0), cA, voffA); PG8_STAGE(PG8_SB(0, 1), cB + hstep, voffB); PG8_STAGE(PG8_SA(0, 1), cA + hstep, voffA);
        if (wr == 1) PG8_BAR;
        PG8_WAIT_V(4); PG8_BAR;
        PG8_STAGE(PG8_SB(1, 0), cB + kstep, voffB); PG8_STAGE(PG8_SA(1, 0), cA + kstep, voffA); PG8_STAGE(PG8_SB(1, 1), cB + hstep + kstep, voffB);
        PG8_WAIT_V(6); PG8_BAR;
    }
    for (;;) {
        const bool has_next = S.next(ui + 1, nxt);
        const char* nA = has_next ? (const char*)g.A + (size_t)nxt.pm * tstep : cA; const char* nB = has_next ? (const char*)g.Bt + (size_t)nxt.pn * tstep : cB;
        for (int t = 0; t < nt; t += 2) {
            const bool last = (t == nt - 2);
            const char* a1 = cA + (size_t)(t + 1) * kstep;
            const char* a2 = last ? nA : cA + (size_t)(t + 2) * kstep; const char* b2 = last ? nB : cB + (size_t)(t + 2) * kstep;
            const char* a3 = a2 + kstep; const char* b3 = b2 + kstep;
            if (last && has_next) S.a_ready(nxt);
            if constexpr (SP2) {
            PG8_LDB(B0, 0, 0); PG8_LDB(B1, 0, 1); PG8_SCHED; PG8_LDA(At, 0, 0); PG8_STAGE(PG8_SA(1, 1), a1 + hstep, voffA);
            PG8_WAIT_V(8); PG8_WAIT_L(0); PG8_BAR; PG8_MMA(0, 0, At, B0); PG8_MMA(0, 1, At, B1); PG8_BAR; PG8_SCHED;
            PG8_LDA(At, 0, 1); PG8_STAGE(PG8_SB(0, 0), b2, voffB); PG8_STAGE(PG8_SB(0, 1), b2 + hstep, voffB); PG8_STAGE(PG8_SA(0, 0), a2, voffA);
            PG8_WAIT_V(8); PG8_WAIT_L(0); PG8_BAR; PG8_MMA(1, 0, At, B0); PG8_MMA(1, 1, At, B1); PG8_BAR; PG8_SCHED;
            PG8_LDB(B0, 1, 0); PG8_LDB(B1, 1, 1); PG8_SCHED; PG8_LDA(At, 1, 0); PG8_STAGE(PG8_SA(0, 1), a2 + hstep, voffA);
            PG8_WAIT_V(8); PG8_WAIT_L(0); PG8_BAR; PG8_MMA(0, 0, At, B0); PG8_MMA(0, 1, At, B1); PG8_BAR; PG8_SCHED;
            PG8_LDA(At, 1, 1); PG8_STAGE(PG8_SB(1, 0), b3, voffB); PG8_STAGE(PG8_SB(1, 1), b3 + hstep, voffB); PG8_STAGE(PG8_SA(1, 0), a3, voffA);
            PG8_WAIT_V(8); PG8_WAIT_L(0); PG8_BAR; PG8_MMA(1, 0, At, B0); PG8_MMA(1, 1, At, B1); PG8_BAR; PG8_SCHED;
            } else {
            PG8_LDB(B0, 0, 0); PG8_SCHED; PG8_LDA(At, 0, 0); PG8_STAGE(PG8_SA(1, 1), a1 + hstep, voffA);
            PG8_WAIT_L(8); PG8_BAR; PG8_WAIT_L(0); PG8_MMA(0, 0, At, B0); PG8_BAR; PG8_SCHED;
            PG8_LDB(B1, 0, 1); PG8_STAGE(PG8_SB(0, 0), b2, voffB);
            PG8_BAR; PG8_WAIT_L(0); PG8_MMA(0, 1, At, B1); PG8_BAR;
            PG8_LDA(At, 0, 1); PG8_STAGE(PG8_SA(0, 0), a2, voffA);
            PG8_BAR; PG8_WAIT_L(0); PG8_MMA(1, 0, At, B0); PG8_BAR; PG8_SCHED;
            PG8_STAGE(PG8_SB(0, 1), b2 + hstep, voffB);
            PG8_WAIT_V(6); PG8_BAR; PG8_MMA(1, 1, At, B1); PG8_BAR;
            PG8_LDB(B0, 1, 0); PG8_SCHED; PG8_LDA(At, 1, 0); PG8_STAGE(PG8_SA(0, 1), a2 + hstep, voffA);
            PG8_WAIT_L(8); PG8_BAR; PG8_WAIT_L(0); PG8_MMA(0, 0, At, B0); PG8_BAR; PG8_SCHED;
            PG8_LDB(B1, 1, 1); PG8_STAGE(PG8_SB(1, 0), b3, voffB);
            PG8_BAR; PG8_WAIT_L(0); PG8_MMA(0, 1, At, B1); PG8_BAR;
            PG8_LDA(At, 1, 1); PG8_STAGE(PG8_SA(1, 0), a3, voffA);
            PG8_BAR; PG8_WAIT_L(0); PG8_MMA(1, 0, At, B0); PG8_BAR; PG8_SCHED;
            PG8_STAGE(PG8_SB(1, 1), b3 + hstep, voffB);
            PG8_WAIT_V(6); PG8_BAR; PG8_MMA(1, 1, At, B1); PG8_BAR;
            }
        }
        if constexpr (ALIGN_EPI) { if (wr == 0) PG8_BAR; }
        if constexpr (!Epi::AFTER_DRAIN) { E(acc, cur, wr, wc, fr, fq); S.done(cur); }
        if (!has_next) break;
#pragma unroll
        for (int a = 0; a < 2; ++a)
#pragma unroll
            for (int b = 0; b < 2; ++b)
#pragma unroll
                for (int m = 0; m < 4; ++m)
#pragma unroll
                    for (int n = 0; n < 2; ++n) acc[a][b][m][n] = (f32x4){0.f, 0.f, 0.f, 0.f};
        cur = nxt; cA = nA; cB = nB; ++ui;
        if constexpr (ALIGN_EPI) { if (wr == 1) PG8_BAR; }
    }
    PG8_WAIT_V(0);
    if constexpr (!ALIGN_EPI) { if (wr == 0) PG8_BAR; }
    PG8_BAR;
    if constexpr (Epi::AFTER_DRAIN) { E.fused(acc, cur, wr, wc, fr, fq, lds, wid, lane); S.done(cur); }
#undef PG8_SA
#undef PG8_SB
#undef PG8_STAGE
#undef PG8_LDA
#undef PG8_LDB
#undef PG8_MMA
#undef PG8_WAIT_V
#undef PG8_WAIT_L
#undef PG8_BAR
#undef PG8_SCHED
}
}
#define LAS __attribute__((address_space(3)))
#define XB_TMO      128
#define XB_XCNT(j)  (256  + 64 * (j))
#define XB_XSUB(j)  (1280 + 64 * (j))
#define XB_XGEN(j)  (2304 + 64 * (j))
#define XB_TOP      3328
#define XB_TOPGEN   3392
#define XCD_BAR_WORDS 3456
#define XB_SPIN_CAP (1u << 18)

__device__ __forceinline__ unsigned xb_ld(unsigned* p)              { return __hip_atomic_load(p, __ATOMIC_RELAXED, __HIP_MEMORY_SCOPE_AGENT); }
__device__ __forceinline__ unsigned xb_add(unsigned* p, unsigned v) { return __hip_atomic_fetch_add(p, v, __ATOMIC_RELAXED, __HIP_MEMORY_SCOPE_AGENT); }
__device__ __forceinline__ unsigned xb_xcc_id() { return (unsigned)__builtin_amdgcn_s_getreg((3 << 11) | 20) & 0xFu; }
#define XB_SPIN(cond, bar) do { unsigned _sp = 0; while (cond) { __builtin_amdgcn_s_sleep(1); \
    if ((++_sp & 255u) == 0u) { if (xb_ld(&(bar)[XB_TMO])) break; if (_sp > XB_SPIN_CAP) { atomicAdd(&(bar)[XB_TMO], 1u); break; } } } } while (0)

struct XcdBarrier {
    unsigned* bar; unsigned x;
    volatile LAS unsigned* st;
};

__device__ __forceinline__ XcdBarrier xcd_barrier_post(unsigned* bar, volatile LAS unsigned* st) {
    XcdBarrier b; b.bar = bar; b.x = xb_xcc_id(); b.st = st;
    if (threadIdx.x == 0) (void)xb_add(&bar[XB_XCNT(b.x)], 1u);
    return b;
}
__device__ __forceinline__ void xcd_barrier_complete(unsigned* bar, unsigned x, unsigned& nloc, unsigned& nx) {
    const unsigned G = gridDim.x * gridDim.y * gridDim.z;
    unsigned sum, cnt, mine, sp = 0u;
    for (;;) {
        sum = 0u; cnt = 0u; mine = 0u;
#pragma unroll
        for (unsigned j = 0; j < 16; ++j) { const unsigned c = xb_ld(&bar[XB_XCNT(j)]); sum += c; cnt += (c > 0u) ? 1u : 0u; mine = (j == x) ? c : mine; }
        if (sum == G) break;
        __builtin_amdgcn_s_sleep(1);
        if ((++sp & 255u) == 0u) { if (xb_ld(&bar[XB_TMO])) break; if (sp > XB_SPIN_CAP) { atomicAdd(&bar[XB_TMO], 1u); break; } }
    }
    nloc = mine > 0u ? mine : 1u; nx = cnt > 0u ? cnt : 1u;
}

__device__ __forceinline__ void xcd_barrier(const XcdBarrier& b) {
    asm volatile("s_waitcnt vmcnt(0)" ::: "memory");
    __syncthreads();
    if (threadIdx.x == 0) {
        unsigned* bar = b.bar;
        __builtin_amdgcn_s_waitcnt(0);
        unsigned nloc = b.st[0], nx = b.st[1];
        if (nloc == 0u) { xcd_barrier_complete(bar, b.x, nloc, nx); b.st[0] = nloc; b.st[1] = nx; }
        const unsigned old = xb_add(&bar[XB_XSUB(b.x)], 1u);
        const unsigned gen = old / nloc;
        if (old + 1u == (gen + 1u) * nloc) {
            __builtin_amdgcn_fence(__ATOMIC_RELEASE, "agent");
            asm volatile("s_waitcnt vmcnt(0)" ::: "memory");
            const unsigned og = xb_add(&bar[XB_TOP], 1u);
            const unsigned tg = og / nx;
            if (og + 1u == (tg + 1u) * nx) xb_add(&bar[XB_TOPGEN], 1u);
            else XB_SPIN(xb_ld(&bar[XB_TOPGEN]) == tg, bar);
            __builtin_amdgcn_fence(__ATOMIC_ACQUIRE, "agent");
            xb_add(&bar[XB_XGEN(b.x)], 1u);
            asm volatile("s_waitcnt vmcnt(0)" ::: "memory");
        } else {
            XB_SPIN(xb_ld(&bar[XB_XGEN(b.x)]) == gen, bar);
            __builtin_amdgcn_fence(__ATOMIC_ACQUIRE, "agent");
            asm volatile("s_waitcnt vmcnt(0)" ::: "memory");
        }
    }
    __syncthreads();
}
namespace moba {
constexpr int D = 128;
constexpr float THR = 8.f;
constexpr bool WSKIP = false;
constexpr int QP = MHD, KVP = MHD, OP = MW;
template <class A, class Bt> struct same_t { static constexpr bool v = false; };
template <class A> struct same_t<A, A> { static constexpr bool v = true; };
constexpr float SCALE = 0.08838834764831845f;
constexpr int NW = 8, QBLK = 32, KVBLK = 64, QB = NW * QBLK;
constexpr int SHM_V = KVBLK * D * 2, SHM_K = KVBLK * D * 2;
constexpr int LDS_BYTES = 2 * SHM_V + 2 * SHM_K + NW * 64 * 4;
using bf16 = unsigned short;
typedef short bf16x8 __attribute__((ext_vector_type(8)));
typedef short s16x4 __attribute__((ext_vector_type(4)));
typedef float f32x16 __attribute__((ext_vector_type(16)));
typedef float f32x4 __attribute__((ext_vector_type(4)));
typedef unsigned u32x4 __attribute__((ext_vector_type(4)));
#define KSWZ(row, colB) ((row) * 256 + ((colB) ^ (((row) & 7) << 4)))
#define SBAR() __builtin_amdgcn_sched_barrier(0)
__device__ __forceinline__ int v_st(int k, int c) { const int kk = (k & ~0xC) | ((k & 4) << 1) | ((k & 8) >> 1); return ((kk >> 3) * 4 + (c >> 5)) * 512 + ((kk & 7) * 32 + (c & 31)) * 2; }
__device__ __forceinline__ int v_rd_base(int lane) { return ((lane & 3) << 3) | (((lane >> 2) & 3) << 6) | (((lane >> 4) & 1) << 5) | (((lane >> 5) & 1) << 8); }
constexpr int v_rd_off(int d0, int ks, int half) { return d0 * 512 + ks * 4096 + half * 2048; }
__device__ __forceinline__ int crow(int r, int hi) { return (r & 3) + 8 * (r >> 2) + 4 * hi; }
__device__ __forceinline__ unsigned cvtpk(float lo, float hi) {
    unsigned r; asm volatile("v_cvt_pk_bf16_f32 %0, %1, %2" : "=v"(r) : "v"(lo), "v"(hi)); return r;
}
__device__ __forceinline__ bf16x8 pack8(f32x4 a, f32x4 b) {
    u32x4 w = {cvtpk(a[0], a[1]), cvtpk(a[2], a[3]), cvtpk(b[0], b[1]), cvtpk(b[2], b[3])};
    return *reinterpret_cast<bf16x8*>(&w);
}
template <class T> __device__ __forceinline__ bf16x8 load8(const T* p) {
    if constexpr (same_t<T, float>::v) { return pack8(*(const f32x4*)p, *(const f32x4*)(p + 4)); }
    else { return *reinterpret_cast<const bf16x8*>(p); }
}
__device__ __forceinline__ void mask_tile(f32x16& p0, f32x16& p1, int dq, unsigned W) {
    const float NEG = -__builtin_inff();
#pragma unroll
    for (int r = 0; r < 16; ++r) {
        const int c = (r & 3) + 8 * (r >> 2);
        if ((unsigned)(dq - c) >= W) p0[r] = NEG;
        if ((unsigned)(dq - c - 32) >= W) p1[r] = NEG;
    }
}
__device__ __forceinline__ void partialSM(f32x16& p0, f32x16& p1, float& m_reg, float& mn, float& alpha) {
    float pmax = p0[0]; for (int r = 1; r < 16; ++r) pmax = fmaxf(pmax, p0[r]); for (int r = 0; r < 16; ++r) pmax = fmaxf(pmax, p1[r]);
    { auto rr = __builtin_amdgcn_permlane32_swap(__float_as_uint(pmax), __float_as_uint(pmax), false, false);
      pmax = fmaxf(__uint_as_float(rr[0]), __uint_as_float(rr[1])); }
    constexpr float C2 = 1.4426950408889634f * SCALE;
    if (__builtin_expect(__all((pmax - m_reg) * SCALE <= THR), 1)) { mn = m_reg; alpha = 1.f; }
    else { mn = fmaxf(m_reg, pmax); alpha = __builtin_amdgcn_exp2f((m_reg - mn) * C2); m_reg = mn; }
    const float mnL = -mn * C2;
    for (int r = 0; r < 16; ++r) p0[r] = fmaf(p0[r], C2, mnL); for (int r = 0; r < 16; ++r) p1[r] = fmaf(p1[r], C2, mnL);
    for (int r = 0; r < 16; ++r) p0[r] = __builtin_amdgcn_exp2f(p0[r]);
}
__device__ __forceinline__ void finishSM(f32x16& p0, f32x16& p1, float alpha, float& l_reg, bf16x8& pa0, bf16x8& pa1, bf16x8& pa2, bf16x8& pa3) {
    for (int r = 0; r < 16; ++r) p1[r] = __builtin_amdgcn_exp2f(p1[r]);
    float ps = 0; for (int r = 0; r < 16; ++r) ps += p0[r]; for (int r = 0; r < 16; ++r) ps += p1[r];
    { auto rr = __builtin_amdgcn_permlane32_swap(__float_as_uint(ps), __float_as_uint(ps), false, false);
      ps = __uint_as_float(rr[0]) + __uint_as_float(rr[1]); }
    l_reg = l_reg * alpha + ps;
#define PK4(P, B_, OUT) do { unsigned a0 = cvtpk(P[B_+0], P[B_+1]), a1 = cvtpk(P[B_+2], P[B_+3]);                          \
        unsigned b0 = cvtpk(P[B_+4], P[B_+5]), b1 = cvtpk(P[B_+6], P[B_+7]);                                             \
        auto r0 = __builtin_amdgcn_permlane32_swap(a0, b0, false, false); auto r1 = __builtin_amdgcn_permlane32_swap(a1, b1, false, false); \
        u32x4 w = {r0[0], r1[0], r0[1], r1[1]}; OUT = *reinterpret_cast<bf16x8*>(&w); } while (0)
    PK4(p0, 0, pa0); PK4(p0, 8, pa1); PK4(p1, 0, pa2); PK4(p1, 8, pa3);
#undef PK4
}
template <int KB, bool SK>
__device__ __forceinline__ void qkt(f32x16& p0, f32x16& p1, const char* K_lds, int r32, int hi, const bf16x8* qr, bool act) {
    if (SK && !act) { const float NEG = -__builtin_inff();
#pragma unroll
        for (int r = 0; r < 16; ++r) { p0[r] = NEG; p1[r] = NEG; } return; }
    p0 = f32x16{}; p1 = f32x16{};
    const char* kb[4];
#pragma unroll
    for (int dd = 0; dd < 4; ++dd) kb[dd] = K_lds + KB * SHM_K + KSWZ(r32, (dd * 16 + hi * 8) * 2);
#pragma unroll
    for (int d0 = 0; d0 < 8; ++d0) { const char* a = kb[d0 & 3] + (d0 >> 2) * 128;
        bf16x8 b0 = *reinterpret_cast<const bf16x8*>(a);
        bf16x8 b1 = *reinterpret_cast<const bf16x8*>(a + 32 * 256);
        p0 = __builtin_amdgcn_mfma_f32_32x32x16_bf16(b0, qr[d0], p0, 0, 0, 0);
        p1 = __builtin_amdgcn_mfma_f32_32x32x16_bf16(b1, qr[d0], p1, 0, 0, 0); }
}
template <int VB, bool SK>
__device__ __forceinline__ void pv_tile(f32x16* o, int vb0, bf16x8 pa0, bf16x8 pa1, bf16x8 pa2, bf16x8 pa3, bool act) {
    if (SK && !act) return;
#define TRRD(dst, off) asm volatile("ds_read_b64_tr_b16 %0, %1 offset:%2" : "=&v"(dst) : "v"(vb0), "i"(off) : "memory")
#define PV_D0(d0) do { s16x4 l0, l1, l2, l3, h0, h1, h2, h3; constexpr int b_ = VB * SHM_V + v_rd_off(d0, 0, 0);     \
        TRRD(l0, b_); TRRD(h0, b_ + 2048); TRRD(l1, b_ + 4096); TRRD(h1, b_ + 6144); TRRD(l2, b_ + 8192); TRRD(h2, b_ + 10240); TRRD(l3, b_ + 12288); TRRD(h3, b_ + 14336); \
        asm volatile("s_waitcnt lgkmcnt(0)" ::: "memory"); SBAR();                 \
        o[d0] = __builtin_amdgcn_mfma_f32_32x32x16_bf16(pa0, (bf16x8){l0[0], l0[1], l0[2], l0[3], h0[0], h0[1], h0[2], h0[3]}, o[d0], 0, 0, 0);   \
        o[d0] = __builtin_amdgcn_mfma_f32_32x32x16_bf16(pa1, (bf16x8){l1[0], l1[1], l1[2], l1[3], h1[0], h1[1], h1[2], h1[3]}, o[d0], 0, 0, 0);   \
        o[d0] = __builtin_amdgcn_mfma_f32_32x32x16_bf16(pa2, (bf16x8){l2[0], l2[1], l2[2], l2[3], h2[0], h2[1], h2[2], h2[3]}, o[d0], 0, 0, 0);   \
        o[d0] = __builtin_amdgcn_mfma_f32_32x32x16_bf16(pa3, (bf16x8){l3[0], l3[1], l3[2], l3[3], h3[0], h3[1], h3[2], h3[3]}, o[d0], 0, 0, 0); } while (0)
    PV_D0(0); PV_D0(1); PV_D0(2); PV_D0(3);
#undef PV_D0
#undef TRRD
}
__device__ __forceinline__ float bfv(short s) { return __builtin_bit_cast(float, ((unsigned)(unsigned short)s) << 16); }
__device__ __forceinline__ void sel_fill(f32x16& p0, f32x16& p1, bool ok) { const float NEG = -__builtin_inff();
#pragma unroll
    for (int r = 0; r < 16; ++r) { p0[r] = ok ? p0[r] : NEG; p1[r] = ok ? p1[r] : NEG; } }
template <class TIn, class TOut> struct BlockRef { const TIn* Q; const TIn* K; const TIn* V; TOut* O; int P0; const float* km; int qb; };
template <class TIn> struct Seam {
    bf16x8 qr[8];
    bf16x8 st_v0, st_v1, st_k0, st_k1; f32x4 sf0, sf1, sf2, sf3;
    f32x4 tq[16];
};
__device__ __forceinline__ int swa_jlo(int P0, int W) { const int lowk = P0 - W + 1; return lowk > 0 ? lowk / KVBLK : 0; }
#define ROW(p, k0, rr) ((p) + (size_t)((k0) + (rr)) * KVP + sc)
#define VMW() asm volatile("s_waitcnt vmcnt(0)" ::: "memory")
#define VMWN(n) asm volatile("s_waitcnt vmcnt(%0)" :: "i"(n) : "memory")
#define SLOAD_H(Kp, Vp, k0) do { S.st_v0 = load8<TIn>(ROW(Vp, k0, sr)); S.st_v1 = load8<TIn>(ROW(Vp, k0, 32 + sr));              \
                         S.st_k0 = load8<TIn>(ROW(Kp, k0, sr)); S.st_k1 = load8<TIn>(ROW(Kp, k0, 32 + sr)); } while (0)
#define SWRITE_HK(bf) do { *(bf16x8*)(K_lds + (bf) * SHM_K + kws) = S.st_k0; *(bf16x8*)(K_lds + (bf) * SHM_K + kws + 32 * 256) = S.st_k1; } while (0)
#define SWRITE_HV(bf) do { *(bf16x8*)(V_lds + (bf) * SHM_V + vst0) = S.st_v0; *(bf16x8*)(V_lds + (bf) * SHM_V + vst1) = S.st_v1; } while (0)
#define SWRITE_H(bf) do { SWRITE_HV(bf); SWRITE_HK(bf); } while (0)
#define SLOAD_F(p, k0) do { S.sf0 = *(const f32x4*)ROW(p, k0, sr); S.sf1 = *(const f32x4*)(ROW(p, k0, sr) + 4);                \
                            S.sf2 = *(const f32x4*)ROW(p, k0, 32 + sr); S.sf3 = *(const f32x4*)(ROW(p, k0, 32 + sr) + 4); } while (0)
#define SWRITE_KF(bf) do { *(bf16x8*)(K_lds + (bf) * SHM_K + kws) = pack8(S.sf0, S.sf1); *(bf16x8*)(K_lds + (bf) * SHM_K + kws + 32 * 256) = pack8(S.sf2, S.sf3); } while (0)
#define SWRITE_VF(bf) do { *(bf16x8*)(V_lds + (bf) * SHM_V + vst0) = pack8(S.sf0, S.sf1); *(bf16x8*)(V_lds + (bf) * SHM_V + vst1) = pack8(S.sf2, S.sf3); } while (0)
template <class TIn, class TOut>
__device__ __forceinline__ void causal_swa_prime(const BlockRef<TIn, TOut>& cur, int W, char* lds, Seam<TIn>& S) {
    constexpr bool F32 = same_t<TIn, float>::v;
    int tid_o = threadIdx.x; asm volatile("" : "+v"(tid_o));
    const int tid = tid_o, wid = __builtin_amdgcn_readfirstlane(tid >> 6), lane = tid & 63, r32 = lane & 31, hi = lane >> 5;
    const int sr = tid >> 4, sc = (tid & 15) * 8, kws = KSWZ(sr, sc * 2); char* K_lds = lds + 2 * SHM_V;
    const int kb0 = swa_jlo(cur.P0, W) * KVBLK;
    for (int d0 = 0; d0 < 8; ++d0) S.qr[d0] = load8<TIn>(cur.Q + (size_t)(wid * QBLK + r32) * QP + d0 * 16 + hi * 8);
    if constexpr (F32) { SLOAD_F((const float*)cur.K, kb0); VMW(); SWRITE_KF(0); SBAR(); SLOAD_F((const float*)cur.V, kb0); }
    else { SLOAD_H(cur.K, cur.V, kb0); VMW(); SWRITE_HK(0); }
    __syncthreads();
}
template <class TIn, class TOut, int FK = 0>
__device__ __forceinline__ void causal_swa_block(const BlockRef<TIn, TOut>& cur, const BlockRef<TIn, TOut>& nxt, int skv, int W, char* lds, Seam<TIn>& S) {
    constexpr bool F32 = same_t<TIn, float>::v;
    int tid_o = threadIdx.x; asm volatile("" : "+v"(tid_o));
    const int tid = tid_o, wid = __builtin_amdgcn_readfirstlane(tid >> 6), lane = tid & 63, r32 = lane & 31, hi = lane >> 5;
    const int j_lo = swa_jlo(cur.P0, W);
    int j_hi = (cur.P0 + QB - 1) / KVBLK + 1; if (j_hi > skv / KVBLK) j_hi = skv / KVBLK;
    const int NT = j_hi - j_lo;
    const int kbn = swa_jlo(nxt.P0, W) * KVBLK;
    const int qlo = cur.P0 + wid * QBLK, qm = qlo + r32 - 4 * hi;
    char* V_lds = lds; char* K_lds = lds + 2 * SHM_V;
    float* ws = (float*)(lds + 2 * SHM_V + 2 * SHM_K) + wid * 64; float* li_l = ws, * al_l = ws + 32;
    float m_reg = -1e30f, l_reg = 0; f32x16 o[4] = {};
    unsigned selbits = 0u;
    if (cur.qb > 0) {
        float sc_[7];
#pragma unroll
        for (int j = 0; j < 7; ++j) { float a_ = 0.f;
            if (j < cur.qb) { const float* kmj = cur.km + j * 128 + hi * 8;
#pragma unroll
                for (int d0 = 0; d0 < 8; ++d0) { const f32x4 k0_ = *(const f32x4*)(kmj + d0 * 16), k1_ = *(const f32x4*)(kmj + d0 * 16 + 4); const bf16x8 q_ = S.qr[d0];
                    a_ += (bfv(q_[0]) * k0_[0] + bfv(q_[1]) * k0_[1]) + (bfv(q_[2]) * k0_[2] + bfv(q_[3]) * k0_[3]) + (bfv(q_[4]) * k1_[0] + bfv(q_[5]) * k1_[1]) + (bfv(q_[6]) * k1_[2] + bfv(q_[7]) * k1_[3]); }
                a_ += __shfl_xor(a_, 32); }
            sc_[j] = a_; }
#pragma unroll
        for (int j = 0; j < 7; ++j) { int rank_ = 0;
#pragma unroll
            for (int i = 0; i < 7; ++i) if (i != j) rank_ += (i < cur.qb && (sc_[i] > sc_[j] || (sc_[i] == sc_[j] && i < j))) ? 1 : 0;
            if (j < cur.qb && rank_ < 3) selbits |= 1u << j; }
    }
    const int sr = tid >> 4, sc = (tid & 15) * 8, vst0 = v_st(sr, sc), vst1 = v_st(32 + sr, sc), kws = KSWZ(sr, sc * 2);
    const int vb0 = (int)(uintptr_t)V_lds + v_rd_base(lane);
    const TIn* Kh = cur.K; const TIn* Vh = cur.V;
#define RESC(a) do { if (__any((a) < 1.f)) { if (hi == 0) al_l[r32] = (a); asm volatile("s_waitcnt lgkmcnt(0)" ::: "memory");              \
                     for (int d_ = 0; d_ < 4; ++d_) for (int r = 0; r < 16; ++r) o[d_][r] *= al_l[crow(r, hi)]; } } while (0)
#define KBASE(t) ((j_lo + (t)) * KVBLK)
#define ACT(t) (KBASE(t) <= qlo + QBLK - 1 && KBASE(t) + KVBLK - 1 >= qlo - W + 1)
#define MASKT(P0_, P1_, t) do { const int kb_ = KBASE(t); if (kb_ + KVBLK - 1 > qlo) mask_tile(P0_, P1_, qm - kb_, (unsigned)W); \
        else if ((t) < 4 * cur.qb) { const bool ok_ = ((selbits >> ((t) >> 2)) & 1u) != 0u; if (!__all(ok_)) sel_fill(P0_, P1_, ok_); } } while (0)
    constexpr int NQL = F32 ? 16 : 8;
    constexpr bool SK = WSKIP && !F32;
#define SEAM_K0() do { VMWN(NQL); if constexpr (F32) { SWRITE_KF(0); SBAR(); SLOAD_F((const float*)nxt.V, kbn); } else { SWRITE_HK(0); } SBAR(); } while (0)
    f32x16 pA0, pA1, pB0, pB1; float mnA, mnB, alA, alB; bf16x8 pa0, pa1, pa2, pa3;
    if constexpr (F32) { VMW(); SWRITE_VF(0); SBAR(); } else { SWRITE_HV(0); SBAR(); }
    if (NT > 1) { if constexpr (F32) SLOAD_F((const float*)Kh, KBASE(1)); else SLOAD_H(Kh, Vh, (FK == 1) ? 0 : KBASE(1)); }
    SBAR(); qkt<0, SK>(pA0, pA1, K_lds, r32, hi, S.qr, ACT(0));
    if constexpr (F32) { if (NT > 1) { VMW(); SWRITE_KF(1); SBAR(); SLOAD_F((const float*)Vh, KBASE(1)); } }
    MASKT(pA0, pA1, 0); partialSM(pA0, pA1, m_reg, mnA, alA);
    if (NT > 1) { VMW(); if constexpr (F32) { SWRITE_VF(1); SBAR(); if (NT > 2) SLOAD_F((const float*)Kh, KBASE(2)); } else SWRITE_H(1); }
    __syncthreads();
#define HALF_STEP(PX0, PX1, mnX, alX, PY0, PY1, alY, t, KB, VB, SB) do {                                                      \
        SBAR(); qkt<KB, SK>(PX0, PX1, K_lds, r32, hi, S.qr, ACT(t));                                             \
        finishSM(PY0, PY1, alY, l_reg, pa0, pa1, pa2, pa3); SBAR();                                                           \
        if ((t) + 1 < NT) { if constexpr (F32) { VMW(); SWRITE_KF(SB); SBAR(); SLOAD_F((const float*)Vh, KBASE((t) + 1)); }  \
                            else { SLOAD_H(Kh, Vh, (FK == 1) ? 0 : KBASE((t) + 1)); } SBAR(); }                                               \
        pv_tile<VB, SK>(o, vb0, pa0, pa1, pa2, pa3, ACT((t) - 1)); MASKT(PX0, PX1, (t)); partialSM(PX0, PX1, m_reg, mnX, alX);                                        \
        __syncthreads();                                                                                                      \
        if ((t) + 1 < NT) { VMW(); if constexpr (F32) { SWRITE_VF(SB); SBAR(); if ((t) + 2 < NT) SLOAD_F((const float*)Kh, KBASE((t) + 2)); } \
                            else { SWRITE_H(SB); } }                                                                          \
        RESC(alX); __syncthreads(); } while (0)
    for (int t = 1; t + 1 < NT; t += 2) {
        HALF_STEP(pB0, pB1, mnB, alB, pA0, pA1, alA, t, 1, 0, 0);
        HALF_STEP(pA0, pA1, mnA, alA, pB0, pB1, alB, t + 1, 0, 1, 1);
    }
    const bool even = (NT & 1) == 0;
    if (even) { SBAR(); qkt<1, SK>(pB0, pB1, K_lds, r32, hi, S.qr, ACT(NT - 1)); SBAR(); }
#define QROW(e) (nxt.Q + (size_t)(wid * QBLK + r32) * QP + ((e) >> 1) * 16 + hi * 8 + ((e) & 1) * 4)
    if constexpr (F32) { SLOAD_F((const float*)nxt.K, kbn); SBAR();
#pragma unroll
        for (int e = 0; e < 8; ++e) S.tq[e] = *(const f32x4*)QROW(e); }
    else { SLOAD_H(nxt.K, nxt.V, kbn); SBAR();
#pragma unroll
        for (int d0 = 0; d0 < 8; ++d0) S.qr[d0] = load8<TIn>(nxt.Q + (size_t)(wid * QBLK + r32) * QP + d0 * 16 + hi * 8); }
    SBAR();
    finishSM(pA0, pA1, alA, l_reg, pa0, pa1, pa2, pa3); SBAR();
    if constexpr (F32) {
#pragma unroll
        for (int e = 8; e < 16; ++e) S.tq[e] = *(const f32x4*)QROW(e); SBAR(); }
#undef QROW
    pv_tile<0, SK>(o, vb0, pa0, pa1, pa2, pa3, ACT(even ? NT - 2 : NT - 1));
    if (even) { MASKT(pB0, pB1, NT - 1); partialSM(pB0, pB1, m_reg, mnB, alB); __syncthreads(); RESC(alB);
        finishSM(pB0, pB1, alB, l_reg, pa0, pa1, pa2, pa3); SBAR(); pv_tile<1, SK>(o, vb0, pa0, pa1, pa2, pa3, ACT(NT - 1)); }
    SBAR(); SEAM_K0();
    if (hi == 0) li_l[r32] = l_reg; asm volatile("s_waitcnt lgkmcnt(0)" ::: "memory");
    float rli[16];
#pragma unroll
    for (int r = 0; r < 16; ++r) rli[r] = __builtin_amdgcn_rcpf(li_l[crow(r, hi)]);
    TOut* Ow = cur.O + (size_t)(wid * QBLK) * OP;
#pragma unroll
    for (int r = 0; r < 16; ++r) { const int orow = crow(r, hi);
#pragma unroll
        for (int d0 = 0; d0 < 4; ++d0) { const float v = o[d0][r] * rli[r];
            if constexpr (same_t<TOut, float>::v) { Ow[(size_t)orow * OP + d0 * 32 + r32] = v; }
            else { const float vn = __shfl_xor(v, 1);
                   if ((r32 & 1) == 0) *(unsigned*)(Ow + (size_t)orow * OP + d0 * 32 + r32) = cvtpk(v, vn); } } }
    if constexpr (F32) {
#pragma unroll
        for (int d0 = 0; d0 < 8; ++d0) S.qr[d0] = pack8(S.tq[2 * d0], S.tq[2 * d0 + 1]); }
    __syncthreads();
#undef RESC
#undef KBASE
#undef ACT
#undef MASKT
#undef SEAM_K0
#undef HALF_STEP
}
#undef ROW
#undef VMW
#undef VMWN
#undef SLOAD_H
#undef SWRITE_HK
#undef SWRITE_HV
#undef SWRITE_H
#undef SLOAD_F
#undef SWRITE_KF
#undef SWRITE_VF
}
namespace gla {
typedef float f32x16 __attribute__((ext_vector_type(16)));
typedef short s16x4 __attribute__((ext_vector_type(4)));
typedef float f32x2_t __attribute__((ext_vector_type(2)));
typedef __bf16 bf16x2_t __attribute__((ext_vector_type(2)));
__device__ __forceinline__ unsigned cvt2(float lo, float hi) { f32x2_t v = {lo, hi}; bf16x2_t b = __builtin_convertvector(v, bf16x2_t); return __builtin_bit_cast(unsigned, b); }
__device__ __forceinline__ float bfu(unsigned short s) { return __builtin_bit_cast(float, ((unsigned)s) << 16); }
constexpr int RS = 272, VS = 528, AS = 144;
constexpr int L_QT = 0, L_KT = 17408, L_KH = 34816, L_V = 52224, L_AT = 86016, L_GLR = 95232, L_DEC = 99328, L_SEG = 99840, L_RED = 101888, L_GN = 103936, L_END = 104960;
#define GLA_MFMA(a, b, c) __builtin_amdgcn_mfma_f32_32x32x16_bf16((a), (b), (c), 0, 0, 0)
#define GLA_LBAR() do { asm volatile("s_waitcnt lgkmcnt(0)" ::: "memory"); __builtin_amdgcn_s_barrier(); asm volatile("" ::: "memory"); } while (0)
#define GLA_TR(off) __builtin_amdgcn_ds_read_tr16_b64_v4i16((LAS s16x4*)(lds + (off)))

constexpr size_t WS_GQT = 710 * MiB, WS_GKH = 726 * MiB, WS_GA = 742 * MiB, WS_GDEC = 750 * MiB;

__device__ __forceinline__ void gla_pre_load(const Params& P, int b, int c, int h, int tid, u32x4 (&rq)[2], u32x4 (&rk)[2]) {
    const bf16* gq = (const bf16*)(P.ws + WS_PROJ) + PJ_GQ + ((size_t)(b * GH + h) * SEQ + c * GCH) * GDK; const bf16* gk = (const bf16*)(P.ws + WS_PROJ) + PJ_GK + ((size_t)(b * GH + h) * SEQ + c * GCH) * GDK;
#pragma unroll
    for (int i = 0; i < 2; ++i) { const int idx = tid + 512 * i, row = idx >> 4, ch = idx & 15; rq[i] = *(const u32x4*)(gq + (size_t)row * GDK + ch * 8); rk[i] = *(const u32x4*)(gk + (size_t)row * GDK + ch * 8); }
}
__device__ __forceinline__ void gla_pre_head(const Params& P, int l, int b, int c, int h, LAS unsigned char* lds, int tid, const u32x4 (&rq)[2], const u32x4 (&rk)[2]) {
    const int lane = tid & 63, w = __builtin_amdgcn_readfirstlane(tid >> 6), r = lane & 31, hh = lane >> 5;
    const int sd = tid & 127, stq = tid >> 7, t0 = c * GCH, item = (b * GH + h) * (SEQ / GCH) + c;
    float w2r[16];
#pragma unroll
    for (int j = 0; j < 16; ++j) w2r[j] = P.gate_w2[((size_t)l * GRANK + j) * GKW + h * GDK + sd];
    const float gbias = P.gate_b[(size_t)l * GKW + h * GDK + sd];
#pragma unroll
    for (int i = 0; i < 2; ++i) { const int idx = tid + 512 * i, row = idx >> 4, ch = idx & 15;
        *(LAS u32x4*)(lds + L_QT + row * RS + ch * 16) = rq[i]; *(LAS u32x4*)(lds + L_KT + row * RS + ch * 16) = rk[i]; }
    float bl[16]; float run = 0.f;
#pragma unroll
    for (int i = 0; i < 16; ++i) { const LAS f32x4* gr4 = (const LAS f32x4*)(lds + L_GLR + (16 * stq + i) * 64); float x = gbias;
#pragma unroll
        for (int j = 0; j < 4; ++j) { const f32x4 gv = gr4[j]; x += (gv[0] * w2r[4 * j] + gv[1] * w2r[4 * j + 1]) + (gv[2] * w2r[4 * j + 2] + gv[3] * w2r[4 * j + 3]); }
        run -= __logf(1.0f + __expf(-x)) * (1.0f / 16.0f); bl[i] = run; }
    *(LAS float*)(lds + L_SEG + (stq * 128 + sd) * 4) = run;
    GLA_LBAR();
    float prefix = 0.f, total = 0.f;
#pragma unroll
    for (int j = 0; j < 4; ++j) { const float sv = *(const LAS float*)(lds + L_SEG + (j * 128 + sd) * 4); total += sv; prefix += (j < stq) ? sv : 0.f; }
    const float etot = __expf(total);
#pragma unroll
    for (int i = 0; i < 16; ++i) { const int row = 16 * stq + i; const float bb = bl[i] + prefix; const float eb = __expf(bb), enb = __builtin_amdgcn_rcpf(eb), ekl = etot * enb;
        LAS unsigned short* qp = (LAS unsigned short*)(lds + L_QT + row * RS + sd * 2); LAS unsigned short* kp = (LAS unsigned short*)(lds + L_KT + row * RS + sd * 2);
        const float qv = bfu(*qp), kv = bfu(*kp);
        *qp = (unsigned short)cvt2(qv * eb, 0.f); *kp = (unsigned short)cvt2(kv * enb, 0.f); *(LAS unsigned short*)(lds + L_KH + row * RS + sd * 2) = (unsigned short)cvt2(kv * ekl, 0.f); }
    if (stq == 0) ((float*)(P.ws + WS_GDEC))[(size_t)item * GDK + sd] = etot;
    GLA_LBAR();
#pragma unroll
    for (int i = 0; i < 2; ++i) { const int idx = tid + 512 * i, row = idx >> 4, ch = idx & 15; const size_t go = (size_t)(b * SEQ + t0 + row) * GKW + h * GDK + ch * 8;
        *(u32x4*)((bf16*)(P.ws + WS_GQT) + go) = *(const LAS u32x4*)(lds + L_QT + row * RS + ch * 16);
        *(u32x4*)((bf16*)(P.ws + WS_GKH) + go) = *(const LAS u32x4*)(lds + L_KH + row * RS + ch * 16); }
    if (w < 4) { const int ti = w >> 1, si = w & 1; f32x16 at;
#pragma unroll
        for (int i = 0; i < 16; ++i) at[i] = 0.f;
        if (si <= ti) {
#pragma unroll
            for (int kk = 0; kk < 8; ++kk) { const bf16x8 a = *(const LAS bf16x8*)(lds + L_KT + (32 * si + r) * RS + (16 * kk + 8 * hh) * 2); const bf16x8 bq = *(const LAS bf16x8*)(lds + L_QT + (32 * ti + r) * RS + (16 * kk + 8 * hh) * 2);
                at = GLA_MFMA(a, bq, at); } }
        const int t = 32 * ti + r; bf16* ag = (bf16*)(P.ws + WS_GA) + ((size_t)item * GCH + t) * GCH;
#pragma unroll
        for (int g = 0; g < 4; ++g) { const int s0 = 32 * si + 8 * g + 4 * hh; float v[4];
#pragma unroll
            for (int e = 0; e < 4; ++e) v[e] = (s0 + e <= t) ? at[4 * g + e] : 0.f;
            u32x2 pkd; pkd.x = cvt2(v[0], v[1]); pkd.y = cvt2(v[2], v[3]); *(u32x2*)(ag + s0) = pkd; } }
    GLA_LBAR();
}

template <int VAR>
__device__ __forceinline__ void gla_seq_unit(const Params& P, int l, int bh, LAS unsigned char* lds, int tid) {
    const int lane = tid & 63, w = __builtin_amdgcn_readfirstlane(tid >> 6), r = lane & 31, hh = lane >> 5;
    const int b = bh >> 2, h = bh & 3;
    const int blk = (lane >> 4) & 1, q4 = (lane & 15) >> 2, p4 = lane & 3;
    const char* ub_v = (const char*)((const bf16*)(P.ws + WS_PROJ) + PJ_GV + (size_t)bh * SEQ * GDV); const char* ub_gr = (const char*)((const bf16*)(P.ws + WS_PROJ) + PJ_GR + (size_t)bh * SEQ * GDV);
    const char* ub_qt = (const char*)((const bf16*)(P.ws + WS_GQT) + (size_t)(b * SEQ) * GKW + h * GDK); const char* ub_kh = (const char*)((const bf16*)(P.ws + WS_GKH) + (size_t)(b * SEQ) * GKW + h * GDK);
    const char* ub_a = (const char*)((const bf16*)(P.ws + WS_GA) + (size_t)bh * (SEQ / GCH) * GCH * GCH); const char* ub_dec = (const char*)((const float*)(P.ws + WS_GDEC) + (size_t)bh * (SEQ / GCH) * GDK);
    char* ub_og = (char*)((bf16*)(P.ws + (VAR ? (size_t)760 * MiB : WS_OGOM)) + (size_t)(b * SEQ) * GVW + h * GDV);
    const unsigned vo_qk = (unsigned)((tid >> 4) * GKW * 2 + (tid & 15) * 16), vo_v = (unsigned)((tid >> 5) * GDV * 2 + (tid & 31) * 16), vo_16 = (unsigned)(tid * 16);
    const unsigned vo_ogc = (unsigned)((tid >> 5) * GVW * 2 + (tid & 31) * 16);
    constexpr int SRS = 272, SKS = 320, SVS = 576, SAS = 144;
    constexpr int S_QT = 0, S_KH = S_QT + 64 * SRS, S_V = S_KH + 64 * SKS, S_AT = S_V + 64 * SVS, S_DEC = S_AT + 64 * SAS, S_RED = S_DEC + 512, S_GN = S_RED + 2048, S_OT = S_GN + 1024, S_END = S_OT + 64 * SVS;
    static_assert(S_END <= 131072, "GLA scan LDS map");
    const unsigned tr_v = S_V + (8 * hh + q4) * SVS + (32 * w + 16 * blk + 4 * p4) * 2;
    const unsigned tr_kh = S_KH + (8 * hh + q4) * SKS + (16 * blk + 4 * p4) * 2;
    if (tid < GDV) *(LAS float*)(lds + S_GN + tid * 4) = P.gla_norm_g[(size_t)l * GDV + tid];
    f32x16 S[4];
#pragma unroll
    for (int d = 0; d < 4; ++d)
#pragma unroll
        for (int i = 0; i < 16; ++i) S[d][i] = 0.f;
    u32x4 pq[2], pk[2], pv[4], pa; f32x4 pd = {0.f, 0.f, 0.f, 0.f};
#define GLA_LOAD(c_) do { const size_t tb_ = (size_t)(c_) * GCH; \
        _Pragma("unroll") for (int i = 0; i < 2; ++i) { pq[i] = *(const u32x4*)(ub_qt + (tb_ + 32 * i) * (GKW * 2) + vo_qk); pk[i] = *(const u32x4*)(ub_kh + (tb_ + 32 * i) * (GKW * 2) + vo_qk); } \
        _Pragma("unroll") for (int i = 0; i < 4; ++i) pv[i] = *(const u32x4*)(ub_v + (tb_ + 16 * i) * (GDV * 2) + vo_v); \
        pa = *(const u32x4*)(ub_a + (size_t)(c_) * (GCH * GCH * 2) + vo_16); \
        if (tid < 32) pd = *(const f32x4*)(ub_dec + (size_t)(c_) * (GDK * 4) + vo_16); } while (0)
    GLA_LOAD(0);
    for (int c = 0; c < SEQ / GCH; ++c) {
        const int t0 = c * GCH;
#pragma unroll
        for (int i = 0; i < 2; ++i) { const int idx = tid + 512 * i, row = idx >> 4, ch = idx & 15; *(LAS u32x4*)(lds + S_QT + row * SRS + ch * 16) = pq[i]; *(LAS u32x4*)(lds + S_KH + row * SKS + ch * 16) = pk[i]; }
#pragma unroll
        for (int i = 0; i < 4; ++i) { const int idx = tid + 512 * i, row = idx >> 5, ch = idx & 31; *(LAS u32x4*)(lds + S_V + row * SVS + ch * 16) = pv[i]; }
        *(LAS u32x4*)(lds + S_AT + (tid >> 3) * SAS + (tid & 7) * 16) = pa;
        if (tid < 32) *(LAS f32x4*)(lds + S_DEC + tid * 16) = pd;
        u32x4 sg[4];
#pragma unroll
        for (int i = 0; i < 4; ++i) { if (VAR & 1) sg[i] = (u32x4){0x3f803f80u, 0x3f803f80u, 0x3f803f80u, 0x3f803f80u}; else sg[i] = *(const u32x4*)(ub_gr + (size_t)(t0 + 16 * i) * (GDV * 2) + vo_v); }
        if (c + 1 < SEQ / GCH && !((VAR & 4) && c > 0)) GLA_LOAD(c + 1);
        GLA_LBAR();
        f32x16 ot[2];
#pragma unroll
        for (int ti = 0; ti < 2; ++ti)
#pragma unroll
            for (int i = 0; i < 16; ++i) ot[ti][i] = 0.f;
        if (!(VAR & 2)) {
        bf16x8 vf[4];
#pragma unroll
        for (int kk = 0; kk < 4; ++kk) { const s16x4 lo = GLA_TR(tr_v + kk * 16 * SVS), hi = GLA_TR(tr_v + kk * 16 * SVS + 4 * SVS); vf[kk] = __builtin_shufflevector(lo, hi, 0, 1, 2, 3, 4, 5, 6, 7); }
        s16x4 bq[2][8];
#define GLA_LDBQ(buf, dblk_) do { _Pragma("unroll") for (int s = 0; s < 2; ++s) _Pragma("unroll") for (int ti = 0; ti < 2; ++ti) { \
            const LAS unsigned char* qa = lds + S_QT + (32 * ti + r) * SRS + (32 * (dblk_) + 16 * s + 4 * hh) * 2; bq[buf][(s * 2 + ti) * 2] = *(const LAS s16x4*)qa; bq[buf][(s * 2 + ti) * 2 + 1] = *(const LAS s16x4*)(qa + 16); } } while (0)
        GLA_LDBQ(0, 0);
#pragma unroll
        for (int dblk = 0; dblk < 4; ++dblk) {
            if (dblk + 1 < 4) GLA_LDBQ((dblk + 1) & 1, dblk + 1);
#pragma unroll
            for (int s = 0; s < 2; ++s) { u32x4 pa_; pa_.x = cvt2(S[dblk][8 * s + 0], S[dblk][8 * s + 1]); pa_.y = cvt2(S[dblk][8 * s + 2], S[dblk][8 * s + 3]); pa_.z = cvt2(S[dblk][8 * s + 4], S[dblk][8 * s + 5]); pa_.w = cvt2(S[dblk][8 * s + 6], S[dblk][8 * s + 7]);
                const bf16x8 a = __builtin_bit_cast(bf16x8, pa_);
#pragma unroll
                for (int ti = 0; ti < 2; ++ti) { const bf16x8 bqv = __builtin_shufflevector(bq[dblk & 1][(s * 2 + ti) * 2], bq[dblk & 1][(s * 2 + ti) * 2 + 1], 0, 1, 2, 3, 4, 5, 6, 7); ot[ti] = GLA_MFMA(a, bqv, ot[ti]); } } }
#undef GLA_LDBQ
        s16x4 kf[2][8]; f32x4 dcv[2][4];
#define GLA_LDKF(buf, dblk_) do { _Pragma("unroll") for (int kk = 0; kk < 4; ++kk) { kf[buf][2 * kk] = GLA_TR(tr_kh + (dblk_) * 64 + kk * 16 * SKS); kf[buf][2 * kk + 1] = GLA_TR(tr_kh + (dblk_) * 64 + kk * 16 * SKS + 4 * SKS); } \
            _Pragma("unroll") for (int g = 0; g < 4; ++g) dcv[buf][g] = *(const LAS f32x4*)(lds + S_DEC + (32 * (dblk_) + 8 * g + 4 * hh) * 4); } while (0)
        GLA_LDKF(0, 0);
#pragma unroll
        for (int dblk = 0; dblk < 4; ++dblk) {
            if (dblk + 1 < 4) GLA_LDKF((dblk + 1) & 1, dblk + 1);
#pragma unroll
            for (int g = 0; g < 4; ++g)
#pragma unroll
                for (int e = 0; e < 4; ++e) S[dblk][4 * g + e] *= dcv[dblk & 1][g][e];
#pragma unroll
            for (int kk = 0; kk < 4; ++kk) { const bf16x8 a = __builtin_shufflevector(kf[dblk & 1][2 * kk], kf[dblk & 1][2 * kk + 1], 0, 1, 2, 3, 4, 5, 6, 7); S[dblk] = GLA_MFMA(a, vf[kk], S[dblk]); } }
#undef GLA_LDKF
        bf16x8 baf[6];
#pragma unroll
        for (int j = 0; j < 6; ++j) { const int ti = j < 2 ? 0 : 1, kk = j < 2 ? j : j - 2; baf[j] = *(const LAS bf16x8*)(lds + S_AT + (32 * ti + r) * SAS + (16 * kk + 8 * hh) * 2); }
#pragma unroll
        for (int j = 0; j < 6; ++j) { const int ti = j < 2 ? 0 : 1, kk = j < 2 ? j : j - 2; ot[ti] = GLA_MFMA(vf[kk], baf[j], ot[ti]); }
        }
#pragma unroll
        for (int ti = 0; ti < 2; ++ti) { float ss = 0.f;
#pragma unroll
            for (int i = 0; i < 16; ++i) ss += ot[ti][i] * ot[ti][i];
            ss += __shfl_xor(ss, 32); if (hh == 0) *(LAS float*)(lds + S_RED + (w * 64 + 32 * ti + r) * 4) = ss; }
        GLA_LBAR();
#pragma unroll
        for (int ti = 0; ti < 2; ++ti) { float tot = 0.f;
#pragma unroll
            for (int ww = 0; ww < 8; ++ww) tot += *(const LAS float*)(lds + S_RED + (ww * 64 + 32 * ti + r) * 4);
            const float rstd = rsqrtf(tot * (1.0f / GDV) + EPS);
#pragma unroll
            for (int g = 0; g < 4; ++g) { const f32x4 gg = *(const LAS f32x4*)(lds + S_GN + (32 * w + 4 * hh + 8 * g) * 4);
                u32x2 pkd; pkd.x = cvt2(ot[ti][4 * g + 0] * rstd * gg[0], ot[ti][4 * g + 1] * rstd * gg[1]); pkd.y = cvt2(ot[ti][4 * g + 2] * rstd * gg[2], ot[ti][4 * g + 3] * rstd * gg[3]);
                *(LAS u32x2*)(lds + S_OT + (32 * ti + r) * SVS + (32 * w + 8 * g + 4 * hh) * 2) = pkd; } }
        GLA_LBAR();
#pragma unroll
        for (int i = 0; i < 4; ++i) { const int idx = tid + 512 * i, row = idx >> 5, ch = idx & 31; const u32x4 ov = *(const LAS u32x4*)(lds + S_OT + row * SVS + ch * 16), sv = sg[i];
            u32x4 res; res.x = cvt2(pg8::bflo(ov.x) * pg8::bflo(sv.x), pg8::bfhi(ov.x) * pg8::bfhi(sv.x)); res.y = cvt2(pg8::bflo(ov.y) * pg8::bflo(sv.y), pg8::bfhi(ov.y) * pg8::bfhi(sv.y));
            res.z = cvt2(pg8::bflo(ov.z) * pg8::bflo(sv.z), pg8::bfhi(ov.z) * pg8::bfhi(sv.z)); res.w = cvt2(pg8::bflo(ov.w) * pg8::bflo(sv.w), pg8::bfhi(ov.w) * pg8::bfhi(sv.w));
            if (!(VAR & 1) || (c == SEQ / GCH - 1)) *(u32x4*)(ub_og + (size_t)(t0 + 16 * i) * (GVW * 2) + vo_ogc) = res; }
    }
#undef GLA_LOAD
}
#undef GLA_MFMA
#undef GLA_TR
#undef GLA_LBAR
}
constexpr int NWAVES = 8;
constexpr int RING_BYTES = 131072;
constexpr int LDSCTL_OFF = RING_BYTES, MISC_OFF = LDSCTL_OFF + 320;
constexpr int LDS_BYTES = 147456;
constexpr int CW_TMO = 0, CW_QUEUE = 64, CW_BAR = 4096;
constexpr int PH_P0A = 0, PH_P0B = 1, PH_P0C = 2, PH_L0 = 3, PH_PER_LAYER = 7, PH_FINAL = PH_L0 + DEPTH * PH_PER_LAYER, PH_COUNT = PH_FINAL + 1;
constexpr int PL_IN = 0, PL_PRE = 1, PL_MIX = 2, PL_UP = 3, PL_OUT = 4, PL_FFI = 5, PL_FFO = 6;

#ifndef EN_P0
#define EN_P0 1
#endif
#ifndef EN_IN
#define EN_IN 1
#endif
#ifndef EN_PRE
#define EN_PRE 1
#endif
#ifndef EN_MOBA
#define EN_MOBA 1
#endif
#ifndef EN_GLA
#define EN_GLA 1
#endif
#ifndef EN_UP
#define EN_UP 1
#endif
#ifndef EN_OUT
#define EN_OUT 1
#endif
#ifndef EN_FFI
#define EN_FFI 1
#endif
#ifndef EN_FFO
#define EN_FFO 1
#endif
struct Args { Params P; int ph_lo, ph_hi, li, pad; };

__device__ __forceinline__ void glr_unit(const Params& P, int l, const float* ssq, int rg64, int wave, int lane, LAS unsigned char* lds) {
    const bf16* A = (const bf16*)(P.ws + WS_ABUF); const bf16* W = wt_ptr(P, l, WT_GLR);
    const int rg = wave & 3, kh = wave >> 2, r16 = lane & 15, q = lane >> 4, row0 = rg64 * 64 + rg * 16;
    const bf16* ap = A + (size_t)(row0 + r16) * DM + kh * 1024 + 8 * q; const bf16* bp = W + (size_t)r16 * DM + kh * 1024 + 8 * q;
    f32x4 acc = {0.f, 0.f, 0.f, 0.f};
#pragma unroll 8
    for (int k0 = 0; k0 < 1024; k0 += 32) acc = __builtin_amdgcn_mfma_f32_16x16x32_bf16(*(const bf16x8*)(ap + k0), *(const bf16x8*)(bp + k0), acc, 0, 0, 0);
    LAS f32x4* part = (LAS f32x4*)lds;
    if (kh == 1) part[rg * 64 + lane] = acc;
    __syncthreads();
    if (kh == 0) { const f32x4 o = part[rg * 64 + lane];
        const float* shw = (const float*)(P.ws + WS_SHWGLR) + (size_t)l * 8 * GRANK;
#pragma unroll
        for (int j = 0; j < 4; ++j) { const int row = row0 + 4 * q + j, b = row / SEQ; *(LAS float*)(lds + gla::L_GLR + ((rg * 16 + 4 * q + j) * GRANK + r16) * 4) = rsqrtf(ssq[row] * (1.f / DM) + EPS) * (acc[j] + o[j]) + shw[b * GRANK + r16]; } }
    __syncthreads();
}
__device__ __forceinline__ void kmean_unit(const Params& P, int item, int tid, LAS unsigned char* lds) {
    const int blk = item % MNB, bh = item / MNB, b = bh / MH, h = bh % MH, c8 = tid & 15, rgp = tid >> 4;
    const bf16* p = (const bf16*)(P.ws + WS_PROJ) + PJ_MK + ((size_t)bh * SEQ + blk * MBLK + rgp) * MHD + 8 * c8;
    float s[8];
#pragma unroll
    for (int j = 0; j < 8; ++j) s[j] = 0.f;
#pragma unroll
    for (int i = 0; i < 8; ++i) { const u32x4 w = *(const u32x4*)(p + (size_t)(32 * i) * MHD);
        s[0] += pg8::bflo(w.x); s[1] += pg8::bfhi(w.x); s[2] += pg8::bflo(w.y); s[3] += pg8::bfhi(w.y); s[4] += pg8::bflo(w.z); s[5] += pg8::bfhi(w.z); s[6] += pg8::bflo(w.w); s[7] += pg8::bfhi(w.w); }
    LAS float* red = (LAS float*)lds;
#pragma unroll
    for (int j = 0; j < 8; ++j) red[rgp * 128 + 8 * c8 + j] = s[j];
    __syncthreads();
    if (tid < 128) { float a = 0.f;
#pragma unroll
        for (int r = 0; r < 32; ++r) a += red[r * 128 + tid];
        ((float*)(P.ws + WS_KMEAN))[((size_t)bh * MNB + blk) * MHD + tid] = a * (1.f / MBLK); }
    __syncthreads();
}
__device__ __forceinline__ void final_row(float* x, const float* g, int m, int lane) {
    f32x4* xr = (f32x4*)(x + (size_t)m * DM); float s = 0.f; f32x4 v[8];
#pragma unroll
    for (int j = 0; j < 8; ++j) { v[j] = xr[lane + 64 * j]; s += (v[j].x * v[j].x + v[j].y * v[j].y) + (v[j].z * v[j].z + v[j].w * v[j].w); }
    const float rstd = rsqrtf(wave_sum(s) * (1.f / DM) + EPS);
#pragma unroll
    for (int j = 0; j < 8; ++j) { const f32x4 gg = *(const f32x4*)(g + 4 * (lane + 64 * j)); xr[lane + 64 * j] = v[j] * rstd * gg; }
}

template <int FK>
__device__ __forceinline__ void moba_phase(const Params& P, unsigned* queues  , char* ldsg, volatile LAS unsigned* qslot  , int tid) {
    const bf16* PROJ = (const bf16*)(P.ws + WS_PROJ); bf16* OM = FK ? (bf16*)(P.ws + (size_t)768 * MiB) : (bf16*)(P.ws + WS_OGOM) + (size_t)MT * GVW; const float* KM = (const float*)(P.ws + WS_KMEAN);
    constexpr int W = 1 << 20; constexpr unsigned NONE = 0xffffffffu;
    const unsigned x0 = xb_xcc_id() & 7u; unsigned xo = 0u;
#define MOBA_POP(dst) do { unsigned u_ = NONE; while (xo < 8u) { const unsigned x_ = (x0 + xo) & 7u; const unsigned i_ = __hip_atomic_fetch_add(queues + 64 * x_, 1u, __ATOMIC_RELAXED, __HIP_MEMORY_SCOPE_AGENT); \
        if (i_ < 64u) { u_ = (x_ << 8) | i_; break; } ++xo; } (dst) = u_; } while (0)
#define MOBA_REF(ref, u_) do { const int i_ = (int)((u_) & 63u), x_ = (int)((u_) >> 8), qb_ = MNB - 1 - (i_ >> 3), bh_ = 8 * x_ + (i_ & 7);   \
        (ref).Q = PROJ + PJ_MQ + ((size_t)bh_ * SEQ + qb_ * MBLK) * MHD; (ref).K = PROJ + PJ_MK + (size_t)bh_ * SEQ * MHD; (ref).V = PROJ + PJ_MV + (size_t)bh_ * SEQ * MHD; \
        (ref).O = OM + (size_t)((bh_ >> 3) * SEQ + qb_ * MBLK) * MW + (bh_ & 7) * MHD; (ref).P0 = qb_ * MBLK; (ref).km = KM + (size_t)bh_ * MNB * MHD; (ref).qb = qb_; } while (0)
    if (tid == 0) { unsigned a_, b_; MOBA_POP(a_); MOBA_POP(b_); qslot[0] = a_; qslot[1] = b_; }
    __syncthreads();
    unsigned u = __builtin_amdgcn_readfirstlane(qslot[0]);
    if (u == NONE) return;
    moba::Seam<bf16> S; moba::BlockRef<bf16, bf16> cur, nxt;
    MOBA_REF(cur, u);
    moba::causal_swa_prime<bf16, bf16>(cur, W, ldsg, S);
    for (int it = 0;; ++it) {
        const unsigned un = __builtin_amdgcn_readfirstlane(qslot[(it + 1) % 3]);
        if (tid == 0) { unsigned c_; MOBA_POP(c_); qslot[(it + 2) % 3] = c_; }
        const bool last = un == NONE;
        if (last) nxt = cur; else MOBA_REF(nxt, un);
        moba::causal_swa_block<bf16, bf16, FK>(cur, nxt, SEQ, W, ldsg, S);
        if (last) break;
        cur = nxt;
    }
#undef MOBA_POP
#undef MOBA_REF
}

__global__ void __launch_bounds__(NWAVES * 64, 2) mega(Args args) {
    extern __shared__ __attribute__((aligned(16))) unsigned char lds_raw[];
    LAS unsigned char* lds = (LAS unsigned char*)lds_raw;
    volatile LAS unsigned* MISC = (volatile LAS unsigned*)(lds + MISC_OFF);
    const Params& P = args.P;
    const int wave = __builtin_amdgcn_readfirstlane(threadIdx.x >> 6);
#define OTID(name) int name = threadIdx.x; asm volatile("" : "+v"(name))
    const int G = gridDim.x, bx = blockIdx.x, vcu = (G % 8 == 0) ? (bx % 8) * (G / 8) + bx / 8 : bx;
    const int gw = vcu * NWAVES + wave, ngw = G * NWAVES;
    unsigned* ctl = (unsigned*)(P.ws + WS_CTL);
    { OTID(t0); for (int u = t0; u < (LDS_BYTES - LDSCTL_OFF) / 4; u += NWAVES * 64) ((LAS unsigned*)(lds + LDSCTL_OFF))[u] = 0u; }
    __syncthreads();
    const int lo = args.ph_lo, hi = args.ph_hi;
    XcdBarrier bar; bar.bar = ctl + CW_BAR + args.li * XCD_BAR_WORDS; bar.x = 0; bar.st = nullptr;
    if (hi - lo > 1) bar = xcd_barrier_post(ctl + CW_BAR + args.li * XCD_BAR_WORDS, MISC + 8);
#define IN(k) (lo <= (k) && (k) < hi)
#if defined(PROBE_MASK)
#define PROBE_AT(k) PROBE_TY((k) < PH_L0 ? (k) : ((k) >= PH_FINAL ? 10 : PH_L0 + ((k) - PH_L0) % PH_PER_LAYER))
#define PROBE_TY(ty) do { if (blockIdx.x == 0 && threadIdx.x == 0) { const unsigned long long now_ = __builtin_amdgcn_s_memrealtime(); const int ty_ = (ty); \
        unsigned long long last_ = ((unsigned long long)MISC[21] << 32) | MISC[20], acc_ = ((unsigned long long)MISC[23] << 32) | MISC[22]; if ((PROBE_MASK >> ty_) & 1) acc_ += now_ - last_; \
        MISC[20] = (unsigned)now_; MISC[21] = (unsigned)(now_ >> 32); MISC[22] = (unsigned)acc_; MISC[23] = (unsigned)(acc_ >> 32); } } while (0)
#else
#define PROBE_AT(k) do { } while (0)
#endif
#define SEAM(k) do { if (IN(k) && IN((k) + 1)) xcd_barrier(bar); PROBE_AT(k); } while (0)
#if defined(PROBE_MASK)
    if (blockIdx.x == 0 && threadIdx.x == 0) { const unsigned long long now_ = __builtin_amdgcn_s_memrealtime(); MISC[20] = (unsigned)now_; MISC[21] = (unsigned)(now_ >> 32); MISC[22] = 0u; MISC[23] = 0u; }
#endif

    if (EN_P0 && IN(PH_P0A)) { OTID(t1); phase_p0a(P, gw, ngw, t1 & 63, (float*)(lds_raw + wave * 16384)); __syncthreads(); SEAM(PH_P0A); }
    if (EN_P0 && IN(PH_P0B)) { OTID(t1); phase_p0b(P, vcu * NWAVES * 64 + t1, G * NWAVES * 64); SEAM(PH_P0B); }
    if (EN_P0 && IN(PH_P0C)) {
        OTID(t1);
        for (int m = gw; m < MT / 2; m += ngw) a1prep_row(P, m, t1 & 63);
        shw_all(P, gw, ngw, t1 & 63);
        SEAM(PH_P0C);
    }
    for (int l = 0; l < DEPTH; ++l) {
        const int pb = PH_L0 + l * PH_PER_LAYER;
        bf16* ABUF = (bf16*)(P.ws + WS_ABUF); bf16* OGOM = (bf16*)(P.ws + WS_OGOM); bf16* PROJ = (bf16*)(P.ws + WS_PROJ); bf16* HID = PROJ;
        float* SSQA = (float*)(P.ws + WS_SSQ0); float* SSQB = (float*)(P.ws + WS_SSQ) + (size_t)l * MT; float* SSQN = (float*)(P.ws + WS_SSQ) + (size_t)(2 + l) * MT;
        const float* mv = (const float*)(P.ws + WS_MODV) + (size_t)l * 8 * 6 * DM;
        const float* mvn = (const float*)(P.ws + WS_MODV) + (size_t)(l + 1 < DEPTH ? l + 1 : l) * 8 * 6 * DM;
        const float* ssq_in = l == 0 ? SSQA : (const float*)(P.ws + WS_SSQ) + (size_t)(2 + l - 1) * MT;
        if (EN_IN && IN(pb + PL_IN)) {
            pg8::Gemm g{ABUF, wt_ptr(P, l, WT_IN), MT, NIN, DM}; pg8::StaticOrder S; S.init(MT, NIN, G, bx);
            pg8::EpiIn E{ssq_in, (const float*)(P.ws + WS_SHWIN) + (size_t)l * 8 * NIN, PROJ};
            pg8::gemm_phase<pg8::EpiIn, pg8::StaticOrder, true, true>(lds, g, S, E);
            SEAM(pb + PL_IN);
        }
        if (EN_PRE && IN(pb + PL_PRE)) {
            OTID(t2);
            for (int u = vcu; u < MT / 64; u += G) { glr_unit(P, l, ssq_in, u, wave, t2 & 63, lds);
                u32x4 rq[2], rk[2], nq[2], nk[2]; gla::gla_pre_load(P, u >> 5, u & 31, 0, t2, rq, rk);
#pragma unroll
                for (int h = 0; h < GH; ++h) { if (h + 1 < GH) gla::gla_pre_load(P, u >> 5, u & 31, h + 1, t2, nq, nk);
                    gla::gla_pre_head(P, l, u >> 5, u & 31, h, lds, t2, rq, rk);
                    rq[0] = nq[0]; rq[1] = nq[1]; rk[0] = nk[0]; rk[1] = nk[1]; } }
            for (int it = vcu; it < NB * MH * MNB; it += G) kmean_unit(P, it, t2, lds);
            SEAM(pb + PL_PRE);
        }
        if (IN(pb + PL_MIX)) {
            if (EN_GLA && bx < NB * GH) { OTID(t3); gla::gla_seq_unit<0>(P, l, bx, lds, t3);
#if defined(GLA_PROBE_VAR)
                __syncthreads(); { OTID(t3b); gla::gla_seq_unit<GLA_PROBE_VAR>(P, l, bx, lds, t3b); }
#endif
            }
#if defined(PROBE_MASK) && defined(PROBE_SPLIT)
            xcd_barrier(bar); PROBE_TY(11);
#endif
            if (EN_MOBA) { OTID(t4); moba_phase<0>(P, ctl + CW_QUEUE + 512 * l, (char*)lds_raw, MISC + 16, t4); }
#if defined(MOBA_PROBE_VAR)
            __syncthreads(); { OTID(t4b); moba_phase<MOBA_PROBE_VAR>(P, ctl + CW_QUEUE + 1024 + 512 * l, (char*)lds_raw, MISC + 24, t4b); }
#endif
            SEAM(pb + PL_MIX);
        }
        if (EN_UP && IN(pb + PL_UP)) {
            { pg8::Gemm g{OGOM, wt_ptr(P, l, WT_UPG), MT, DM, GVW};     pg8::StaticOrder S; S.init(MT, DM, G, bx); pg8::EpiUp<false> E{PROJ, GT_OFF, ABUF};
              pg8::gemm_phase<pg8::EpiUp<false>, pg8::StaticOrder, true, true>(lds, g, S, E); }
            { pg8::Gemm g{OGOM + (size_t)MT * GVW, wt_ptr(P, l, WT_UPM), MT, DM, MW};     pg8::StaticOrder S; S.init(MT, DM, G, bx); pg8::EpiUp<true> E{PROJ, GT_OFF + DM, ABUF};
              pg8::gemm_phase<pg8::EpiUp<true>, pg8::StaticOrder, true, true>(lds, g, S, E); }
            SEAM(pb + PL_UP);
        }
        if (EN_OUT && IN(pb + PL_OUT)) {
            pg8::Gemm g{ABUF, wt_ptr(P, l, WT_OUT), MT, DM, DM}; pg8::StaticOrder S; S.init(MT, DM, G, bx);
            pg8::EpiRes E{l == 0 ? P.x : P.out, P.out, mv + 2 * DM, mv + 4 * DM, OGOM, SSQB};
            pg8::gemm_phase<pg8::EpiRes, pg8::StaticOrder, true, true>(lds, g, S, E);
            SEAM(pb + PL_OUT);
        }
        if (EN_FFI && IN(pb + PL_FFI)) {
            pg8::Gemm g{OGOM, wt_ptr(P, l, WT_FFI), MT, NFFI, DM}; pg8::StaticOrder S; S.init(MT, NFFI, G, bx);
            pg8::EpiFfi E{SSQB, (const float*)(P.ws + WS_SHWFFI) + (size_t)l * 8 * NFFI, HID};
            pg8::gemm_phase<pg8::EpiFfi, pg8::StaticOrder, true, true>(lds, g, S, E);
            SEAM(pb + PL_FFI);
        }
        if (EN_FFO && IN(pb + PL_FFO)) {
            pg8::Gemm g{HID, wt_ptr(P, l, WT_FFO), MT, DM, DFF}; pg8::StaticOrder S; S.init(MT, DM, G, bx);
            pg8::EpiRes E{P.out, P.out, mv + 5 * DM, mvn + 1 * DM, l + 1 < DEPTH ? ABUF : nullptr, l + 1 < DEPTH ? SSQN : nullptr};
            pg8::gemm_phase<pg8::EpiRes, pg8::StaticOrder, true, true>(lds, g, S, E);
            SEAM(pb + PL_FFO);
        }
    }
    if (IN(PH_FINAL)) { OTID(t5); for (int m = gw; m < MT; m += ngw) final_row(P.out, P.final_g, m, t5 & 63); }
#if defined(PROBE_MASK)
    PROBE_AT(PH_FINAL);
    if (blockIdx.x == 0 && threadIdx.x == 0) { const unsigned long long acc_ = ((unsigned long long)MISC[23] << 32) | MISC[22]; const unsigned long long t_end = __builtin_amdgcn_s_memrealtime() + (unsigned long long)(PROBE_MULT) * acc_;
        while (__builtin_amdgcn_s_memrealtime() < t_end) __builtin_amdgcn_s_sleep(8); }
#endif
#undef IN
#undef SEAM
#undef OTID
}
extern "C" void kernel_launch(void* const* d_in, const int* in_sizes, int n_in, void* d_out, int out_size, void* d_ws, size_t ws_size, hipStream_t stream) {
    static int grid = 0;
    if (grid == 0) {
        if (n_in != 16 || in_sizes[0] != MT * DM || out_size != MT * DM || ws_size < WS_NEED) { fprintf(stderr, "kernel_launch: unexpected shapes/ws (n_in %d, ws %zu, need %zu)\n", n_in, ws_size, (size_t)WS_NEED); grid = -1; return; }
        int dev = 0, cus = 0, per_cu = 0;
        if (hipGetDevice(&dev) != hipSuccess || hipDeviceGetAttribute(&cus, hipDeviceAttributeMultiprocessorCount, dev) != hipSuccess) { grid = -1; return; }
        if (hipFuncSetAttribute((const void*)mega, hipFuncAttributeMaxDynamicSharedMemorySize, LDS_BYTES) != hipSuccess) { fprintf(stderr, "kernel_launch: hipFuncSetAttribute failed\n"); grid = -1; return; }
        if (hipOccupancyMaxActiveBlocksPerMultiprocessor(&per_cu, (const void*)mega, NWAVES * 64, LDS_BYTES) != hipSuccess || per_cu < 1) fprintf(stderr, "kernel_launch: occupancy query says %d\n", per_cu);
        (void)hipGetLastError();
        grid = cus;
    }
    if (grid < 0) return;
    Args a{};
    Params& P = a.P;
    P.x = (const float*)d_in[0]; P.c = (const float*)d_in[1]; P.ada_w = (const float*)d_in[2]; P.ada_b = (const float*)d_in[3]; P.norm1_g = (const float*)d_in[4]; P.w_in = (const float*)d_in[5];
    P.gate_w2 = (const float*)d_in[6]; P.gate_b = (const float*)d_in[7]; P.gla_norm_g = (const float*)d_in[8]; P.w_up_gla = (const float*)d_in[9]; P.w_up_moba = (const float*)d_in[10];
    P.w_out = (const float*)d_in[11]; P.norm2_g = (const float*)d_in[12]; P.w_ffn_in = (const float*)d_in[13]; P.w_ffn_out = (const float*)d_in[14]; P.final_g = (const float*)d_in[15];
    P.out = (float*)d_out; P.ws = (unsigned char*)d_ws;
    unsigned char* ws = (unsigned char*)d_ws;
    (void)hipMemsetAsync(ws + WS_CTL, 0, CTL_ZERO_BYTES, stream);
#define MEGA(lo_, hi_) do { a.ph_lo = (lo_); a.ph_hi = (hi_); a.li = 0; hipLaunchKernelGGL(mega, dim3(grid), dim3(NWAVES * 64), LDS_BYTES, stream, a); } while (0)
    MEGA(0, PH_COUNT);
#undef MEGA
}
```

```cpp
#include <hip/hip_runtime.h>
#include <cstdio>
#include <cstdint>

constexpr int NB = 8, SEQ = 2048, DM = 2048, MT = NB * SEQ, DEPTH = 2;
constexpr int GH = 4, GDK = 128, GDV = 256, GKW = 512, GVW = 1024, GRANK = 16, GCH = 64;
constexpr int MH = 8, MHD = 128, MW = 1024, MBLK = 256, MNB = SEQ / MBLK, MTOPK = 3;
constexpr int DFF = 5632, NFFI = 2 * DFF;
constexpr int NINSRC = 10256, NIN = 10240;
constexpr float EPS = 1e-6f;
constexpr int GQ_OFF = 0, GK_OFF = 512, GV_OFF = 1024, GR_OFF = 2048, MQ_OFF = 3072, MK_OFF = 4096, MV_OFF = 5120, GT_OFF = 6144;
constexpr int GLR_SRC = 3072;
constexpr size_t PJ_GQ = 0, PJ_GK = (size_t)MT * 512, PJ_GV = (size_t)MT * 1024, PJ_GR = (size_t)MT * 2048, PJ_MQ = (size_t)MT * 3072, PJ_MK = (size_t)MT * 4096, PJ_MV = (size_t)MT * 5120, PJ_GT = (size_t)MT * 6144;

constexpr size_t MiB = 1u << 20;
constexpr size_t WS_CTL = 0, CTL_ZERO_BYTES = 2 * MiB;
constexpr size_t WS_SSQ = 1 * MiB;
constexpr size_t WS_MODP = 2 * MiB;
constexpr size_t WS_MODV = 8 * MiB;
constexpr size_t WS_SHWIN = 9 * MiB;
constexpr size_t WS_SHWFFI = 10 * MiB;
constexpr size_t WS_SHWGLR = 11 * MiB;
constexpr size_t WS_GLR = 12 * MiB;
constexpr size_t WS_KMEAN = 13 * MiB;
constexpr size_t WS_SSQ0 = 14 * MiB;
constexpr size_t WS_WT = 16 * MiB, WT_LAYER = 123 * MiB;
constexpr size_t WT_IN = 0, WT_GLR = 40 * MiB, WT_UPG = 41 * MiB, WT_UPM = 45 * MiB, WT_OUT = 49 * MiB, WT_FFI = 57 * MiB, WT_FFO = 101 * MiB;
constexpr size_t WS_ABUF = 262 * MiB;
constexpr size_t WS_OGOM = 326 * MiB;
constexpr size_t WS_PROJ = 390 * MiB;
constexpr size_t WS_END = 710 * MiB;
constexpr size_t WS_DBG_G = 710 * MiB;
constexpr size_t WS_DBG_O = 742 * MiB;
constexpr size_t WS_DBG_END = 806 * MiB;
constexpr size_t WS_NEED = 752 * MiB;

typedef unsigned short bf16;
typedef short bf16x8 __attribute__((ext_vector_type(8)));
typedef float f32x4 __attribute__((ext_vector_type(4)));
typedef unsigned u32x4 __attribute__((ext_vector_type(4)));
typedef unsigned u32x2 __attribute__((ext_vector_type(2)));

struct Params {
    const float* x; const float* c; const float* ada_w; const float* ada_b; const float* norm1_g; const float* w_in;
    const float* gate_w2; const float* gate_b; const float* gla_norm_g; const float* w_up_gla; const float* w_up_moba;
    const float* w_out; const float* norm2_g; const float* w_ffn_in; const float* w_ffn_out; const float* final_g;
    float* out; unsigned char* ws;
};

__device__ __forceinline__ unsigned f2bf(float f) { unsigned u = __builtin_bit_cast(unsigned, f); return (u + 0x7fffu + ((u >> 16) & 1u)) >> 16; }
__device__ __forceinline__ unsigned pk2(float lo, float hi) { return f2bf(lo) | (f2bf(hi) << 16); }
__device__ __forceinline__ float bf2f(unsigned short b) { return __builtin_bit_cast(float, ((unsigned)b) << 16); }
__device__ __forceinline__ float wave_sum(float v) {
#pragma unroll
    for (int o = 1; o < 64; o <<= 1) v += __shfl_xor(v, o);
    return v;
}
__device__ __forceinline__ float sigmoidf_(float v) { return 1.0f / (1.0f + __expf(-v)); }
__device__ __forceinline__ float siluf_(float v) { return v / (1.0f + __expf(-v)); }
__device__ __forceinline__ float logsigmoidf_(float v) { return fminf(v, 0.f) - log1pf(__expf(-fabsf(v))); }

__device__ __forceinline__ const bf16* wt_ptr(const Params& P, int l, size_t off) { return (const bf16*)(P.ws + WS_WT + (size_t)l * WT_LAYER + off); }
__device__ __forceinline__ int in_src_col(int n) { return n < 3072 ? n : n + 16; }
__device__ __forceinline__ int ffi_src_col(int r) { const int pn = r >> 8, c = r & 255; return c < 128 ? pn * 128 + c : DFF + pn * 128 + (c - 128); }

__device__ __forceinline__ void ada_item(const Params& P, int item, int lane, float* scr) {
    const int cg = item % 96, kc = (item / 96) % 8, l = item / 768;
    const int k0 = kc * 256;
    for (int i = 0; i < 32; ++i) { const int idx = lane + 64 * i, b = idx >> 8, kk = idx & 255; scr[idx] = siluf_(P.c[b * DM + k0 + kk]); }
    __builtin_amdgcn_s_waitcnt(0);
    const float* W = P.ada_w + (size_t)l * DM * (6 * DM) + (size_t)k0 * (6 * DM) + cg * 128 + 2 * lane;
    float a0[8], a1[8];
#pragma unroll
    for (int b = 0; b < 8; ++b) { a0[b] = 0.f; a1[b] = 0.f; }
#pragma unroll 8
    for (int kk = 0; kk < 256; ++kk) {
        typedef float f32x2n __attribute__((ext_vector_type(2))); const f32x2n w = __builtin_nontemporal_load((const f32x2n*)(W + (size_t)kk * (6 * DM)));
#pragma unroll
        for (int b = 0; b < 8; ++b) { const float cv = scr[b * 256 + kk]; a0[b] += cv * w.x; a1[b] += cv * w.y; }
    }
    float* MP = (float*)(P.ws + WS_MODP) + ((size_t)(kc * 2 + l) * 8) * (6 * DM) + cg * 128 + 2 * lane;
#pragma unroll
    for (int b = 0; b < 8; ++b) *(float2*)(MP + (size_t)b * (6 * DM)) = make_float2(a0[b], a1[b]);
    __builtin_amdgcn_s_waitcnt(0);
}
__device__ __forceinline__ void transpose_item(const float* W, int Nsrc, int src_col0, int K, int k0, bf16* WT, int dst_row0, float* scr, int lane) {
    f32x4 v[8];
    const float* src = W + (size_t)(k0 + (lane >> 3)) * Nsrc + src_col0 + 4 * (lane & 7);
#pragma unroll
    for (int i = 0; i < 8; ++i) v[i] = __builtin_nontemporal_load((const f32x4*)(src + (size_t)(8 * i) * Nsrc));
#pragma unroll
    for (int i = 0; i < 8; ++i) { float* d = scr + (8 * i + (lane >> 3)) * 33 + 4 * (lane & 7); d[0] = v[i][0]; d[1] = v[i][1]; d[2] = v[i][2]; d[3] = v[i][3]; }
    __builtin_amdgcn_s_waitcnt(0);
    const int c = lane & 7;
#pragma unroll
    for (int j = 0; j < 4; ++j) { const int n = (lane >> 3) + 8 * j; const float* s = scr + (8 * c) * 33 + n;
        u32x4 o; o.x = pk2(s[0 * 33], s[1 * 33]); o.y = pk2(s[2 * 33], s[3 * 33]); o.z = pk2(s[4 * 33], s[5 * 33]); o.w = pk2(s[6 * 33], s[7 * 33]);
        *(u32x4*)(WT + (size_t)(dst_row0 + n) * K + k0 + 8 * c) = o; }
    __builtin_amdgcn_s_waitcnt(0);
}
constexpr int TI_IN = (DM / 64) * (NIN / 32), TI_UP = (GVW / 64) * (DM / 32), TI_OUT = (DM / 64) * (DM / 32), TI_FFI = (DM / 64) * (NFFI / 32), TI_FFO = (DFF / 64) * (DM / 32), TI_GLR = DM / 64;
constexpr int TI_LAYER = TI_IN + 2 * TI_UP + TI_OUT + TI_FFI + TI_FFO + TI_GLR;
__device__ __forceinline__ void wconv_item(const Params& P, int item, int lane, float* scr) {
    const int l = item / TI_LAYER; int r = item % TI_LAYER;
    unsigned char* wl = P.ws + WS_WT + (size_t)l * WT_LAYER;
    if (r < TI_IN) { const int nb = r % (NIN / 32), kb = r / (NIN / 32);
        transpose_item(P.w_in + (size_t)l * DM * NINSRC, NINSRC, in_src_col(nb * 32), DM, kb * 64, (bf16*)(wl + WT_IN), nb * 32, scr, lane); return; } r -= TI_IN;
    if (r < TI_UP) { const int nb = r % (DM / 32), kb = r / (DM / 32);
        transpose_item(P.w_up_gla + (size_t)l * GVW * DM, DM, nb * 32, GVW, kb * 64, (bf16*)(wl + WT_UPG), nb * 32, scr, lane); return; } r -= TI_UP;
    if (r < TI_UP) { const int nb = r % (DM / 32), kb = r / (DM / 32);
        transpose_item(P.w_up_moba + (size_t)l * MW * DM, DM, nb * 32, MW, kb * 64, (bf16*)(wl + WT_UPM), nb * 32, scr, lane); return; } r -= TI_UP;
    if (r < TI_OUT) { const int nb = r % (DM / 32), kb = r / (DM / 32);
        transpose_item(P.w_out + (size_t)l * DM * DM, DM, nb * 32, DM, kb * 64, (bf16*)(wl + WT_OUT), nb * 32, scr, lane); return; } r -= TI_OUT;
    if (r < TI_FFI) { const int nb = r % (NFFI / 32), kb = r / (NFFI / 32);
        transpose_item(P.w_ffn_in + (size_t)l * DM * NFFI, NFFI, ffi_src_col(nb * 32), DM, kb * 64, (bf16*)(wl + WT_FFI), nb * 32, scr, lane); return; } r -= TI_FFI;
    if (r < TI_FFO) { const int nb = r % (DM / 32), kb = r / (DM / 32);
        transpose_item(P.w_ffn_out + (size_t)l * DFF * DM, DM, nb * 32, DFF, kb * 64, (bf16*)(wl + WT_FFO), nb * 32, scr, lane); return; } r -= TI_FFO;
    { const int k0 = r * 64, j = lane & 15, kq = lane >> 4; bf16* G = (bf16*)(wl + WT_GLR); const float* W = P.w_in + (size_t)l * DM * NINSRC;
        for (int kk = 0; kk < 16; ++kk) { const int k = k0 + kq * 16 + kk; G[(size_t)j * DM + k] = (bf16)f2bf(W[(size_t)k * NINSRC + GLR_SRC + j]); } }
}
__device__ __forceinline__ void phase_p0a(const Params& P, int gw, int ngw, int lane, float* scr) {
    constexpr int NADA = 2 * 8 * 96;
    for (int it = gw; it < NADA; it += ngw) ada_item(P, it, lane, scr);
    for (int it = gw; it < DEPTH * TI_LAYER; it += ngw) wconv_item(P, it, lane, scr);
}
__device__ __forceinline__ void phase_p0b(const Params& P, int gtid, int ngt) {
    const float* MP = (const float*)(P.ws + WS_MODP); float* MV = (float*)(P.ws + WS_MODV);
    for (int i = gtid; i < 2 * 8 * DM; i += ngt) {
        const int j = i % DM, b = (i / DM) % 8, l = i / (8 * DM);
        float m[6];
#pragma unroll
        for (int s = 0; s < 6; ++s) { float a = P.ada_b[l * 6 * DM + s * DM + j];
            for (int kc = 0; kc < 8; ++kc) a += MP[((size_t)(kc * 2 + l) * 8 + b) * (6 * DM) + s * DM + j]; m[s] = a; }
        float* o = MV + ((size_t)(l * 8 + b) * 6) * DM + j;
        o[0 * DM] = m[0]; o[1 * DM] = P.norm1_g[l * DM + j] * (1.f + m[1]); o[2 * DM] = m[2];
        o[3 * DM] = m[3]; o[4 * DM] = P.norm2_g[l * DM + j] * (1.f + m[4]); o[5 * DM] = m[5];
    }
}
__device__ __forceinline__ void a1prep_row(const Params& P, int m0, int lane) {
    f32x4 v[2][8];
#pragma unroll
    for (int rr = 0; rr < 2; ++rr) { const f32x4* xr = (const f32x4*)(P.x + (size_t)(m0 + rr * (MT / 2)) * DM);
#pragma unroll
        for (int j = 0; j < 8; ++j) v[rr][j] = xr[lane + 64 * j]; }
#pragma unroll
    for (int rr = 0; rr < 2; ++rr) { const int m = m0 + rr * (MT / 2), b = m / SEQ; const float* gm = (const float*)(P.ws + WS_MODV) + ((size_t)(0 * 8 + b) * 6 + 1) * DM;
        bf16* A = (bf16*)(P.ws + WS_ABUF) + (size_t)m * DM; float s = 0.f;
#pragma unroll
        for (int j = 0; j < 8; ++j) { const f32x4 x4 = v[rr][j]; const f32x4 g = *(const f32x4*)(gm + 4 * (lane + 64 * j));
            s += (x4.x * x4.x + x4.y * x4.y) + (x4.z * x4.z + x4.w * x4.w);
            u32x2 w; w.x = pk2(x4.x * g.x, x4.y * g.y); w.y = pk2(x4.z * g.z, x4.w * g.w); *(u32x2*)(A + 4 * (lane + 64 * j)) = w; }
        s = wave_sum(s);
        if (lane == 0) ((float*)(P.ws + WS_SSQ0))[m] = s; }
}
constexpr int SHW_T_IN = (NIN + GRANK) / 16, SHW_T_FFI = NFFI / 16, SHW_TILES = DEPTH * (SHW_T_IN + SHW_T_FFI);
__device__ __forceinline__ void shw_all(const Params& P, int gw, int ngw, int lane) {
    const float* MV = (const float*)(P.ws + WS_MODV); const int r16 = lane & 15, q = lane >> 4;
    for (int item = gw; item < SHW_TILES; item += ngw) {
        const int l = item / (SHW_T_IN + SHW_T_FFI), rr = item % (SHW_T_IN + SHW_T_FFI), which = rr >= SHW_T_IN ? 1 : 0, n0 = (which ? rr - SHW_T_IN : rr) * 16;
        const bf16* rows = which ? wt_ptr(P, l, WT_FFI) + (size_t)n0 * DM : (n0 < NIN ? wt_ptr(P, l, WT_IN) + (size_t)n0 * DM : wt_ptr(P, l, WT_GLR));
        const bf16* bp = rows + (size_t)r16 * DM + 8 * q; const float* ap = MV + ((size_t)(l * 8 + (r16 & 7)) * 6 + (which ? 3 : 0)) * DM + 8 * q;
        f32x4 acc = {0.f, 0.f, 0.f, 0.f};
#pragma unroll 1
        for (int kb = 0; kb < DM; kb += 256) { bf16x8 bw[8]; f32x4 a0[8], a1[8];
#pragma unroll
            for (int j = 0; j < 8; ++j) { bw[j] = *(const bf16x8*)(bp + kb + 32 * j); a0[j] = *(const f32x4*)(ap + kb + 32 * j); a1[j] = *(const f32x4*)(ap + kb + 32 * j + 4); }
#pragma unroll
            for (int j = 0; j < 8; ++j) { u32x4 aw; aw.x = pk2(a0[j].x, a0[j].y); aw.y = pk2(a0[j].z, a0[j].w); aw.z = pk2(a1[j].x, a1[j].y); aw.w = pk2(a1[j].z, a1[j].w);
                acc = __builtin_amdgcn_mfma_f32_16x16x32_bf16(__builtin_bit_cast(bf16x8, aw), bw[j], acc, 0, 0, 0); } }
        if (q < 2) {
#pragma unroll
            for (int j = 0; j < 4; ++j) { const int b = 4 * q + j, n = n0 + r16;
                if (which) ((float*)(P.ws + WS_SHWFFI))[((size_t)l * 8 + b) * NFFI + n] = acc[j];
                else if (n0 < NIN) ((float*)(P.ws + WS_SHWIN))[((size_t)l * 8 + b) * NIN + n] = acc[j];
                else ((float*)(P.ws + WS_SHWGLR))[((size_t)l * 8 + b) * GRANK + (n - NIN)] = acc[j]; } }
    }
}

namespace pg8 {
#define PG8_LAS __attribute__((address_space(3)))
typedef unsigned short bf16_t;
typedef short bf16x8 __attribute__((ext_vector_type(8)));
typedef float f32x4 __attribute__((ext_vector_type(4)));
typedef unsigned u32x4 __attribute__((ext_vector_type(4)));
constexpr int BM = 256, BK = 64, HALF = 128, HTB = HALF * BK * 2  , STAGE_BYTES = 8 * HTB, NXCD = 8, WGM = 8;

__host__ __device__ __forceinline__ int lds_byte(int r, int c) { const int st = (r >> 4) * 2 + (c >> 5), rr = r & 15, cc = c & 31, ob = rr * 64 + cc * 2; return st * 1024 + (ob ^ (((ob >> 9) & 1) << 5)); }
__host__ __device__ __forceinline__ void stage_rc(int b, int& R, int& C) { const int st = b / 1024, sb = b % 1024, swz = sb ^ (((sb >> 9) & 1) << 5); R = (st >> 1) * 16 + swz / 64; C = (st & 1) * 32 + (swz % 64) / 2; }
__host__ __device__ __forceinline__ int perm32(int rho) { const int n = rho >> 4, i = rho & 15; return 8 * (i >> 2) + 4 * n + (i & 3); }

struct Unit { int pm, pn; };
struct Gemm { const bf16_t* A; const bf16_t* Bt; int M, N, K; };

struct StaticOrder {
    int nM, nN, nwg, G, c;
    __host__ __device__ void init(int M, int N, int G_, int c_) { nM = M / BM; nN = N / BM; nwg = nM * nN; G = G_; c = c_; }
    __host__ __device__ bool next(int i, Unit& u) const {
        const long L = (long)i * G + c; if (L >= nwg) return false;
        int wgid = (int)L; { const int q = nwg / NXCD, r = nwg % NXCD, xcd = wgid % NXCD, off = wgid / NXCD; wgid = (xcd < r ? xcd * (q + 1) : r * (q + 1) + (xcd - r) * q) + off; }
        const int nig = WGM * nN, gid = wgid / nig, fm = gid * WGM, gsz = (nM - fm) < WGM ? (nM - fm) : WGM;
        u.pm = fm + ((wgid % nig) % gsz); u.pn = (wgid % nig) / gsz; return true;
    }
    __device__ __forceinline__ void a_ready(const Unit&) const {}
    __device__ __forceinline__ void done(const Unit&) const {}
};
__device__ __forceinline__ unsigned cvt_pk_bf16(float lo, float hi) { unsigned r; asm volatile("v_cvt_pk_bf16_f32 %0, %1, %2" : "=v"(r) : "v"(lo), "v"(hi)); return r; }
typedef float f32x2 __attribute__((ext_vector_type(2)));
__device__ __forceinline__ float fsig(float v) { return __builtin_amdgcn_rcpf(1.0f + __builtin_amdgcn_exp2f(-1.4426950408889634f * v)); }
__device__ __forceinline__ float bflo(unsigned w) { return __builtin_bit_cast(float, w << 16); }
__device__ __forceinline__ float bfhi(unsigned w) { return __builtin_bit_cast(float, w & 0xffff0000u); }
struct EpiIn {
    static constexpr bool PERM = true, AFTER_DRAIN = false;
    const float* ssq; const float* shw; bf16_t* proj;
    __device__ __forceinline__ void operator()(const f32x4 (&acc)[2][2][4][2], const Unit& u, int wr, int wc, int fr, int fq) const {
        const int row0 = u.pm * BM + wr * 64 + fr, col0 = u.pn * BM + wc * 32 + 8 * fq, b = u.pm >> 3, t0 = (u.pm & 7) * BM + wr * 64 + fr;
        const int mode = u.pn < 2 ? 1 : ((u.pn >= 8 && u.pn < 12) ? 2 : (u.pn >= 24 ? 3 : 0));
        size_t off[2]; int stride;
        if (u.pn >= 24) { stride = 4096; off[0] = PJ_GT + (size_t)b * SEQ * 4096 + (u.pn * BM - GT_OFF) + wc * 32 + 8 * fq; off[1] = off[0] + HALF; }
        else { const int seg = u.pn < 2 ? 0 : u.pn < 4 ? 1 : u.pn < 8 ? 2 : u.pn < 12 ? 3 : u.pn < 16 ? 4 : u.pn < 20 ? 5 : 6;
            const size_t base = seg == 0 ? PJ_GQ : seg == 1 ? PJ_GK : seg == 2 ? PJ_GV : seg == 3 ? PJ_GR : seg == 4 ? PJ_MQ : seg == 5 ? PJ_MK : PJ_MV;
            const int c0 = seg == 0 ? GQ_OFF : seg == 1 ? GK_OFF : seg == 2 ? GV_OFF : seg == 3 ? GR_OFF : seg == 4 ? MQ_OFF : seg == 5 ? MK_OFF : MV_OFF;
            const bool wide = (seg == 2 || seg == 3); const int nh = seg >= 4 ? MH : GH; stride = wide ? 256 : 128;
#pragma unroll
            for (int bj = 0; bj < 2; ++bj) { const int cs = u.pn * BM - c0 + bj * HALF, head = wide ? (cs >> 8) : (cs >> 7), d = (wide ? (cs & 255) : 0) + wc * 32 + 8 * fq;
                off[bj] = base + ((size_t)(b * nh + head) * SEQ) * stride + d; } }
        f32x4 bv[2][2];
#pragma unroll
        for (int bj = 0; bj < 2; ++bj)
#pragma unroll
            for (int n = 0; n < 2; ++n) bv[bj][n] = *(const f32x4*)(shw + (size_t)b * NIN + col0 + bj * HALF + 4 * n);
#pragma unroll
        for (int ai = 0; ai < 2; ++ai)
#pragma unroll
            for (int m = 0; m < 4; ++m) { const int r = row0 + ai * HALF + m * 16, t = t0 + ai * HALF + m * 16; const float rstd = rsqrtf(ssq[r] * (1.0f / DM) + EPS);
#pragma unroll
                for (int bj = 0; bj < 2; ++bj) { f32x4 v0 = acc[ai][bj][m][0] * rstd + bv[bj][0], v1 = acc[ai][bj][m][1] * rstd + bv[bj][1];
                    if (mode == 1) { v0 = v0 * 0.08838834764831845f; v1 = v1 * 0.08838834764831845f; }
                    else if (mode == 2) {
#pragma unroll
                        for (int j = 0; j < 4; ++j) { v0[j] = v0[j] * fsig(v0[j]); v1[j] = v1[j] * fsig(v1[j]); } }
                    else if (mode == 3) {
#pragma unroll
                        for (int j = 0; j < 4; ++j) { v0[j] = fsig(v0[j]); v1[j] = fsig(v1[j]); } }
                    u32x4 w; w.x = cvt_pk_bf16(v0[0], v0[1]); w.y = cvt_pk_bf16(v0[2], v0[3]); w.z = cvt_pk_bf16(v1[0], v1[1]); w.w = cvt_pk_bf16(v1[2], v1[3]);
                    *(u32x4*)(proj + off[bj] + (size_t)t * stride) = w; } }
    }
};
struct EpiFfi {
    static constexpr bool PERM = true, AFTER_DRAIN = false;
    const float* ssq; const float* shw; bf16_t* hid;
    __device__ __forceinline__ void operator()(const f32x4 (&acc)[2][2][4][2], const Unit& u, int wr, int wc, int fr, int fq) const {
        const int row0 = u.pm * BM + wr * 64 + fr, bcol0 = u.pn * BM + wc * 32 + 8 * fq, hcol0 = u.pn * HALF + wc * 32 + 8 * fq, b = u.pm >> 3;
        f32x4 bv[2][2];
#pragma unroll
        for (int bj = 0; bj < 2; ++bj)
#pragma unroll
            for (int n = 0; n < 2; ++n) bv[bj][n] = *(const f32x4*)(shw + (size_t)b * NFFI + bcol0 + bj * HALF + 4 * n);
#pragma unroll
        for (int ai = 0; ai < 2; ++ai)
#pragma unroll
            for (int m = 0; m < 4; ++m) { const int r = row0 + ai * HALF + m * 16; const float rstd = rsqrtf(ssq[r] * (1.0f / DM) + EPS);
                f32x4 a0 = acc[ai][0][m][0] * rstd + bv[0][0], a1 = acc[ai][0][m][1] * rstd + bv[0][1];
                const f32x4 u0 = acc[ai][1][m][0] * rstd + bv[1][0], u1 = acc[ai][1][m][1] * rstd + bv[1][1];
#pragma unroll
                for (int j = 0; j < 4; ++j) { a0[j] = a0[j] * fsig(a0[j]) * u0[j]; a1[j] = a1[j] * fsig(a1[j]) * u1[j]; }
                u32x4 w; w.x = cvt_pk_bf16(a0[0], a0[1]); w.y = cvt_pk_bf16(a0[2], a0[3]); w.z = cvt_pk_bf16(a1[0], a1[1]); w.w = cvt_pk_bf16(a1[2], a1[3]);
                *(u32x4*)(hid + (size_t)r * DFF + hcol0) = w; }
    }
};
template <bool SECOND> struct EpiUp {
    static constexpr bool PERM = true, AFTER_DRAIN = false;
    const bf16_t* proj; int goff; bf16_t* mg;
    __device__ __forceinline__ void operator()(const f32x4 (&acc)[2][2][4][2], const Unit& u, int wr, int wc, int fr, int fq) const {
        const int row0 = u.pm * BM + wr * 64 + fr, col0 = u.pn * BM + wc * 32 + 8 * fq;
#pragma unroll
        for (int ai = 0; ai < 2; ++ai) {
            u32x4 gt[4][2], tp[4][2];
#pragma unroll
            for (int m = 0; m < 4; ++m)
#pragma unroll
                for (int bj = 0; bj < 2; ++bj) { const int r = row0 + ai * HALF + m * 16;
                    gt[m][bj] = *(const u32x4*)(proj + PJ_GT + (size_t)r * 4096 + (goff - GT_OFF) + col0 + bj * HALF);
                    if (SECOND) tp[m][bj] = *(const u32x4*)(mg + (size_t)r * DM + col0 + bj * HALF); }
#pragma unroll
            for (int m = 0; m < 4; ++m) { const int r = row0 + ai * HALF + m * 16;
#pragma unroll
                for (int bj = 0; bj < 2; ++bj) { const u32x4 g = gt[m][bj]; bf16_t* op = mg + (size_t)r * DM + col0 + bj * HALF;
                    f32x4 v0 = acc[ai][bj][m][0], v1 = acc[ai][bj][m][1];
                    v0[0] *= bflo(g.x); v0[1] *= bfhi(g.x); v0[2] *= bflo(g.y); v0[3] *= bfhi(g.y); v1[0] *= bflo(g.z); v1[1] *= bfhi(g.z); v1[2] *= bflo(g.w); v1[3] *= bfhi(g.w);
                    if (SECOND) { const u32x4 t = tp[m][bj];
                        v0[0] += bflo(t.x); v0[1] += bfhi(t.x); v0[2] += bflo(t.y); v0[3] += bfhi(t.y); v1[0] += bflo(t.z); v1[1] += bfhi(t.z); v1[2] += bflo(t.w); v1[3] += bfhi(t.w); }
                    u32x4 w; w.x = cvt_pk_bf16(v0[0], v0[1]); w.y = cvt_pk_bf16(v0[2], v0[3]); w.z = cvt_pk_bf16(v1[0], v1[1]); w.w = cvt_pk_bf16(v1[2], v1[3]);
                    *(u32x4*)op = w; } }
            asm volatile("" ::: "memory"); }
    }
};
struct EpiRes {
    static constexpr bool PERM = false, AFTER_DRAIN = false;
    const float* xin; float* xout; const float* gate; const float* gm; bf16_t* aout; float* ssq;
    __device__ __forceinline__ void operator()(const f32x4 (&acc)[2][2][4][2], const Unit& u, int wr, int wc, int fr, int fq) const {
        const int row0 = u.pm * BM + wr * 64 + fr, col0 = u.pn * BM + wc * 32 + 4 * fq, b = u.pm >> 3;
        f32x4 gv[2][2], mv[2][2];
#pragma unroll
        for (int bj = 0; bj < 2; ++bj)
#pragma unroll
            for (int n = 0; n < 2; ++n) { gv[bj][n] = *(const f32x4*)(gate + (size_t)b * 6 * DM + col0 + bj * HALF + n * 16);
                mv[bj][n] = aout ? *(const f32x4*)(gm + (size_t)b * 6 * DM + col0 + bj * HALF + n * 16) : (f32x4){0.f, 0.f, 0.f, 0.f}; }
#pragma unroll
        for (int ap = 0; ap < 4; ++ap) { const int ai = ap >> 1, mb = (ap & 1) * 2;
            f32x4 xv[2][2][2];
#pragma unroll
            for (int mm = 0; mm < 2; ++mm)
#pragma unroll
                for (int bj = 0; bj < 2; ++bj)
#pragma unroll
                    for (int n = 0; n < 2; ++n) xv[mm][bj][n] = *(const f32x4*)(xin + (size_t)(row0 + ai * HALF + (mb + mm) * 16) * DM + col0 + bj * HALF + n * 16);
#pragma unroll
            for (int mm = 0; mm < 2; ++mm) { const int m = mb + mm, r = row0 + ai * HALF + m * 16; const size_t off = (size_t)r * DM + col0; float s = 0.f;
#pragma unroll
                for (int bj = 0; bj < 2; ++bj)
#pragma unroll
                    for (int n = 0; n < 2; ++n) { const f32x4 o = xv[mm][bj][n] + gv[bj][n] * acc[ai][bj][m][n];
                        *(f32x4*)(xout + off + bj * HALF + n * 16) = o; s += (o[0] * o[0] + o[1] * o[1]) + (o[2] * o[2] + o[3] * o[3]);
                        if (aout) { const f32x4 a = o * mv[bj][n]; u32x2 w; w.x = cvt_pk_bf16(a[0], a[1]); w.y = cvt_pk_bf16(a[2], a[3]); *(u32x2*)(aout + off + bj * HALF + n * 16) = w; } }
                if (ssq) { s += __shfl_xor(s, 16); s += __shfl_xor(s, 32); if (fq == 0) __hip_atomic_fetch_add(ssq + r, s, __ATOMIC_RELAXED, __HIP_MEMORY_SCOPE_AGENT); } }
            asm volatile("" ::: "memory"); }
    }
};
template <class Epi, class Sched, bool ALIGN_EPI = false, bool SP2 = false>
__device__ __forceinline__ void gemm_phase(PG8_LAS unsigned char* lds, const Gemm g, const Sched& S, const Epi& E) {
    int tid_ = threadIdx.x; asm volatile("" : "+v"(tid_));
    const int tid = tid_, wid = __builtin_amdgcn_readfirstlane(tid >> 6), lane = tid & 63, wr = wid >> 2, wc = wid & 3, fr = lane & 15, fq = lane >> 4;
    const int K = g.K, nt = K / BK;
    unsigned voffA[2], voffB[2];
#pragma unroll
    for (int i = 0; i < 2; ++i) { int R, C; stage_rc(tid * 16 + i * 8192, R, C); const int Rb = Epi::PERM ? ((R & ~31) + perm32(R & 31)) : R;
        voffA[i] = (unsigned)(R * K + C) * 2u; voffB[i] = (unsigned)(Rb * K + C) * 2u; }
    const size_t kstep = (size_t)(BK * 2);
    const size_t hstep = (size_t)HALF * K * 2;
    const size_t tstep = 2 * hstep;
    const unsigned ldsw = (unsigned)wid * 1024u;
    const int aoff = lds_byte(wr * 64 + fr, fq * 8), boff = lds_byte(wc * 32 + fr, fq * 8);
#define PG8_SA(b, h) (((b) * 2 + (h)) * HTB)
#define PG8_SB(b, h) ((4 + (b) * 2 + (h)) * HTB)
#define PG8_STAGE(bufoff, gbase, voff) do { _Pragma("unroll") for (int _i = 0; _i < 2; ++_i) \
        __builtin_amdgcn_global_load_lds((const unsigned*)((const char*)(gbase) + (voff)[_i]), (PG8_LAS unsigned*)(lds + (bufoff) + ldsw + _i * 8192), 16, 0, 0); } while (0)
#define PG8_LDA(dst, b, h) do { _Pragma("unroll") for (int m = 0; m < 4; ++m) _Pragma("unroll") for (int k = 0; k < 2; ++k) dst[m][k] = *(const PG8_LAS bf16x8*)(lds + PG8_SA(b, h) + aoff + m * 2048 + k * 1024); } while (0)
#define PG8_LDB(dst, b, h) do { _Pragma("unroll") for (int n = 0; n < 2; ++n) _Pragma("unroll") for (int k = 0; k < 2; ++k) dst[n][k] = *(const PG8_LAS bf16x8*)(lds + PG8_SB(b, h) + boff + n * 2048 + k * 1024); } while (0)
#define PG8_MMA(ai, bj, At, Bt) do { __builtin_amdgcn_s_setprio(1); _Pragma("unroll") for (int m = 0; m < 4; ++m) _Pragma("unroll") for (int n = 0; n < 2; ++n) _Pragma("unroll") for (int k = 0; k < 2; ++k) \
        acc[ai][bj][m][n] = __builtin_amdgcn_mfma_f32_16x16x32_bf16(Bt[n][k], At[m][k], acc[ai][bj][m][n], 0, 0, 0); __builtin_amdgcn_s_setprio(0); } while (0)
#define PG8_WAIT_V(n) asm volatile("s_waitcnt vmcnt(" #n ")" ::: "memory")
#define PG8_WAIT_L(n) asm volatile("s_waitcnt lgkmcnt(" #n ")" ::: "memory")
#define PG8_BAR __builtin_amdgcn_s_barrier()
#define PG8_SCHED __builtin_amdgcn_sched_barrier(0)
    Unit cur, nxt; int ui = 0;
    if (!S.next(0, cur)) return;
    f32x4 acc[2][2][4][2];
#pragma unroll
    for (int a = 0; a < 2; ++a)
#pragma unroll
        for (int b = 0; b < 2; ++b)
#pragma unroll
            for (int m = 0; m < 4; ++m)
#pragma unroll
                for (int n = 0; n < 2; ++n) acc[a][b][m][n] = (f32x4){0.f, 0.f, 0.f, 0.f};
    bf16x8 At[4][2], B0[2][2], B1[2][2];
    const char* cA = (const char*)g.A + (size_t)cur.pm * tstep; const char* cB = (const char*)g.Bt + (size_t)cur.pn * tstep;
    S.a_ready(cur);
    if constexpr (SP2) {
        PG8_STAGE(PG8_SB(0, 0), cB, voffB); PG8_STAGE(PG8_SB(0, 1), cB + hstep, voffB); PG8_STAGE(PG8_SA(0, 0), cA, voffA); PG8_STAGE(PG8_SA(0, 1), cA + hstep, voffA);
        if (wr == 1) PG8_BAR;
        PG8_WAIT_V(2); PG8_BAR;
        PG8_STAGE(PG8_SB(1, 0), cB + kstep, voffB); PG8_STAGE(PG8_SA(1, 0), cA + kstep, voffA); PG8_STAGE(PG8_SB(1, 1), cB + hstep + kstep, voffB);
        PG8_WAIT_V(6); PG8_BAR;
    } else {
        PG8_STAGE(PG8_SB(0, 0), cB, voffB); PG8_STAGE(PG8_SA(0, 0), cA, voffA); PG8_STAGE(PG8_SB(0, 1), cB + hstep, voffB); PG8_STAGE(PG8_SA(0, 1), cA + hstep, voffA);
        if (wr == 1) PG8_BAR;
        PG8_WAIT_V(4); PG8_BAR;
        PG8_STAGE(PG8_SB(1, 0), cB + kstep, voffB); PG8_STAGE(PG8_SA(1, 0), cA + kstep, voffA); PG8_STAGE(PG8_SB(1, 1), cB + hstep + kstep, voffB);
        PG8_WAIT_V(6); PG8_BAR;
    }
    for (;;) {
        const bool has_next = S.next(ui + 1, nxt);
        const char* nA = has_next ? (const char*)g.A + (size_t)nxt.pm * tstep : cA; const char* nB = has_next ? (const char*)g.Bt + (size_t)nxt.pn * tstep : cB;
        for (int t = 0; t < nt; t += 2) {
            const bool last = (t == nt - 2);
            const char* a1 = cA + (size_t)(t + 1) * kstep;
            const char* a2 = last ? nA : cA + (size_t)(t + 2) * kstep; const char* b2 = last ? nB : cB + (size_t)(t + 2) * kstep;
            const char* a3 = a2 + kstep; const char* b3 = b2 + kstep;
            if (last && has_next) S.a_ready(nxt);
            if constexpr (SP2) {
            PG8_LDB(B0, 0, 0); PG8_LDB(B1, 0, 1); PG8_SCHED; PG8_LDA(At, 0, 0); PG8_STAGE(PG8_SA(1, 1), a1 + hstep, voffA);
            PG8_WAIT_V(8); PG8_WAIT_L(0); PG8_BAR; PG8_MMA(0, 0, At, B0); PG8_MMA(0, 1, At, B1); PG8_BAR; PG8_SCHED;
            PG8_LDA(At, 0, 1); PG8_STAGE(PG8_SB(0, 0), b2, voffB); PG8_STAGE(PG8_SB(0, 1), b2 + hstep, voffB); PG8_STAGE(PG8_SA(0, 0), a2, voffA);
            PG8_WAIT_V(8); PG8_WAIT_L(0); PG8_BAR; PG8_MMA(1, 0, At, B0); PG8_MMA(1, 1, At, B1); PG8_BAR; PG8_SCHED;
            PG8_LDB(B0, 1, 0); PG8_LDB(B1, 1, 1); PG8_SCHED; PG8_LDA(At, 1, 0); PG8_STAGE(PG8_SA(0, 1), a2 + hstep, voffA);
            PG8_WAIT_V(8); PG8_WAIT_L(0); PG8_BAR; PG8_MMA(0, 0, At, B0); PG8_MMA(0, 1, At, B1); PG8_BAR; PG8_SCHED;
            PG8_LDA(At, 1, 1); PG8_STAGE(PG8_SB(1, 0), b3, voffB); PG8_STAGE(PG8_SB(1, 1), b3 + hstep, voffB); PG8_STAGE(PG8_SA(1, 0), a3, voffA);
            PG8_WAIT_V(8); PG8_WAIT_L(0); PG8_BAR; PG8_MMA(1, 0, At, B0); PG8_MMA(1, 1, At, B1); PG8_BAR; PG8_SCHED;
            } else {
            PG8_LDB(B0, 0, 0); PG8_SCHED; PG8_LDA(At, 0, 0); PG8_STAGE(PG8_SA(1, 1), a1 + hstep, voffA);
            PG8_WAIT_L(8); PG8_BAR; PG8_WAIT_L(0); PG8_MMA(0, 0, At, B0); PG8_BAR; PG8_SCHED;
            PG8_LDB(B1, 0, 1); PG8_STAGE(PG8_SB(0, 0), b2, voffB);
            PG8_BAR; PG8_WAIT_L(0); PG8_MMA(0, 1, At, B1); PG8_BAR;
            PG8_LDA(At, 0, 1); PG8_STAGE(PG8_SA(0, 0), a2, voffA);
            PG8_BAR; PG8_WAIT_L(0); PG8_MMA(1, 0, At, B0); PG8_BAR; PG8_SCHED;
            PG8_STAGE(PG8_SB(0, 1), b2 + hstep, voffB);
            PG8_WAIT_V(6); PG8_BAR; PG8_MMA(1, 1, At, B1); PG8_BAR;
            PG8_LDB(B0, 1, 0); PG8_SCHED; PG8_LDA(At, 1, 0); PG8_STAGE(PG8_SA(0, 1), a2 + hstep, voffA);
            PG8_WAIT_L(8); PG8_BAR; PG8_WAIT_L(0); PG8_MMA(0, 0, At, B0); PG8_BAR; PG8_SCHED;
            PG8_LDB(B1, 1, 1); PG8_STAGE(PG8_SB(1, 0), b3, voffB);
            PG8_BAR; PG8_WAIT_L(0); PG8_MMA(0, 1, At, B1); PG8_BAR;
            PG8_LDA(At, 1, 1); PG8_STAGE(PG8_SA(1, 0), a3, voffA);
            PG8_BAR; PG8_WAIT_L(0); PG8_MMA(1, 0, At, B0); PG8_BAR; PG8_SCHED;
            PG8_STAGE(PG8_SB(1, 1), b3 + hstep, voffB);
            PG8_WAIT_V(6); PG8_BAR; PG8_MMA(1, 1, At, B1); PG8_BAR;
            }
        }
        if constexpr (ALIGN_EPI) { if (wr == 0) PG8_BAR; }
        if constexpr (!Epi::AFTER_DRAIN) { E(acc, cur, wr, wc, fr, fq); S.done(cur); }
        if (!has_next) break;
#pragma unroll
        for (int a = 0; a < 2; ++a)
#pragma unroll
            for (int b = 0; b < 2; ++b)
#pragma unroll
                for (int m = 0; m < 4; ++m)
#pragma unroll
                    for (int n = 0; n < 2; ++n) acc[a][b][m][n] = (f32x4){0.f, 0.f, 0.f, 0.f};
        cur = nxt; cA = nA; cB = nB; ++ui;
        if constexpr (ALIGN_EPI) { if (wr == 1) PG8_BAR; }
    }
    PG8_WAIT_V(0);
    if constexpr (!ALIGN_EPI) { if (wr == 0) PG8_BAR; }
    PG8_BAR;
    if constexpr (Epi::AFTER_DRAIN) { E.fused(acc, cur, wr, wc, fr, fq, lds, wid, lane); S.done(cur); }
#undef PG8_SA
#undef PG8_SB
#undef PG8_STAGE
#undef PG8_LDA
#undef PG8_LDB
#undef PG8_MMA
#undef PG8_WAIT_V
#undef PG8_WAIT_L
#undef PG8_BAR
#undef PG8_SCHED
}
}
#define LAS __attribute__((address_space(3)))
#define XB_TMO      128
#define XB_XCNT(j)  (256  + 64 * (j))
#define XB_XSUB(j)  (1280 + 64 * (j))
#define XB_XGEN(j)  (2304 + 64 * (j))
#define XB_TOP      3328
#define XB_TOPGEN   3392
#define XCD_BAR_WORDS 3456
#define XB_SPIN_CAP (1u << 18)

__device__ __forceinline__ unsigned xb_ld(unsigned* p)              { return __hip_atomic_load(p, __ATOMIC_RELAXED, __HIP_MEMORY_SCOPE_AGENT); }
__device__ __forceinline__ unsigned xb_add(unsigned* p, unsigned v) { return __hip_atomic_fetch_add(p, v, __ATOMIC_RELAXED, __HIP_MEMORY_SCOPE_AGENT); }
__device__ __forceinline__ unsigned xb_xcc_id() { return (unsigned)__builtin_amdgcn_s_getreg((3 << 11) | 20) & 0xFu; }
#define XB_SPIN(cond, bar) do { unsigned _sp = 0; while (cond) { __builtin_amdgcn_s_sleep(1); \
    if ((++_sp & 255u) == 0u) { if (xb_ld(&(bar)[XB_TMO])) break; if (_sp > XB_SPIN_CAP) { atomicAdd(&(bar)[XB_TMO], 1u); break; } } } } while (0)

struct XcdBarrier {
    unsigned* bar; unsigned x;
    volatile LAS unsigned* st;
};

__device__ __forceinline__ XcdBarrier xcd_barrier_post(unsigned* bar, volatile LAS unsigned* st) {
    XcdBarrier b; b.bar = bar; b.x = xb_xcc_id(); b.st = st;
    if (threadIdx.x == 0) (void)xb_add(&bar[XB_XCNT(b.x)], 1u);
    return b;
}
__device__ __forceinline__ void xcd_barrier_complete(unsigned* bar, unsigned x, unsigned& nloc, unsigned& nx) {
    const unsigned G = gridDim.x * gridDim.y * gridDim.z;
    unsigned sum, cnt, mine, sp = 0u;
    for (;;) {
        sum = 0u; cnt = 0u; mine = 0u;
#pragma unroll
        for (unsigned j = 0; j < 16; ++j) { const unsigned c = xb_ld(&bar[XB_XCNT(j)]); sum += c; cnt += (c > 0u) ? 1u : 0u; mine = (j == x) ? c : mine; }
        if (sum == G) break;
        __builtin_amdgcn_s_sleep(1);
        if ((++sp & 255u) == 0u) { if (xb_ld(&bar[XB_TMO])) break; if (sp > XB_SPIN_CAP) { atomicAdd(&bar[XB_TMO], 1u); break; } }
    }
    nloc = mine > 0u ? mine : 1u; nx = cnt > 0u ? cnt : 1u;
}

__device__ __forceinline__ void xcd_barrier(const XcdBarrier& b) {
    asm volatile("s_waitcnt vmcnt(0)" ::: "memory");
    __syncthreads();
    if (threadIdx.x == 0) {
        unsigned* bar = b.bar;
        __builtin_amdgcn_s_waitcnt(0);
        unsigned nloc = b.st[0], nx = b.st[1];
        if (nloc == 0u) { xcd_barrier_complete(bar, b.x, nloc, nx); b.st[0] = nloc; b.st[1] = nx; }
        const unsigned old = xb_add(&bar[XB_XSUB(b.x)], 1u);
        const unsigned gen = old / nloc;
        if (old + 1u == (gen + 1u) * nloc) {
            __builtin_amdgcn_fence(__ATOMIC_RELEASE, "agent");
            asm volatile("s_waitcnt vmcnt(0)" ::: "memory");
            const unsigned og = xb_add(&bar[XB_TOP], 1u);
            const unsigned tg = og / nx;
            if (og + 1u == (tg + 1u) * nx) xb_add(&bar[XB_TOPGEN], 1u);
            else XB_SPIN(xb_ld(&bar[XB_TOPGEN]) == tg, bar);
            __builtin_amdgcn_fence(__ATOMIC_ACQUIRE, "agent");
            xb_add(&bar[XB_XGEN(b.x)], 1u);
            asm volatile("s_waitcnt vmcnt(0)" ::: "memory");
        } else {
            XB_SPIN(xb_ld(&bar[XB_XGEN(b.x)]) == gen, bar);
            __builtin_amdgcn_fence(__ATOMIC_ACQUIRE, "agent");
            asm volatile("s_waitcnt vmcnt(0)" ::: "memory");
        }
    }
    __syncthreads();
}
namespace moba {
constexpr int D = 128;
constexpr float THR = 8.f;
constexpr bool WSKIP = false;
constexpr int QP = MHD, KVP = MHD, OP = MW;
template <class A, class Bt> struct same_t { static constexpr bool v = false; };
template <class A> struct same_t<A, A> { static constexpr bool v = true; };
constexpr float SCALE = 0.08838834764831845f;
constexpr int NW = 8, QBLK = 32, KVBLK = 64, QB = NW * QBLK;
constexpr int SHM_V = KVBLK * D * 2, SHM_K = KVBLK * D * 2;
constexpr int LDS_BYTES = 2 * SHM_V + 2 * SHM_K + NW * 64 * 4;
using bf16 = unsigned short;
typedef short bf16x8 __attribute__((ext_vector_type(8)));
typedef short s16x4 __attribute__((ext_vector_type(4)));
typedef float f32x16 __attribute__((ext_vector_type(16)));
typedef float f32x4 __attribute__((ext_vector_type(4)));
typedef unsigned u32x4 __attribute__((ext_vector_type(4)));
#define KSWZ(row, colB) ((row) * 256 + ((colB) ^ (((row) & 7) << 4)))
#define SBAR() __builtin_amdgcn_sched_barrier(0)
__device__ __forceinline__ int v_st(int k, int c) { const int kk = (k & ~0xC) | ((k & 4) << 1) | ((k & 8) >> 1); return ((kk >> 3) * 4 + (c >> 5)) * 512 + ((kk & 7) * 32 + (c & 31)) * 2; }
__device__ __forceinline__ int v_rd_base(int lane) { return ((lane & 3) << 3) | (((lane >> 2) & 3) << 6) | (((lane >> 4) & 1) << 5) | (((lane >> 5) & 1) << 8); }
constexpr int v_rd_off(int d0, int ks, int half) { return d0 * 512 + ks * 4096 + half * 2048; }
__device__ __forceinline__ int crow(int r, int hi) { return (r & 3) + 8 * (r >> 2) + 4 * hi; }
__device__ __forceinline__ unsigned cvtpk(float lo, float hi) {
    unsigned r; asm volatile("v_cvt_pk_bf16_f32 %0, %1, %2" : "=v"(r) : "v"(lo), "v"(hi)); return r;
}
__device__ __forceinline__ bf16x8 pack8(f32x4 a, f32x4 b) {
    u32x4 w = {cvtpk(a[0], a[1]), cvtpk(a[2], a[3]), cvtpk(b[0], b[1]), cvtpk(b[2], b[3])};
    return *reinterpret_cast<bf16x8*>(&w);
}
template <class T> __device__ __forceinline__ bf16x8 load8(const T* p) {
    if constexpr (same_t<T, float>::v) { return pack8(*(const f32x4*)p, *(const f32x4*)(p + 4)); }
    else { return *reinterpret_cast<const bf16x8*>(p); }
}
__device__ __forceinline__ void mask_tile(f32x16& p0, f32x16& p1, int dq, unsigned W) {
    const float NEG = -__builtin_inff();
#pragma unroll
    for (int r = 0; r < 16; ++r) {
        const int c = (r & 3) + 8 * (r >> 2);
        if ((unsigned)(dq - c) >= W) p0[r] = NEG;
        if ((unsigned)(dq - c - 32) >= W) p1[r] = NEG;
    }
}
__device__ __forceinline__ void partialSM(f32x16& p0, f32x16& p1, float& m_reg, float& mn, float& alpha, float pen) {
    float pmax = p0[0]; for (int r = 1; r < 16; ++r) pmax = fmaxf(pmax, p0[r]); for (int r = 0; r < 16; ++r) pmax = fmaxf(pmax, p1[r]);
    { auto rr = __builtin_amdgcn_permlane32_swap(__float_as_uint(pmax), __float_as_uint(pmax), false, false);
      pmax = fmaxf(__uint_as_float(rr[0]), __uint_as_float(rr[1])) + pen; }
    constexpr float C2 = 1.4426950408889634f * SCALE;
    if (__builtin_expect(__all((pmax - m_reg) * SCALE <= THR), 1)) { mn = m_reg; alpha = 1.f; }
    else { mn = fmaxf(m_reg, pmax); alpha = __builtin_amdgcn_exp2f((m_reg - mn) * C2); m_reg = mn; }
    const float mnL = -mn * C2 + pen;
    for (int r = 0; r < 16; ++r) p0[r] = fmaf(p0[r], C2, mnL); for (int r = 0; r < 16; ++r) p1[r] = fmaf(p1[r], C2, mnL);
    for (int r = 0; r < 16; ++r) p0[r] = __builtin_amdgcn_exp2f(p0[r]);
}
__device__ __forceinline__ void finishSM(f32x16& p0, f32x16& p1, float alpha, float& l_reg, bf16x8& pa0, bf16x8& pa1, bf16x8& pa2, bf16x8& pa3) {
    for (int r = 0; r < 16; ++r) p1[r] = __builtin_amdgcn_exp2f(p1[r]);
    float ps = 0; for (int r = 0; r < 16; ++r) ps += p0[r]; for (int r = 0; r < 16; ++r) ps += p1[r];
    { auto rr = __builtin_amdgcn_permlane32_swap(__float_as_uint(ps), __float_as_uint(ps), false, false);
      ps = __uint_as_float(rr[0]) + __uint_as_float(rr[1]); }
    l_reg = l_reg * alpha + ps;
#define PK4(P, B_, OUT) do { unsigned a0 = cvtpk(P[B_+0], P[B_+1]), a1 = cvtpk(P[B_+2], P[B_+3]);                          \
        unsigned b0 = cvtpk(P[B_+4], P[B_+5]), b1 = cvtpk(P[B_+6], P[B_+7]);                                             \
        auto r0 = __builtin_amdgcn_permlane32_swap(a0, b0, false, false); auto r1 = __builtin_amdgcn_permlane32_swap(a1, b1, false, false); \
        u32x4 w = {r0[0], r1[0], r0[1], r1[1]}; OUT = *reinterpret_cast<bf16x8*>(&w); } while (0)
    PK4(p0, 0, pa0); PK4(p0, 8, pa1); PK4(p1, 0, pa2); PK4(p1, 8, pa3);
#undef PK4
}
template <int KB, bool SK>
__device__ __forceinline__ void qkt(f32x16& p0, f32x16& p1, const char* K_lds, int r32, int hi, const bf16x8* qr, bool act) {
    if (SK && !act) { const float NEG = -__builtin_inff();
#pragma unroll
        for (int r = 0; r < 16; ++r) { p0[r] = NEG; p1[r] = NEG; } return; }
    p0 = f32x16{}; p1 = f32x16{};
    const char* kb[4];
#pragma unroll
    for (int dd = 0; dd < 4; ++dd) kb[dd] = K_lds + KB * SHM_K + KSWZ(r32, (dd * 16 + hi * 8) * 2);
#pragma unroll
    for (int d0 = 0; d0 < 8; ++d0) { const char* a = kb[d0 & 3] + (d0 >> 2) * 128;
        bf16x8 b0 = *reinterpret_cast<const bf16x8*>(a);
        bf16x8 b1 = *reinterpret_cast<const bf16x8*>(a + 32 * 256);
        p0 = __builtin_amdgcn_mfma_f32_32x32x16_bf16(b0, qr[d0], p0, 0, 0, 0);
        p1 = __builtin_amdgcn_mfma_f32_32x32x16_bf16(b1, qr[d0], p1, 0, 0, 0); }
}
template <int VB, bool SK>
__device__ __forceinline__ void pv_tile(f32x16* o, int vb0, bf16x8 pa0, bf16x8 pa1, bf16x8 pa2, bf16x8 pa3, bool act) {
    if (SK && !act) return;
#define TRRD(dst, off) asm volatile("ds_read_b64_tr_b16 %0, %1 offset:%2" : "=&v"(dst) : "v"(vb0), "i"(off) : "memory")
#define PV_D0(d0) do { s16x4 l0, l1, l2, l3, h0, h1, h2, h3; constexpr int b_ = VB * SHM_V + v_rd_off(d0, 0, 0);     \
        TRRD(l0, b_); TRRD(h0, b_ + 2048); TRRD(l1, b_ + 4096); TRRD(h1, b_ + 6144); TRRD(l2, b_ + 8192); TRRD(h2, b_ + 10240); TRRD(l3, b_ + 12288); TRRD(h3, b_ + 14336); \
        asm volatile("s_waitcnt lgkmcnt(0)" ::: "memory"); SBAR();                 \
        o[d0] = __builtin_amdgcn_mfma_f32_32x32x16_bf16(pa0, (bf16x8){l0[0], l0[1], l0[2], l0[3], h0[0], h0[1], h0[2], h0[3]}, o[d0], 0, 0, 0);   \
        o[d0] = __builtin_amdgcn_mfma_f32_32x32x16_bf16(pa1, (bf16x8){l1[0], l1[1], l1[2], l1[3], h1[0], h1[1], h1[2], h1[3]}, o[d0], 0, 0, 0);   \
        o[d0] = __builtin_amdgcn_mfma_f32_32x32x16_bf16(pa2, (bf16x8){l2[0], l2[1], l2[2], l2[3], h2[0], h2[1], h2[2], h2[3]}, o[d0], 0, 0, 0);   \
        o[d0] = __builtin_amdgcn_mfma_f32_32x32x16_bf16(pa3, (bf16x8){l3[0], l3[1], l3[2], l3[3], h3[0], h3[1], h3[2], h3[3]}, o[d0], 0, 0, 0); } while (0)
    PV_D0(0); PV_D0(1); PV_D0(2); PV_D0(3);
#undef PV_D0
#undef TRRD
}
__device__ __forceinline__ float bfv(short s) { return __builtin_bit_cast(float, ((unsigned)(unsigned short)s) << 16); }
__device__ __forceinline__ void sel_fill(f32x16& p0, f32x16& p1, bool ok) { const float NEG = -__builtin_inff();
#pragma unroll
    for (int r = 0; r < 16; ++r) { p0[r] = ok ? p0[r] : NEG; p1[r] = ok ? p1[r] : NEG; } }
template <class TIn, class TOut> struct BlockRef { const TIn* Q; const TIn* K; const TIn* V; TOut* O; int P0; const float* km; int qb; };
template <class TIn> struct Seam {
    bf16x8 qr[8];
    bf16x8 st_v0, st_v1, st_k0, st_k1; f32x4 sf0, sf1, sf2, sf3;
    f32x4 tq[16];
};
__device__ __forceinline__ int swa_jlo(int P0, int W) { const int lowk = P0 - W + 1; return lowk > 0 ? lowk / KVBLK : 0; }
#define ROW(p, k0, rr) ((p) + (size_t)((k0) + (rr)) * KVP + sc)
#define VMW() asm volatile("s_waitcnt vmcnt(0)" ::: "memory")
#define VMWN(n) asm volatile("s_waitcnt vmcnt(%0)" :: "i"(n) : "memory")
#define SLOAD_H(Kp, Vp, k0) do { S.st_v0 = load8<TIn>(ROW(Vp, k0, sr)); S.st_v1 = load8<TIn>(ROW(Vp, k0, 32 + sr));              \
                         S.st_k0 = load8<TIn>(ROW(Kp, k0, sr)); S.st_k1 = load8<TIn>(ROW(Kp, k0, 32 + sr)); } while (0)
#define SWRITE_HK(bf) do { *(bf16x8*)(K_lds + (bf) * SHM_K + kws) = S.st_k0; *(bf16x8*)(K_lds + (bf) * SHM_K + kws + 32 * 256) = S.st_k1; } while (0)
#define SWRITE_HV(bf) do { *(bf16x8*)(V_lds + (bf) * SHM_V + vst0) = S.st_v0; *(bf16x8*)(V_lds + (bf) * SHM_V + vst1) = S.st_v1; } while (0)
#define SWRITE_H(bf) do { SWRITE_HV(bf); SWRITE_HK(bf); } while (0)
#define SLOAD_F(p, k0) do { S.sf0 = *(const f32x4*)ROW(p, k0, sr); S.sf1 = *(const f32x4*)(ROW(p, k0, sr) + 4);                \
                            S.sf2 = *(const f32x4*)ROW(p, k0, 32 + sr); S.sf3 = *(const f32x4*)(ROW(p, k0, 32 + sr) + 4); } while (0)
#define SWRITE_KF(bf) do { *(bf16x8*)(K_lds + (bf) * SHM_K + kws) = pack8(S.sf0, S.sf1); *(bf16x8*)(K_lds + (bf) * SHM_K + kws + 32 * 256) = pack8(S.sf2, S.sf3); } while (0)
#define SWRITE_VF(bf) do { *(bf16x8*)(V_lds + (bf) * SHM_V + vst0) = pack8(S.sf0, S.sf1); *(bf16x8*)(V_lds + (bf) * SHM_V + vst1) = pack8(S.sf2, S.sf3); } while (0)
template <class TIn, class TOut>
__device__ __forceinline__ void causal_swa_prime(const BlockRef<TIn, TOut>& cur, int W, char* lds, Seam<TIn>& S) {
    constexpr bool F32 = same_t<TIn, float>::v;
    int tid_o = threadIdx.x; asm volatile("" : "+v"(tid_o));
    const int tid = tid_o, wid = __builtin_amdgcn_readfirstlane(tid >> 6), lane = tid & 63, r32 = lane & 31, hi = lane >> 5;
    const int sr = tid >> 4, sc = (tid & 15) * 8, kws = KSWZ(sr, sc * 2); char* K_lds = lds + 2 * SHM_V;
    const int kb0 = cur.P0;
    for (int d0 = 0; d0 < 8; ++d0) S.qr[d0] = load8<TIn>(cur.Q + (size_t)(wid * QBLK + r32) * QP + d0 * 16 + hi * 8);
    if constexpr (F32) { SLOAD_F((const float*)cur.K, kb0); VMW(); SWRITE_KF(0); SBAR(); SLOAD_F((const float*)cur.V, kb0); }
    else { SLOAD_H(cur.K, cur.V, kb0); VMW(); SWRITE_HK(0); }
    __syncthreads();
}
template <class TIn, class TOut, int FK = 0>
__device__ __forceinline__ void causal_swa_block(const BlockRef<TIn, TOut>& cur, const BlockRef<TIn, TOut>& nxt, int skv, int W, char* lds, Seam<TIn>& S) {
    constexpr bool F32 = same_t<TIn, float>::v;
    int tid_o = threadIdx.x; asm volatile("" : "+v"(tid_o));
    const int tid = tid_o, wid = __builtin_amdgcn_readfirstlane(tid >> 6), lane = tid & 63, r32 = lane & 31, hi = lane >> 5;
    const int j_lo = swa_jlo(cur.P0, W);
    int j_hi = (cur.P0 + QB - 1) / KVBLK + 1; if (j_hi > skv / KVBLK) j_hi = skv / KVBLK;
    const int NT = j_hi - j_lo;
    const int kbn = nxt.P0;
    const int tsh = 4 * cur.qb;
    const int qlo = cur.P0 + wid * QBLK, qm = qlo + r32 - 4 * hi;
    char* V_lds = lds; char* K_lds = lds + 2 * SHM_V;
    float* ws = (float*)(lds + 2 * SHM_V + 2 * SHM_K) + wid * 64; float* li_l = ws, * al_l = ws + 32;
    float m_reg = -1e30f, l_reg = 0; f32x16 o[4] = {};
    unsigned selbits = 0u;
    if (cur.qb > 0) {
        float sc_[7];
#pragma unroll
        for (int j = 0; j < 7; ++j) { float a_ = 0.f;
            if (j < cur.qb) { const float* kmj = cur.km + j * 128 + hi * 8;
#pragma unroll
                for (int d0 = 0; d0 < 8; ++d0) { const f32x4 k0_ = *(const f32x4*)(kmj + d0 * 16), k1_ = *(const f32x4*)(kmj + d0 * 16 + 4); const bf16x8 q_ = S.qr[d0];
                    a_ += (bfv(q_[0]) * k0_[0] + bfv(q_[1]) * k0_[1]) + (bfv(q_[2]) * k0_[2] + bfv(q_[3]) * k0_[3]) + (bfv(q_[4]) * k1_[0] + bfv(q_[5]) * k1_[1]) + (bfv(q_[6]) * k1_[2] + bfv(q_[7]) * k1_[3]); }
                a_ += __shfl_xor(a_, 32); }
            sc_[j] = a_; }
#pragma unroll
        for (int j = 0; j < 7; ++j) { int rank_ = 0;
#pragma unroll
            for (int i = 0; i < 7; ++i) if (i != j) rank_ += (i < cur.qb && (sc_[i] > sc_[j] || (sc_[i] == sc_[j] && i < j))) ? 1 : 0;
            if (j < cur.qb && rank_ < 3) selbits |= 1u << j; }
    }
    if (FK == 3) selbits = 0xffu;
    const int sr = tid >> 4, sc = (tid & 15) * 8, vst0 = v_st(sr, sc), vst1 = v_st(32 + sr, sc), kws = KSWZ(sr, sc * 2);
    const int vb0 = (int)(uintptr_t)V_lds + v_rd_base(lane);
    const TIn* Kh = cur.K; const TIn* Vh = cur.V;
#define RESC(a) do { if (__any((a) < 1.f)) { if (hi == 0) al_l[r32] = (a); asm volatile("s_waitcnt lgkmcnt(0)" ::: "memory");              \
                     for (int d_ = 0; d_ < 4; ++d_) for (int r = 0; r < 16; ++r) o[d_][r] *= al_l[crow(r, hi)]; } } while (0)
#define KBASE(t) ((((t) + tsh) < NT ? (t) + tsh : (t) + tsh - NT) * KVBLK)
#define ACT(t) (KBASE(t) <= qlo + QBLK - 1 && KBASE(t) + KVBLK - 1 >= qlo - W + 1)
#define MASKT(P0_, P1_, t) do { const int kb_ = KBASE(t); pen_ = 0.f; if (kb_ + KVBLK - 1 > qlo) mask_tile(P0_, P1_, qm - kb_, (unsigned)W); \
        else if (kb_ < cur.P0) pen_ = ((selbits >> (kb_ >> 8)) & 1u) != 0u ? 0.f : -__builtin_inff(); } while (0)
    constexpr int NQL = F32 ? 16 : 8;
    constexpr bool SK = WSKIP && !F32;
#define SEAM_K0() do { VMWN(NQL); if constexpr (F32) { SWRITE_KF(0); SBAR(); SLOAD_F((const float*)nxt.V, kbn); } else { SWRITE_HK(0); } SBAR(); } while (0)
    f32x16 pA0, pA1, pB0, pB1; float mnA, mnB, alA, alB; bf16x8 pa0, pa1, pa2, pa3;
    if constexpr (F32) { VMW(); SWRITE_VF(0); SBAR(); } else { SWRITE_HV(0); SBAR(); }
    if (NT > 1) { if constexpr (F32) SLOAD_F((const float*)Kh, KBASE(1)); else SLOAD_H(Kh, Vh, (FK == 1) ? 0 : KBASE(1)); }
    SBAR(); qkt<0, SK>(pA0, pA1, K_lds, r32, hi, S.qr, ACT(0));
    if constexpr (F32) { if (NT > 1) { VMW(); SWRITE_KF(1); SBAR(); SLOAD_F((const float*)Vh, KBASE(1)); } }
    float pen_ = 0.f;
    MASKT(pA0, pA1, 0); partialSM(pA0, pA1, m_reg, mnA, alA, pen_);
    if (NT > 1) { VMW(); if constexpr (F32) { SWRITE_VF(1); SBAR(); if (NT > 2) SLOAD_F((const float*)Kh, KBASE(2)); } else SWRITE_H(1); }
    __syncthreads();
#define HALF_STEP(PX0, PX1, mnX, alX, PY0, PY1, alY, t, KB, VB, SB) do {                                                      \
        SBAR(); qkt<KB, SK>(PX0, PX1, K_lds, r32, hi, S.qr, ACT(t));                                             \
        finishSM(PY0, PY1, alY, l_reg, pa0, pa1, pa2, pa3); SBAR();                                                           \
        if ((t) + 1 < NT) { if constexpr (F32) { VMW(); SWRITE_KF(SB); SBAR(); SLOAD_F((const float*)Vh, KBASE((t) + 1)); }  \
                            else { SLOAD_H(Kh, Vh, (FK == 1) ? 0 : KBASE((t) + 1)); } SBAR(); }                                               \
        pv_tile<VB, SK>(o, vb0, pa0, pa1, pa2, pa3, ACT((t) - 1)); MASKT(PX0, PX1, (t)); partialSM(PX0, PX1, m_reg, mnX, alX, pen_);                                        \
        __syncthreads();                                                                                                      \
        if ((t) + 1 < NT) { VMW(); if constexpr (F32) { SWRITE_VF(SB); SBAR(); if ((t) + 2 < NT) SLOAD_F((const float*)Kh, KBASE((t) + 2)); } \
                            else { SWRITE_H(SB); } }                                                                          \
        RESC(alX); __syncthreads(); } while (0)
    for (int t = 1; t + 1 < NT; t += 2) {
        HALF_STEP(pB0, pB1, mnB, alB, pA0, pA1, alA, t, 1, 0, 0);
        HALF_STEP(pA0, pA1, mnA, alA, pB0, pB1, alB, t + 1, 0, 1, 1);
    }
    const bool even = (NT & 1) == 0;
    if (even) { SBAR(); qkt<1, SK>(pB0, pB1, K_lds, r32, hi, S.qr, ACT(NT - 1)); SBAR(); }
#define QROW(e) (nxt.Q + (size_t)(wid * QBLK + r32) * QP + ((e) >> 1) * 16 + hi * 8 + ((e) & 1) * 4)
    if constexpr (F32) { SLOAD_F((const float*)nxt.K, kbn); SBAR();
#pragma unroll
        for (int e = 0; e < 8; ++e) S.tq[e] = *(const f32x4*)QROW(e); }
    else { SLOAD_H(nxt.K, nxt.V, kbn); SBAR();
#pragma unroll
        for (int d0 = 0; d0 < 8; ++d0) S.qr[d0] = load8<TIn>(nxt.Q + (size_t)(wid * QBLK + r32) * QP + d0 * 16 + hi * 8); }
    SBAR();
    finishSM(pA0, pA1, alA, l_reg, pa0, pa1, pa2, pa3); SBAR();
    if constexpr (F32) {
#pragma unroll
        for (int e = 8; e < 16; ++e) S.tq[e] = *(const f32x4*)QROW(e); SBAR(); }
#undef QROW
    pv_tile<0, SK>(o, vb0, pa0, pa1, pa2, pa3, ACT(even ? NT - 2 : NT - 1));
    if (even) { MASKT(pB0, pB1, NT - 1); partialSM(pB0, pB1, m_reg, mnB, alB, pen_); __syncthreads(); RESC(alB);
        finishSM(pB0, pB1, alB, l_reg, pa0, pa1, pa2, pa3); SBAR(); pv_tile<1, SK>(o, vb0, pa0, pa1, pa2, pa3, ACT(NT - 1)); }
    SBAR(); SEAM_K0();
    if (hi == 0) li_l[r32] = l_reg; asm volatile("s_waitcnt lgkmcnt(0)" ::: "memory");
    float rli[16];
#pragma unroll
    for (int r = 0; r < 16; ++r) rli[r] = __builtin_amdgcn_rcpf(li_l[crow(r, hi)]);
    TOut* Ow = cur.O + (size_t)(wid * QBLK) * OP;
#pragma unroll
    for (int r = 0; r < 16; ++r) { const int orow = crow(r, hi);
#pragma unroll
        for (int d0 = 0; d0 < 4; ++d0) { const float v = o[d0][r] * rli[r];
            if constexpr (same_t<TOut, float>::v) { Ow[(size_t)orow * OP + d0 * 32 + r32] = v; }
            else { const float vn = __shfl_xor(v, 1);
                   if ((r32 & 1) == 0) *(unsigned*)(Ow + (size_t)orow * OP + d0 * 32 + r32) = cvtpk(v, vn); } } }
    if constexpr (F32) {
#pragma unroll
        for (int d0 = 0; d0 < 8; ++d0) S.qr[d0] = pack8(S.tq[2 * d0], S.tq[2 * d0 + 1]); }
    __syncthreads();
#undef RESC
#undef KBASE
#undef ACT
#undef MASKT
#undef SEAM_K0
#undef HALF_STEP
}
#undef ROW
#undef VMW
#undef VMWN
#undef SLOAD_H
#undef SWRITE_HK
#undef SWRITE_HV
#undef SWRITE_H
#undef SLOAD_F
#undef SWRITE_KF
#undef SWRITE_VF
}
namespace gla {
typedef float f32x16 __attribute__((ext_vector_type(16)));
typedef short s16x4 __attribute__((ext_vector_type(4)));
typedef float f32x2_t __attribute__((ext_vector_type(2)));
typedef __bf16 bf16x2_t __attribute__((ext_vector_type(2)));
__device__ __forceinline__ unsigned cvt2(float lo, float hi) { f32x2_t v = {lo, hi}; bf16x2_t b = __builtin_convertvector(v, bf16x2_t); return __builtin_bit_cast(unsigned, b); }
__device__ __forceinline__ float bfu(unsigned short s) { return __builtin_bit_cast(float, ((unsigned)s) << 16); }
constexpr int RS = 272, VS = 528, AS = 144;
constexpr int L_QT = 0, L_KT = 17408, L_KH = 34816, L_V = 52224, L_AT = 86016, L_GLR = 95232, L_DEC = 99328, L_SEG = 99840, L_RED = 101888, L_GN = 103936, L_END = 104960;
#define GLA_MFMA(a, b, c) __builtin_amdgcn_mfma_f32_32x32x16_bf16((a), (b), (c), 0, 0, 0)
#define GLA_LBAR() do { asm volatile("s_waitcnt lgkmcnt(0)" ::: "memory"); __builtin_amdgcn_s_barrier(); asm volatile("" ::: "memory"); } while (0)
#define GLA_TR(off) __builtin_amdgcn_ds_read_tr16_b64_v4i16((LAS s16x4*)(lds + (off)))

constexpr size_t WS_GQT = 710 * MiB, WS_GKH = 726 * MiB, WS_GA = 742 * MiB, WS_GDEC = 750 * MiB;

__device__ __forceinline__ void gla_pre_load(const Params& P, int b, int c, int h, int tid, u32x4 (&rq)[2], u32x4 (&rk)[2]) {
    const bf16* gq = (const bf16*)(P.ws + WS_PROJ) + PJ_GQ + ((size_t)(b * GH + h) * SEQ + c * GCH) * GDK; const bf16* gk = (const bf16*)(P.ws + WS_PROJ) + PJ_GK + ((size_t)(b * GH + h) * SEQ + c * GCH) * GDK;
#pragma unroll
    for (int i = 0; i < 2; ++i) { const int idx = tid + 512 * i, row = idx >> 4, ch = idx & 15; rq[i] = *(const u32x4*)(gq + (size_t)row * GDK + ch * 8); rk[i] = *(const u32x4*)(gk + (size_t)row * GDK + ch * 8); }
}
__device__ __forceinline__ void gla_pre_head(const Params& P, int l, int b, int c, int h, LAS unsigned char* lds, int tid, const u32x4 (&rq)[2], const u32x4 (&rk)[2]) {
    const int lane = tid & 63, w = __builtin_amdgcn_readfirstlane(tid >> 6), r = lane & 31, hh = lane >> 5;
    const int sd = tid & 127, stq = tid >> 7, t0 = c * GCH, item = (b * GH + h) * (SEQ / GCH) + c;
    float w2r[16];
#pragma unroll
    for (int j = 0; j < 16; ++j) w2r[j] = P.gate_w2[((size_t)l * GRANK + j) * GKW + h * GDK + sd];
    const float gbias = P.gate_b[(size_t)l * GKW + h * GDK + sd];
#pragma unroll
    for (int i = 0; i < 2; ++i) { const int idx = tid + 512 * i, row = idx >> 4, ch = idx & 15;
        *(LAS u32x4*)(lds + L_QT + row * RS + ch * 16) = rq[i]; *(LAS u32x4*)(lds + L_KT + row * RS + ch * 16) = rk[i]; }
    float bl[16]; float run = 0.f;
#pragma unroll
    for (int i = 0; i < 16; ++i) { const LAS f32x4* gr4 = (const LAS f32x4*)(lds + L_GLR + (16 * stq + i) * 64); float x = gbias;
#pragma unroll
        for (int j = 0; j < 4; ++j) { const f32x4 gv = gr4[j]; x += (gv[0] * w2r[4 * j] + gv[1] * w2r[4 * j + 1]) + (gv[2] * w2r[4 * j + 2] + gv[3] * w2r[4 * j + 3]); }
        run -= __logf(1.0f + __expf(-x)) * (1.0f / 16.0f); bl[i] = run; }
    *(LAS float*)(lds + L_SEG + (stq * 128 + sd) * 4) = run;
    GLA_LBAR();
    float prefix = 0.f, total = 0.f;
#pragma unroll
    for (int j = 0; j < 4; ++j) { const float sv = *(const LAS float*)(lds + L_SEG + (j * 128 + sd) * 4); total += sv; prefix += (j < stq) ? sv : 0.f; }
    const float etot = __expf(total);
#pragma unroll
    for (int i = 0; i < 16; ++i) { const int row = 16 * stq + i; const float bb = bl[i] + prefix; const float eb = __expf(bb), enb = __builtin_amdgcn_rcpf(eb), ekl = etot * enb;
        LAS unsigned short* qp = (LAS unsigned short*)(lds + L_QT + row * RS + sd * 2); LAS unsigned short* kp = (LAS unsigned short*)(lds + L_KT + row * RS + sd * 2);
        const float qv = bfu(*qp), kv = bfu(*kp);
        *qp = (unsigned short)cvt2(qv * eb, 0.f); *kp = (unsigned short)cvt2(kv * enb, 0.f); *(LAS unsigned short*)(lds + L_KH + row * RS + sd * 2) = (unsigned short)cvt2(kv * ekl, 0.f); }
    if (stq == 0) ((float*)(P.ws + WS_GDEC))[(size_t)item * GDK + sd] = etot;
    GLA_LBAR();
#pragma unroll
    for (int i = 0; i < 2; ++i) { const int idx = tid + 512 * i, row = idx >> 4, ch = idx & 15; const size_t go = (size_t)(b * SEQ + t0 + row) * GKW + h * GDK + ch * 8;
        *(u32x4*)((bf16*)(P.ws + WS_GQT) + go) = *(const LAS u32x4*)(lds + L_QT + row * RS + ch * 16);
        *(u32x4*)((bf16*)(P.ws + WS_GKH) + go) = *(const LAS u32x4*)(lds + L_KH + row * RS + ch * 16); }
    if (w < 4) { const int ti = w >> 1, si = w & 1; f32x16 at;
#pragma unroll
        for (int i = 0; i < 16; ++i) at[i] = 0.f;
        if (si <= ti) {
#pragma unroll
            for (int kk = 0; kk < 8; ++kk) { const bf16x8 a = *(const LAS bf16x8*)(lds + L_KT + (32 * si + r) * RS + (16 * kk + 8 * hh) * 2); const bf16x8 bq = *(const LAS bf16x8*)(lds + L_QT + (32 * ti + r) * RS + (16 * kk + 8 * hh) * 2);
                at = GLA_MFMA(a, bq, at); } }
        const int t = 32 * ti + r; bf16* ag = (bf16*)(P.ws + WS_GA) + ((size_t)item * GCH + t) * GCH;
#pragma unroll
        for (int g = 0; g < 4; ++g) { const int s0 = 32 * si + 8 * g + 4 * hh; float v[4];
#pragma unroll
            for (int e = 0; e < 4; ++e) v[e] = (s0 + e <= t) ? at[4 * g + e] : 0.f;
            u32x2 pkd; pkd.x = cvt2(v[0], v[1]); pkd.y = cvt2(v[2], v[3]); *(u32x2*)(ag + s0) = pkd; } }
    GLA_LBAR();
}

__device__ __forceinline__ void gla_seq_unit(const Params& P, int l, int bh, LAS unsigned char* lds, int tid) {
    const int lane = tid & 63, w = __builtin_amdgcn_readfirstlane(tid >> 6), r = lane & 31, hh = lane >> 5;
    const int b = bh >> 2, h = bh & 3;
    const int blk = (lane >> 4) & 1, q4 = (lane & 15) >> 2, p4 = lane & 3;
    const char* ub_v = (const char*)((const bf16*)(P.ws + WS_PROJ) + PJ_GV + (size_t)bh * SEQ * GDV); const char* ub_gr = (const char*)((const bf16*)(P.ws + WS_PROJ) + PJ_GR + (size_t)bh * SEQ * GDV);
    const char* ub_qt = (const char*)((const bf16*)(P.ws + WS_GQT) + (size_t)(b * SEQ) * GKW + h * GDK); const char* ub_kh = (const char*)((const bf16*)(P.ws + WS_GKH) + (size_t)(b * SEQ) * GKW + h * GDK);
    const char* ub_a = (const char*)((const bf16*)(P.ws + WS_GA) + (size_t)bh * (SEQ / GCH) * GCH * GCH); const char* ub_dec = (const char*)((const float*)(P.ws + WS_GDEC) + (size_t)bh * (SEQ / GCH) * GDK);
    char* ub_raw = (char*)(P.ws + WS_ABUF) + (size_t)bh * (SEQ / GCH) * (GCH * GDV * 4);
    const unsigned vo_qk = (unsigned)((tid >> 4) * GKW * 2 + (tid & 15) * 16), vo_v = (unsigned)((tid >> 5) * GDV * 2 + (tid & 31) * 16), vo_16 = (unsigned)(tid * 16);
    constexpr int SRS = 272, SKS = 320, SVS = 576, SAS = 144;
    constexpr int S_QT = 0, S_KH = S_QT + 64 * SRS, S_V = S_KH + 64 * SKS, S_AT = S_V + 64 * SVS, S_DEC = S_AT + 64 * SAS, S_END = S_DEC + 512;
    static_assert(S_END <= 131072, "GLA scan LDS map");
    const unsigned tr_v = S_V + (8 * hh + q4) * SVS + (32 * w + 16 * blk + 4 * p4) * 2;
    const unsigned tr_kh = S_KH + (8 * hh + q4) * SKS + (16 * blk + 4 * p4) * 2;
    f32x16 S[4];
#pragma unroll
    for (int d = 0; d < 4; ++d)
#pragma unroll
        for (int i = 0; i < 16; ++i) S[d][i] = 0.f;
    u32x4 pq[2], pk[2], pv[4], pa; f32x4 pd = {0.f, 0.f, 0.f, 0.f};
#define GLA_LOAD(c_) do { const size_t tb_ = (size_t)(c_) * GCH; \
        _Pragma("unroll") for (int i = 0; i < 2; ++i) { pq[i] = *(const u32x4*)(ub_qt + (tb_ + 32 * i) * (GKW * 2) + vo_qk); pk[i] = *(const u32x4*)(ub_kh + (tb_ + 32 * i) * (GKW * 2) + vo_qk); } \
        _Pragma("unroll") for (int i = 0; i < 4; ++i) pv[i] = *(const u32x4*)(ub_v + (tb_ + 16 * i) * (GDV * 2) + vo_v); \
        pa = *(const u32x4*)(ub_a + (size_t)(c_) * (GCH * GCH * 2) + vo_16); \
        if (tid < 32) pd = *(const f32x4*)(ub_dec + (size_t)(c_) * (GDK * 4) + vo_16); } while (0)
    GLA_LOAD(0);
    for (int c = 0; c < SEQ / GCH; ++c) {
        const int t0 = c * GCH;
#pragma unroll
        for (int i = 0; i < 2; ++i) { const int idx = tid + 512 * i, row = idx >> 4, ch = idx & 15; *(LAS u32x4*)(lds + S_QT + row * SRS + ch * 16) = pq[i]; *(LAS u32x4*)(lds + S_KH + row * SKS + ch * 16) = pk[i]; }
#pragma unroll
        for (int i = 0; i < 4; ++i) { const int idx = tid + 512 * i, row = idx >> 5, ch = idx & 31; *(LAS u32x4*)(lds + S_V + row * SVS + ch * 16) = pv[i]; }
        *(LAS u32x4*)(lds + S_AT + (tid >> 3) * SAS + (tid & 7) * 16) = pa;
        if (tid < 32) *(LAS f32x4*)(lds + S_DEC + tid * 16) = pd;
        if (c + 1 < SEQ / GCH) GLA_LOAD(c + 1);
        GLA_LBAR();
        f32x16 ot[2];
#pragma unroll
        for (int ti = 0; ti < 2; ++ti)
#pragma unroll
            for (int i = 0; i < 16; ++i) ot[ti][i] = 0.f;
        {
        bf16x8 vf[4];
#pragma unroll
        for (int kk = 0; kk < 4; ++kk) { const s16x4 lo = GLA_TR(tr_v + kk * 16 * SVS), hi = GLA_TR(tr_v + kk * 16 * SVS + 4 * SVS); vf[kk] = __builtin_shufflevector(lo, hi, 0, 1, 2, 3, 4, 5, 6, 7); }
        s16x4 bq[2][8];
#define GLA_LDBQ(buf, dblk_) do { _Pragma("unroll") for (int s = 0; s < 2; ++s) _Pragma("unroll") for (int ti = 0; ti < 2; ++ti) { \
            const LAS unsigned char* qa = lds + S_QT + (32 * ti + r) * SRS + (32 * (dblk_) + 16 * s + 4 * hh) * 2; bq[buf][(s * 2 + ti) * 2] = *(const LAS s16x4*)qa; bq[buf][(s * 2 + ti) * 2 + 1] = *(const LAS s16x4*)(qa + 16); } } while (0)
        GLA_LDBQ(0, 0);
#pragma unroll
        for (int dblk = 0; dblk < 4; ++dblk) {
            if (dblk + 1 < 4) GLA_LDBQ((dblk + 1) & 1, dblk + 1);
#pragma unroll
            for (int s = 0; s < 2; ++s) { u32x4 pa_; pa_.x = cvt2(S[dblk][8 * s + 0], S[dblk][8 * s + 1]); pa_.y = cvt2(S[dblk][8 * s + 2], S[dblk][8 * s + 3]); pa_.z = cvt2(S[dblk][8 * s + 4], S[dblk][8 * s + 5]); pa_.w = cvt2(S[dblk][8 * s + 6], S[dblk][8 * s + 7]);
                const bf16x8 a = __builtin_bit_cast(bf16x8, pa_);
#pragma unroll
                for (int ti = 0; ti < 2; ++ti) { const bf16x8 bqv = __builtin_shufflevector(bq[dblk & 1][(s * 2 + ti) * 2], bq[dblk & 1][(s * 2 + ti) * 2 + 1], 0, 1, 2, 3, 4, 5, 6, 7); ot[ti] = GLA_MFMA(a, bqv, ot[ti]); } } }
#undef GLA_LDBQ
        s16x4 kf[2][8]; f32x4 dcv[2][4];
#define GLA_LDKF(buf, dblk_) do { _Pragma("unroll") for (int kk = 0; kk < 4; ++kk) { kf[buf][2 * kk] = GLA_TR(tr_kh + (dblk_) * 64 + kk * 16 * SKS); kf[buf][2 * kk + 1] = GLA_TR(tr_kh + (dblk_) * 64 + kk * 16 * SKS + 4 * SKS); } \
            _Pragma("unroll") for (int g = 0; g < 4; ++g) dcv[buf][g] = *(const LAS f32x4*)(lds + S_DEC + (32 * (dblk_) + 8 * g + 4 * hh) * 4); } while (0)
        GLA_LDKF(0, 0);
#pragma unroll
        for (int dblk = 0; dblk < 4; ++dblk) {
            if (dblk + 1 < 4) GLA_LDKF((dblk + 1) & 1, dblk + 1);
#pragma unroll
            for (int g = 0; g < 4; ++g)
#pragma unroll
                for (int e = 0; e < 4; ++e) S[dblk][4 * g + e] *= dcv[dblk & 1][g][e];
#pragma unroll
            for (int kk = 0; kk < 4; ++kk) { const bf16x8 a = __builtin_shufflevector(kf[dblk & 1][2 * kk], kf[dblk & 1][2 * kk + 1], 0, 1, 2, 3, 4, 5, 6, 7); S[dblk] = GLA_MFMA(a, vf[kk], S[dblk]); } }
#undef GLA_LDKF
        bf16x8 baf[6];
#pragma unroll
        for (int j = 0; j < 6; ++j) { const int ti = j < 2 ? 0 : 1, kk = j < 2 ? j : j - 2; baf[j] = *(const LAS bf16x8*)(lds + S_AT + (32 * ti + r) * SAS + (16 * kk + 8 * hh) * 2); }
#pragma unroll
        for (int j = 0; j < 6; ++j) { const int ti = j < 2 ? 0 : 1, kk = j < 2 ? j : j - 2; ot[ti] = GLA_MFMA(vf[kk], baf[j], ot[ti]); }
        }
#pragma unroll
        for (int ti = 0; ti < 2; ++ti)
#pragma unroll
            for (int g = 0; g < 4; ++g) { f32x4 o4 = {ot[ti][4 * g + 0], ot[ti][4 * g + 1], ot[ti][4 * g + 2], ot[ti][4 * g + 3]};
                *(f32x4*)(ub_raw + ((size_t)((c * 8 + w) * 2 + ti) * 4 + g) * 1024 + lane * 16) = o4; }
        GLA_LBAR();
    }
#undef GLA_LOAD
}

__device__ __forceinline__ void gla_post_item(const Params& P, int l, int item, LAS unsigned char* lds, int tid) {
    const int lane = tid & 63, w = __builtin_amdgcn_readfirstlane(tid >> 6), r = lane & 31, hh = lane >> 5;
    const int bh = item >> 5, c = item & 31, b = bh >> 2, h = bh & 3, t0 = c * GCH;
    constexpr int PVS = 528, P_RED = 0, P_GN = 2048, P_OT = 3072;
    const char* raw = (const char*)(P.ws + WS_ABUF) + ((size_t)bh * (SEQ / GCH) + c) * (GCH * GDV * 4);
    const char* grp = (const char*)((const bf16*)(P.ws + WS_PROJ) + PJ_GR + ((size_t)bh * SEQ + t0) * GDV);
    char* ogp = (char*)((bf16*)(P.ws + WS_OGOM) + (size_t)(b * SEQ + t0) * GVW + h * GDV);
    f32x4 ot[2][4]; u32x4 sg[4];
#pragma unroll
    for (int ti = 0; ti < 2; ++ti)
#pragma unroll
        for (int g = 0; g < 4; ++g) ot[ti][g] = *(const f32x4*)(raw + ((size_t)(w * 2 + ti) * 4 + g) * 1024 + lane * 16);
#pragma unroll
    for (int i = 0; i < 4; ++i) sg[i] = *(const u32x4*)(grp + (size_t)(16 * i + (tid >> 5)) * (GDV * 2) + (tid & 31) * 16);
    if (tid < GDV) *(LAS float*)(lds + P_GN + tid * 4) = P.gla_norm_g[(size_t)l * GDV + tid];
#pragma unroll
    for (int ti = 0; ti < 2; ++ti) { float ss = 0.f;
#pragma unroll
        for (int g = 0; g < 4; ++g) ss += (ot[ti][g][0] * ot[ti][g][0] + ot[ti][g][1] * ot[ti][g][1]) + (ot[ti][g][2] * ot[ti][g][2] + ot[ti][g][3] * ot[ti][g][3]);
        ss += __shfl_xor(ss, 32); if (hh == 0) *(LAS float*)(lds + P_RED + (w * 64 + 32 * ti + r) * 4) = ss; }
    __syncthreads();
#pragma unroll
    for (int ti = 0; ti < 2; ++ti) { float tot = 0.f;
#pragma unroll
        for (int ww = 0; ww < 8; ++ww) tot += *(const LAS float*)(lds + P_RED + (ww * 64 + 32 * ti + r) * 4);
        const float rstd = rsqrtf(tot * (1.0f / GDV) + EPS);
#pragma unroll
        for (int g = 0; g < 4; ++g) { const f32x4 gg = *(const LAS f32x4*)(lds + P_GN + (32 * w + 4 * hh + 8 * g) * 4);
            u32x2 pkd; pkd.x = cvt2(ot[ti][g][0] * rstd * gg[0], ot[ti][g][1] * rstd * gg[1]); pkd.y = cvt2(ot[ti][g][2] * rstd * gg[2], ot[ti][g][3] * rstd * gg[3]);
            *(LAS u32x2*)(lds + P_OT + (32 * ti + r) * PVS + (32 * w + 8 * g + 4 * hh) * 2) = pkd; } }
    __syncthreads();
#pragma unroll
    for (int i = 0; i < 4; ++i) { const int idx = tid + 512 * i, row = idx >> 5, ch = idx & 31; const u32x4 ov = *(const LAS u32x4*)(lds + P_OT + row * PVS + ch * 16), sv = sg[i];
        u32x4 res; res.x = cvt2(pg8::bflo(ov.x) * pg8::bflo(sv.x), pg8::bfhi(ov.x) * pg8::bfhi(sv.x)); res.y = cvt2(pg8::bflo(ov.y) * pg8::bflo(sv.y), pg8::bfhi(ov.y) * pg8::bfhi(sv.y));
        res.z = cvt2(pg8::bflo(ov.z) * pg8::bflo(sv.z), pg8::bfhi(ov.z) * pg8::bfhi(sv.z)); res.w = cvt2(pg8::bflo(ov.w) * pg8::bflo(sv.w), pg8::bfhi(ov.w) * pg8::bfhi(sv.w));
        *(u32x4*)(ogp + (size_t)row * (GVW * 2) + ch * 16) = res; }
    __syncthreads();
}
#undef GLA_MFMA
#undef GLA_TR
#undef GLA_LBAR
}
constexpr int NWAVES = 8;
constexpr int RING_BYTES = 131072;
constexpr int LDSCTL_OFF = RING_BYTES, MISC_OFF = LDSCTL_OFF + 320;
constexpr int LDS_BYTES = 147456;
constexpr int CW_TMO = 0, CW_QUEUE = 64, CW_BAR = 4096;
constexpr int PH_P0A = 0, PH_P0B = 1, PH_P0C = 2, PH_L0 = 3, PH_PER_LAYER = 7, PH_FINAL = PH_L0 + DEPTH * PH_PER_LAYER, PH_COUNT = PH_FINAL + 1;
constexpr int PL_IN = 0, PL_PRE = 1, PL_MIX = 2, PL_UP = 3, PL_OUT = 4, PL_FFI = 5, PL_FFO = 6;

#ifndef EN_P0
#define EN_P0 1
#endif
#ifndef EN_IN
#define EN_IN 1
#endif
#ifndef EN_PRE
#define EN_PRE 1
#endif
#ifndef EN_MOBA
#define EN_MOBA 1
#endif
#ifndef EN_GLA
#define EN_GLA 1
#endif
#ifndef EN_UP
#define EN_UP 1
#endif
#ifndef EN_OUT
#define EN_OUT 1
#endif
#ifndef EN_FFI
#define EN_FFI 1
#endif
#ifndef EN_FFO
#define EN_FFO 1
#endif
struct Args { Params P; int ph_lo, ph_hi, li, pad; };

__device__ __forceinline__ void glr_unit(const Params& P, int l, const float* ssq, int rg64, int wave, int lane, LAS unsigned char* lds) {
    const bf16* A = (const bf16*)(P.ws + WS_ABUF); const bf16* W = wt_ptr(P, l, WT_GLR);
    const int rg = wave & 3, kh = wave >> 2, r16 = lane & 15, q = lane >> 4, row0 = rg64 * 64 + rg * 16;
    const bf16* ap = A + (size_t)(row0 + r16) * DM + kh * 1024 + 8 * q; const bf16* bp = W + (size_t)r16 * DM + kh * 1024 + 8 * q;
    f32x4 acc = {0.f, 0.f, 0.f, 0.f};
#pragma unroll 8
    for (int k0 = 0; k0 < 1024; k0 += 32) acc = __builtin_amdgcn_mfma_f32_16x16x32_bf16(*(const bf16x8*)(ap + k0), *(const bf16x8*)(bp + k0), acc, 0, 0, 0);
    LAS f32x4* part = (LAS f32x4*)lds;
    if (kh == 1) part[rg * 64 + lane] = acc;
    __syncthreads();
    if (kh == 0) { const f32x4 o = part[rg * 64 + lane];
        const float* shw = (const float*)(P.ws + WS_SHWGLR) + (size_t)l * 8 * GRANK;
#pragma unroll
        for (int j = 0; j < 4; ++j) { const int row = row0 + 4 * q + j, b = row / SEQ; *(LAS float*)(lds + gla::L_GLR + ((rg * 16 + 4 * q + j) * GRANK + r16) * 4) = rsqrtf(ssq[row] * (1.f / DM) + EPS) * (acc[j] + o[j]) + shw[b * GRANK + r16]; } }
    __syncthreads();
}
__device__ __forceinline__ void kmean_unit(const Params& P, int item, int tid, LAS unsigned char* lds) {
    const int blk = item % MNB, bh = item / MNB, b = bh / MH, h = bh % MH, c8 = tid & 15, rgp = tid >> 4;
    const bf16* p = (const bf16*)(P.ws + WS_PROJ) + PJ_MK + ((size_t)bh * SEQ + blk * MBLK + rgp) * MHD + 8 * c8;
    float s[8];
#pragma unroll
    for (int j = 0; j < 8; ++j) s[j] = 0.f;
#pragma unroll
    for (int i = 0; i < 8; ++i) { const u32x4 w = *(const u32x4*)(p + (size_t)(32 * i) * MHD);
        s[0] += pg8::bflo(w.x); s[1] += pg8::bfhi(w.x); s[2] += pg8::bflo(w.y); s[3] += pg8::bfhi(w.y); s[4] += pg8::bflo(w.z); s[5] += pg8::bfhi(w.z); s[6] += pg8::bflo(w.w); s[7] += pg8::bfhi(w.w); }
    LAS float* red = (LAS float*)lds;
#pragma unroll
    for (int j = 0; j < 8; ++j) red[rgp * 128 + 8 * c8 + j] = s[j];
    __syncthreads();
    if (tid < 128) { float a = 0.f;
#pragma unroll
        for (int r = 0; r < 32; ++r) a += red[r * 128 + tid];
        ((float*)(P.ws + WS_KMEAN))[((size_t)bh * MNB + blk) * MHD + tid] = a * (1.f / MBLK); }
    __syncthreads();
}
__device__ __forceinline__ void final_row(float* x, const float* g, int m, int lane) {
    f32x4* xr = (f32x4*)(x + (size_t)m * DM); float s = 0.f; f32x4 v[8];
#pragma unroll
    for (int j = 0; j < 8; ++j) { v[j] = xr[lane + 64 * j]; s += (v[j].x * v[j].x + v[j].y * v[j].y) + (v[j].z * v[j].z + v[j].w * v[j].w); }
    const float rstd = rsqrtf(wave_sum(s) * (1.f / DM) + EPS);
#pragma unroll
    for (int j = 0; j < 8; ++j) { const f32x4 gg = *(const f32x4*)(g + 4 * (lane + 64 * j)); xr[lane + 64 * j] = v[j] * rstd * gg; }
}

template <int FK>
__device__ __forceinline__ void moba_phase(const Params& P, unsigned* queues  , char* ldsg, volatile LAS unsigned* qslot  , int tid) {
    const bf16* PROJ = (const bf16*)(P.ws + WS_PROJ); bf16* OM = FK ? (bf16*)(P.ws + (size_t)768 * MiB) : (bf16*)(P.ws + WS_OGOM) + (size_t)MT * GVW; const float* KM = (const float*)(P.ws + WS_KMEAN);
    constexpr int W = 1 << 20; constexpr unsigned NONE = 0xffffffffu;
    const unsigned x0 = xb_xcc_id() & 7u; unsigned xo = 0u;
#define MOBA_POP(dst) do { unsigned u_ = NONE; while (xo < 8u) { const unsigned x_ = (x0 + xo) & 7u; const unsigned i_ = __hip_atomic_fetch_add(queues + 64 * x_, 1u, __ATOMIC_RELAXED, __HIP_MEMORY_SCOPE_AGENT); \
        if (i_ < 64u) { u_ = (x_ << 8) | i_; break; } ++xo; } (dst) = u_; } while (0)
#define MOBA_REF(ref, u_) do { const int i_ = (int)((u_) & 63u), x_ = (int)((u_) >> 8), qb_ = MNB - 1 - (i_ >> 3), bh_ = 8 * x_ + (i_ & 7);   \
        (ref).Q = PROJ + PJ_MQ + ((size_t)bh_ * SEQ + qb_ * MBLK) * MHD; (ref).K = PROJ + PJ_MK + (size_t)bh_ * SEQ * MHD; (ref).V = PROJ + PJ_MV + (size_t)bh_ * SEQ * MHD; \
        (ref).O = OM + (size_t)((bh_ >> 3) * SEQ + qb_ * MBLK) * MW + (bh_ & 7) * MHD; (ref).P0 = qb_ * MBLK; (ref).km = KM + (size_t)bh_ * MNB * MHD; (ref).qb = qb_; } while (0)
    if (tid == 0) { unsigned a_, b_; MOBA_POP(a_); MOBA_POP(b_); qslot[0] = a_; qslot[1] = b_; }
    __syncthreads();
    unsigned u = __builtin_amdgcn_readfirstlane(qslot[0]);
    if (u == NONE) return;
    moba::Seam<bf16> S; moba::BlockRef<bf16, bf16> cur, nxt;
    MOBA_REF(cur, u);
    moba::causal_swa_prime<bf16, bf16>(cur, W, ldsg, S);
    for (int it = 0;; ++it) {
        const unsigned un = __builtin_amdgcn_readfirstlane(qslot[(it + 1) % 3]);
        if (tid == 0) { unsigned c_; MOBA_POP(c_); qslot[(it + 2) % 3] = c_; }
        const bool last = un == NONE;
        if (last) nxt = cur; else MOBA_REF(nxt, un);
        moba::causal_swa_block<bf16, bf16, FK>(cur, nxt, SEQ, W, ldsg, S);
        if (last) break;
        cur = nxt;
    }
#undef MOBA_POP
#undef MOBA_REF
}

__global__ void __launch_bounds__(NWAVES * 64, 2) mega(Args args) {
    extern __shared__ __attribute__((aligned(16))) unsigned char lds_raw[];
    LAS unsigned char* lds = (LAS unsigned char*)lds_raw;
    volatile LAS unsigned* MISC = (volatile LAS unsigned*)(lds + MISC_OFF);
    const Params& P = args.P;
    const int wave = __builtin_amdgcn_readfirstlane(threadIdx.x >> 6);
#define OTID(name) int name = threadIdx.x; asm volatile("" : "+v"(name))
    const int G = gridDim.x, bx = blockIdx.x, vcu = (G % 8 == 0) ? (bx % 8) * (G / 8) + bx / 8 : bx;
    const int gw = vcu * NWAVES + wave, ngw = G * NWAVES;
    unsigned* ctl = (unsigned*)(P.ws + WS_CTL);
    { OTID(t0); for (int u = t0; u < (LDS_BYTES - LDSCTL_OFF) / 4; u += NWAVES * 64) ((LAS unsigned*)(lds + LDSCTL_OFF))[u] = 0u; }
    __syncthreads();
    const int lo = args.ph_lo, hi = args.ph_hi;
    XcdBarrier bar; bar.bar = ctl + CW_BAR + args.li * XCD_BAR_WORDS; bar.x = 0; bar.st = nullptr;
    if (hi - lo > 1) bar = xcd_barrier_post(ctl + CW_BAR + args.li * XCD_BAR_WORDS, MISC + 8);
#define IN(k) (lo <= (k) && (k) < hi)
#if defined(PROBE_MASK)
#define PROBE_AT(k) PROBE_TY((k) < PH_L0 ? (k) : ((k) >= PH_FINAL ? 10 : PH_L0 + ((k) - PH_L0) % PH_PER_LAYER))
#define PROBE_TY(ty) do { if (blockIdx.x == 0 && threadIdx.x == 0) { const unsigned long long now_ = __builtin_amdgcn_s_memrealtime(); const int ty_ = (ty); \
        unsigned long long last_ = ((unsigned long long)MISC[21] << 32) | MISC[20], acc_ = ((unsigned long long)MISC[23] << 32) | MISC[22]; if ((PROBE_MASK >> ty_) & 1) acc_ += now_ - last_; \
        MISC[20] = (unsigned)now_; MISC[21] = (unsigned)(now_ >> 32); MISC[22] = (unsigned)acc_; MISC[23] = (unsigned)(acc_ >> 32); } } while (0)
#else
#define PROBE_AT(k) do { } while (0)
#endif
#define SEAM(k) do { if (IN(k) && IN((k) + 1)) xcd_barrier(bar); PROBE_AT(k); } while (0)
#if defined(PROBE_MASK)
    if (blockIdx.x == 0 && threadIdx.x == 0) { const unsigned long long now_ = __builtin_amdgcn_s_memrealtime(); MISC[20] = (unsigned)now_; MISC[21] = (unsigned)(now_ >> 32); MISC[22] = 0u; MISC[23] = 0u; }
#endif

    if (EN_P0 && IN(PH_P0A)) { OTID(t1); phase_p0a(P, gw, ngw, t1 & 63, (float*)(lds_raw + wave * 16384)); __syncthreads(); SEAM(PH_P0A); }
    if (EN_P0 && IN(PH_P0B)) { OTID(t1); phase_p0b(P, vcu * NWAVES * 64 + t1, G * NWAVES * 64); SEAM(PH_P0B); }
    if (EN_P0 && IN(PH_P0C)) {
        OTID(t1);
        for (int m = gw; m < MT / 2; m += ngw) a1prep_row(P, m, t1 & 63);
        shw_all(P, gw, ngw, t1 & 63);
        SEAM(PH_P0C);
    }
    for (int l = 0; l < DEPTH; ++l) {
        const int pb = PH_L0 + l * PH_PER_LAYER;
        bf16* ABUF = (bf16*)(P.ws + WS_ABUF); bf16* OGOM = (bf16*)(P.ws + WS_OGOM); bf16* PROJ = (bf16*)(P.ws + WS_PROJ); bf16* HID = PROJ;
        float* SSQA = (float*)(P.ws + WS_SSQ0); float* SSQB = (float*)(P.ws + WS_SSQ) + (size_t)l * MT; float* SSQN = (float*)(P.ws + WS_SSQ) + (size_t)(2 + l) * MT;
        const float* mv = (const float*)(P.ws + WS_MODV) + (size_t)l * 8 * 6 * DM;
        const float* mvn = (const float*)(P.ws + WS_MODV) + (size_t)(l + 1 < DEPTH ? l + 1 : l) * 8 * 6 * DM;
        const float* ssq_in = l == 0 ? SSQA : (const float*)(P.ws + WS_SSQ) + (size_t)(2 + l - 1) * MT;
        if (EN_IN && IN(pb + PL_IN)) {
            pg8::Gemm g{ABUF, wt_ptr(P, l, WT_IN), MT, NIN, DM}; pg8::StaticOrder S; S.init(MT, NIN, G, bx);
            pg8::EpiIn E{ssq_in, (const float*)(P.ws + WS_SHWIN) + (size_t)l * 8 * NIN, PROJ};
            pg8::gemm_phase<pg8::EpiIn, pg8::StaticOrder, true, true>(lds, g, S, E);
            SEAM(pb + PL_IN);
        }
        if (EN_PRE && IN(pb + PL_PRE)) {
            OTID(t2);
            for (int u = vcu; u < MT / 64; u += G) { glr_unit(P, l, ssq_in, u, wave, t2 & 63, lds);
                u32x4 rq[2], rk[2], nq[2], nk[2]; gla::gla_pre_load(P, u >> 5, u & 31, 0, t2, rq, rk);
#pragma unroll
                for (int h = 0; h < GH; ++h) { if (h + 1 < GH) gla::gla_pre_load(P, u >> 5, u & 31, h + 1, t2, nq, nk);
                    gla::gla_pre_head(P, l, u >> 5, u & 31, h, lds, t2, rq, rk);
                    rq[0] = nq[0]; rq[1] = nq[1]; rk[0] = nk[0]; rk[1] = nk[1]; } }
            for (int it = vcu; it < NB * MH * MNB; it += G) kmean_unit(P, it, t2, lds);
            SEAM(pb + PL_PRE);
        }
        if (IN(pb + PL_MIX)) {
            if (EN_GLA && bx < NB * GH) { OTID(t3); gla::gla_seq_unit(P, l, bx, lds, t3); }
#if defined(PROBE_MASK) && defined(PROBE_SPLIT)
            xcd_barrier(bar); PROBE_TY(11);
#endif
            if (EN_MOBA) { OTID(t4); moba_phase<0>(P, ctl + CW_QUEUE + 512 * l, (char*)lds_raw, MISC + 16, t4); }
#if defined(MOBA_PROBE_VAR)
            __syncthreads(); { OTID(t4b); moba_phase<MOBA_PROBE_VAR>(P, ctl + CW_QUEUE + 1024 + 512 * l, (char*)lds_raw, MISC + 24, t4b); }
#endif
            xcd_barrier(bar);
            { OTID(t6); for (int it = vcu; it < NB * GH * (SEQ / GCH); it += G) gla::gla_post_item(P, l, it, lds, t6); }
            SEAM(pb + PL_MIX);
        }
        if (EN_UP && IN(pb + PL_UP)) {
            { pg8::Gemm g{OGOM, wt_ptr(P, l, WT_UPG), MT, DM, GVW};     pg8::StaticOrder S; S.init(MT, DM, G, bx); pg8::EpiUp<false> E{PROJ, GT_OFF, ABUF};
              pg8::gemm_phase<pg8::EpiUp<false>, pg8::StaticOrder, true, true>(lds, g, S, E); }
            { pg8::Gemm g{OGOM + (size_t)MT * GVW, wt_ptr(P, l, WT_UPM), MT, DM, MW};     pg8::StaticOrder S; S.init(MT, DM, G, bx); pg8::EpiUp<true> E{PROJ, GT_OFF + DM, ABUF};
              pg8::gemm_phase<pg8::EpiUp<true>, pg8::StaticOrder, true, true>(lds, g, S, E); }
            SEAM(pb + PL_UP);
        }
        if (EN_OUT && IN(pb + PL_OUT)) {
            pg8::Gemm g{ABUF, wt_ptr(P, l, WT_OUT), MT, DM, DM}; pg8::StaticOrder S; S.init(MT, DM, G, bx);
            pg8::EpiRes E{l == 0 ? P.x : P.out, P.out, mv + 2 * DM, mv + 4 * DM, OGOM, SSQB};
            pg8::gemm_phase<pg8::EpiRes, pg8::StaticOrder, true, true>(lds, g, S, E);
#if defined(PROBE_OUT_TWICE)
            if (l == 0) { pg8::EpiRes E2{P.x, P.out, mv + 2 * DM, mv + 4 * DM, OGOM, PROBE_OUT_TWICE == 2 ? (float*)(P.ws + (size_t)760 * MiB) : nullptr};
                pg8::gemm_phase<pg8::EpiRes, pg8::StaticOrder, true, true>(lds, g, S, E2); }
#endif
            SEAM(pb + PL_OUT);
        }
        if (EN_FFI && IN(pb + PL_FFI)) {
            pg8::Gemm g{OGOM, wt_ptr(P, l, WT_FFI), MT, NFFI, DM}; pg8::StaticOrder S; S.init(MT, NFFI, G, bx);
            pg8::EpiFfi E{SSQB, (const float*)(P.ws + WS_SHWFFI) + (size_t)l * 8 * NFFI, HID};
            pg8::gemm_phase<pg8::EpiFfi, pg8::StaticOrder, true, true>(lds, g, S, E);
            SEAM(pb + PL_FFI);
        }
        if (EN_FFO && IN(pb + PL_FFO)) {
            pg8::Gemm g{HID, wt_ptr(P, l, WT_FFO), MT, DM, DFF}; pg8::StaticOrder S; S.init(MT, DM, G, bx);
            pg8::EpiRes E{P.out, P.out, mv + 5 * DM, mvn + 1 * DM, l + 1 < DEPTH ? ABUF : nullptr, l + 1 < DEPTH ? SSQN : nullptr};
            pg8::gemm_phase<pg8::EpiRes, pg8::StaticOrder, true, true>(lds, g, S, E);
            SEAM(pb + PL_FFO);
        }
    }
    if (IN(PH_FINAL)) { OTID(t5); for (int m = gw; m < MT; m += ngw) final_row(P.out, P.final_g, m, t5 & 63); }
#if defined(PROBE_MASK)
    PROBE_AT(PH_FINAL);
    if (blockIdx.x == 0 && threadIdx.x == 0) { const unsigned long long acc_ = ((unsigned long long)MISC[23] << 32) | MISC[22]; const unsigned long long t_end = __builtin_amdgcn_s_memrealtime() + (unsigned long long)(PROBE_MULT) * acc_;
        while (__builtin_amdgcn_s_memrealtime() < t_end) __builtin_amdgcn_s_sleep(8); }
#endif
#undef IN
#undef SEAM
#undef OTID
}
extern "C" void kernel_launch(void* const* d_in, const int* in_sizes, int n_in, void* d_out, int out_size, void* d_ws, size_t ws_size, hipStream_t stream) {
    static int grid = 0;
    if (grid == 0) {
        if (n_in != 16 || in_sizes[0] != MT * DM || out_size != MT * DM || ws_size < WS_NEED) { fprintf(stderr, "kernel_launch: unexpected shapes/ws (n_in %d, ws %zu, need %zu)\n", n_in, ws_size, (size_t)WS_NEED); grid = -1; return; }
        int dev = 0, cus = 0, per_cu = 0;
        if (hipGetDevice(&dev) != hipSuccess || hipDeviceGetAttribute(&cus, hipDeviceAttributeMultiprocessorCount, dev) != hipSuccess) { grid = -1; return; }
        if (hipFuncSetAttribute((const void*)mega, hipFuncAttributeMaxDynamicSharedMemorySize, LDS_BYTES) != hipSuccess) { fprintf(stderr, "kernel_launch: hipFuncSetAttribute failed\n"); grid = -1; return; }
        if (hipOccupancyMaxActiveBlocksPerMultiprocessor(&per_cu, (const void*)mega, NWAVES * 64, LDS_BYTES) != hipSuccess || per_cu < 1) fprintf(stderr, "kernel_launch: occupancy query says %d\n", per_cu);
        (void)hipGetLastError();
        grid = cus;
    }
    if (grid < 0) return;
    Args a{};
    Params& P = a.P;
    P.x = (const float*)d_in[0]; P.c = (const float*)d_in[1]; P.ada_w = (const float*)d_in[2]; P.ada_b = (const float*)d_in[3]; P.norm1_g = (const float*)d_in[4]; P.w_in = (const float*)d_in[5];
    P.gate_w2 = (const float*)d_in[6]; P.gate_b = (const float*)d_in[7]; P.gla_norm_g = (const float*)d_in[8]; P.w_up_gla = (const float*)d_in[9]; P.w_up_moba = (const float*)d_in[10];
    P.w_out = (const float*)d_in[11]; P.norm2_g = (const float*)d_in[12]; P.w_ffn_in = (const float*)d_in[13]; P.w_ffn_out = (const float*)d_in[14]; P.final_g = (const float*)d_in[15];
    P.out = (float*)d_out; P.ws = (unsigned char*)d_ws;
    unsigned char* ws = (unsigned char*)d_ws;
    (void)hipMemsetAsync(ws + WS_CTL, 0, CTL_ZERO_BYTES, stream);
#define MEGA(lo_, hi_) do { a.ph_lo = (lo_); a.ph_hi = (hi_); a.li = 0; hipLaunchKernelGGL(mega, dim3(grid), dim3(NWAVES * 64), LDS_BYTES, stream, a); } while (0)
    MEGA(0, PH_COUNT);
#undef MEGA
}
```
